# Optimizing an MI355X kernel written in HIP

```python
import jax
import jax.numpy as jnp
from jax import lax
import numpy as np

D_MODEL = 1024
BATCH = 1
SEQ = 16384
DEPTH = 2

D_MIX = D_MODEL
GROUP_W = D_MIX // 4
HEAD_DIM = 64
N_HEADS_GROUP = GROUP_W // HEAD_DIM

RWKV_DECAY_RANK = 64
RWKV_A_RANK = 64
RWKV_GATE_RANK = 128
RWKV_VRES_RANK = 32
RWKV_GN_EPS = 64e-5

GDN_CONV = 4
GDN_CHUNK = 64

GLA_KEY_DIM = GROUP_W // 2
GLA_HEAD_K = GLA_KEY_DIM // N_HEADS_GROUP
GLA_GATE_RANK = 16
GLA_GATE_NORMALIZER = 16.0
GLA_CHUNK = 64

SGU_CHUNK = 128
SGU_GROUPS = 4
SGU_GROUP_W = GROUP_W // SGU_GROUPS

D_FF = 4 * D_MODEL
EPS = 1e-6

RWKV_COLS = 3 * GROUP_W + RWKV_DECAY_RANK + RWKV_A_RANK + RWKV_GATE_RANK
GDN_COLS = 4 * GROUP_W + 2 * N_HEADS_GROUP
GLA_COLS = 2 * GLA_KEY_DIM + 2 * GROUP_W + GLA_GATE_RANK
SGU_COLS = 2 * GROUP_W
N_IN = RWKV_COLS + GDN_COLS + GLA_COLS + SGU_COLS

kernel_name = 'hymba_style_rwkv7_gdn_gla_sgu_hybrid'


def _split(x, sizes):
    return jnp.split(x, np.cumsum(sizes)[:-1].tolist(), axis=-1)


def rms_norm(x, g, eps=EPS):
    xf = x.astype(jnp.float32)
    y = xf * lax.rsqrt(jnp.mean(xf * xf, axis=-1, keepdims=True) + eps)
    return (y * g.astype(jnp.float32)).astype(x.dtype)


def layer_norm(x, g, b, eps=1e-5):
    xf = x.astype(jnp.float32)
    mu = jnp.mean(xf, axis=-1, keepdims=True)
    var = jnp.mean(jnp.square(xf - mu), axis=-1, keepdims=True)
    return ((xf - mu) * lax.rsqrt(var + eps) * g + b).astype(x.dtype)


def l2_normalize(t, eps=1e-6):
    tf = t.astype(jnp.float32)
    return tf * lax.rsqrt(jnp.sum(tf * tf, axis=-1, keepdims=True) + eps)


def token_shift(x, mu):
    x_prev = jnp.pad(x, ((0, 0), (1, 0), (0, 0)))[:, :-1]
    return x + (x_prev - x) * mu


def causal_depthwise_conv(x, w):
    K, C = w.shape
    return lax.conv_general_dilated(
        x, w[:, None, :].astype(x.dtype), window_strides=(1,), padding=[(K - 1, 0)],
        dimension_numbers=('NWC', 'WIO', 'NWC'), feature_group_count=C)


def rwkv7_recurrence(r, decay, k, v, a_vec, b_vec):
    B, T, H, D = r.shape
    tm = lambda t: jnp.moveaxis(t.astype(jnp.float32), 1, 0)

    def step(S, inp):
        r_t, w_t, k_t, v_t, a_t, b_t = inp
        sa = jnp.einsum('bhvk,bhk->bhv', S, a_t)
        S = S * w_t[:, :, None, :] + sa[..., None] * b_t[:, :, None, :] + v_t[..., None] * k_t[:, :, None, :]
        return S, jnp.einsum('bhvk,bhk->bhv', S, r_t)

    S0 = jnp.zeros((B, H, D, D), jnp.float32)
    _, y = lax.scan(step, S0, (tm(r), tm(decay), tm(k), tm(v), tm(a_vec), tm(b_vec)))
    return jnp.moveaxis(y, 0, 1)


def rwkv7_time_mix(cols, mu, w0, w_up, a0, a_up, g_up, k_k, k_a, r_k, lnx_w, lnx_b, v_first, vres):
    B, T, _ = cols.shape
    H, Dh = N_HEADS_GROUP, HEAD_DIM
    f32 = jnp.float32
    xs = token_shift(cols, mu)
    r, k, v, w_d, a_d, g_d = _split(xs, (GROUP_W, GROUP_W, GROUP_W, RWKV_DECAY_RANK, RWKV_A_RANK, RWKV_GATE_RANK))
    w_log = -jax.nn.softplus(-(w0 + jnp.tanh(w_d) @ w_up).astype(f32)) - 0.5
    decay = jnp.exp(-jnp.exp(w_log))
    a = jax.nn.sigmoid(a0 + a_d @ a_up)
    g = jax.nn.sigmoid(g_d) @ g_up
    if vres is None:
        v_first = v
    else:
        v0, vres_cols, vres_up = vres
        v = v + (v_first - v) * jax.nn.sigmoid(v0 + vres_cols @ vres_up)
    heads = lambda t: t.reshape(B, T, H, Dh)
    kk = l2_normalize(heads(k * k_k), eps=1e-24)
    k = k * (1 + (a - 1) * k_a)
    r_h, k_h, v_h, a_h = heads(r), heads(k), heads(v), heads(a)
    y = rwkv7_recurrence(r_h, heads(decay), k_h, v_h, -kk, kk * a_h)
    mean = jnp.mean(y, axis=-1, keepdims=True)
    var = jnp.mean(jnp.square(y - mean), axis=-1, keepdims=True)
    y = (y - mean) * lax.rsqrt(var + RWKV_GN_EPS) * lnx_w.reshape(H, Dh) + lnx_b.reshape(H, Dh)
    y = y + jnp.sum(r_h * k_h * r_k, axis=-1, keepdims=True) * v_h
    return (y.reshape(B, T, GROUP_W) * g).astype(cols.dtype), v_first


def chunk_gated_delta_rule(q, k, v, g, beta):
    B, T, H, dk = q.shape
    dv = v.shape[-1]
    C = GDN_CHUNK
    N = T // C
    f32 = jnp.float32

    def chunks(t):
        return t.astype(f32).reshape(B, N, C, H, -1).transpose(1, 0, 3, 2, 4)

    q = chunks(q) * dk ** -0.5
    k, v = chunks(k), chunks(v)
    g = chunks(g[..., None])[..., 0]
    beta = chunks(beta[..., None])[..., 0]
    gc = jnp.cumsum(g, axis=-1)
    tril = jnp.tril(jnp.ones((C, C), bool))
    decay = jnp.exp(jnp.where(tril, gc[..., :, None] - gc[..., None, :], -jnp.inf))
    k_beta = k * beta[..., None]
    lower = jnp.tril(jnp.einsum('nbhid,nbhjd->nbhij', k_beta, k) * decay, -1)
    rhs = jnp.concatenate([v * beta[..., None], k_beta * jnp.exp(gc)[..., None]], axis=-1)
    sol = lax.linalg.triangular_solve(lower + jnp.eye(C, dtype=f32), rhs,
                                      left_side=True, lower=True, unit_diagonal=True)
    u, w = sol[..., :dv], sol[..., dv:]
    qk = jnp.einsum('nbhid,nbhjd->nbhij', q, k) * decay
    q_dec = q * jnp.exp(gc)[..., None]
    k_dec = k * jnp.exp(gc[..., -1:] - gc)[..., None]
    g_last = jnp.exp(gc[..., -1])

    def step(S, inp):
        u_n, w_n, qk_n, qd_n, kd_n, gl_n = inp
        v_new = u_n - w_n @ S
        o = qd_n @ S + qk_n @ v_new
        S = S * gl_n[..., None, None] + jnp.einsum('bhck,bhcv->bhkv', kd_n, v_new)
        return S, o

    S0 = jnp.zeros((B, H, dk, dv), f32)
    _, o = lax.scan(step, S0, (u, w, qk, q_dec, k_dec, g_last))
    return o.transpose(1, 0, 3, 2, 4).reshape(B, T, H, dv)


def gated_deltanet_mix(cols, conv_w, a_log, dt_bias, norm_g):
    B, T, _ = cols.shape
    H, Dh = N_HEADS_GROUP, HEAD_DIM
    qkv, z, b_raw, a_raw = _split(cols, (3 * GROUP_W, GROUP_W, H, H))
    qkv = jax.nn.silu(causal_depthwise_conv(qkv, conv_w))
    q, k, v = _split(qkv, (GROUP_W, GROUP_W, GROUP_W))
    heads = lambda t: t.reshape(B, T, H, Dh)
    q, k = l2_normalize(heads(q)), l2_normalize(heads(k))
    beta = jax.nn.sigmoid(b_raw.astype(jnp.float32))
    g = -jnp.exp(a_log) * jax.nn.softplus(a_raw.astype(jnp.float32) + dt_bias)
    o = chunk_gated_delta_rule(q, k, heads(v), g, beta)
    o = rms_norm(o, norm_g) * jax.nn.silu(heads(z))
    return o.reshape(B, T, GROUP_W).astype(cols.dtype)


def chunk_gla(q, k, v, log_a):
    B, T, H, dk = q.shape
    dv = v.shape[-1]
    C = GLA_CHUNK
    N = T // C
    f32 = jnp.float32

    def chunks(t):
        return t.astype(f32).reshape(B, N, C, H, -1).transpose(1, 0, 3, 2, 4)

    q = chunks(q) * dk ** -0.5
    k, v = chunks(k), chunks(v)
    b = jnp.cumsum(chunks(log_a), axis=3)
    q_inter = q * jnp.exp(b)
    k_state = k * jnp.exp(b[..., -1:, :] - b)
    a_last = jnp.exp(b[..., -1, :])
    tril = jnp.tril(jnp.ones((C, C), bool))[:, :, None]

    def step(S, inp):
        q_n, k_n, v_n, b_n, qi_n, ks_n, al_n = inp
        rel = jnp.exp(jnp.where(tril, b_n[..., :, None, :] - b_n[..., None, :, :], -jnp.inf))
        scores = jnp.einsum('bhid,bhjd,bhijd->bhij', q_n, k_n, rel)
        o = scores @ v_n + qi_n @ S
        S = S * al_n[..., None] + jnp.einsum('bhck,bhcv->bhkv', ks_n, v_n)
        return S, o

    S0 = jnp.zeros((B, H, dk, dv), f32)
    _, o = lax.scan(step, S0, (q, k, v, b, q_inter, k_state, a_last))
    return o.transpose(1, 0, 3, 2, 4).reshape(B, T, H, dv)


def gla_mix(cols, gk_up, gk_bias, norm_g):
    B, T, _ = cols.shape
    H = N_HEADS_GROUP
    q, k, v, gate, gk_d = _split(cols, (GLA_KEY_DIM, GLA_KEY_DIM, GROUP_W, GROUP_W, GLA_GATE_RANK))
    log_a = jax.nn.log_sigmoid((gk_d @ gk_up + gk_bias).astype(jnp.float32)) / GLA_GATE_NORMALIZER
    hk = lambda t: t.reshape(B, T, H, GLA_HEAD_K)
    hv = lambda t: t.reshape(B, T, H, HEAD_DIM)
    o = chunk_gla(hk(q), hk(k), hv(v), hk(log_a))
    o = rms_norm(o, norm_g) * jax.nn.silu(hv(gate))
    return o.reshape(B, T, GROUP_W).astype(cols.dtype)


def sgu_mix(cols, ln_g, ln_b, w_s, b_s):
    B, T, _ = cols.shape
    N = T // SGU_CHUNK
    u, v = _split(jax.nn.gelu(cols), (GROUP_W, GROUP_W))
    v = layer_norm(v, ln_g, ln_b).reshape(B, N, SGU_CHUNK, SGU_GROUPS, SGU_GROUP_W)
    w_causal = jnp.where(jnp.tril(jnp.ones((SGU_CHUNK, SGU_CHUNK), bool)), w_s, 0.0)
    mixed = jnp.einsum('gts,bnsgc->bntgc', w_causal, v) + b_s.T[None, None, :, :, None]
    return (u * mixed.reshape(B, T, GROUP_W)).astype(cols.dtype)


def setup_inputs(seed: int = 0) -> dict:
    key = jax.random.key(seed)
    ks = iter(jax.random.split(key, 48))
    f32 = jnp.float32
    nrm = lambda shape, scale: jax.random.normal(next(ks), shape, f32) * scale
    uni = lambda shape, lo, hi: jax.random.uniform(next(ks), shape, f32, lo, hi)
    L, H = DEPTH, N_HEADS_GROUP
    dt = jnp.exp(uni((L, H), float(np.log(1e-3)), float(np.log(1e-1))))
    return {
        'x': nrm((BATCH, SEQ, D_MODEL), 1.0),
        'w_in': nrm((L, D_MODEL, N_IN), D_MODEL ** -0.5),
        'w_out': nrm((L, D_MIX, D_MODEL), D_MIX ** -0.5),
        'norm_mix_g': 1.0 + nrm((L, D_MODEL), 0.02),
        'norm_ffn_g': 1.0 + nrm((L, D_MODEL), 0.02),
        'norm_final_g': 1.0 + nrm((D_MODEL,), 0.02),
        'rwkv_mu': uni((L, RWKV_COLS), 0.0, 1.0),
        'rwkv_w0': uni((L, GROUP_W), -6.0, -1.0),
        'rwkv_w_up': nrm((L, RWKV_DECAY_RANK, GROUP_W), 0.1 * RWKV_DECAY_RANK ** -0.5),
        'rwkv_a0': nrm((L, GROUP_W), 0.1),
        'rwkv_a_up': nrm((L, RWKV_A_RANK, GROUP_W), RWKV_A_RANK ** -0.5),
        'rwkv_g_up': nrm((L, RWKV_GATE_RANK, GROUP_W), RWKV_GATE_RANK ** -0.5),
        'rwkv_k_k': 0.85 + nrm((L, GROUP_W), 0.02),
        'rwkv_k_a': 1.0 + nrm((L, GROUP_W), 0.02),
        'rwkv_r_k': nrm((L, H, HEAD_DIM), 0.1),
        'rwkv_lnx_w': 1.0 + nrm((L, GROUP_W), 0.02),
        'rwkv_lnx_b': nrm((L, GROUP_W), 0.02),
        'rwkv_v0': 1.0 + nrm((L - 1, GROUP_W), 0.1),
        'rwkv_vres_down': nrm((L - 1, D_MODEL, RWKV_VRES_RANK), D_MODEL ** -0.5),
        'rwkv_vres_up': nrm((L - 1, RWKV_VRES_RANK, GROUP_W), RWKV_VRES_RANK ** -0.5),
        'gdn_conv_w': nrm((L, GDN_CONV, 3 * GROUP_W), GDN_CONV ** -0.5),
        'gdn_a_log': jnp.log(uni((L, H), 1.0, 16.0)),
        'gdn_dt_bias': dt + jnp.log(-jnp.expm1(-dt)),
        'gdn_norm_g': 1.0 + nrm((L, HEAD_DIM), 0.02),
        'gla_gk_up': nrm((L, GLA_GATE_RANK, GLA_KEY_DIM), GLA_GATE_RANK ** -0.5),
        'gla_gk_bias': nrm((L, GLA_KEY_DIM), 0.1),
        'gla_norm_g': 1.0 + nrm((L, HEAD_DIM), 0.02),
        'sgu_ln_g': 1.0 + nrm((L, GROUP_W), 0.02),
        'sgu_ln_b': nrm((L, GROUP_W), 0.02),
        'sgu_w_s': nrm((L, SGU_GROUPS, SGU_CHUNK, SGU_CHUNK), SGU_CHUNK ** -0.5),
        'sgu_b_s': 1.0 + nrm((L, SGU_GROUPS, SGU_CHUNK), 0.1),
        'ffn_w_up': nrm((L, D_MODEL, D_FF), D_MODEL ** -0.5),
        'ffn_w_down': nrm((L, D_FF, D_MODEL), D_FF ** -0.5),
    }


def reference(x, w_in, w_out, norm_mix_g, norm_ffn_g, norm_final_g,
              rwkv_mu, rwkv_w0, rwkv_w_up, rwkv_a0, rwkv_a_up, rwkv_g_up, rwkv_k_k, rwkv_k_a, rwkv_r_k,
              rwkv_lnx_w, rwkv_lnx_b, rwkv_v0, rwkv_vres_down, rwkv_vres_up,
              gdn_conv_w, gdn_a_log, gdn_dt_bias, gdn_norm_g,
              gla_gk_up, gla_gk_bias, gla_norm_g,
              sgu_ln_g, sgu_ln_b, sgu_w_s, sgu_b_s,
              ffn_w_up, ffn_w_down):
    v_first = None
    for l in range(DEPTH):
        h = rms_norm(x, norm_mix_g[l])
        if l == 0:
            w_comb = w_in[l]
        else:
            w_comb = jnp.concatenate([w_in[l], rwkv_vres_down[l - 1]], axis=1)
        cols = h @ w_comb
        c_a, c_b, c_c, c_d = _split(cols[..., :N_IN], (RWKV_COLS, GDN_COLS, GLA_COLS, SGU_COLS))
        vres = None if l == 0 else (rwkv_v0[l - 1], cols[..., N_IN:], rwkv_vres_up[l - 1])
        y_a, v_first = rwkv7_time_mix(c_a, rwkv_mu[l], rwkv_w0[l], rwkv_w_up[l], rwkv_a0[l], rwkv_a_up[l],
                                      rwkv_g_up[l], rwkv_k_k[l], rwkv_k_a[l], rwkv_r_k[l],
                                      rwkv_lnx_w[l], rwkv_lnx_b[l], v_first, vres)
        y_b = gated_deltanet_mix(c_b, gdn_conv_w[l], gdn_a_log[l], gdn_dt_bias[l], gdn_norm_g[l])
        y_c = gla_mix(c_c, gla_gk_up[l], gla_gk_bias[l], gla_norm_g[l])
        y_d = sgu_mix(c_d, sgu_ln_g[l], sgu_ln_b[l], sgu_w_s[l], sgu_b_s[l])
        x = x + jnp.concatenate([y_a, y_b, y_c, y_d], axis=-1) @ w_out[l]
        h = rms_norm(x, norm_ffn_g[l])
        x = x + jnp.square(jax.nn.relu(h @ ffn_w_up[l])) @ ffn_w_down[l]
    return rms_norm(x, norm_final_g)
```

```cpp
#include <hip/hip_runtime.h>
#include <hip/hip_cooperative_groups.h>
#include <cstdio>
#include <cstdint>
namespace cg = cooperative_groups;
namespace pg8 {
#define PG8_LAS __attribute__((address_space(3)))
typedef unsigned short bf16_t;
typedef short bf16x8 __attribute__((ext_vector_type(8)));
typedef float f32x4 __attribute__((ext_vector_type(4)));
typedef unsigned u32x4 __attribute__((ext_vector_type(4)));
constexpr int BM = 256, BK = 64, HALF = 128, HTB = HALF * BK * 2  , STAGE_BYTES = 8 * HTB, NXCD = 8, WGM = 8;

__host__ __device__ __forceinline__ int lds_byte(int r, int c) { const int st = (r >> 4) * 2 + (c >> 5), rr = r & 15, cc = c & 31, ob = rr * 64 + cc * 2; return st * 1024 + (ob ^ (((ob >> 9) & 1) << 5)); }
__host__ __device__ __forceinline__ void stage_rc(int b, int& R, int& C) { const int st = b / 1024, sb = b % 1024, swz = sb ^ (((sb >> 9) & 1) << 5); R = (st >> 1) * 16 + swz / 64; C = (st & 1) * 32 + (swz % 64) / 2; }
__host__ __device__ __forceinline__ int perm32(int rho) { const int n = rho >> 4, i = rho & 15; return 8 * (i >> 2) + 4 * n + (i & 3); }

struct Unit { int pm, pn; };
struct Gemm { const bf16_t* A; const bf16_t* Bt; int M, N, K; };

struct StaticOrder {
    int nM, nN, nwg, G, c;
    __host__ __device__ void init(int M, int N, int G_, int c_) { nM = M / BM; nN = N / BM; nwg = nM * nN; G = G_; c = c_; }
    __host__ __device__ bool next(int i, Unit& u) const {
        const long L = (long)i * G + c; if (L >= nwg) return false;
        int wgid = (int)L; { const int q = nwg / NXCD, r = nwg % NXCD, xcd = wgid % NXCD, off = wgid / NXCD; wgid = (xcd < r ? xcd * (q + 1) : r * (q + 1) + (xcd - r) * q) + off; }
        const int nig = WGM * nN, gid = wgid / nig, fm = gid * WGM, gsz = (nM - fm) < WGM ? (nM - fm) : WGM;
        u.pm = fm + ((wgid % nig) % gsz); u.pn = (wgid % nig) / gsz; return true;
    }
    __device__ __forceinline__ void a_ready(const Unit&) const {}
    __device__ __forceinline__ void done(const Unit&) const {}
};

__device__ __forceinline__ unsigned cvt_pk_bf16(float lo, float hi) { unsigned r; asm volatile("v_cvt_pk_bf16_f32 %0, %1, %2" : "=v"(r) : "v"(lo), "v"(hi)); return r; }
typedef float f32x2 __attribute__((ext_vector_type(2)));
__device__ __forceinline__ float row_rstd16(const float* ssq, int row) {
    const f32x4* p = (const f32x4*)(ssq + (size_t)row * 16);
    const f32x4 a = p[0], b = p[1], c = p[2], d = p[3];
    const float s = ((a[0] + a[1]) + (a[2] + a[3])) + ((b[0] + b[1]) + (b[2] + b[3])) + ((c[0] + c[1]) + (c[2] + c[3])) + ((d[0] + d[1]) + (d[2] + d[3]));
    return 1.0f / sqrtf(s * (1.0f / 1024.0f) + 1e-6f);
}
template <int ACT> struct EpiScaleBf16 {
    static constexpr bool PERM = true, AFTER_DRAIN = false;
    bf16_t* O; int ldc; const float* ssq;
    __device__ __forceinline__ void operator()(const f32x4 (&acc)[2][2][4][2], const Unit& u, int wr, int wc, int fr, int fq) const {
        const int row0 = u.pm * BM + wr * 64 + fr; const int col0 = u.pn * BM + wc * 32 + 8 * fq;
#pragma unroll
        for (int ai = 0; ai < 2; ++ai)
#pragma unroll
            for (int m = 0; m < 4; ++m) { const int row = row0 + ai * HALF + m * 16; const float sc = row_rstd16(ssq, row); bf16_t* rowp = O + (size_t)row * ldc + col0;
#pragma unroll
                for (int bj = 0; bj < 2; ++bj) { f32x4 v0 = acc[ai][bj][m][0] * sc, v1 = acc[ai][bj][m][1] * sc;
                    if (ACT == 2) {
#pragma unroll
                        for (int e = 0; e < 4; ++e) { const float a0 = v0[e] > 0.f ? v0[e] : 0.f, a1 = v1[e] > 0.f ? v1[e] : 0.f; v0[e] = a0 * a0; v1[e] = a1 * a1; } }
                    u32x4 w; w.x = cvt_pk_bf16(v0[0], v0[1]); w.y = cvt_pk_bf16(v0[2], v0[3]); w.z = cvt_pk_bf16(v1[0], v1[1]); w.w = cvt_pk_bf16(v1[2], v1[3]);
                    *(u32x4*)(rowp + bj * HALF) = w; } }
    }
};
struct EpiResid {
    static constexpr bool PERM = false, AFTER_DRAIN = false;
    const float* base; float* out; bf16_t* xb; float* ssq;
    __device__ __forceinline__ void operator()(const f32x4 (&acc)[2][2][4][2], const Unit& u, int wr, int wc, int fr, int fq) const {
        typedef unsigned u32x2v __attribute__((ext_vector_type(2)));
        const int row0 = u.pm * BM + wr * 64 + fr; const int col0 = u.pn * BM + wc * 32 + 4 * fq;
#pragma unroll
        for (int ai = 0; ai < 2; ++ai)
#pragma unroll
            for (int m = 0; m < 4; ++m) { const int row = row0 + ai * HALF + m * 16; const size_t off = (size_t)row * 1024 + col0; float s = 0.f;
#pragma unroll
                for (int bj = 0; bj < 2; ++bj)
#pragma unroll
                    for (int n = 0; n < 2; ++n) { const f32x4 bs = *(const f32x4*)(base + off + bj * HALF + n * 16); const f32x4 o = bs + acc[ai][bj][m][n];
                        *(f32x4*)(out + off + bj * HALF + n * 16) = o; s += (o[0] * o[0] + o[1] * o[1]) + (o[2] * o[2] + o[3] * o[3]);
                        u32x2v w; w.x = cvt_pk_bf16(o[0], o[1]); w.y = cvt_pk_bf16(o[2], o[3]); *(u32x2v*)(xb + off + bj * HALF + n * 16) = w; }
                s += __shfl_xor(s, 16); s += __shfl_xor(s, 32);
                if (fq == 0) ssq[(size_t)row * 16 + u.pn * 4 + wc] = s; }
    }
};
template <class Epi, class Sched, bool ALIGN_EPI = false, bool SP2 = false>
__device__ __forceinline__ void gemm_phase(PG8_LAS unsigned char* lds, const Gemm g, const Sched& S, const Epi& E) {
    int tid_o = threadIdx.x; asm volatile("" : "+v"(tid_o));
    const int tid = tid_o, wid = __builtin_amdgcn_readfirstlane(tid >> 6), lane = tid & 63, wr = wid >> 2, wc = wid & 3, fr = lane & 15, fq = lane >> 4;
    const int K = g.K, nt = K / BK;
    unsigned voffA[2], voffB[2];
#pragma unroll
    for (int i = 0; i < 2; ++i) { int R, C; stage_rc(tid * 16 + i * 8192, R, C); const int Rb = Epi::PERM ? ((R & ~31) + perm32(R & 31)) : R;
        voffA[i] = (unsigned)(R * K + C) * 2u; voffB[i] = (unsigned)(Rb * K + C) * 2u; }
    const size_t kstep = (size_t)(BK * 2);
    const size_t hstep = (size_t)HALF * K * 2;
    const size_t tstep = 2 * hstep;
    const unsigned ldsw = (unsigned)wid * 1024u;
    const int aoff = lds_byte(wr * 64 + fr, fq * 8), boff = lds_byte(wc * 32 + fr, fq * 8);
#define PG8_SA(b, h) (((b) * 2 + (h)) * HTB)
#define PG8_SB(b, h) ((4 + (b) * 2 + (h)) * HTB)
#define PG8_STAGE(bufoff, gbase, voff) do { _Pragma("unroll") for (int _i = 0; _i < 2; ++_i) \
        __builtin_amdgcn_global_load_lds((const unsigned*)((const char*)(gbase) + (voff)[_i]), (PG8_LAS unsigned*)(lds + (bufoff) + ldsw + _i * 8192), 16, 0, 0); } while (0)
#define PG8_LDA(dst, b, h) do { _Pragma("unroll") for (int m = 0; m < 4; ++m) _Pragma("unroll") for (int k = 0; k < 2; ++k) dst[m][k] = *(const PG8_LAS bf16x8*)(lds + PG8_SA(b, h) + aoff + m * 2048 + k * 1024); } while (0)
#define PG8_LDB(dst, b, h) do { _Pragma("unroll") for (int n = 0; n < 2; ++n) _Pragma("unroll") for (int k = 0; k < 2; ++k) dst[n][k] = *(const PG8_LAS bf16x8*)(lds + PG8_SB(b, h) + boff + n * 2048 + k * 1024); } while (0)
#define PG8_MMA(ai, bj, At, Bt) do { __builtin_amdgcn_s_setprio(1); _Pragma("unroll") for (int m = 0; m < 4; ++m) _Pragma("unroll") for (int n = 0; n < 2; ++n) _Pragma("unroll") for (int k = 0; k < 2; ++k) \
        acc[ai][bj][m][n] = __builtin_amdgcn_mfma_f32_16x16x32_bf16(Bt[n][k], At[m][k], acc[ai][bj][m][n], 0, 0, 0); __builtin_amdgcn_s_setprio(0); } while (0)
#define PG8_WAIT_V(n) asm volatile("s_waitcnt vmcnt(" #n ")" ::: "memory")
#define PG8_WAIT_L(n) asm volatile("s_waitcnt lgkmcnt(" #n ")" ::: "memory")
#define PG8_BAR __builtin_amdgcn_s_barrier()
#define PG8_SCHED __builtin_amdgcn_sched_barrier(0)
    Unit cur, nxt; int ui = 0;
    if (!S.next(0, cur)) return;
    f32x4 acc[2][2][4][2];
#pragma unroll
    for (int a = 0; a < 2; ++a)
#pragma unroll
        for (int b = 0; b < 2; ++b)
#pragma unroll
            for (int m = 0; m < 4; ++m)
#pragma unroll
                for (int n = 0; n < 2; ++n) acc[a][b][m][n] = (f32x4){0.f, 0.f, 0.f, 0.f};
    bf16x8 At[4][2], B0[2][2], B1[2][2];
    const char* cA = (const char*)g.A + (size_t)cur.pm * tstep; const char* cB = (const char*)g.Bt + (size_t)cur.pn * tstep;
    S.a_ready(cur);
    if constexpr (SP2) {
        PG8_STAGE(PG8_SB(0, 0), cB, voffB); PG8_STAGE(PG8_SB(0, 1), cB + hstep, voffB); PG8_STAGE(PG8_SA(0, 0), cA, voffA); PG8_STAGE(PG8_SA(0, 1), cA + hstep, voffA);
        if (wr == 1) PG8_BAR;
        PG8_WAIT_V(2); PG8_BAR;
        PG8_STAGE(PG8_SB(1, 0), cB + kstep, voffB); PG8_STAGE(PG8_SA(1, 0), cA + kstep, voffA); PG8_STAGE(PG8_SB(1, 1), cB + hstep + kstep, voffB);
        PG8_WAIT_V(6); PG8_BAR;
    } else {
        PG8_STAGE(PG8_SB(0, 0), cB, voffB); PG8_STAGE(PG8_SA(0, 0), cA, voffA); PG8_STAGE(PG8_SB(0, 1), cB + hstep, voffB); PG8_STAGE(PG8_SA(0, 1), cA + hstep, voffA);
        if (wr == 1) PG8_BAR;
        PG8_WAIT_V(4); PG8_BAR;
        PG8_STAGE(PG8_SB(1, 0), cB + kstep, voffB); PG8_STAGE(PG8_SA(1, 0), cA + kstep, voffA); PG8_STAGE(PG8_SB(1, 1), cB + hstep + kstep, voffB);
        PG8_WAIT_V(6); PG8_BAR;
    }
    for (;;) {
        const bool has_next = S.next(ui + 1, nxt);
        const char* nA = has_next ? (const char*)g.A + (size_t)nxt.pm * tstep : cA; const char* nB = has_next ? (const char*)g.Bt + (size_t)nxt.pn * tstep : cB;
        for (int t = 0; t < nt; t += 2) {
            const bool last = (t == nt - 2);
            const char* a1 = cA + (size_t)(t + 1) * kstep;
            const char* a2 = last ? nA : cA + (size_t)(t + 2) * kstep; const char* b2 = last ? nB : cB + (size_t)(t + 2) * kstep;
            const char* a3 = a2 + kstep; const char* b3 = b2 + kstep;
            if (last && has_next) S.a_ready(nxt);
            if constexpr (SP2) {
            PG8_LDB(B0, 0, 0); PG8_LDB(B1, 0, 1); PG8_SCHED; PG8_LDA(At, 0, 0); PG8_STAGE(PG8_SA(1, 1), a1 + hstep, voffA);
            PG8_WAIT_V(8); PG8_WAIT_L(0); PG8_BAR; PG8_MMA(0, 0, At, B0); PG8_MMA(0, 1, At, B1); PG8_BAR; PG8_SCHED;
            PG8_LDA(At, 0, 1); PG8_STAGE(PG8_SB(0, 0), b2, voffB); PG8_STAGE(PG8_SB(0, 1), b2 + hstep, voffB); PG8_STAGE(PG8_SA(0, 0), a2, voffA);
            PG8_WAIT_V(8); PG8_WAIT_L(0); PG8_BAR; PG8_MMA(1, 0, At, B0); PG8_MMA(1, 1, At, B1); PG8_BAR; PG8_SCHED;
            PG8_LDB(B0, 1, 0); PG8_LDB(B1, 1, 1); PG8_SCHED; PG8_LDA(At, 1, 0); PG8_STAGE(PG8_SA(0, 1), a2 + hstep, voffA);
            PG8_WAIT_V(8); PG8_WAIT_L(0); PG8_BAR; PG8_MMA(0, 0, At, B0); PG8_MMA(0, 1, At, B1); PG8_BAR; PG8_SCHED;
            PG8_LDA(At, 1, 1); PG8_STAGE(PG8_SB(1, 0), b3, voffB); PG8_STAGE(PG8_SB(1, 1), b3 + hstep, voffB); PG8_STAGE(PG8_SA(1, 0), a3, voffA);
            PG8_WAIT_V(8); PG8_WAIT_L(0); PG8_BAR; PG8_MMA(1, 0, At, B0); PG8_MMA(1, 1, At, B1); PG8_BAR; PG8_SCHED;
            } else {
            PG8_LDB(B0, 0, 0); PG8_SCHED; PG8_LDA(At, 0, 0); PG8_STAGE(PG8_SA(1, 1), a1 + hstep, voffA);
            PG8_WAIT_L(8); PG8_BAR; PG8_WAIT_L(0); PG8_MMA(0, 0, At, B0); PG8_BAR; PG8_SCHED;
            PG8_LDB(B1, 0, 1); PG8_STAGE(PG8_SB(0, 0), b2, voffB);
            PG8_BAR; PG8_WAIT_L(0); PG8_MMA(0, 1, At, B1); PG8_BAR;
            PG8_LDA(At, 0, 1); PG8_STAGE(PG8_SA(0, 0), a2, voffA);
            PG8_BAR; PG8_WAIT_L(0); PG8_MMA(1, 0, At, B0); PG8_BAR; PG8_SCHED;
            PG8_STAGE(PG8_SB(0, 1), b2 + hstep, voffB);
            PG8_WAIT_V(6); PG8_BAR; PG8_MMA(1, 1, At, B1); PG8_BAR;
            PG8_LDB(B0, 1, 0); PG8_SCHED; PG8_LDA(At, 1, 0); PG8_STAGE(PG8_SA(0, 1), a2 + hstep, voffA);
            PG8_WAIT_L(8); PG8_BAR; PG8_WAIT_L(0); PG8_MMA(0, 0, At, B0); PG8_BAR; PG8_SCHED;
            PG8_LDB(B1, 1, 1); PG8_STAGE(PG8_SB(1, 0), b3, voffB);
            PG8_BAR; PG8_WAIT_L(0); PG8_MMA(0, 1, At, B1); PG8_BAR;
            PG8_LDA(At, 1, 1); PG8_STAGE(PG8_SA(1, 0), a3, voffA);
            PG8_BAR; PG8_WAIT_L(0); PG8_MMA(1, 0, At, B0); PG8_BAR; PG8_SCHED;
            PG8_STAGE(PG8_SB(1, 1), b3 + hstep, voffB);
            PG8_WAIT_V(6); PG8_BAR; PG8_MMA(1, 1, At, B1); PG8_BAR;
            }
        }
        if constexpr (ALIGN_EPI) { if (wr == 0) PG8_BAR; }
        if constexpr (!Epi::AFTER_DRAIN) { E(acc, cur, wr, wc, fr, fq); S.done(cur); }
        if (!has_next) break;
#pragma unroll
        for (int a = 0; a < 2; ++a)
#pragma unroll
            for (int b = 0; b < 2; ++b)
#pragma unroll
                for (int m = 0; m < 4; ++m)
#pragma unroll
                    for (int n = 0; n < 2; ++n) acc[a][b][m][n] = (f32x4){0.f, 0.f, 0.f, 0.f};
        cur = nxt; cA = nA; cB = nB; ++ui;
        if constexpr (ALIGN_EPI) { if (wr == 1) PG8_BAR; }
    }
    PG8_WAIT_V(0);
    if constexpr (!ALIGN_EPI) { if (wr == 0) PG8_BAR; }
    PG8_BAR;
    if constexpr (Epi::AFTER_DRAIN) { E.fused(acc, cur, wr, wc, fr, fq, lds, wid, lane); S.done(cur); }
#undef PG8_SA
#undef PG8_SB
#undef PG8_STAGE
#undef PG8_LDA
#undef PG8_LDB
#undef PG8_MMA
#undef PG8_WAIT_V
#undef PG8_WAIT_L
#undef PG8_BAR
#undef PG8_SCHED
}
}
constexpr int T = 16384, D = 1024, FF = 4096, DEPTH = 2;
constexpr int NIN = 3352, NPAD = 3584;
constexpr int C_RWKV = 0, C_GDN = 1024, C_GLA = 2056, C_SGU = 2840, C_VRES = 3352;
constexpr int NT = 512, NWAVES = 8;
constexpr int LDS_BYTES = 147456;
typedef unsigned short bf16;
typedef float f32x4 __attribute__((ext_vector_type(4)));
typedef unsigned v4u __attribute__((ext_vector_type(4)));
#define LAS __attribute__((address_space(3)))

constexpr size_t MiB = 1u << 20;
constexpr size_t WS_SSQ = 1 * MiB;
constexpr size_t WS_GAL = 2 * MiB;
constexpr size_t WS_XG = 2 * MiB + 256 * 1024;
constexpr size_t WS_W = 3 * MiB;
constexpr size_t W_LAYER = 0, W_IN = 0, W_OUT = 7 * MiB, W_UP = 9 * MiB, W_DN = 17 * MiB;
constexpr size_t WS_XB = 30 * MiB;
constexpr size_t WS_Y = 62 * MiB;
constexpr size_t WS_H = 94 * MiB;
constexpr size_t WS_COLS = 94 * MiB;
constexpr size_t WS_VF = 222 * MiB;
constexpr size_t WS_RP = 30 * MiB, WS_RQ = 38 * MiB, WS_RR = 46 * MiB, WS_RBV = 54 * MiB;
constexpr size_t WS_DP = 206 * MiB, WS_DQ = 214 * MiB, WS_DR = 230 * MiB;
constexpr size_t WS_GKV = 238 * MiB, WS_GQI = 246 * MiB;
constexpr size_t WS_END = 250 * MiB;

__device__ __forceinline__ unsigned f2bf(float f) { unsigned u = __builtin_bit_cast(unsigned, f); return (u + 0x7fffu + ((u >> 16) & 1u)) >> 16; }
__device__ __forceinline__ unsigned pk2(float lo, float hi) { return f2bf(lo) | (f2bf(hi) << 16); }
__device__ __forceinline__ float bf2f(bf16 b) { return __builtin_bit_cast(float, (unsigned)b << 16); }
__device__ __forceinline__ float wave_sum(float v) {
#pragma unroll
    for (int o = 1; o < 64; o <<= 1) v += __shfl_xor(v, o);
    return v;
}
__device__ __forceinline__ float sigmoidf_(float x) { return 1.0f / (1.0f + __expf(-x)); }
__device__ __forceinline__ float softplusf_(float x) { return fmaxf(x, 0.f) + log1pf(__expf(-fabsf(x))); }
__device__ __forceinline__ float siluf_(float x) { return x * sigmoidf_(x); }
__device__ __forceinline__ float geluf_(float x) { const float u = 0.7978845608028654f * (x + 0.044715f * x * x * x); return 0.5f * x * (1.0f + tanhf(u)); }

struct Params { const float* in[33]; float* out; unsigned char* ws; };
enum { I_X = 0, I_WIN, I_WOUT, I_NMIX, I_NFFN, I_NFIN, I_MU, I_W0, I_WUP, I_A0, I_AUP, I_GUP, I_KK, I_KA, I_RK, I_LNW, I_LNB, I_V0, I_VDOWN, I_VUP,
       I_CONV, I_ALOG, I_DTB, I_GDNG, I_GKUP, I_GKB, I_GLAG, I_SLG, I_SLB, I_SWS, I_SBS, I_FUP, I_FDN };

__device__ __forceinline__ void transpose_item(const float* W, int K, int N, const float* gk, bf16* WT, int row_off, float* scr, int item, int lane) {
    const int nblk = (N + 31) / 32, kb = item / nblk, nb = item % nblk, k0 = 64 * kb, n0 = 32 * nb;
    const bool nok = (n0 + (lane & 31)) < N;
#pragma unroll 8
    for (int i = 0; i < 32; ++i) { const int kk = 2 * i + (lane >> 5); float v = 0.f; if (nok) v = W[(size_t)(k0 + kk) * N + n0 + (lane & 31)]; if (gk) v *= gk[k0 + kk]; scr[kk * 33 + (lane & 31)] = v; }
    __builtin_amdgcn_wave_barrier(); asm volatile("s_waitcnt lgkmcnt(0)" ::: "memory");
    const int c = lane & 7;
#pragma unroll
    for (int j = 0; j < 4; ++j) { const int n = (lane >> 3) + 8 * j; const float* s = scr + (8 * c) * 33 + n;
        v4u o; o.x = pk2(s[0 * 33], s[1 * 33]); o.y = pk2(s[2 * 33], s[3 * 33]); o.z = pk2(s[4 * 33], s[5 * 33]); o.w = pk2(s[6 * 33], s[7 * 33]);
        if (n0 + n < N) *(v4u*)(WT + (size_t)(row_off + n0 + n) * K + k0 + 8 * c) = o; }
    __builtin_amdgcn_wave_barrier(); asm volatile("s_waitcnt lgkmcnt(0)" ::: "memory");
}
__device__ __forceinline__ void prologue_weights(const Params& P, int l, int mask, float* lds, int gw, int NGW, int wave, int lane) {
    float* scr = lds + wave * 4096;
    unsigned char* wb = P.ws + WS_W;
    const int I_in = (mask & 1) ? (D / 64) * ((NIN + 31) / 32) : 0, I_vr = ((mask & 1) && l > 0) ? (D / 64) * 1 : 0, I_out = (mask & 2) ? (D / 64) * (D / 32) : 0, I_up = (mask & 4) ? (D / 64) * (FF / 32) : 0, I_dn = (mask & 8) ? (FF / 64) * (D / 32) : 0;
    const int NITEMS = I_in + I_vr + I_out + I_up + I_dn;
    for (int it = gw; it < NITEMS; it += NGW) {
        int r = it;
        if (r < I_in) { transpose_item(P.in[I_WIN] + (size_t)l * D * NIN, D, NIN, P.in[I_NMIX] + l * D, (bf16*)(wb + W_IN), 0, scr, r, lane); continue; } r -= I_in;
        if (r < I_vr) { transpose_item(P.in[I_VDOWN] + (size_t)(l - 1) * D * 32, D, 32, P.in[I_NMIX] + l * D, (bf16*)(wb + W_IN), NIN, scr, r, lane); continue; } r -= I_vr;
        if (r < I_out) { transpose_item(P.in[I_WOUT] + (size_t)l * D * D, D, D, nullptr, (bf16*)(wb + W_OUT), 0, scr, r, lane); continue; } r -= I_out;
        if (r < I_up) { transpose_item(P.in[I_FUP] + (size_t)l * D * FF, D, FF, P.in[I_NFFN] + l * D, (bf16*)(wb + W_UP), 0, scr, r, lane); continue; } r -= I_up;
        transpose_item(P.in[I_FDN] + (size_t)l * FF * D, FF, D, nullptr, (bf16*)(wb + W_DN), 0, scr, r, lane);
    }
}
__device__ __forceinline__ void prologue_rows(const Params& P, int gw, int NGW, int lane) {
    const float* x = P.in[I_X]; bf16* xb = (bf16*)(P.ws + WS_XB); float* ssq = (float*)(P.ws + WS_SSQ);
    for (int m = gw; m < T; m += NGW) {
        const f32x4* xr = (const f32x4*)(x + (size_t)m * D) + lane; f32x4 v[4]; float s = 0.f;
#pragma unroll
        for (int j = 0; j < 4; ++j) { v[j] = xr[64 * j]; s += (v[j][0] * v[j][0] + v[j][1] * v[j][1]) + (v[j][2] * v[j][2] + v[j][3] * v[j][3]); }
        s = wave_sum(s);
        unsigned long long* o8 = (unsigned long long*)(xb + (size_t)m * D) + lane;
#pragma unroll
        for (int j = 0; j < 4; ++j) o8[64 * j] = (unsigned long long)pk2(v[j][0], v[j][1]) | ((unsigned long long)pk2(v[j][2], v[j][3]) << 32);
        if (lane < 16) ssq[(size_t)m * 16 + lane] = (lane == 0) ? s : 0.f;
    }
}
__device__ __forceinline__ void final_norm(const Params& P, int gw, int NGW, int lane) {
    float* x = P.out; const float* ssq = (const float*)(P.ws + WS_SSQ); const f32x4* g4 = (const f32x4*)P.in[I_NFIN] + lane;
    for (int m = gw; m < T; m += NGW) {
        const float rstd = pg8::row_rstd16(ssq, m);
        f32x4* xr = (f32x4*)(x + (size_t)m * D) + lane;
#pragma unroll
        for (int j = 0; j < 4; ++j) { f32x4 v = xr[64 * j]; const f32x4 g = g4[64 * j]; v = v * rstd * g; xr[64 * j] = v; }
    }
}
__device__ __forceinline__ float ldcol(const bf16* cols, int t, int c) { return bf2f(cols[(size_t)t * NPAD + c]); }

__device__ __forceinline__ void rwkv_head_v1(const Params& P, int l, int h, float* lds, int tid) {
    const bf16* cols = (const bf16*)(P.ws + WS_COLS); bf16* Y = (bf16*)(P.ws + WS_Y); bf16* VF = (bf16*)(P.ws + WS_VF);
    float* sR = lds; float* sK = sR + 4096; float* sV = sK + 4096; float* sX = sV + 4096;
    float* sW = sX; float* sA = sX + 4096; float* sB = sX + 8192; float* sG = sX + 12288;
    float* sY = sX + 16384; float* sS = sY + 4096; float* sVr = sS + 64;
    const float* mu = P.in[I_MU] + l * 1024;
    const float* w_up = P.in[I_WUP] + (size_t)l * 64 * 256; const float* a_up = P.in[I_AUP] + (size_t)l * 64 * 256; const float* g_up = P.in[I_GUP] + (size_t)l * 128 * 256;
    const float* vr_up = P.in[I_VUP];
    const int lane = tid & 63, wv = tid >> 6, cc = h * 64 + lane;
    const float w0c = P.in[I_W0][l * 256 + cc], a0c = P.in[I_A0][l * 256 + cc], kkc = P.in[I_KK][l * 256 + cc], kac = P.in[I_KA][l * 256 + cc];
    const float rkc = P.in[I_RK][l * 256 + cc], lnw = P.in[I_LNW][l * 256 + cc], lnb = P.in[I_LNB][l * 256 + cc];
    const float v0c = (l > 0) ? P.in[I_V0][(l - 1) * 256 + cc] : 0.f;
    float S[64];
#pragma unroll
    for (int k = 0; k < 64; ++k) S[k] = 0.f;
    for (int ci = 0; ci < T / 64; ++ci) {
        const int t0 = ci * 64;
#pragma unroll 1
        for (int idx = tid; idx < 3 * 4096; idx += NT) { const int a = idx >> 12, t = (idx >> 6) & 63, c = idx & 63, col = a * 256 + h * 64 + c, tt = t0 + t;
            const float cur = ldcol(cols, tt, col), prv = (tt > 0) ? ldcol(cols, tt - 1, col) : 0.f; const float xs = cur + (prv - cur) * mu[col];
            (a == 0 ? sR : (a == 1 ? sK : sV))[t * 64 + c] = xs; }
#pragma unroll 1
        for (int idx = tid; idx < 64 * 256; idx += NT) { const int t = idx >> 8, j = idx & 255, col = 768 + j, tt = t0 + t;
            const float cur = ldcol(cols, tt, col), prv = (tt > 0) ? ldcol(cols, tt - 1, col) : 0.f; float xs = cur + (prv - cur) * mu[col];
            if (j < 64) xs = tanhf(xs); else if (j >= 128) xs = sigmoidf_(xs);
            sX[t * 256 + j] = xs; }
        if (l > 0)
#pragma unroll 1
        for (int idx = tid; idx < 64 * 32; idx += NT) { const int t = idx >> 5, j = idx & 31; sVr[idx] = ldcol(cols, t0 + t, C_VRES + j); }
        __syncthreads();
        float o_decay[8], o_asig[8], o_g[8], o_vmix[8];
#pragma unroll
        for (int hp = 0; hp < 2; ++hp) {
            float accw[4], acca[4], accg[4], accv[4];
#pragma unroll
            for (int i = 0; i < 4; ++i) { accw[i] = 0.f; acca[i] = 0.f; accg[i] = 0.f; accv[i] = 0.f; }
            const float* xb = sX + (wv * 8 + hp * 4) * 256;
#pragma unroll 2
            for (int j = 0; j < 64; ++j) { const float wvv = w_up[j * 256 + cc], avv = a_up[j * 256 + cc];
#pragma unroll
                for (int i = 0; i < 4; ++i) { accw[i] += xb[i * 256 + j] * wvv; acca[i] += xb[i * 256 + 64 + j] * avv; } }
#pragma unroll 2
            for (int j = 0; j < 128; ++j) { const float gvv = g_up[j * 256 + cc];
#pragma unroll
                for (int i = 0; i < 4; ++i) accg[i] += xb[i * 256 + 128 + j] * gvv; }
            if (l > 0) {
#pragma unroll 2
                for (int j = 0; j < 32; ++j) { const float vv = vr_up[j * 256 + cc];
#pragma unroll
                    for (int i = 0; i < 4; ++i) accv[i] += sVr[(wv * 8 + hp * 4 + i) * 32 + j] * vv; } }
#pragma unroll
            for (int i = 0; i < 4; ++i) { const float wpre = w0c + accw[i]; const float wlog = -softplusf_(-wpre) - 0.5f; o_decay[hp * 4 + i] = __expf(-__expf(wlog));
                o_asig[hp * 4 + i] = sigmoidf_(a0c + acca[i]); o_g[hp * 4 + i] = accg[i]; o_vmix[hp * 4 + i] = sigmoidf_(v0c + accv[i]); }
        }
        __syncthreads();
#pragma unroll
        for (int i = 0; i < 8; ++i) { const int t = wv * 8 + i, tt = t0 + t;
            const float r = sR[t * 64 + lane], k = sK[t * 64 + lane]; float v = sV[t * 64 + lane];
            const float asig = o_asig[i];
            if (l == 0) VF[(size_t)tt * 256 + cc] = (bf16)f2bf(v);
            else { const float vf = bf2f(VF[(size_t)tt * 256 + cc]); v = v + (vf - v) * o_vmix[i]; }
            const float kkr = k * kkc; const float ss = wave_sum(kkr * kkr); const float kk = kkr * (1.0f / sqrtf(ss + 1e-24f));
            const float kmod = k * (1.0f + (asig - 1.0f) * kac);
            const float bon = wave_sum(r * kmod * rkc);
            sW[t * 64 + lane] = o_decay[i]; sA[t * 64 + lane] = -kk; sB[t * 64 + lane] = kk * asig; sG[t * 64 + lane] = o_g[i]; sK[t * 64 + lane] = kmod; sV[t * 64 + lane] = v;
            if (lane == 0) sS[t] = bon; }
        __syncthreads();
        if (wv == 0) {
            for (int t = 0; t < 64; ++t) {
                const float vt = sV[t * 64 + lane];
                const f32x4* a4 = (const f32x4*)(sA + t * 64); const f32x4* w4 = (const f32x4*)(sW + t * 64); const f32x4* b4 = (const f32x4*)(sB + t * 64);
                const f32x4* k4 = (const f32x4*)(sK + t * 64); const f32x4* r4 = (const f32x4*)(sR + t * 64);
                float s0 = 0.f, s1 = 0.f, s2 = 0.f, s3 = 0.f;
#pragma unroll
                for (int q = 0; q < 16; ++q) { const f32x4 a = a4[q]; s0 += S[4 * q] * a[0]; s1 += S[4 * q + 1] * a[1]; s2 += S[4 * q + 2] * a[2]; s3 += S[4 * q + 3] * a[3]; }
                const float sa = (s0 + s1) + (s2 + s3);
                float y0 = 0.f, y1 = 0.f, y2 = 0.f, y3 = 0.f;
#pragma unroll
                for (int q = 0; q < 16; ++q) { const f32x4 w = w4[q], b = b4[q], kq = k4[q], rq = r4[q];
#pragma unroll
                    for (int e = 0; e < 4; ++e) S[4 * q + e] = S[4 * q + e] * w[e] + sa * b[e] + vt * kq[e];
                    y0 += S[4 * q] * rq[0]; y1 += S[4 * q + 1] * rq[1]; y2 += S[4 * q + 2] * rq[2]; y3 += S[4 * q + 3] * rq[3]; }
                sY[t * 64 + lane] = (y0 + y1) + (y2 + y3);
            }
        }
        __syncthreads();
#pragma unroll
        for (int i = 0; i < 8; ++i) { const int t = wv * 8 + i, tt = t0 + t;
            const float y = sY[t * 64 + lane]; const float mean = wave_sum(y) * (1.0f / 64.0f); const float d = y - mean; const float var = wave_sum(d * d) * (1.0f / 64.0f);
            float yn = d * (1.0f / sqrtf(var + 64e-5f)) * lnw + lnb; yn += sS[t] * sV[t * 64 + lane];
            Y[(size_t)tt * 1024 + cc] = (bf16)f2bf(yn * sG[t * 64 + lane]); }
        __syncthreads();
    }
}

__device__ __forceinline__ void gdn_head_v1(const Params& P, int l, int h, float* lds, int tid) {
    const bf16* cols = (const bf16*)(P.ws + WS_COLS); bf16* Y = (bf16*)(P.ws + WS_Y);
    float* sQ = lds; float* sK = sQ + 4096; float* sV = sK + 4096; float* sO = sV + 4096; float* sBeta = sO + 4096; float* sAl = sBeta + 64;
    const float* cw = P.in[I_CONV] + (size_t)l * 4 * 768;
    const int lane = tid & 63, wv = tid >> 6;
    const float alog = P.in[I_ALOG][l * 4 + h], dtb = P.in[I_DTB][l * 4 + h], ng = P.in[I_GDNG][l * 64 + lane];
    float S[64];
#pragma unroll
    for (int k = 0; k < 64; ++k) S[k] = 0.f;
    for (int ci = 0; ci < T / 64; ++ci) {
        const int t0 = ci * 64;
#pragma unroll 1
        for (int idx = tid; idx < 3 * 4096; idx += NT) { const int a = idx >> 12, t = (idx >> 6) & 63, c = idx & 63, ch = a * 256 + h * 64 + c, tt = t0 + t; float acc = 0.f;
#pragma unroll
            for (int i = 0; i < 4; ++i) { const int ts = tt - 3 + i; if (ts >= 0) acc += cw[i * 768 + ch] * ldcol(cols, ts, C_GDN + ch); }
            (a == 0 ? sQ : (a == 1 ? sK : sV))[t * 64 + c] = siluf_(acc); }
        if (tid < 64) { const int tt = t0 + tid; const float braw = ldcol(cols, tt, C_GDN + 1024 + h), araw = ldcol(cols, tt, C_GDN + 1028 + h);
            sBeta[tid] = sigmoidf_(braw); sAl[tid] = __expf(-__expf(alog) * softplusf_(araw + dtb)); }
        __syncthreads();
#pragma unroll
        for (int i = 0; i < 8; ++i) { const int t = wv * 8 + i; const float q = sQ[t * 64 + lane], k = sK[t * 64 + lane];
            const float sq = wave_sum(q * q), sk = wave_sum(k * k);
            sQ[t * 64 + lane] = q * (1.0f / sqrtf(sq + 1e-6f)) * 0.125f; sK[t * 64 + lane] = k * (1.0f / sqrtf(sk + 1e-6f)); }
        __syncthreads();
        if (wv == 0) {
            for (int t = 0; t < 64; ++t) {
                const float vt = sV[t * 64 + lane], beta = sBeta[t], al = sAl[t];
                const f32x4* k4 = (const f32x4*)(sK + t * 64); const f32x4* q4 = (const f32x4*)(sQ + t * 64);
                float s0 = 0.f, s1 = 0.f, s2 = 0.f, s3 = 0.f;
#pragma unroll
                for (int q = 0; q < 16; ++q) { const f32x4 kq = k4[q]; s0 += S[4 * q] * kq[0]; s1 += S[4 * q + 1] * kq[1]; s2 += S[4 * q + 2] * kq[2]; s3 += S[4 * q + 3] * kq[3]; }
                const float kS = al * ((s0 + s1) + (s2 + s3)); const float vn = beta * (vt - kS);
                float y0 = 0.f, y1 = 0.f, y2 = 0.f, y3 = 0.f;
#pragma unroll
                for (int q = 0; q < 16; ++q) { const f32x4 kq = k4[q], qq = q4[q];
#pragma unroll
                    for (int e = 0; e < 4; ++e) S[4 * q + e] = al * S[4 * q + e] + kq[e] * vn;
                    y0 += S[4 * q] * qq[0]; y1 += S[4 * q + 1] * qq[1]; y2 += S[4 * q + 2] * qq[2]; y3 += S[4 * q + 3] * qq[3]; }
                sO[t * 64 + lane] = (y0 + y1) + (y2 + y3);
            }
        }
        __syncthreads();
#pragma unroll
        for (int i = 0; i < 8; ++i) { const int t = wv * 8 + i, tt = t0 + t; const float o = sO[t * 64 + lane]; const float ms = wave_sum(o * o) * (1.0f / 64.0f);
            const float z = ldcol(cols, tt, C_GDN + 768 + h * 64 + lane);
            Y[(size_t)tt * 1024 + 256 + h * 64 + lane] = (bf16)f2bf(o * (1.0f / sqrtf(ms + 1e-6f)) * ng * siluf_(z)); }
        __syncthreads();
    }
}

__device__ __forceinline__ void gla_head_v1(const Params& P, int l, int h, float* lds, int tid) {
    const bf16* cols = (const bf16*)(P.ws + WS_COLS); bf16* Y = (bf16*)(P.ws + WS_Y);
    float* sQ = lds; float* sK = sQ + 2048; float* sAl = sK + 2048; float* sV = sAl + 2048; float* sO = sV + 4096; float* sGd = sO + 4096;
    const float* gk_up = P.in[I_GKUP] + (size_t)l * 16 * 128; const float* gk_b = P.in[I_GKB] + l * 128;
    const int lane = tid & 63, wv = tid >> 6; const float ng = P.in[I_GLAG][l * 64 + lane];
    float S[32];
#pragma unroll
    for (int k = 0; k < 32; ++k) S[k] = 0.f;
    for (int ci = 0; ci < T / 64; ++ci) {
        const int t0 = ci * 64;
#pragma unroll 1
        for (int idx = tid; idx < 64 * 32; idx += NT) { const int t = idx >> 5, j = idx & 31; sQ[idx] = ldcol(cols, t0 + t, C_GLA + h * 32 + j) * 0.17677669529663687f; sK[idx] = ldcol(cols, t0 + t, C_GLA + 128 + h * 32 + j); }
#pragma unroll 1
        for (int idx = tid; idx < 64 * 64; idx += NT) { const int t = idx >> 6, c = idx & 63; sV[idx] = ldcol(cols, t0 + t, C_GLA + 256 + h * 64 + c); }
#pragma unroll 1
        for (int idx = tid; idx < 64 * 16; idx += NT) { const int t = idx >> 4, i = idx & 15; sGd[idx] = ldcol(cols, t0 + t, C_GLA + 768 + i); }
        __syncthreads();
#pragma unroll 1
        for (int idx = tid; idx < 64 * 32; idx += NT) { const int t = idx >> 5, j = idx & 31; float a = gk_b[h * 32 + j];
#pragma unroll
            for (int i = 0; i < 16; ++i) a += sGd[t * 16 + i] * gk_up[i * 128 + h * 32 + j];
            sAl[idx] = __expf(-softplusf_(-a) * (1.0f / 16.0f)); }
        __syncthreads();
        if (wv == 0) {
            for (int t = 0; t < 64; ++t) {
                const float vt = sV[t * 64 + lane];
                const f32x4* a4 = (const f32x4*)(sAl + t * 32); const f32x4* k4 = (const f32x4*)(sK + t * 32); const f32x4* q4 = (const f32x4*)(sQ + t * 32);
                float y0 = 0.f, y1 = 0.f, y2 = 0.f, y3 = 0.f;
#pragma unroll
                for (int q = 0; q < 8; ++q) { const f32x4 a = a4[q], kq = k4[q], qq = q4[q];
#pragma unroll
                    for (int e = 0; e < 4; ++e) S[4 * q + e] = a[e] * S[4 * q + e] + kq[e] * vt;
                    y0 += S[4 * q] * qq[0]; y1 += S[4 * q + 1] * qq[1]; y2 += S[4 * q + 2] * qq[2]; y3 += S[4 * q + 3] * qq[3]; }
                sO[t * 64 + lane] = (y0 + y1) + (y2 + y3);
            }
        }
        __syncthreads();
#pragma unroll
        for (int i = 0; i < 8; ++i) { const int t = wv * 8 + i, tt = t0 + t; const float o = sO[t * 64 + lane]; const float ms = wave_sum(o * o) * (1.0f / 64.0f);
            const float gt = ldcol(cols, tt, C_GLA + 512 + h * 64 + lane);
            Y[(size_t)tt * 1024 + 512 + h * 64 + lane] = (bf16)f2bf(o * (1.0f / sqrtf(ms + 1e-6f)) * ng * siluf_(gt)); }
        __syncthreads();
    }
}

__device__ __forceinline__ void sgu_unit_v1(const Params& P, int l, int n, float* lds, int tid) {
    const bf16* cols = (const bf16*)(P.ws + WS_COLS); bf16* Y = (bf16*)(P.ws + WS_Y);
    float* sVl = lds;
    const int lane = tid & 63, wv = tid >> 6, t0 = n * 128;
    const float* lg = P.in[I_SLG] + l * 256; const float* lb = P.in[I_SLB] + l * 256;
    const float* ws_ = P.in[I_SWS] + (size_t)l * 4 * 128 * 128; const float* bs_ = P.in[I_SBS] + l * 4 * 128;
    for (int i = 0; i < 16; ++i) { const int t = wv * 16 + i; float v[4]; float s = 0.f;
#pragma unroll
        for (int e = 0; e < 4; ++e) { v[e] = geluf_(ldcol(cols, t0 + t, C_SGU + 256 + lane * 4 + e)); s += v[e]; }
        const float mean = wave_sum(s) * (1.0f / 256.0f); float q = 0.f;
#pragma unroll
        for (int e = 0; e < 4; ++e) { v[e] -= mean; q += v[e] * v[e]; }
        const float rstd = 1.0f / sqrtf(wave_sum(q) * (1.0f / 256.0f) + 1e-5f);
#pragma unroll
        for (int e = 0; e < 4; ++e) sVl[t * 256 + lane * 4 + e] = v[e] * rstd * lg[lane * 4 + e] + lb[lane * 4 + e]; }
    __syncthreads();
    const int g = lane >> 4;
    for (int i = 0; i < 16; ++i) { const int t = wv + 8 * i; const float* wr = ws_ + ((size_t)g * 128 + t) * 128; f32x4 acc = {0.f, 0.f, 0.f, 0.f};
        for (int s = 0; s <= t; ++s) { const float w = wr[s]; const f32x4 vv = *(const f32x4*)(sVl + s * 256 + lane * 4); acc += vv * w; }
        const float b = bs_[g * 128 + t];
#pragma unroll
        for (int e = 0; e < 4; ++e) { const float u = geluf_(ldcol(cols, t0 + t, C_SGU + lane * 4 + e)); Y[(size_t)(t0 + t) * 1024 + 768 + lane * 4 + e] = (bf16)f2bf(u * (acc[e] + b)); } }
    __syncthreads();
}
typedef short bf16x8 __attribute__((ext_vector_type(8)));
typedef float f32x16 __attribute__((ext_vector_type(16)));
typedef unsigned u32x2 __attribute__((ext_vector_type(2)));
constexpr int TS = 72;
constexpr int TILE_B = 64 * TS * 2;
template <int KT> __device__ __forceinline__ void mm_tile(f32x16& acc, const LAS bf16* Arows, const LAS bf16* Bcols, int lane) {
    const int off = (lane & 31) * TS + (lane >> 5) * 8;
#pragma unroll
    for (int kk = 0; kk < KT; ++kk) {
        const bf16x8 a = *(const LAS bf16x8*)(Arows + off + kk * 16);
        const bf16x8 b = *(const LAS bf16x8*)(Bcols + off + kk * 16);
        acc = __builtin_amdgcn_mfma_f32_32x32x16_bf16(a, b, acc, 0, 0, 0);
    }
}
__device__ __forceinline__ int acc_i(int r, int hh) { return (r & 3) + 8 * (r >> 2) + 4 * hh; }
__device__ __forceinline__ void store_lane_major(LAS bf16* Z, int j0, int i0, const f32x16& acc, int lane) {
    const int c = lane & 31, hh = lane >> 5;
    LAS bf16* p = Z + (j0 + c) * TS + i0 + 4 * hh;
#pragma unroll
    for (int q = 0; q < 4; ++q) { uint2 w; w.x = pk2(acc[4 * q], acc[4 * q + 1]); w.y = pk2(acc[4 * q + 2], acc[4 * q + 3]); *(LAS u32x2*)(p + 8 * q) = (u32x2){w.x, w.y}; }
}
__device__ __forceinline__ void store_reg_major(LAS bf16* Z, int i0, int j0, const f32x16& acc, int lane) {
    const int c = lane & 31, hh = lane >> 5;
#pragma unroll
    for (int r = 0; r < 16; ++r) Z[(i0 + acc_i(r, hh)) * TS + j0 + c] = (bf16)f2bf(acc[r]);
}
__device__ __forceinline__ f32x16 zero16() { f32x16 z;
#pragma unroll
    for (int r = 0; r < 16; ++r) z[r] = 0.f; return z; }
__device__ __forceinline__ void gla_m1(const Params& P, int l, int ci, LAS unsigned char* lds, int tid) {
    const bf16* cols = (const bf16*)(P.ws + WS_COLS); bf16* Y = (bf16*)(P.ws + WS_Y);
    float* GKV = (float*)(P.ws + WS_GKV); float* GAL = (float*)(P.ws + WS_GAL); bf16* GQI = (bf16*)(P.ws + WS_GQI);
    LAS float* fLa = (LAS float*)lds; LAS float* fGd = fLa + 64 * 128; LAS unsigned char* tb0 = lds + 32768 + 4096;
    const float* gk_up = P.in[I_GKUP] + (size_t)l * 16 * 128; const float* gk_b = P.in[I_GKB] + l * 128;
    const int lane = tid & 63, wv = tid >> 6, t0 = ci * 64;
#pragma unroll 1
    for (int idx = tid; idx < 64 * 16; idx += NT) fGd[idx] = ldcol(cols, t0 + (idx >> 4), C_GLA + 768 + (idx & 15));
    __syncthreads();
#pragma unroll 1
    for (int idx = tid; idx < 64 * 128; idx += NT) { const int t = idx >> 7, j = idx & 127; float a = gk_b[j];
#pragma unroll
        for (int i = 0; i < 16; ++i) a += fGd[t * 16 + i] * gk_up[i * 128 + j];
        fLa[idx] = -softplusf_(-a) * (1.0f / 16.0f); }
    __syncthreads();
    if (tid < 128) { float run = 0.f;
#pragma unroll 8
        for (int t = 0; t < 64; ++t) { run += fLa[t * 128 + tid]; fLa[t * 128 + tid] = run; }
        GAL[ci * 128 + tid] = __expf(run); }
    __syncthreads();
#pragma unroll 1
    for (int hp = 0; hp < 2; ++hp) {
#pragma unroll 1
        for (int idx = tid; idx < 2 * 64 * 32; idx += NT) { const int s = idx >> 11, t = (idx >> 5) & 63, j = idx & 31, h = 2 * hp + s;
            LAS bf16* tQ = (LAS bf16*)(tb0 + s * 5 * TILE_B); LAS bf16* tK = tQ + 64 * TS; LAS bf16* tKs = tK + 64 * TS;
            const float b = fLa[t * 128 + h * 32 + j], b63 = fLa[63 * 128 + h * 32 + j];
            const float q = ldcol(cols, t0 + t, C_GLA + h * 32 + j) * 0.17677669529663687f, k = ldcol(cols, t0 + t, C_GLA + 128 + h * 32 + j);
            const bf16 qt = (bf16)f2bf(q * __expf(b));
            tQ[t * TS + j] = qt; tK[t * TS + j] = (bf16)f2bf(k * __expf(-b)); tKs[j * TS + t] = (bf16)f2bf(k * __expf(b63 - b));
            GQI[(((size_t)ci * 4 + h) * 64 + t) * 32 + j] = qt; }
#pragma unroll 1
        for (int idx = tid; idx < 2 * 64 * 64; idx += NT) { const int s = idx >> 12, t = (idx >> 6) & 63, v = idx & 63, h = 2 * hp + s;
            LAS bf16* tV = (LAS bf16*)(tb0 + s * 5 * TILE_B + 3 * TILE_B);
            tV[v * TS + t] = cols[(size_t)(t0 + t) * NPAD + C_GLA + 256 + h * 64 + v]; }
        __syncthreads();
        for (int jb = wv; jb < 12; jb += 8) { const int s = jb / 6, r = jb % 6, h = 2 * hp + s;
            LAS bf16* tQ = (LAS bf16*)(tb0 + s * 5 * TILE_B); LAS bf16* tK = tQ + 64 * TS; LAS bf16* tKs = tK + 64 * TS; LAS bf16* tV = tKs + 64 * TS; LAS bf16* tSc = tV + 64 * TS;
            f32x16 acc = zero16(); const int c = lane & 31, hh = lane >> 5;
            if (r < 4) { const int tb = (r == 0 || r == 3) ? 0 : 1, sb = (r == 0 || r == 1) ? 0 : 1;
                if (r < 3) { mm_tile<2>(acc, tK + sb * 32 * TS, tQ + tb * 32 * TS, lane);
#pragma unroll
                    for (int q = 0; q < 16; ++q) { const int sI = 32 * sb + acc_i(q, hh), tI = 32 * tb + c; if (sI > tI) acc[q] = 0.f; } }
                store_lane_major(tSc, 32 * tb, 32 * sb, acc, lane);
            } else { const int vb = r - 4; mm_tile<4>(acc, tKs, tV + vb * 32 * TS, lane);
                float* g = GKV + (((size_t)ci * 4 + h) * 32) * 64 + 32 * vb + c;
#pragma unroll
                for (int q = 0; q < 16; ++q) g[acc_i(q, hh) * 64] = acc[q]; }
        }
        __syncthreads();
        { const int s = wv >> 2, tb = (wv >> 1) & 1, vb = wv & 1, h = 2 * hp + s;
            LAS bf16* tV = (LAS bf16*)(tb0 + s * 5 * TILE_B + 3 * TILE_B); LAS bf16* tSc = tV + 64 * TS;
            f32x16 acc = zero16(); const int c = lane & 31, hh = lane >> 5;
            mm_tile<4>(acc, tSc + tb * 32 * TS, tV + vb * 32 * TS, lane);
            bf16* y = Y + (size_t)(t0 + 32 * tb) * 1024 + 512 + h * 64 + 32 * vb + c;
#pragma unroll
            for (int q = 0; q < 16; ++q) y[(size_t)acc_i(q, hh) * 1024] = (bf16)f2bf(acc[q]); }
        __syncthreads();
    }
}
__device__ __forceinline__ void gla_m2(const Params& P, int e) {
    float* GKV = (float*)(P.ws + WS_GKV); const float* GAL = (const float*)(P.ws + WS_GAL);
    const int hk = e >> 6;
    float S = 0.f;
#pragma unroll 1
    for (int c0 = 0; c0 < T / 64; c0 += 16) { float kv[16], al[16];
#pragma unroll
        for (int u = 0; u < 16; ++u) { kv[u] = GKV[(size_t)(c0 + u) * 8192 + e]; al[u] = GAL[(c0 + u) * 128 + hk]; }
#pragma unroll
        for (int u = 0; u < 16; ++u) { GKV[(size_t)(c0 + u) * 8192 + e] = S; S = al[u] * S + kv[u]; } }
}
__device__ __forceinline__ void gla_m3(const Params& P, int l, int ci, LAS unsigned char* lds, int tid) {
    const bf16* cols = (const bf16*)(P.ws + WS_COLS); bf16* Y = (bf16*)(P.ws + WS_Y);
    const float* GKV = (const float*)(P.ws + WS_GKV); const bf16* GQI = (const bf16*)(P.ws + WS_GQI);
    const float* ng = P.in[I_GLAG] + l * 64;
    const int lane = tid & 63, wv = tid >> 6, t0 = ci * 64;
#pragma unroll 1
    for (int idx = tid; idx < 4 * 32 * 64; idx += NT) { const int h = idx >> 11, k = (idx >> 6) & 31, v = idx & 63;
        ((LAS bf16*)(lds + h * TILE_B))[v * TS + k] = (bf16)f2bf(GKV[(size_t)ci * 8192 + idx]); }
    __syncthreads();
    const int h = wv >> 1, tb = wv & 1, c = lane & 31, hh = lane >> 5;
    const LAS bf16* tS = (const LAS bf16*)(lds + h * TILE_B);
    f32x16 acc[2]; acc[0] = zero16(); acc[1] = zero16();
    const bf16* qg = GQI + (((size_t)ci * 4 + h) * 64 + 32 * tb + c) * 32 + hh * 8;
#pragma unroll
    for (int kk = 0; kk < 2; ++kk) { const bf16x8 b = *(const bf16x8*)(qg + kk * 16);
#pragma unroll
        for (int vb = 0; vb < 2; ++vb) { const bf16x8 a = *(const LAS bf16x8*)(tS + (vb * 32 + c) * TS + hh * 8 + kk * 16);
            acc[vb] = __builtin_amdgcn_mfma_f32_32x32x16_bf16(a, b, acc[vb], 0, 0, 0); } }
    const size_t trow = (size_t)(t0 + 32 * tb + c);
    bf16* yrow = Y + trow * 1024 + 512 + h * 64; const bf16* grow = cols + trow * NPAD + C_GLA + 512 + h * 64;
    float ss = 0.f;
#pragma unroll
    for (int vb = 0; vb < 2; ++vb)
#pragma unroll
        for (int q = 0; q < 4; ++q) { const int v = 32 * vb + 8 * q + 4 * hh; const uint2 w = *(const uint2*)(yrow + v);
            acc[vb][4 * q] += bf2f((bf16)(w.x & 0xffff)); acc[vb][4 * q + 1] += bf2f((bf16)(w.x >> 16)); acc[vb][4 * q + 2] += bf2f((bf16)(w.y & 0xffff)); acc[vb][4 * q + 3] += bf2f((bf16)(w.y >> 16));
#pragma unroll
            for (int e = 0; e < 4; ++e) ss += acc[vb][4 * q + e] * acc[vb][4 * q + e]; }
    ss += __shfl_xor(ss, 32);
    const float rstd = 1.0f / sqrtf(ss * (1.0f / 64.0f) + 1e-6f);
#pragma unroll
    for (int vb = 0; vb < 2; ++vb)
#pragma unroll
        for (int q = 0; q < 4; ++q) { const int v = 32 * vb + 8 * q + 4 * hh; const uint2 gw = *(const uint2*)(grow + v); float o[4];
            const float g0 = bf2f((bf16)(gw.x & 0xffff)), g1 = bf2f((bf16)(gw.x >> 16)), g2 = bf2f((bf16)(gw.y & 0xffff)), g3 = bf2f((bf16)(gw.y >> 16));
            o[0] = acc[vb][4 * q] * rstd * ng[v] * siluf_(g0); o[1] = acc[vb][4 * q + 1] * rstd * ng[v + 1] * siluf_(g1);
            o[2] = acc[vb][4 * q + 2] * rstd * ng[v + 2] * siluf_(g2); o[3] = acc[vb][4 * q + 3] * rstd * ng[v + 3] * siluf_(g3);
            uint2 w; w.x = pk2(o[0], o[1]); w.y = pk2(o[2], o[3]); *(uint2*)(yrow + v) = w; }
    __syncthreads();
}
__device__ __forceinline__ void nm_square(const LAS bf16* Xr, const LAS bf16* Xc, LAS bf16* Xr_o, LAS bf16* Xc_o, int I, int J, int lane) {
    f32x16 acc = zero16();
    if (I == J) mm_tile<2>(acc, Xr + I * 32 * TS + 32 * I, Xc + J * 32 * TS + 32 * I, lane);
    else mm_tile<4>(acc, Xr + 32 * TS, Xc, lane);
    store_lane_major(Xc_o, 32 * J, 32 * I, acc, lane);
    store_reg_major(Xr_o, 32 * I, 32 * J, acc, lane);
}
__device__ __forceinline__ void nm_update(const LAS bf16* Tt, const LAS bf16* Xc, LAS bf16* Tt_o, int I, int J, int lane) {
    const int c = lane & 31, hh = lane >> 5; f32x16 acc;
#pragma unroll
    for (int q = 0; q < 4; ++q) { const u32x2 w = *(const LAS u32x2*)(Tt + (32 * I + c) * TS + 32 * J + 8 * q + 4 * hh);
        acc[4 * q] = bf2f((bf16)(w.x & 0xffff)); acc[4 * q + 1] = bf2f((bf16)(w.x >> 16)); acc[4 * q + 2] = bf2f((bf16)(w.y & 0xffff)); acc[4 * q + 3] = bf2f((bf16)(w.y >> 16)); }
    if (I == J) mm_tile<2>(acc, Xc + J * 32 * TS + 32 * I, Tt + I * 32 * TS + 32 * I, lane);
    else mm_tile<4>(acc, Xc, Tt + 32 * TS, lane);
    store_lane_major(Tt_o, 32 * I, 32 * J, acc, lane);
}
#define NM_TILE_IJ(w3, I_, J_) const int I_ = ((w3) == 0) ? 0 : 1, J_ = ((w3) == 2) ? 1 : 0
template <class Extra> __device__ __forceinline__ void neumann_solve(LAS bf16* const (&Xr)[2], LAS bf16* const (&Xc)[2], LAS bf16* const (&Tt)[2], int wv, int lane, const Extra& extra) {
    if (wv < 3) { NM_TILE_IJ(wv, I, J); nm_square(Xr[0], Xc[0], Xr[1], Xc[1], I, J, lane); }
    else if (wv >= 4) extra();
    __syncthreads();
#pragma unroll 1
    for (int k = 1; k <= 4; ++k) {
        const int xb = k & 1, tbuf = (k - 1) & 1;
        if (wv < 3) { NM_TILE_IJ(wv, I, J); nm_update(Tt[tbuf], Xc[xb], Tt[tbuf ^ 1], I, J, lane); }
        else if (wv < 6) { NM_TILE_IJ(wv - 3, I, J); nm_square(Xr[xb], Xc[xb], Xr[xb ^ 1], Xc[xb ^ 1], I, J, lane); }
        __syncthreads();
    }
    if (wv < 3) { NM_TILE_IJ(wv, I, J); nm_update(Tt[0], Xc[1], Tt[1], I, J, lane); }
    __syncthreads();
}
typedef float f32x4v __attribute__((ext_vector_type(4)));
__device__ __forceinline__ void dplr_m2(const bf16* XP, bf16* XQ, const float* XG, int h, int vs, int lane) {
    const int g = lane >> 4, n = lane & 15, v0 = vs * 16;
    f32x4v H[4];
#pragma unroll
    for (int m = 0; m < 4; ++m) H[m] = (f32x4v){0.f, 0.f, 0.f, 0.f};
    uint2 pa[4][2][2], pa_n[4][2][2]; bf16 qv[4][4], qv_n[4][4]; f32x4v gm[4], gm_n[4];
#define M2_LOAD(c, PA, QV, GM) do { const size_t ch_ = (size_t)(c) * 4 + h; const bf16* Pp = XP + ch_ * 4096; const bf16* Qp = XQ + ch_ * 4096; const float* Gp = XG + ch_ * 64; \
        _Pragma("unroll") for (int m = 0; m < 4; ++m) { _Pragma("unroll") for (int s = 0; s < 2; ++s) { PA[m][s][0] = *(const uint2*)(Pp + (16 * m + n) * 64 + 32 * s + 4 * g); PA[m][s][1] = *(const uint2*)(Pp + (16 * m + n) * 64 + 32 * s + 16 + 4 * g); } \
            _Pragma("unroll") for (int i = 0; i < 4; ++i) QV[m][i] = Qp[(16 * m + 4 * g + i) * 64 + v0 + n]; \
            GM[m] = *(const f32x4v*)(Gp + 16 * m + 4 * g); } } while (0)
#define M2_STEP(c, PA, QV, GM) do { const size_t ch_ = (size_t)(c) * 4 + h; bf16* Qp = XQ + ch_ * 4096; \
        bf16x8 bfr[2]; \
        _Pragma("unroll") for (int s = 0; s < 2; ++s) { v4u w; w.x = pk2(H[2 * s][0], H[2 * s][1]); w.y = pk2(H[2 * s][2], H[2 * s][3]); w.z = pk2(H[2 * s + 1][0], H[2 * s + 1][1]); w.w = pk2(H[2 * s + 1][2], H[2 * s + 1][3]); bfr[s] = __builtin_bit_cast(bf16x8, w); } \
        _Pragma("unroll") for (int m = 0; m < 4; ++m) { f32x4v a; \
            _Pragma("unroll") for (int i = 0; i < 4; ++i) { Qp[(16 * m + 4 * g + i) * 64 + v0 + n] = (bf16)f2bf(H[m][i]); a[i] = GM[m][i] * H[m][i] + bf2f(QV[m][i]); } \
            _Pragma("unroll") for (int s = 0; s < 2; ++s) { v4u w; w.x = PA[m][s][0].x; w.y = PA[m][s][0].y; w.z = PA[m][s][1].x; w.w = PA[m][s][1].y; \
                a = __builtin_amdgcn_mfma_f32_16x16x32_bf16(__builtin_bit_cast(bf16x8, w), bfr[s], a, 0, 0, 0); } \
            H[m] = a; } } while (0)
    M2_LOAD(0, pa, qv, gm);
#pragma unroll 1
    for (int c = 0; c < T / 64; c += 2) {
        M2_LOAD(c + 1, pa_n, qv_n, gm_n);
        M2_STEP(c, pa, qv, gm);
        if (c + 2 < T / 64) M2_LOAD(c + 2, pa, qv, gm);
        M2_STEP(c + 1, pa_n, qv_n, gm_n);
    }
#undef M2_LOAD
#undef M2_STEP
}
__device__ __forceinline__ void dplr_m3_stage(const bf16* XQ, int ci, LAS unsigned char* lds, int tid) {
#pragma unroll 1
    for (int idx = tid; idx < 4 * 64 * 64; idx += NT) { const int h = idx >> 12, d = (idx >> 6) & 63, v = idx & 63;
        ((LAS bf16*)(lds + h * TILE_B))[v * TS + d] = XQ[(size_t)ci * 16384 + idx]; }
}
__device__ __forceinline__ void dplr_m3_core(f32x16 (&acc)[2], const LAS bf16* tHT, const bf16* XRch, int tb, int lane) {
    const int c = lane & 31, hh = lane >> 5;
    const bf16* rg = XRch + (32 * tb + c) * 64 + hh * 8;
    acc[0] = zero16(); acc[1] = zero16();
#pragma unroll
    for (int kk = 0; kk < 4; ++kk) { const bf16x8 b = *(const bf16x8*)(rg + kk * 16);
#pragma unroll
        for (int vb = 0; vb < 2; ++vb) { const bf16x8 a = *(const LAS bf16x8*)(tHT + (vb * 32 + c) * TS + hh * 8 + kk * 16);
            acc[vb] = __builtin_amdgcn_mfma_f32_32x32x16_bf16(a, b, acc[vb], 0, 0, 0); } }
}
__device__ __forceinline__ void rwkv_m1(const Params& P, int l, int ci, LAS unsigned char* lds, int tid) {
    const bf16* cols = (const bf16*)(P.ws + WS_COLS); bf16* Y = (bf16*)(P.ws + WS_Y); bf16* VF = (bf16*)(P.ws + WS_VF);
    bf16* XP = (bf16*)(P.ws + WS_RP); bf16* XQ = (bf16*)(P.ws + WS_RQ); bf16* XR = (bf16*)(P.ws + WS_RR); bf16* XBV = (bf16*)(P.ws + WS_RBV); float* XG = (float*)(P.ws + WS_XG);
    LAS bf16* tA = (LAS bf16*)lds; LAS bf16* tB = tA + 64 * TS; LAS bf16* tK = tB + 64 * TS; LAS bf16* tR = tK + 64 * TS; LAS bf16* tV = tR + 64 * TS;
    LAS bf16* tAab = tV + 64 * TS; LAS bf16* tAak = tAab + 64 * TS; LAS bf16* tArb = tAak + 64 * TS; LAS bf16* tArk = tArb + 64 * TS;
    LAS bf16* tAabT = tArk + 64 * TS; LAS bf16* tX1r = tAabT + 64 * TS; LAS bf16* tX1c = tX1r + 64 * TS; LAS bf16* tT0 = tX1c + 64 * TS; LAS bf16* tT1 = tT0 + 64 * TS; LAS bf16* tAV = tT1 + 64 * TS;
    LAS bf16* tW = tAab; LAS bf16* tU = tAak; LAS bf16* tT = tT1;
    LAS float* gC = (LAS float*)(lds + 15 * TILE_B);
    LAS float* sX = (LAS float*)(lds + 5 * TILE_B); LAS float* sVr = (LAS float*)(lds + 5 * TILE_B + 65536); LAS float* sLw = (LAS float*)(lds + 5 * TILE_B + 65536 + 8192);
    const float* mu = P.in[I_MU] + l * 1024;
    const float* w_up = P.in[I_WUP] + (size_t)l * 64 * 256; const float* a_up = P.in[I_AUP] + (size_t)l * 64 * 256; const float* g_up = P.in[I_GUP] + (size_t)l * 128 * 256;
    const float* vr_up = P.in[I_VUP];
#pragma unroll 1
    for (int h = 0; h < 4; ++h) {
        int tidh = tid, t0 = ci * 64; asm volatile("" : "+v"(tidh), "+s"(t0));
        const int lane = tidh & 63, wv = tidh >> 6;
        const int cc = h * 64 + lane; const size_t ch = (size_t)ci * 4 + h;
#pragma unroll 1
        for (int idx = tidh; idx < 64 * 256; idx += NT) { const int t = idx >> 8, j = idx & 255, col = 768 + j, tt = t0 + t;
            const float cur = ldcol(cols, tt, col), prv = (tt > 0) ? ldcol(cols, tt - 1, col) : 0.f; float xs = cur + (prv - cur) * mu[col];
            if (j < 64) xs = tanhf(xs); else if (j >= 128) xs = sigmoidf_(xs);
            sX[t * 256 + j] = xs; }
        if (l > 0) {
#pragma unroll 1
            for (int idx = tidh; idx < 64 * 32; idx += NT) { const int t = idx >> 5, j = idx & 31; sVr[idx] = ldcol(cols, t0 + t, C_VRES + j); } }
        __syncthreads();
        const float w0c = P.in[I_W0][l * 256 + cc], a0c = P.in[I_A0][l * 256 + cc], kkc = P.in[I_KK][l * 256 + cc], kac = P.in[I_KA][l * 256 + cc], rkc = P.in[I_RK][l * 256 + cc];
        const float v0c = (l > 0) ? P.in[I_V0][(l - 1) * 256 + cc] : 0.f;
        float o_lw[8], o_asig[8], o_vmix[8];
#pragma unroll
        for (int hp = 0; hp < 2; ++hp) {
            float accw[4], acca[4], accg[4], accv[4];
#pragma unroll
            for (int i = 0; i < 4; ++i) { accw[i] = 0.f; acca[i] = 0.f; accg[i] = 0.f; accv[i] = 0.f; }
            const LAS float* xb = sX + (wv * 8 + hp * 4) * 256;
#pragma unroll 2
            for (int j = 0; j < 64; ++j) { const float wvv = w_up[j * 256 + cc], avv = a_up[j * 256 + cc];
#pragma unroll
                for (int i = 0; i < 4; ++i) { accw[i] += xb[i * 256 + j] * wvv; acca[i] += xb[i * 256 + 64 + j] * avv; } }
#pragma unroll 2
            for (int j = 0; j < 128; ++j) { const float gvv = g_up[j * 256 + cc];
#pragma unroll
                for (int i = 0; i < 4; ++i) accg[i] += xb[i * 256 + 128 + j] * gvv; }
            if (l > 0) {
#pragma unroll 2
                for (int j = 0; j < 32; ++j) { const float vv = vr_up[j * 256 + cc];
#pragma unroll
                    for (int i = 0; i < 4; ++i) accv[i] += sVr[(wv * 8 + hp * 4 + i) * 32 + j] * vv; } }
#pragma unroll
            for (int i = 0; i < 4; ++i) { const int t = wv * 8 + hp * 4 + i; const float wpre = w0c + accw[i]; const float wlog = -softplusf_(-wpre) - 0.5f; o_lw[hp * 4 + i] = -__expf(wlog);
                o_asig[hp * 4 + i] = sigmoidf_(a0c + acca[i]); o_vmix[hp * 4 + i] = sigmoidf_(v0c + accv[i]);
                Y[(size_t)(t0 + t) * 1024 + 768 + cc] = (bf16)f2bf(accg[i]); }
        }
        float e_r[8], e_k[8], e_v[8], e_kk[8];
#pragma unroll
        for (int i = 0; i < 8; ++i) { const int t = wv * 8 + i, tt = t0 + t;
            float x3[3];
#pragma unroll
            for (int a = 0; a < 3; ++a) { const int col = a * 256 + cc; const float cur = ldcol(cols, tt, col), prv = (tt > 0) ? ldcol(cols, tt - 1, col) : 0.f; x3[a] = cur + (prv - cur) * mu[col]; }
            const float r = x3[0], k = x3[1]; float v = x3[2];
            if (l == 0) VF[(size_t)tt * 256 + cc] = (bf16)f2bf(v);
            else { const float vf = bf2f(VF[(size_t)tt * 256 + cc]); v = v + (vf - v) * o_vmix[i]; }
            const float kkr = k * kkc; const float ss = wave_sum(kkr * kkr); const float kk = kkr * (1.0f / sqrtf(ss + 1e-24f));
            const float kmod = k * (1.0f + (o_asig[i] - 1.0f) * kac);
            const float bon = wave_sum(r * kmod * rkc);
            XBV[(ch * 64 + t) * 64 + lane] = (bf16)f2bf(bon * v);
            sLw[t * 64 + lane] = o_lw[i];
            e_r[i] = r; e_k[i] = kmod; e_v[i] = v; e_kk[i] = kk; }
        __syncthreads();
        if (tidh < 64) { float run = 0.f;
#pragma unroll 8
            for (int t = 0; t < 64; ++t) { run += sLw[t * 64 + tidh]; sLw[t * 64 + tidh] = run; }
            const float gam = __expf(run); gC[tidh] = gam; XG[ch * 64 + tidh] = gam; }
        __syncthreads();
        float at[8], bt[8], kt[8];
#pragma unroll
        for (int i = 0; i < 8; ++i) { const int t = wv * 8 + i; const float cum = sLw[t * 64 + lane], cumm = (t > 0) ? sLw[(t - 1) * 64 + lane] : 0.f;
            const float ep = __expf(cum), en = __expf(-cum), epm = __expf(cumm);
            at[i] = -e_kk[i] * epm; bt[i] = e_kk[i] * o_asig[i] * en; kt[i] = e_k[i] * en;
            tA[t * TS + lane] = (bf16)f2bf(at[i]); tB[t * TS + lane] = (bf16)f2bf(bt[i]); tK[t * TS + lane] = (bf16)f2bf(kt[i]); tR[t * TS + lane] = (bf16)f2bf(e_r[i] * ep); }
        { v4u w; w.x = pk2(e_v[0], e_v[1]); w.y = pk2(e_v[2], e_v[3]); w.z = pk2(e_v[4], e_v[5]); w.w = pk2(e_v[6], e_v[7]); *(LAS v4u*)(tV + lane * TS + wv * 8) = w; }
        __syncthreads();
        for (int jb = wv; jb < 16; jb += 8) { const int mat = jb >> 2, r = jb & 3; const int tb = (r == 0 || r == 3) ? 0 : 1, sb = (r == 0 || r == 1) ? 0 : 1;
            f32x16 acc = zero16(); const int c = lane & 31, hh = lane >> 5;
            if (r < 3) { mm_tile<4>(acc, ((mat & 1) ? tK : tB) + sb * 32 * TS, ((mat >> 1) ? tR : tA) + tb * 32 * TS, lane);
#pragma unroll
                for (int q = 0; q < 16; ++q) { const int sI = 32 * sb + acc_i(q, hh), tI = 32 * tb + c; if ((mat < 2) ? (sI >= tI) : (sI > tI)) acc[q] = 0.f; } }
            store_lane_major(tAab + mat * 64 * TS, 32 * tb, 32 * sb, acc, lane);
            if (mat == 0) {
                if (r == 3) store_lane_major(tT1, 0, 32, acc, lane);
                else { store_reg_major(tAabT, 32 * sb, 32 * tb, acc, lane);
#pragma unroll
                    for (int q = 0; q < 16; ++q) if (32 * sb + acc_i(q, hh) == 32 * tb + c) acc[q] += 1.0f;
                    store_lane_major(tT0, 32 * tb, 32 * sb, acc, lane); } }
        }
        __syncthreads();
        { v4u w; w.x = pk2(at[0], at[1]); w.y = pk2(at[2], at[3]); w.z = pk2(at[4], at[5]); w.w = pk2(at[6], at[7]); *(LAS v4u*)(tA + lane * TS + wv * 8) = w;
          w.x = pk2(bt[0], bt[1]); w.y = pk2(bt[2], bt[3]); w.z = pk2(bt[4], bt[5]); w.w = pk2(bt[6], bt[7]); *(LAS v4u*)(tB + lane * TS + wv * 8) = w;
          w.x = pk2(kt[0], kt[1]); w.y = pk2(kt[2], kt[3]); w.z = pk2(kt[4], kt[5]); w.w = pk2(kt[6], kt[7]); *(LAS v4u*)(tK + lane * TS + wv * 8) = w; }
        { LAS bf16* const Xr[2] = {tAab, tX1r}; LAS bf16* const Xc[2] = {tAabT, tX1c}; LAS bf16* const Tb[2] = {tT0, tT1};
          neumann_solve(Xr, Xc, Tb, wv, lane, [&]() { const int sb = (wv - 4) >> 1, vb = (wv - 4) & 1; f32x16 acc = zero16();
              mm_tile<4>(acc, tAak + sb * 32 * TS, tV + vb * 32 * TS, lane); store_lane_major(tAV, 32 * vb, 32 * sb, acc, lane); }); }
        { const int which = wv >> 2, tb = (wv >> 1) & 1, jb2 = wv & 1; f32x16 acc = zero16();
            mm_tile<4>(acc, tT + tb * 32 * TS, (which ? tAV : tA) + jb2 * 32 * TS, lane);
            store_lane_major(which ? tU : tW, 32 * jb2, 32 * tb, acc, lane); }
        __syncthreads();
        for (int jb = wv; jb < 16; jb += 8) { const int out = jb >> 2, ib = (jb >> 1) & 1, jb2 = jb & 1; f32x16 acc = zero16(); const int c = lane & 31, hh = lane >> 5;
            if (out == 0) mm_tile<4>(acc, tB + ib * 32 * TS, tW + jb2 * 32 * TS, lane);
            else if (out == 1) { mm_tile<4>(acc, tB + ib * 32 * TS, tU + jb2 * 32 * TS, lane); mm_tile<4>(acc, tK + ib * 32 * TS, tV + jb2 * 32 * TS, lane); }
            else if (out == 2) mm_tile<4>(acc, tArb + ib * 32 * TS, tW + jb2 * 32 * TS, lane);
            else { mm_tile<4>(acc, tArb + ib * 32 * TS, tU + jb2 * 32 * TS, lane); mm_tile<4>(acc, tArk + ib * 32 * TS, tV + jb2 * 32 * TS, lane); }
            if (out < 2) { bf16* g = (out == 0 ? XP : XQ) + ch * 4096 + 32 * jb2 + c;
#pragma unroll
                for (int q = 0; q < 16; ++q) { const int row = 32 * ib + acc_i(q, hh); g[row * 64] = (bf16)f2bf(acc[q] * gC[row]); } }
            else if (out == 2) { bf16* g = XR + ch * 4096 + 32 * jb2 + c;
#pragma unroll
                for (int q = 0; q < 16; ++q) { const int row = 32 * ib + acc_i(q, hh); g[row * 64] = (bf16)f2bf(acc[q] + bf2f(tR[row * TS + 32 * jb2 + c])); } }
            else { bf16* g = Y + (size_t)t0 * 1024 + h * 64 + 32 * jb2 + c;
#pragma unroll
                for (int q = 0; q < 16; ++q) { const int row = 32 * ib + acc_i(q, hh); g[(size_t)row * 1024] = (bf16)f2bf(acc[q]); } }
        }
        __syncthreads();
    }
}
__device__ __forceinline__ void rwkv_m3(const Params& P, int l, int ci, LAS unsigned char* lds, int tid) {
    bf16* Y = (bf16*)(P.ws + WS_Y); const bf16* XQ = (const bf16*)(P.ws + WS_RQ); const bf16* XR = (const bf16*)(P.ws + WS_RR); const bf16* XBV = (const bf16*)(P.ws + WS_RBV);
    const int lane = tid & 63, wv = tid >> 6, t0 = ci * 64;
    dplr_m3_stage(XQ, ci, lds, tid);
    __syncthreads();
    const int h = wv >> 1, tb = wv & 1, c = lane & 31, hh = lane >> 5; const size_t ch = (size_t)ci * 4 + h;
    f32x16 acc[2];
    dplr_m3_core(acc, (const LAS bf16*)(lds + h * TILE_B), XR + ch * 4096, tb, lane);
    const size_t trow = (size_t)(t0 + 32 * tb + c);
    bf16* yrow = Y + trow * 1024 + h * 64; const bf16* grow = Y + trow * 1024 + 768 + h * 64; const bf16* bvrow = XBV + (ch * 64 + 32 * tb + c) * 64;
    const float* lnw = P.in[I_LNW] + l * 256 + h * 64; const float* lnb = P.in[I_LNB] + l * 256 + h * 64;
    float s = 0.f;
#pragma unroll
    for (int vb = 0; vb < 2; ++vb)
#pragma unroll
        for (int q = 0; q < 4; ++q) { const int v = 32 * vb + 8 * q + 4 * hh; const uint2 w = *(const uint2*)(yrow + v);
            acc[vb][4 * q] += bf2f((bf16)(w.x & 0xffff)); acc[vb][4 * q + 1] += bf2f((bf16)(w.x >> 16)); acc[vb][4 * q + 2] += bf2f((bf16)(w.y & 0xffff)); acc[vb][4 * q + 3] += bf2f((bf16)(w.y >> 16));
            s += (acc[vb][4 * q] + acc[vb][4 * q + 1]) + (acc[vb][4 * q + 2] + acc[vb][4 * q + 3]); }
    s += __shfl_xor(s, 32);
    const float mean = s * (1.0f / 64.0f); float qq = 0.f;
#pragma unroll
    for (int vb = 0; vb < 2; ++vb)
#pragma unroll
        for (int r = 0; r < 16; ++r) { acc[vb][r] -= mean; qq += acc[vb][r] * acc[vb][r]; }
    qq += __shfl_xor(qq, 32);
    const float rstd = 1.0f / sqrtf(qq * (1.0f / 64.0f) + 64e-5f);
#pragma unroll
    for (int vb = 0; vb < 2; ++vb)
#pragma unroll
        for (int q = 0; q < 4; ++q) { const int v = 32 * vb + 8 * q + 4 * hh; const uint2 gw = *(const uint2*)(grow + v); const uint2 bw = *(const uint2*)(bvrow + v); float o[4];
            const float g4[4] = {bf2f((bf16)(gw.x & 0xffff)), bf2f((bf16)(gw.x >> 16)), bf2f((bf16)(gw.y & 0xffff)), bf2f((bf16)(gw.y >> 16))};
            const float b4[4] = {bf2f((bf16)(bw.x & 0xffff)), bf2f((bf16)(bw.x >> 16)), bf2f((bf16)(bw.y & 0xffff)), bf2f((bf16)(bw.y >> 16))};
#pragma unroll
            for (int e = 0; e < 4; ++e) o[e] = (acc[vb][4 * q + e] * rstd * lnw[v + e] + lnb[v + e] + b4[e]) * g4[e];
            uint2 w; w.x = pk2(o[0], o[1]); w.y = pk2(o[2], o[3]); *(uint2*)(yrow + v) = w; }
    __syncthreads();
}
__device__ __forceinline__ void gdn_m1(const Params& P, int l, int ci, LAS unsigned char* lds, int tid) {
    const bf16* cols = (const bf16*)(P.ws + WS_COLS); bf16* Y = (bf16*)(P.ws + WS_Y);
    bf16* XP = (bf16*)(P.ws + WS_DP); bf16* XQ = (bf16*)(P.ws + WS_DQ); bf16* XR = (bf16*)(P.ws + WS_DR); float* XG = (float*)(P.ws + WS_XG) + 1024 * 64;
    LAS bf16* tKn = (LAS bf16*)lds; LAS bf16* tQn = tKn + 64 * TS; LAS bf16* tBV = tQn + 64 * TS; LAS bf16* tBK = tBV + 64 * TS; LAS bf16* tKd = tBK + 64 * TS;
    LAS bf16* tAab = tKd + 64 * TS; LAS bf16* tAabT = tAab + 64 * TS; LAS bf16* tX1r = tAabT + 64 * TS; LAS bf16* tX1c = tX1r + 64 * TS; LAS bf16* tT0 = tX1c + 64 * TS; LAS bf16* tT1 = tT0 + 64 * TS; LAS bf16* tQk = tT1 + 64 * TS;
    LAS bf16* tW = tAab; LAS bf16* tU = tAabT; LAS bf16* tT = tT1;
    LAS float* sG = (LAS float*)(lds + 12 * TILE_B); LAS float* sGc = sG + 64; LAS float* sBe = sGc + 64;
    const float* cw = P.in[I_CONV] + (size_t)l * 4 * 768;
#pragma unroll 1
    for (int h = 0; h < 4; ++h) {
        int tidh = tid, t0 = ci * 64; asm volatile("" : "+v"(tidh), "+s"(t0));
        const int lane = tidh & 63, wv = tidh >> 6; const size_t ch = (size_t)ci * 4 + h;
        const float alog = P.in[I_ALOG][l * 4 + h], dtb = P.in[I_DTB][l * 4 + h];
        float e_q[8], e_k[8], e_v[8], e_be[8];
        {   float cwv[3][4];
#pragma unroll
            for (int a = 0; a < 3; ++a)
#pragma unroll
                for (int i = 0; i < 4; ++i) cwv[a][i] = cw[i * 768 + a * 256 + h * 64 + lane];
            float win[3][3];
#pragma unroll
            for (int a = 0; a < 3; ++a)
#pragma unroll
                for (int i = 0; i < 3; ++i) { const int ts = t0 + wv * 8 - 3 + i; win[a][i] = (ts >= 0) ? ldcol(cols, ts, C_GDN + a * 256 + h * 64 + lane) : 0.f; }
#pragma unroll
            for (int i = 0; i < 8; ++i) { const int tt = t0 + wv * 8 + i; float o3[3];
#pragma unroll
                for (int a = 0; a < 3; ++a) { const float cur = ldcol(cols, tt, C_GDN + a * 256 + h * 64 + lane);
                    const float acc = cwv[a][0] * win[a][0] + cwv[a][1] * win[a][1] + cwv[a][2] * win[a][2] + cwv[a][3] * cur;
                    win[a][0] = win[a][1]; win[a][1] = win[a][2]; win[a][2] = cur; o3[a] = siluf_(acc); }
                const float sq = wave_sum(o3[0] * o3[0]), sk = wave_sum(o3[1] * o3[1]);
                e_q[i] = o3[0] * (1.0f / sqrtf(sq + 1e-6f)) * 0.125f; e_k[i] = o3[1] * (1.0f / sqrtf(sk + 1e-6f)); e_v[i] = o3[2];
                const float braw = ldcol(cols, tt, C_GDN + 1024 + h), araw = ldcol(cols, tt, C_GDN + 1028 + h);
                e_be[i] = sigmoidf_(braw); const float g = -__expf(alog) * softplusf_(araw + dtb);
                if (lane == 0) { sG[wv * 8 + i] = g; sBe[wv * 8 + i] = e_be[i]; } }
        }
        __syncthreads();
        float gcs[8], gc63;
        { float run = 0.f;
#pragma unroll
            for (int s = 0; s < 64; ++s) { run += sG[s];
#pragma unroll
                for (int i = 0; i < 8; ++i) if (s == wv * 8 + i) gcs[i] = run; }
            gc63 = run; }
        if (tidh < 64) { float run = 0.f; for (int s = 0; s <= tidh; ++s) run += sG[s]; sGc[tidh] = run; XG[ch * 64 + tidh] = __expf(gc63); }
        float bk[8], kd[8], bv[8];
#pragma unroll
        for (int i = 0; i < 8; ++i) { const int t = wv * 8 + i;
            tKn[t * TS + lane] = (bf16)f2bf(e_k[i]); tQn[t * TS + lane] = (bf16)f2bf(e_q[i]);
            bv[i] = e_be[i] * e_v[i]; bk[i] = e_be[i] * e_k[i] * __expf(gcs[i]); kd[i] = e_k[i] * __expf(gc63 - gcs[i]); }
        { v4u w; w.x = pk2(bv[0], bv[1]); w.y = pk2(bv[2], bv[3]); w.z = pk2(bv[4], bv[5]); w.w = pk2(bv[6], bv[7]); *(LAS v4u*)(tBV + lane * TS + wv * 8) = w;
          w.x = pk2(bk[0], bk[1]); w.y = pk2(bk[2], bk[3]); w.z = pk2(bk[4], bk[5]); w.w = pk2(bk[6], bk[7]); *(LAS v4u*)(tBK + lane * TS + wv * 8) = w;
          w.x = pk2(kd[0], kd[1]); w.y = pk2(kd[2], kd[3]); w.z = pk2(kd[4], kd[5]); w.w = pk2(kd[6], kd[7]); *(LAS v4u*)(tKd + lane * TS + wv * 8) = w; }
        __syncthreads();
        { const int mat = wv >> 2, r = wv & 3; const int tb = (r == 0 || r == 3) ? 0 : 1, sb = (r == 0 || r == 1) ? 0 : 1;
            f32x16 acc = zero16(); const int c = lane & 31, hh = lane >> 5;
            if (r < 3) { mm_tile<4>(acc, tKn + sb * 32 * TS, (mat ? tQn : tKn) + tb * 32 * TS, lane);
                const int tI = 32 * tb + c; const float gct = sGc[tI], bet = sBe[tI];
#pragma unroll
                for (int q = 0; q < 16; ++q) { const int sI = 32 * sb + acc_i(q, hh);
                    if ((mat == 0) ? (sI >= tI) : (sI > tI)) acc[q] = 0.f;
                    else { const float dcy = __expf(gct - sGc[sI]); acc[q] = (mat == 0) ? (-bet * acc[q] * dcy) : (acc[q] * dcy); } } }
            if (mat == 0) { store_lane_major(tAab, 32 * tb, 32 * sb, acc, lane);
                if (r == 3) store_lane_major(tT1, 0, 32, acc, lane);
                else { store_reg_major(tAabT, 32 * sb, 32 * tb, acc, lane);
#pragma unroll
                    for (int q = 0; q < 16; ++q) if (32 * sb + acc_i(q, hh) == 32 * tb + c) acc[q] += 1.0f;
                    store_lane_major(tT0, 32 * tb, 32 * sb, acc, lane); } }
            else store_lane_major(tQk, 32 * tb, 32 * sb, acc, lane);
        }
        __syncthreads();
        { LAS bf16* const Xr[2] = {tAab, tX1r}; LAS bf16* const Xc[2] = {tAabT, tX1c}; LAS bf16* const Tb[2] = {tT0, tT1};
          neumann_solve(Xr, Xc, Tb, wv, lane, [&]() {}); }
        { const int which = wv >> 2, tb = (wv >> 1) & 1, jb2 = wv & 1; f32x16 acc = zero16();
            mm_tile<4>(acc, tT + tb * 32 * TS, (which ? tBV : tBK) + jb2 * 32 * TS, lane);
            store_lane_major(which ? tU : tW, 32 * jb2, 32 * tb, acc, lane); }
        __syncthreads();
        for (int jb = wv; jb < 16; jb += 8) { const int out = jb >> 2, ib = (jb >> 1) & 1, jb2 = jb & 1; f32x16 acc = zero16(); const int c = lane & 31, hh = lane >> 5;
            if (out < 2) mm_tile<4>(acc, tKd + ib * 32 * TS, (out ? tU : tW) + jb2 * 32 * TS, lane);
            else mm_tile<4>(acc, tQk + ib * 32 * TS, (out == 3 ? tU : tW) + jb2 * 32 * TS, lane);
            if (out < 2) { bf16* g = (out == 0 ? XP : XQ) + ch * 4096 + 32 * jb2 + c; const float sg = (out == 0) ? -1.0f : 1.0f;
#pragma unroll
                for (int q = 0; q < 16; ++q) { const int row = 32 * ib + acc_i(q, hh); g[row * 64] = (bf16)f2bf(acc[q] * sg); } }
            else if (out == 2) { bf16* g = XR + ch * 4096 + 32 * jb2 + c;
#pragma unroll
                for (int q = 0; q < 16; ++q) { const int row = 32 * ib + acc_i(q, hh); g[row * 64] = (bf16)f2bf(bf2f(tQn[row * TS + 32 * jb2 + c]) * __expf(sGc[row]) - acc[q]); } }
            else { bf16* g = Y + (size_t)t0 * 1024 + 256 + h * 64 + 32 * jb2 + c;
#pragma unroll
                for (int q = 0; q < 16; ++q) { const int row = 32 * ib + acc_i(q, hh); g[(size_t)row * 1024] = (bf16)f2bf(acc[q]); } }
        }
        __syncthreads();
    }
}
__device__ __forceinline__ void gdn_m3(const Params& P, int l, int ci, LAS unsigned char* lds, int tid) {
    const bf16* cols = (const bf16*)(P.ws + WS_COLS); bf16* Y = (bf16*)(P.ws + WS_Y); const bf16* XQ = (const bf16*)(P.ws + WS_DQ); const bf16* XR = (const bf16*)(P.ws + WS_DR);
    const float* ng = P.in[I_GDNG] + l * 64;
    const int lane = tid & 63, wv = tid >> 6, t0 = ci * 64;
    dplr_m3_stage(XQ, ci, lds, tid);
    __syncthreads();
    const int h = wv >> 1, tb = wv & 1, c = lane & 31, hh = lane >> 5; const size_t ch = (size_t)ci * 4 + h;
    f32x16 acc[2];
    dplr_m3_core(acc, (const LAS bf16*)(lds + h * TILE_B), XR + ch * 4096, tb, lane);
    const size_t trow = (size_t)(t0 + 32 * tb + c);
    bf16* yrow = Y + trow * 1024 + 256 + h * 64; const bf16* zrow = cols + trow * NPAD + C_GDN + 768 + h * 64;
    float ss = 0.f;
#pragma unroll
    for (int vb = 0; vb < 2; ++vb)
#pragma unroll
        for (int q = 0; q < 4; ++q) { const int v = 32 * vb + 8 * q + 4 * hh; const uint2 w = *(const uint2*)(yrow + v);
            acc[vb][4 * q] += bf2f((bf16)(w.x & 0xffff)); acc[vb][4 * q + 1] += bf2f((bf16)(w.x >> 16)); acc[vb][4 * q + 2] += bf2f((bf16)(w.y & 0xffff)); acc[vb][4 * q + 3] += bf2f((bf16)(w.y >> 16));
#pragma unroll
            for (int e = 0; e < 4; ++e) ss += acc[vb][4 * q + e] * acc[vb][4 * q + e]; }
    ss += __shfl_xor(ss, 32);
    const float rstd = 1.0f / sqrtf(ss * (1.0f / 64.0f) + 1e-6f);
#pragma unroll
    for (int vb = 0; vb < 2; ++vb)
#pragma unroll
        for (int q = 0; q < 4; ++q) { const int v = 32 * vb + 8 * q + 4 * hh; const uint2 zw = *(const uint2*)(zrow + v); float o[4];
            const float z4[4] = {bf2f((bf16)(zw.x & 0xffff)), bf2f((bf16)(zw.x >> 16)), bf2f((bf16)(zw.y & 0xffff)), bf2f((bf16)(zw.y >> 16))};
#pragma unroll
            for (int e = 0; e < 4; ++e) o[e] = acc[vb][4 * q + e] * rstd * ng[v + e] * siluf_(z4[e]);
            uint2 w; w.x = pk2(o[0], o[1]); w.y = pk2(o[2], o[3]); *(uint2*)(yrow + v) = w; }
    __syncthreads();
}
__device__ __forceinline__ void sgu_m3(const Params& P, int l, int ci, LAS unsigned char* lds, int tid) {
    const bf16* cols = (const bf16*)(P.ws + WS_COLS); bf16* Y = (bf16*)(P.ws + WS_Y);
    LAS float* sVl = (LAS float*)lds;
    const int lane = tid & 63, wv = tid >> 6, half = ci & 1, tbase = (ci >> 1) * 128, ntok = half ? 128 : 64;
    const float* lg = P.in[I_SLG] + l * 256; const float* lb = P.in[I_SLB] + l * 256;
    const float* ws_ = P.in[I_SWS] + (size_t)l * 4 * 128 * 128; const float* bs_ = P.in[I_SBS] + l * 4 * 128;
#pragma unroll 1
    for (int t = wv; t < ntok; t += 8) { float v[4]; float s = 0.f;
#pragma unroll
        for (int e = 0; e < 4; ++e) { v[e] = geluf_(ldcol(cols, tbase + t, C_SGU + 256 + lane * 4 + e)); s += v[e]; }
        const float mean = wave_sum(s) * (1.0f / 256.0f); float q = 0.f;
#pragma unroll
        for (int e = 0; e < 4; ++e) { v[e] -= mean; q += v[e] * v[e]; }
        const float rstd = 1.0f / sqrtf(wave_sum(q) * (1.0f / 256.0f) + 1e-5f);
#pragma unroll
        for (int e = 0; e < 4; ++e) sVl[t * 256 + lane * 4 + e] = v[e] * rstd * lg[lane * 4 + e] + lb[lane * 4 + e]; }
    __syncthreads();
    const int g = lane >> 4;
#pragma unroll 1
    for (int i = 0; i < 8; ++i) { const int t = 64 * half + wv + 8 * i; const float* wr = ws_ + ((size_t)g * 128 + t) * 128; f32x4 acc = {0.f, 0.f, 0.f, 0.f};
#pragma unroll 4
        for (int s = 0; s <= t; ++s) { const float w = wr[s]; const f32x4 vv = *(const LAS f32x4*)(sVl + s * 256 + lane * 4); acc += vv * w; }
        const float b = bs_[g * 128 + t]; float o[4];
#pragma unroll
        for (int e = 0; e < 4; ++e) o[e] = geluf_(ldcol(cols, tbase + t, C_SGU + lane * 4 + e)) * (acc[e] + b);
        uint2 w2; w2.x = pk2(o[0], o[1]); w2.y = pk2(o[2], o[3]); *(uint2*)(Y + (size_t)(tbase + t) * 1024 + 768 + lane * 4) = w2; }
    __syncthreads();
}
#define GRID_SYNC() grid.sync()
__global__ void __launch_bounds__(NT, 2) fwd_kernel(Params P) {
    extern __shared__ __attribute__((aligned(16))) unsigned char lds_raw[];
    cg::grid_group grid = cg::this_grid();
    LAS unsigned char* ldsl = (LAS unsigned char*)lds_raw;
    const int G = gridDim.x;
#define PHASE_TID() int tid = threadIdx.x; asm volatile("" : "+v"(tid)); const int lane = tid & 63, wave = __builtin_amdgcn_readfirstlane(tid >> 6); const int gw = blockIdx.x * NWAVES + wave, NGW = G * NWAVES; (void)lane; (void)gw; (void)NGW
    {
        PHASE_TID();
        prologue_weights(P, 0, 15, (float*)lds_raw, gw, NGW, wave, lane);
        prologue_rows(P, gw, NGW, lane);
    }
    GRID_SYNC();
#pragma unroll 1
    for (int l_ = 0; l_ < DEPTH; ++l_) {
        int l = l_; asm volatile("" : "+s"(l));
        bf16* XB = (bf16*)(P.ws + WS_XB); bf16* YB = (bf16*)(P.ws + WS_Y); bf16* HB = (bf16*)(P.ws + WS_H); bf16* COLS = (bf16*)(P.ws + WS_COLS); float* SSQ = (float*)(P.ws + WS_SSQ);
        const unsigned char* wb = P.ws + WS_W;
        {
            pg8::Gemm g{XB, (const bf16*)(wb + W_IN), T, NPAD, D}; pg8::StaticOrder S; S.init(T, NPAD, G, (int)blockIdx.x);
            pg8::EpiScaleBf16<0> E{COLS, NPAD, SSQ};
            pg8::gemm_phase<pg8::EpiScaleBf16<0>, pg8::StaticOrder, true, true>(ldsl, g, S, E);
        }
        GRID_SYNC();
        {
            PHASE_TID();
            for (int ci = blockIdx.x; ci < T / 64; ci += G) {
#ifndef NO_RWKV1
                rwkv_m1(P, l, ci, ldsl, tid);
#endif
#ifndef NO_GDN1
                gdn_m1(P, l, ci, ldsl, tid);
#endif
#ifndef NO_GLA1
                gla_m1(P, l, ci, ldsl, tid);
#endif
            }
        }
        GRID_SYNC();
        {
            PHASE_TID();
            const int b = blockIdx.x;
#ifndef NO_M2
            if (b < 16) { if (wave == 0) dplr_m2((const bf16*)(P.ws + WS_RP), (bf16*)(P.ws + WS_RQ), (const float*)(P.ws + WS_XG), b >> 2, b & 3, lane); }
            else if (b < 32) { if (wave == 0) dplr_m2((const bf16*)(P.ws + WS_DP), (bf16*)(P.ws + WS_DQ), (const float*)(P.ws + WS_XG) + 1024 * 64, (b - 16) >> 2, b & 3, lane); }
            else if (b < 48) gla_m2(P, (b - 32) * NT + tid);
            else if (l == 0) prologue_weights(P, 1, 1, (float*)lds_raw, (b - 48) * NWAVES + wave, (G - 48) * NWAVES, wave, lane);
            else prologue_weights(P, 1, 14, (float*)lds_raw, (b - 48) * NWAVES + wave, (G - 48) * NWAVES, wave, lane);
#endif
        }
        GRID_SYNC();
        {
            PHASE_TID();
            for (int ci = blockIdx.x; ci < T / 64; ci += G) {
#ifndef NO_M3
                rwkv_m3(P, l, ci, ldsl, tid); gdn_m3(P, l, ci, ldsl, tid); gla_m3(P, l, ci, ldsl, tid); sgu_m3(P, l, ci, ldsl, tid);
#endif
            }
        }
        GRID_SYNC();
        {
            pg8::Gemm g{YB, (const bf16*)(wb + W_OUT), T, D, D}; pg8::StaticOrder S; S.init(T, D, G, (int)blockIdx.x);
            pg8::EpiResid E{l == 0 ? P.in[I_X] : (const float*)P.out, P.out, XB, SSQ};
            pg8::gemm_phase<pg8::EpiResid, pg8::StaticOrder, true, true>(ldsl, g, S, E);
        }
        GRID_SYNC();
        {
            pg8::Gemm g{XB, (const bf16*)(wb + W_UP), T, FF, D}; pg8::StaticOrder S; S.init(T, FF, G, (int)blockIdx.x);
            pg8::EpiScaleBf16<2> E{HB, FF, SSQ};
            pg8::gemm_phase<pg8::EpiScaleBf16<2>, pg8::StaticOrder, true, true>(ldsl, g, S, E);
        }
        GRID_SYNC();
        {
            pg8::Gemm g{HB, (const bf16*)(wb + W_DN), T, D, FF}; pg8::StaticOrder S; S.init(T, D, G, (int)blockIdx.x);
            pg8::EpiResid E{(const float*)P.out, P.out, XB, SSQ};
            pg8::gemm_phase<pg8::EpiResid, pg8::StaticOrder, true, true>(ldsl, g, S, E);
        }
        GRID_SYNC();
    }
    { PHASE_TID(); final_norm(P, gw, NGW, lane); }
}

extern "C" void kernel_launch(void* const* d_in, const int* in_sizes, int n_in, void* d_out, int out_size, void* d_ws, size_t ws_size, hipStream_t stream) {
    static int grid_blocks = 0;
    if (!grid_blocks) {
        int dev = 0, cus = 0, per_cu = 0;
        if (n_in != 33 || out_size != T * D || ws_size < WS_END) { fprintf(stderr, "kernel_launch: unexpected shapes n_in %d out %d ws %zu\n", n_in, out_size, ws_size); grid_blocks = -1; return; }
        (void)hipGetDevice(&dev);
        (void)hipDeviceGetAttribute(&cus, hipDeviceAttributeMultiprocessorCount, dev);
        (void)hipFuncSetAttribute((const void*)fwd_kernel, hipFuncAttributeMaxDynamicSharedMemorySize, LDS_BYTES);
        (void)hipOccupancyMaxActiveBlocksPerMultiprocessor(&per_cu, (const void*)fwd_kernel, NT, LDS_BYTES);
        if (per_cu < 1) fprintf(stderr, "kernel_launch: occupancy query says %d blocks/CU\n", per_cu);
        grid_blocks = cus;
        (void)hipGetLastError();
    }
    if (grid_blocks < 0) return;
    Params p{};
    for (int i = 0; i < 33; ++i) p.in[i] = (const float*)d_in[i];
    p.out = (float*)d_out; p.ws = (unsigned char*)d_ws;
    void* args[] = {&p};
    hipError_t e = hipLaunchCooperativeKernel((void*)fwd_kernel, dim3(grid_blocks), dim3(NT), args, LDS_BYTES, stream);
    if (e != hipSuccess) fprintf(stderr, "cooperative launch failed: %s (grid %d)\n", hipGetErrorString(e), grid_blocks);
}
```

```cpp
#include <hip/hip_runtime.h>
#include <hip/hip_cooperative_groups.h>
#include <cstdio>
#include <cstdint>
namespace cg = cooperative_groups;
namespace pg8 {
#define PG8_LAS __attribute__((address_space(3)))
typedef unsigned short bf16_t;
typedef short bf16x8 __attribute__((ext_vector_type(8)));
typedef float f32x4 __attribute__((ext_vector_type(4)));
typedef unsigned u32x4 __attribute__((ext_vector_type(4)));
constexpr int BM = 256, BK = 64, HALF = 128, HTB = HALF * BK * 2  , STAGE_BYTES = 8 * HTB, NXCD = 8, WGM = 8;

__host__ __device__ __forceinline__ int lds_byte(int r, int c) { const int st = (r >> 4) * 2 + (c >> 5), rr = r & 15, cc = c & 31, ob = rr * 64 + cc * 2; return st * 1024 + (ob ^ (((ob >> 9) & 1) << 5)); }
__host__ __device__ __forceinline__ void stage_rc(int b, int& R, int& C) { const int st = b / 1024, sb = b % 1024, swz = sb ^ (((sb >> 9) & 1) << 5); R = (st >> 1) * 16 + swz / 64; C = (st & 1) * 32 + (swz % 64) / 2; }
__host__ __device__ __forceinline__ int perm32(int rho) { const int n = rho >> 4, i = rho & 15; return 8 * (i >> 2) + 4 * n + (i & 3); }

struct Unit { int pm, pn; };
struct Gemm { const bf16_t* A; const bf16_t* Bt; int M, N, K; };

struct StaticOrder {
    int nM, nN, nwg, G, c;
    __host__ __device__ void init(int M, int N, int G_, int c_) { nM = M / BM; nN = N / BM; nwg = nM * nN; G = G_; c = c_; }
    __host__ __device__ bool next(int i, Unit& u) const {
        const long L = (long)i * G + c; if (L >= nwg) return false;
        int wgid = (int)L; { const int q = nwg / NXCD, r = nwg % NXCD, xcd = wgid % NXCD, off = wgid / NXCD; wgid = (xcd < r ? xcd * (q + 1) : r * (q + 1) + (xcd - r) * q) + off; }
        const int nig = WGM * nN, gid = wgid / nig, fm = gid * WGM, gsz = (nM - fm) < WGM ? (nM - fm) : WGM;
        u.pm = fm + ((wgid % nig) % gsz); u.pn = (wgid % nig) / gsz; return true;
    }
    __device__ __forceinline__ void a_ready(const Unit&) const {}
    __device__ __forceinline__ void done(const Unit&) const {}
};

__device__ __forceinline__ unsigned cvt_pk_bf16(float lo, float hi) { unsigned r; asm volatile("v_cvt_pk_bf16_f32 %0, %1, %2" : "=v"(r) : "v"(lo), "v"(hi)); return r; }
typedef float f32x2 __attribute__((ext_vector_type(2)));
__device__ __forceinline__ float row_rstd16(const float* ssq, int row) {
    const f32x4* p = (const f32x4*)(ssq + (size_t)row * 16);
    const f32x4 a = p[0], b = p[1], c = p[2], d = p[3];
    const float s = ((a[0] + a[1]) + (a[2] + a[3])) + ((b[0] + b[1]) + (b[2] + b[3])) + ((c[0] + c[1]) + (c[2] + c[3])) + ((d[0] + d[1]) + (d[2] + d[3]));
    return 1.0f / sqrtf(s * (1.0f / 1024.0f) + 1e-6f);
}
template <int ACT> struct EpiScaleBf16 {
    static constexpr bool PERM = true, AFTER_DRAIN = false;
    bf16_t* O; int ldc; const float* ssq;
    __device__ __forceinline__ void operator()(const f32x4 (&acc)[2][2][4][2], const Unit& u, int wr, int wc, int fr, int fq) const {
        const int row0 = u.pm * BM + wr * 64 + fr; const int col0 = u.pn * BM + wc * 32 + 8 * fq;
#pragma unroll
        for (int ai = 0; ai < 2; ++ai)
#pragma unroll
            for (int m = 0; m < 4; ++m) { const int row = row0 + ai * HALF + m * 16; const float sc = row_rstd16(ssq, row); bf16_t* rowp = O + (size_t)row * ldc + col0;
#pragma unroll
                for (int bj = 0; bj < 2; ++bj) { f32x4 v0 = acc[ai][bj][m][0] * sc, v1 = acc[ai][bj][m][1] * sc;
                    if (ACT == 2) {
#pragma unroll
                        for (int e = 0; e < 4; ++e) { const float a0 = v0[e] > 0.f ? v0[e] : 0.f, a1 = v1[e] > 0.f ? v1[e] : 0.f; v0[e] = a0 * a0; v1[e] = a1 * a1; } }
                    u32x4 w; w.x = cvt_pk_bf16(v0[0], v0[1]); w.y = cvt_pk_bf16(v0[2], v0[3]); w.z = cvt_pk_bf16(v1[0], v1[1]); w.w = cvt_pk_bf16(v1[2], v1[3]);
                    *(u32x4*)(rowp + bj * HALF) = w; } }
    }
};
struct EpiResid {
    static constexpr bool PERM = false, AFTER_DRAIN = false;
    const float* base; float* out; bf16_t* xb; float* ssq;
    __device__ __forceinline__ void operator()(const f32x4 (&acc)[2][2][4][2], const Unit& u, int wr, int wc, int fr, int fq) const {
        typedef unsigned u32x2v __attribute__((ext_vector_type(2)));
        const int row0 = u.pm * BM + wr * 64 + fr; const int col0 = u.pn * BM + wc * 32 + 4 * fq;
#pragma unroll
        for (int ai = 0; ai < 2; ++ai)
#pragma unroll
            for (int m = 0; m < 4; ++m) { const int row = row0 + ai * HALF + m * 16; const size_t off = (size_t)row * 1024 + col0; float s = 0.f;
#pragma unroll
                for (int bj = 0; bj < 2; ++bj)
#pragma unroll
                    for (int n = 0; n < 2; ++n) { const f32x4 bs = *(const f32x4*)(base + off + bj * HALF + n * 16); const f32x4 o = bs + acc[ai][bj][m][n];
                        *(f32x4*)(out + off + bj * HALF + n * 16) = o; s += (o[0] * o[0] + o[1] * o[1]) + (o[2] * o[2] + o[3] * o[3]);
                        u32x2v w; w.x = cvt_pk_bf16(o[0], o[1]); w.y = cvt_pk_bf16(o[2], o[3]); *(u32x2v*)(xb + off + bj * HALF + n * 16) = w; }
                s += __shfl_xor(s, 16); s += __shfl_xor(s, 32);
                if (fq == 0) ssq[(size_t)row * 16 + u.pn * 4 + wc] = s; }
    }
};
template <class Epi, class Sched, bool ALIGN_EPI = false, bool SP2 = false>
__device__ __forceinline__ void gemm_phase(PG8_LAS unsigned char* lds, const Gemm g, const Sched& S, const Epi& E) {
    int tid_o = threadIdx.x; asm volatile("" : "+v"(tid_o));
    const int tid = tid_o, wid = __builtin_amdgcn_readfirstlane(tid >> 6), lane = tid & 63, wr = wid >> 2, wc = wid & 3, fr = lane & 15, fq = lane >> 4;
    const int K = g.K, nt = K / BK;
    unsigned voffA[2], voffB[2];
#pragma unroll
    for (int i = 0; i < 2; ++i) { int R, C; stage_rc(tid * 16 + i * 8192, R, C); const int Rb = Epi::PERM ? ((R & ~31) + perm32(R & 31)) : R;
        voffA[i] = (unsigned)(R * K + C) * 2u; voffB[i] = (unsigned)(Rb * K + C) * 2u; }
    const size_t kstep = (size_t)(BK * 2);
    const size_t hstep = (size_t)HALF * K * 2;
    const size_t tstep = 2 * hstep;
    const unsigned ldsw = (unsigned)wid * 1024u;
    const int aoff = lds_byte(wr * 64 + fr, fq * 8), boff = lds_byte(wc * 32 + fr, fq * 8);
#define PG8_SA(b, h) (((b) * 2 + (h)) * HTB)
#define PG8_SB(b, h) ((4 + (b) * 2 + (h)) * HTB)
#define PG8_STAGE(bufoff, gbase, voff) do { _Pragma("unroll") for (int _i = 0; _i < 2; ++_i) \
        __builtin_amdgcn_global_load_lds((const unsigned*)((const char*)(gbase) + (voff)[_i]), (PG8_LAS unsigned*)(lds + (bufoff) + ldsw + _i * 8192), 16, 0, 0); } while (0)
#define PG8_LDA(dst, b, h) do { _Pragma("unroll") for (int m = 0; m < 4; ++m) _Pragma("unroll") for (int k = 0; k < 2; ++k) dst[m][k] = *(const PG8_LAS bf16x8*)(lds + PG8_SA(b, h) + aoff + m * 2048 + k * 1024); } while (0)
#define PG8_LDB(dst, b, h) do { _Pragma("unroll") for (int n = 0; n < 2; ++n) _Pragma("unroll") for (int k = 0; k < 2; ++k) dst[n][k] = *(const PG8_LAS bf16x8*)(lds + PG8_SB(b, h) + boff + n * 2048 + k * 1024); } while (0)
#define PG8_MMA(ai, bj, At, Bt) do { __builtin_amdgcn_s_setprio(1); _Pragma("unroll") for (int m = 0; m < 4; ++m) _Pragma("unroll") for (int n = 0; n < 2; ++n) _Pragma("unroll") for (int k = 0; k < 2; ++k) \
        acc[ai][bj][m][n] = __builtin_amdgcn_mfma_f32_16x16x32_bf16(Bt[n][k], At[m][k], acc[ai][bj][m][n], 0, 0, 0); __builtin_amdgcn_s_setprio(0); } while (0)
#define PG8_WAIT_V(n) asm volatile("s_waitcnt vmcnt(" #n ")" ::: "memory")
#define PG8_WAIT_L(n) asm volatile("s_waitcnt lgkmcnt(" #n ")" ::: "memory")
#define PG8_BAR __builtin_amdgcn_s_barrier()
#define PG8_SCHED __builtin_amdgcn_sched_barrier(0)
    Unit cur, nxt; int ui = 0;
    if (!S.next(0, cur)) return;
    f32x4 acc[2][2][4][2];
#pragma unroll
    for (int a = 0; a < 2; ++a)
#pragma unroll
        for (int b = 0; b < 2; ++b)
#pragma unroll
            for (int m = 0; m < 4; ++m)
#pragma unroll
                for (int n = 0; n < 2; ++n) acc[a][b][m][n] = (f32x4){0.f, 0.f, 0.f, 0.f};
    bf16x8 At[4][2], B0[2][2], B1[2][2];
    const char* cA = (const char*)g.A + (size_t)cur.pm * tstep; const char* cB = (const char*)g.Bt + (size_t)cur.pn * tstep;
    S.a_ready(cur);
    if constexpr (SP2) {
        PG8_STAGE(PG8_SB(0, 0), cB, voffB); PG8_STAGE(PG8_SB(0, 1), cB + hstep, voffB); PG8_STAGE(PG8_SA(0, 0), cA, voffA); PG8_STAGE(PG8_SA(0, 1), cA + hstep, voffA);
        if (wr == 1) PG8_BAR;
        PG8_WAIT_V(2); PG8_BAR;
        PG8_STAGE(PG8_SB(1, 0), cB + kstep, voffB); PG8_STAGE(PG8_SA(1, 0), cA + kstep, voffA); PG8_STAGE(PG8_SB(1, 1), cB + hstep + kstep, voffB);
        PG8_WAIT_V(6); PG8_BAR;
    } else {
        PG8_STAGE(PG8_SB(0, 0), cB, voffB); PG8_STAGE(PG8_SA(0, 0), cA, voffA); PG8_STAGE(PG8_SB(0, 1), cB + hstep, voffB); PG8_STAGE(PG8_SA(0, 1), cA + hstep, voffA);
        if (wr == 1) PG8_BAR;
        PG8_WAIT_V(4); PG8_BAR;
        PG8_STAGE(PG8_SB(1, 0), cB + kstep, voffB); PG8_STAGE(PG8_SA(1, 0), cA + kstep, voffA); PG8_STAGE(PG8_SB(1, 1), cB + hstep + kstep, voffB);
        PG8_WAIT_V(6); PG8_BAR;
    }
    for (;;) {
        const bool has_next = S.next(ui + 1, nxt);
        const char* nA = has_next ? (const char*)g.A + (size_t)nxt.pm * tstep : cA; const char* nB = has_next ? (const char*)g.Bt + (size_t)nxt.pn * tstep : cB;
        for (int t = 0; t < nt; t += 2) {
            const bool last = (t == nt - 2);
            const char* a1 = cA + (size_t)(t + 1) * kstep;
            const char* a2 = last ? nA : cA + (size_t)(t + 2) * kstep; const char* b2 = last ? nB : cB + (size_t)(t + 2) * kstep;
            const char* a3 = a2 + kstep; const char* b3 = b2 + kstep;
            if (last && has_next) S.a_ready(nxt);
            if constexpr (SP2) {
            PG8_LDB(B0, 0, 0); PG8_LDB(B1, 0, 1); PG8_SCHED; PG8_LDA(At, 0, 0); PG8_STAGE(PG8_SA(1, 1), a1 + hstep, voffA);
            PG8_WAIT_V(8); PG8_WAIT_L(0); PG8_BAR; PG8_MMA(0, 0, At, B0); PG8_MMA(0, 1, At, B1); PG8_BAR; PG8_SCHED;
            PG8_LDA(At, 0, 1); PG8_STAGE(PG8_SB(0, 0), b2, voffB); PG8_STAGE(PG8_SB(0, 1), b2 + hstep, voffB); PG8_STAGE(PG8_SA(0, 0), a2, voffA);
            PG8_WAIT_V(8); PG8_WAIT_L(0); PG8_BAR; PG8_MMA(1, 0, At, B0); PG8_MMA(1, 1, At, B1); PG8_BAR; PG8_SCHED;
            PG8_LDB(B0, 1, 0); PG8_LDB(B1, 1, 1); PG8_SCHED; PG8_LDA(At, 1, 0); PG8_STAGE(PG8_SA(0, 1), a2 + hstep, voffA);
            PG8_WAIT_V(8); PG8_WAIT_L(0); PG8_BAR; PG8_MMA(0, 0, At, B0); PG8_MMA(0, 1, At, B1); PG8_BAR; PG8_SCHED;
            PG8_LDA(At, 1, 1); PG8_STAGE(PG8_SB(1, 0), b3, voffB); PG8_STAGE(PG8_SB(1, 1), b3 + hstep, voffB); PG8_STAGE(PG8_SA(1, 0), a3, voffA);
            PG8_WAIT_V(8); PG8_WAIT_L(0); PG8_BAR; PG8_MMA(1, 0, At, B0); PG8_MMA(1, 1, At, B1); PG8_BAR; PG8_SCHED;
            } else {
            PG8_LDB(B0, 0, 0); PG8_SCHED; PG8_LDA(At, 0, 0); PG8_STAGE(PG8_SA(1, 1), a1 + hstep, voffA);
            PG8_WAIT_L(8); PG8_BAR; PG8_WAIT_L(0); PG8_MMA(0, 0, At, B0); PG8_BAR; PG8_SCHED;
            PG8_LDB(B1, 0, 1); PG8_STAGE(PG8_SB(0, 0), b2, voffB);
            PG8_BAR; PG8_WAIT_L(0); PG8_MMA(0, 1, At, B1); PG8_BAR;
            PG8_LDA(At, 0, 1); PG8_STAGE(PG8_SA(0, 0), a2, voffA);
            PG8_BAR; PG8_WAIT_L(0); PG8_MMA(1, 0, At, B0); PG8_BAR; PG8_SCHED;
            PG8_STAGE(PG8_SB(0, 1), b2 + hstep, voffB);
            PG8_WAIT_V(6); PG8_BAR; PG8_MMA(1, 1, At, B1); PG8_BAR;
            PG8_LDB(B0, 1, 0); PG8_SCHED; PG8_LDA(At, 1, 0); PG8_STAGE(PG8_SA(0, 1), a2 + hstep, voffA);
            PG8_WAIT_L(8); PG8_BAR; PG8_WAIT_L(0); PG8_MMA(0, 0, At, B0); PG8_BAR; PG8_SCHED;
            PG8_LDB(B1, 1, 1); PG8_STAGE(PG8_SB(1, 0), b3, voffB);
            PG8_BAR; PG8_WAIT_L(0); PG8_MMA(0, 1, At, B1); PG8_BAR;
            PG8_LDA(At, 1, 1); PG8_STAGE(PG8_SA(1, 0), a3, voffA);
            PG8_BAR; PG8_WAIT_L(0); PG8_MMA(1, 0, At, B0); PG8_BAR; PG8_SCHED;
            PG8_STAGE(PG8_SB(1, 1), b3 + hstep, voffB);
            PG8_WAIT_V(6); PG8_BAR; PG8_MMA(1, 1, At, B1); PG8_BAR;
            }
        }
        if constexpr (ALIGN_EPI) { if (wr == 0) PG8_BAR; }
        if constexpr (!Epi::AFTER_DRAIN) { E(acc, cur, wr, wc, fr, fq); S.done(cur); }
        if (!has_next) break;
#pragma unroll
        for (int a = 0; a < 2; ++a)
#pragma unroll
            for (int b = 0; b < 2; ++b)
#pragma unroll
                for (int m = 0; m < 4; ++m)
#pragma unroll
                    for (int n = 0; n < 2; ++n) acc[a][b][m][n] = (f32x4){0.f, 0.f, 0.f, 0.f};
        cur = nxt; cA = nA; cB = nB; ++ui;
        if constexpr (ALIGN_EPI) { if (wr == 1) PG8_BAR; }
    }
    PG8_WAIT_V(0);
    if constexpr (!ALIGN_EPI) { if (wr == 0) PG8_BAR; }
    PG8_BAR;
    if constexpr (Epi::AFTER_DRAIN) { E.fused(acc, cur, wr, wc, fr, fq, lds, wid, lane); S.done(cur); }
#undef PG8_SA
#undef PG8_SB
#undef PG8_STAGE
#undef PG8_LDA
#undef PG8_LDB
#undef PG8_MMA
#undef PG8_WAIT_V
#undef PG8_WAIT_L
#undef PG8_BAR
#undef PG8_SCHED
}
}
constexpr int T = 16384, D = 1024, FF = 4096, DEPTH = 2;
constexpr int NIN = 3352, NPAD = 3584;
constexpr int C_RWKV = 0, C_GDN = 1024, C_GLA = 2056, C_SGU = 2840, C_VRES = 3352;
constexpr int NT = 512, NWAVES = 8;
constexpr int LDS_BYTES = 147456;
typedef unsigned short bf16;
typedef float f32x4 __attribute__((ext_vector_type(4)));
typedef unsigned v4u __attribute__((ext_vector_type(4)));
#define LAS __attribute__((address_space(3)))

constexpr size_t MiB = 1u << 20;
constexpr size_t WS_BAR = 0;
constexpr size_t WS_SSQ = 1 * MiB;
constexpr size_t WS_GAL = 2 * MiB;
constexpr size_t WS_XG = 2 * MiB + 256 * 1024;
constexpr size_t WS_W = 3 * MiB;
constexpr size_t W_LAYER = 0, W_IN = 0, W_OUT = 7 * MiB, W_UP = 9 * MiB, W_DN = 17 * MiB;
constexpr size_t WS_XB = 30 * MiB;
constexpr size_t WS_Y = 62 * MiB;
constexpr size_t WS_H = 94 * MiB;
constexpr size_t WS_COLS = 94 * MiB;
constexpr size_t WS_VF = 222 * MiB;
constexpr size_t WS_RP = 30 * MiB, WS_RQ = 38 * MiB, WS_RR = 46 * MiB, WS_RBV = 54 * MiB;
constexpr size_t WS_DP = 206 * MiB, WS_DQ = 214 * MiB, WS_DR = 230 * MiB;
constexpr size_t WS_GKV = 238 * MiB, WS_GQI = 246 * MiB;
constexpr size_t WS_LORA = 250 * MiB;
constexpr int LORA_W = 0, LORA_A = 256 * 64, LORA_G = 2 * 256 * 64, LORA_V = 2 * 256 * 64 + 256 * 128, LORA_LAYER = LORA_V + 256 * 32;
constexpr size_t WS_END = 251 * MiB;

__device__ __forceinline__ unsigned f2bf(float f) { unsigned u = __builtin_bit_cast(unsigned, f); return (u + 0x7fffu + ((u >> 16) & 1u)) >> 16; }
__device__ __forceinline__ unsigned pk2(float lo, float hi) { return f2bf(lo) | (f2bf(hi) << 16); }
__device__ __forceinline__ float bf2f(bf16 b) { return __builtin_bit_cast(float, (unsigned)b << 16); }
__device__ __forceinline__ float wave_sum(float v) {
#pragma unroll
    for (int o = 1; o < 64; o <<= 1) v += __shfl_xor(v, o);
    return v;
}
__device__ __forceinline__ float sigmoidf_(float x) { return 1.0f / (1.0f + __expf(-x)); }
__device__ __forceinline__ float softplusf_(float x) { return fmaxf(x, 0.f) + log1pf(__expf(-fabsf(x))); }
__device__ __forceinline__ float siluf_(float x) { return x * sigmoidf_(x); }
__device__ __forceinline__ float geluf_(float x) { const float u = 0.7978845608028654f * (x + 0.044715f * x * x * x); return 0.5f * x * (1.0f + tanhf(u)); }

struct Params { const float* in[33]; float* out; unsigned char* ws; };
enum { I_X = 0, I_WIN, I_WOUT, I_NMIX, I_NFFN, I_NFIN, I_MU, I_W0, I_WUP, I_A0, I_AUP, I_GUP, I_KK, I_KA, I_RK, I_LNW, I_LNB, I_V0, I_VDOWN, I_VUP,
       I_CONV, I_ALOG, I_DTB, I_GDNG, I_GKUP, I_GKB, I_GLAG, I_SLG, I_SLB, I_SWS, I_SBS, I_FUP, I_FDN };

__device__ __forceinline__ void transpose_item(const float* W, int K, int N, const float* gk, bf16* WT, int row_off, float* scr, int item, int lane) {
    const int nblk = (N + 31) / 32, kb = item / nblk, nb = item % nblk, k0 = 64 * kb, n0 = 32 * nb;
    const bool nok = (n0 + (lane & 31)) < N;
#pragma unroll 8
    for (int i = 0; i < 32; ++i) { const int kk = 2 * i + (lane >> 5); float v = 0.f; if (nok) v = W[(size_t)(k0 + kk) * N + n0 + (lane & 31)]; if (gk) v *= gk[k0 + kk]; scr[kk * 33 + (lane & 31)] = v; }
    __builtin_amdgcn_wave_barrier(); asm volatile("s_waitcnt lgkmcnt(0)" ::: "memory");
    const int c = lane & 7;
#pragma unroll
    for (int j = 0; j < 4; ++j) { const int n = (lane >> 3) + 8 * j; const float* s = scr + (8 * c) * 33 + n;
        v4u o; o.x = pk2(s[0 * 33], s[1 * 33]); o.y = pk2(s[2 * 33], s[3 * 33]); o.z = pk2(s[4 * 33], s[5 * 33]); o.w = pk2(s[6 * 33], s[7 * 33]);
        if (n0 + n < N) *(v4u*)(WT + (size_t)(row_off + n0 + n) * K + k0 + 8 * c) = o; }
    __builtin_amdgcn_wave_barrier(); asm volatile("s_waitcnt lgkmcnt(0)" ::: "memory");
}
__device__ __forceinline__ void prologue_weights(const Params& P, int l, int mask, float* lds, int gw, int NGW, int wave, int lane) {
    float* scr = lds + wave * 4096;
    unsigned char* wb = P.ws + WS_W;
    const int I_in = (mask & 1) ? (D / 64) * ((NIN + 31) / 32) : 0, I_vr = ((mask & 1) && l > 0) ? (D / 64) * 1 : 0, I_out = (mask & 2) ? (D / 64) * (D / 32) : 0, I_up = (mask & 4) ? (D / 64) * (FF / 32) : 0, I_dn = (mask & 8) ? (FF / 64) * (D / 32) : 0;
    const int NITEMS = I_in + I_vr + I_out + I_up + I_dn;
    for (int it = gw; it < NITEMS; it += NGW) {
        int r = it;
        if (r < I_in) { transpose_item(P.in[I_WIN] + (size_t)l * D * NIN, D, NIN, P.in[I_NMIX] + l * D, (bf16*)(wb + W_IN), 0, scr, r, lane); continue; } r -= I_in;
        if (r < I_vr) { transpose_item(P.in[I_VDOWN] + (size_t)(l - 1) * D * 32, D, 32, P.in[I_NMIX] + l * D, (bf16*)(wb + W_IN), NIN, scr, r, lane); continue; } r -= I_vr;
        if (r < I_out) { transpose_item(P.in[I_WOUT] + (size_t)l * D * D, D, D, nullptr, (bf16*)(wb + W_OUT), 0, scr, r, lane); continue; } r -= I_out;
        if (r < I_up) { transpose_item(P.in[I_FUP] + (size_t)l * D * FF, D, FF, P.in[I_NFFN] + l * D, (bf16*)(wb + W_UP), 0, scr, r, lane); continue; } r -= I_up;
        transpose_item(P.in[I_FDN] + (size_t)l * FF * D, FF, D, nullptr, (bf16*)(wb + W_DN), 0, scr, r, lane);
    }
}
__device__ __forceinline__ void prologue_lora(const Params& P, int gtid, int gsz) {
    bf16* dst = (bf16*)(P.ws + WS_LORA);
    for (int idx = gtid; idx < 2 * 288 * 256; idx += gsz) { const int l = idx / (288 * 256), r = idx % (288 * 256), j = r >> 8, c = r & 255; bf16* d = dst + (size_t)l * LORA_LAYER;
        if (j < 64) d[LORA_W + c * 64 + j] = (bf16)f2bf(P.in[I_WUP][((size_t)l * 64 + j) * 256 + c]);
        else if (j < 128) d[LORA_A + c * 64 + j - 64] = (bf16)f2bf(P.in[I_AUP][((size_t)l * 64 + j - 64) * 256 + c]);
        else if (j < 256) d[LORA_G + c * 128 + j - 128] = (bf16)f2bf(P.in[I_GUP][((size_t)l * 128 + j - 128) * 256 + c]);
        else if (l > 0) d[LORA_V + c * 32 + j - 256] = (bf16)f2bf(P.in[I_VUP][((size_t)(l - 1) * 32 + j - 256) * 256 + c]); }
}
__device__ __forceinline__ void prologue_rows(const Params& P, int gw, int NGW, int lane) {
    const float* x = P.in[I_X]; bf16* xb = (bf16*)(P.ws + WS_XB); float* ssq = (float*)(P.ws + WS_SSQ);
    for (int m = gw; m < T; m += NGW) {
        const f32x4* xr = (const f32x4*)(x + (size_t)m * D) + lane; f32x4 v[4]; float s = 0.f;
#pragma unroll
        for (int j = 0; j < 4; ++j) { v[j] = xr[64 * j]; s += (v[j][0] * v[j][0] + v[j][1] * v[j][1]) + (v[j][2] * v[j][2] + v[j][3] * v[j][3]); }
        s = wave_sum(s);
        unsigned long long* o8 = (unsigned long long*)(xb + (size_t)m * D) + lane;
#pragma unroll
        for (int j = 0; j < 4; ++j) o8[64 * j] = (unsigned long long)pk2(v[j][0], v[j][1]) | ((unsigned long long)pk2(v[j][2], v[j][3]) << 32);
        if (lane < 16) ssq[(size_t)m * 16 + lane] = (lane == 0) ? s : 0.f;
    }
}
__device__ __forceinline__ void final_norm(const Params& P, int gw, int NGW, int lane) {
    float* x = P.out; const float* ssq = (const float*)(P.ws + WS_SSQ); const f32x4* g4 = (const f32x4*)P.in[I_NFIN] + lane;
    for (int m = gw; m < T; m += NGW) {
        const float rstd = pg8::row_rstd16(ssq, m);
        f32x4* xr = (f32x4*)(x + (size_t)m * D) + lane;
#pragma unroll
        for (int j = 0; j < 4; ++j) { f32x4 v = xr[64 * j]; const f32x4 g = g4[64 * j]; v = v * rstd * g; xr[64 * j] = v; }
    }
}
typedef __attribute__((address_space(1))) unsigned gu32;
#define XB_TMO      128
#define XB_XCNT(j)  (256  + 64 * (j))
#define XB_XSUB(j)  (1280 + 64 * (j))
#define XB_XGEN(j)  (2304 + 64 * (j))
#define XB_TOP      3328
#define XB_TOPGEN   3392
#define XCD_BAR_WORDS 3456
#define XB_SPIN_CAP (1u << 18)

__device__ __forceinline__ unsigned xb_ld(unsigned* p)              { return __hip_atomic_load(p, __ATOMIC_RELAXED, __HIP_MEMORY_SCOPE_AGENT); }
__device__ __forceinline__ unsigned xb_add(unsigned* p, unsigned v) { return __hip_atomic_fetch_add(p, v, __ATOMIC_RELAXED, __HIP_MEMORY_SCOPE_AGENT); }
__device__ __forceinline__ unsigned xb_xcc_id() { return (unsigned)__builtin_amdgcn_s_getreg((3 << 11) | 20) & 0xFu; }
#define XB_SPIN(cond, bar) do { unsigned _sp = 0; while (cond) { __builtin_amdgcn_s_sleep(1); \
    if ((++_sp & 255u) == 0u) { if (xb_ld(&(bar)[XB_TMO])) break; if (_sp > XB_SPIN_CAP) { atomicAdd(&(bar)[XB_TMO], 1u); break; } } } } while (0)

struct XcdBarrier {
    unsigned* bar; unsigned x;
    volatile LAS unsigned* st;
};

__device__ __forceinline__ XcdBarrier xcd_barrier_post(unsigned* bar, volatile LAS unsigned* st) {
    XcdBarrier b; b.bar = bar; b.x = xb_xcc_id(); b.st = st;
    if (threadIdx.x == 0) (void)xb_add(&bar[XB_XCNT(b.x)], 1u);
    return b;
}
__device__ __forceinline__ void xcd_barrier_complete(unsigned* bar, unsigned x, unsigned& nloc, unsigned& nx) {
    const unsigned G = gridDim.x * gridDim.y * gridDim.z;
    unsigned sum, cnt, mine, sp = 0u;
    for (;;) {
        sum = 0u; cnt = 0u; mine = 0u;
#pragma unroll
        for (unsigned j = 0; j < 16; ++j) { const unsigned c = xb_ld(&bar[XB_XCNT(j)]); sum += c; cnt += (c > 0u) ? 1u : 0u; mine = (j == x) ? c : mine; }
        if (sum == G) break;
        __builtin_amdgcn_s_sleep(1);
        if ((++sp & 255u) == 0u) { if (xb_ld(&bar[XB_TMO])) break; if (sp > XB_SPIN_CAP) { atomicAdd(&bar[XB_TMO], 1u); break; } }
    }
    nloc = mine > 0u ? mine : 1u; nx = cnt > 0u ? cnt : 1u;
}

__device__ __forceinline__ void xcd_barrier(const XcdBarrier& b) {
    asm volatile("s_waitcnt vmcnt(0)" ::: "memory");
    __syncthreads();
    if (threadIdx.x == 0) {
        unsigned* bar = b.bar;
        __builtin_amdgcn_s_waitcnt(0);
        unsigned nloc = b.st[0], nx = b.st[1];
        if (nloc == 0u) { xcd_barrier_complete(bar, b.x, nloc, nx); b.st[0] = nloc; b.st[1] = nx; }
        const unsigned old = xb_add(&bar[XB_XSUB(b.x)], 1u);
        const unsigned gen = old / nloc;
        if (old + 1u == (gen + 1u) * nloc) {
            __builtin_amdgcn_fence(__ATOMIC_RELEASE, "agent");
            asm volatile("s_waitcnt vmcnt(0)" ::: "memory");
            const unsigned og = xb_add(&bar[XB_TOP], 1u);
            const unsigned tg = og / nx;
            if (og + 1u == (tg + 1u) * nx) xb_add(&bar[XB_TOPGEN], 1u);
            else XB_SPIN(xb_ld(&bar[XB_TOPGEN]) == tg, bar);
            __builtin_amdgcn_fence(__ATOMIC_ACQUIRE, "agent");
            xb_add(&bar[XB_XGEN(b.x)], 1u);
            asm volatile("s_waitcnt vmcnt(0)" ::: "memory");
        } else {
            XB_SPIN(xb_ld(&bar[XB_XGEN(b.x)]) == gen, bar);
            __builtin_amdgcn_fence(__ATOMIC_ACQUIRE, "agent");
            asm volatile("s_waitcnt vmcnt(0)" ::: "memory");
        }
    }
    __syncthreads();
}
__device__ __forceinline__ float ldcol(const bf16* cols, int t, int c) { return bf2f(cols[(size_t)t * NPAD + c]); }

__device__ __forceinline__ void rwkv_head_v1(const Params& P, int l, int h, float* lds, int tid) {
    const bf16* cols = (const bf16*)(P.ws + WS_COLS); bf16* Y = (bf16*)(P.ws + WS_Y); bf16* VF = (bf16*)(P.ws + WS_VF);
    float* sR = lds; float* sK = sR + 4096; float* sV = sK + 4096; float* sX = sV + 4096;
    float* sW = sX; float* sA = sX + 4096; float* sB = sX + 8192; float* sG = sX + 12288;
    float* sY = sX + 16384; float* sS = sY + 4096; float* sVr = sS + 64;
    const float* mu = P.in[I_MU] + l * 1024;
    const float* w_up = P.in[I_WUP] + (size_t)l * 64 * 256; const float* a_up = P.in[I_AUP] + (size_t)l * 64 * 256; const float* g_up = P.in[I_GUP] + (size_t)l * 128 * 256;
    const float* vr_up = P.in[I_VUP];
    const int lane = tid & 63, wv = tid >> 6, cc = h * 64 + lane;
    const float w0c = P.in[I_W0][l * 256 + cc], a0c = P.in[I_A0][l * 256 + cc], kkc = P.in[I_KK][l * 256 + cc], kac = P.in[I_KA][l * 256 + cc];
    const float rkc = P.in[I_RK][l * 256 + cc], lnw = P.in[I_LNW][l * 256 + cc], lnb = P.in[I_LNB][l * 256 + cc];
    const float v0c = (l > 0) ? P.in[I_V0][(l - 1) * 256 + cc] : 0.f;
    float S[64];
#pragma unroll
    for (int k = 0; k < 64; ++k) S[k] = 0.f;
    for (int ci = 0; ci < T / 64; ++ci) {
        const int t0 = ci * 64;
#pragma unroll 1
        for (int idx = tid; idx < 3 * 4096; idx += NT) { const int a = idx >> 12, t = (idx >> 6) & 63, c = idx & 63, col = a * 256 + h * 64 + c, tt = t0 + t;
            const float cur = ldcol(cols, tt, col), prv = (tt > 0) ? ldcol(cols, tt - 1, col) : 0.f; const float xs = cur + (prv - cur) * mu[col];
            (a == 0 ? sR : (a == 1 ? sK : sV))[t * 64 + c] = xs; }
#pragma unroll 1
        for (int idx = tid; idx < 64 * 256; idx += NT) { const int t = idx >> 8, j = idx & 255, col = 768 + j, tt = t0 + t;
            const float cur = ldcol(cols, tt, col), prv = (tt > 0) ? ldcol(cols, tt - 1, col) : 0.f; float xs = cur + (prv - cur) * mu[col];
            if (j < 64) xs = tanhf(xs); else if (j >= 128) xs = sigmoidf_(xs);
            sX[t * 256 + j] = xs; }
        if (l > 0)
#pragma unroll 1
        for (int idx = tid; idx < 64 * 32; idx += NT) { const int t = idx >> 5, j = idx & 31; sVr[idx] = ldcol(cols, t0 + t, C_VRES + j); }
        __syncthreads();
        float o_decay[8], o_asig[8], o_g[8], o_vmix[8];
#pragma unroll
        for (int hp = 0; hp < 2; ++hp) {
            float accw[4], acca[4], accg[4], accv[4];
#pragma unroll
            for (int i = 0; i < 4; ++i) { accw[i] = 0.f; acca[i] = 0.f; accg[i] = 0.f; accv[i] = 0.f; }
            const float* xb = sX + (wv * 8 + hp * 4) * 256;
#pragma unroll 2
            for (int j = 0; j < 64; ++j) { const float wvv = w_up[j * 256 + cc], avv = a_up[j * 256 + cc];
#pragma unroll
                for (int i = 0; i < 4; ++i) { accw[i] += xb[i * 256 + j] * wvv; acca[i] += xb[i * 256 + 64 + j] * avv; } }
#pragma unroll 2
            for (int j = 0; j < 128; ++j) { const float gvv = g_up[j * 256 + cc];
#pragma unroll
                for (int i = 0; i < 4; ++i) accg[i] += xb[i * 256 + 128 + j] * gvv; }
            if (l > 0) {
#pragma unroll 2
                for (int j = 0; j < 32; ++j) { const float vv = vr_up[j * 256 + cc];
#pragma unroll
                    for (int i = 0; i < 4; ++i) accv[i] += sVr[(wv * 8 + hp * 4 + i) * 32 + j] * vv; } }
#pragma unroll
            for (int i = 0; i < 4; ++i) { const float wpre = w0c + accw[i]; const float wlog = -softplusf_(-wpre) - 0.5f; o_decay[hp * 4 + i] = __expf(-__expf(wlog));
                o_asig[hp * 4 + i] = sigmoidf_(a0c + acca[i]); o_g[hp * 4 + i] = accg[i]; o_vmix[hp * 4 + i] = sigmoidf_(v0c + accv[i]); }
        }
        __syncthreads();
#pragma unroll
        for (int i = 0; i < 8; ++i) { const int t = wv * 8 + i, tt = t0 + t;
            const float r = sR[t * 64 + lane], k = sK[t * 64 + lane]; float v = sV[t * 64 + lane];
            const float asig = o_asig[i];
            if (l == 0) VF[(size_t)tt * 256 + cc] = (bf16)f2bf(v);
            else { const float vf = bf2f(VF[(size_t)tt * 256 + cc]); v = v + (vf - v) * o_vmix[i]; }
            const float kkr = k * kkc; const float ss = wave_sum(kkr * kkr); const float kk = kkr * (1.0f / sqrtf(ss + 1e-24f));
            const float kmod = k * (1.0f + (asig - 1.0f) * kac);
            const float bon = wave_sum(r * kmod * rkc);
            sW[t * 64 + lane] = o_decay[i]; sA[t * 64 + lane] = -kk; sB[t * 64 + lane] = kk * asig; sG[t * 64 + lane] = o_g[i]; sK[t * 64 + lane] = kmod; sV[t * 64 + lane] = v;
            if (lane == 0) sS[t] = bon; }
        __syncthreads();
        if (wv == 0) {
            for (int t = 0; t < 64; ++t) {
                const float vt = sV[t * 64 + lane];
                const f32x4* a4 = (const f32x4*)(sA + t * 64); const f32x4* w4 = (const f32x4*)(sW + t * 64); const f32x4* b4 = (const f32x4*)(sB + t * 64);
                const f32x4* k4 = (const f32x4*)(sK + t * 64); const f32x4* r4 = (const f32x4*)(sR + t * 64);
                float s0 = 0.f, s1 = 0.f, s2 = 0.f, s3 = 0.f;
#pragma unroll
                for (int q = 0; q < 16; ++q) { const f32x4 a = a4[q]; s0 += S[4 * q] * a[0]; s1 += S[4 * q + 1] * a[1]; s2 += S[4 * q + 2] * a[2]; s3 += S[4 * q + 3] * a[3]; }
                const float sa = (s0 + s1) + (s2 + s3);
                float y0 = 0.f, y1 = 0.f, y2 = 0.f, y3 = 0.f;
#pragma unroll
                for (int q = 0; q < 16; ++q) { const f32x4 w = w4[q], b = b4[q], kq = k4[q], rq = r4[q];
#pragma unroll
                    for (int e = 0; e < 4; ++e) S[4 * q + e] = S[4 * q + e] * w[e] + sa * b[e] + vt * kq[e];
                    y0 += S[4 * q] * rq[0]; y1 += S[4 * q + 1] * rq[1]; y2 += S[4 * q + 2] * rq[2]; y3 += S[4 * q + 3] * rq[3]; }
                sY[t * 64 + lane] = (y0 + y1) + (y2 + y3);
            }
        }
        __syncthreads();
#pragma unroll
        for (int i = 0; i < 8; ++i) { const int t = wv * 8 + i, tt = t0 + t;
            const float y = sY[t * 64 + lane]; const float mean = wave_sum(y) * (1.0f / 64.0f); const float d = y - mean; const float var = wave_sum(d * d) * (1.0f / 64.0f);
            float yn = d * (1.0f / sqrtf(var + 64e-5f)) * lnw + lnb; yn += sS[t] * sV[t * 64 + lane];
            Y[(size_t)tt * 1024 + cc] = (bf16)f2bf(yn * sG[t * 64 + lane]); }
        __syncthreads();
    }
}

__device__ __forceinline__ void gdn_head_v1(const Params& P, int l, int h, float* lds, int tid) {
    const bf16* cols = (const bf16*)(P.ws + WS_COLS); bf16* Y = (bf16*)(P.ws + WS_Y);
    float* sQ = lds; float* sK = sQ + 4096; float* sV = sK + 4096; float* sO = sV + 4096; float* sBeta = sO + 4096; float* sAl = sBeta + 64;
    const float* cw = P.in[I_CONV] + (size_t)l * 4 * 768;
    const int lane = tid & 63, wv = tid >> 6;
    const float alog = P.in[I_ALOG][l * 4 + h], dtb = P.in[I_DTB][l * 4 + h], ng = P.in[I_GDNG][l * 64 + lane];
    float S[64];
#pragma unroll
    for (int k = 0; k < 64; ++k) S[k] = 0.f;
    for (int ci = 0; ci < T / 64; ++ci) {
        const int t0 = ci * 64;
#pragma unroll 1
        for (int idx = tid; idx < 3 * 4096; idx += NT) { const int a = idx >> 12, t = (idx >> 6) & 63, c = idx & 63, ch = a * 256 + h * 64 + c, tt = t0 + t; float acc = 0.f;
#pragma unroll
            for (int i = 0; i < 4; ++i) { const int ts = tt - 3 + i; if (ts >= 0) acc += cw[i * 768 + ch] * ldcol(cols, ts, C_GDN + ch); }
            (a == 0 ? sQ : (a == 1 ? sK : sV))[t * 64 + c] = siluf_(acc); }
        if (tid < 64) { const int tt = t0 + tid; const float braw = ldcol(cols, tt, C_GDN + 1024 + h), araw = ldcol(cols, tt, C_GDN + 1028 + h);
            sBeta[tid] = sigmoidf_(braw); sAl[tid] = __expf(-__expf(alog) * softplusf_(araw + dtb)); }
        __syncthreads();
#pragma unroll
        for (int i = 0; i < 8; ++i) { const int t = wv * 8 + i; const float q = sQ[t * 64 + lane], k = sK[t * 64 + lane];
            const float sq = wave_sum(q * q), sk = wave_sum(k * k);
            sQ[t * 64 + lane] = q * (1.0f / sqrtf(sq + 1e-6f)) * 0.125f; sK[t * 64 + lane] = k * (1.0f / sqrtf(sk + 1e-6f)); }
        __syncthreads();
        if (wv == 0) {
            for (int t = 0; t < 64; ++t) {
                const float vt = sV[t * 64 + lane], beta = sBeta[t], al = sAl[t];
                const f32x4* k4 = (const f32x4*)(sK + t * 64); const f32x4* q4 = (const f32x4*)(sQ + t * 64);
                float s0 = 0.f, s1 = 0.f, s2 = 0.f, s3 = 0.f;
#pragma unroll
                for (int q = 0; q < 16; ++q) { const f32x4 kq = k4[q]; s0 += S[4 * q] * kq[0]; s1 += S[4 * q + 1] * kq[1]; s2 += S[4 * q + 2] * kq[2]; s3 += S[4 * q + 3] * kq[3]; }
                const float kS = al * ((s0 + s1) + (s2 + s3)); const float vn = beta * (vt - kS);
                float y0 = 0.f, y1 = 0.f, y2 = 0.f, y3 = 0.f;
#pragma unroll
                for (int q = 0; q < 16; ++q) { const f32x4 kq = k4[q], qq = q4[q];
#pragma unroll
                    for (int e = 0; e < 4; ++e) S[4 * q + e] = al * S[4 * q + e] + kq[e] * vn;
                    y0 += S[4 * q] * qq[0]; y1 += S[4 * q + 1] * qq[1]; y2 += S[4 * q + 2] * qq[2]; y3 += S[4 * q + 3] * qq[3]; }
                sO[t * 64 + lane] = (y0 + y1) + (y2 + y3);
            }
        }
        __syncthreads();
#pragma unroll
        for (int i = 0; i < 8; ++i) { const int t = wv * 8 + i, tt = t0 + t; const float o = sO[t * 64 + lane]; const float ms = wave_sum(o * o) * (1.0f / 64.0f);
            const float z = ldcol(cols, tt, C_GDN + 768 + h * 64 + lane);
            Y[(size_t)tt * 1024 + 256 + h * 64 + lane] = (bf16)f2bf(o * (1.0f / sqrtf(ms + 1e-6f)) * ng * siluf_(z)); }
        __syncthreads();
    }
}

__device__ __forceinline__ void gla_head_v1(const Params& P, int l, int h, float* lds, int tid) {
    const bf16* cols = (const bf16*)(P.ws + WS_COLS); bf16* Y = (bf16*)(P.ws + WS_Y);
    float* sQ = lds; float* sK = sQ + 2048; float* sAl = sK + 2048; float* sV = sAl + 2048; float* sO = sV + 4096; float* sGd = sO + 4096;
    const float* gk_up = P.in[I_GKUP] + (size_t)l * 16 * 128; const float* gk_b = P.in[I_GKB] + l * 128;
    const int lane = tid & 63, wv = tid >> 6; const float ng = P.in[I_GLAG][l * 64 + lane];
    float S[32];
#pragma unroll
    for (int k = 0; k < 32; ++k) S[k] = 0.f;
    for (int ci = 0; ci < T / 64; ++ci) {
        const int t0 = ci * 64;
#pragma unroll 1
        for (int idx = tid; idx < 64 * 32; idx += NT) { const int t = idx >> 5, j = idx & 31; sQ[idx] = ldcol(cols, t0 + t, C_GLA + h * 32 + j) * 0.17677669529663687f; sK[idx] = ldcol(cols, t0 + t, C_GLA + 128 + h * 32 + j); }
#pragma unroll 1
        for (int idx = tid; idx < 64 * 64; idx += NT) { const int t = idx >> 6, c = idx & 63; sV[idx] = ldcol(cols, t0 + t, C_GLA + 256 + h * 64 + c); }
#pragma unroll 1
        for (int idx = tid; idx < 64 * 16; idx += NT) { const int t = idx >> 4, i = idx & 15; sGd[idx] = ldcol(cols, t0 + t, C_GLA + 768 + i); }
        __syncthreads();
#pragma unroll 1
        for (int idx = tid; idx < 64 * 32; idx += NT) { const int t = idx >> 5, j = idx & 31; float a = gk_b[h * 32 + j];
#pragma unroll
            for (int i = 0; i < 16; ++i) a += sGd[t * 16 + i] * gk_up[i * 128 + h * 32 + j];
            sAl[idx] = __expf(-softplusf_(-a) * (1.0f / 16.0f)); }
        __syncthreads();
        if (wv == 0) {
            for (int t = 0; t < 64; ++t) {
                const float vt = sV[t * 64 + lane];
                const f32x4* a4 = (const f32x4*)(sAl + t * 32); const f32x4* k4 = (const f32x4*)(sK + t * 32); const f32x4* q4 = (const f32x4*)(sQ + t * 32);
                float y0 = 0.f, y1 = 0.f, y2 = 0.f, y3 = 0.f;
#pragma unroll
                for (int q = 0; q < 8; ++q) { const f32x4 a = a4[q], kq = k4[q], qq = q4[q];
#pragma unroll
                    for (int e = 0; e < 4; ++e) S[4 * q + e] = a[e] * S[4 * q + e] + kq[e] * vt;
                    y0 += S[4 * q] * qq[0]; y1 += S[4 * q + 1] * qq[1]; y2 += S[4 * q + 2] * qq[2]; y3 += S[4 * q + 3] * qq[3]; }
                sO[t * 64 + lane] = (y0 + y1) + (y2 + y3);
            }
        }
        __syncthreads();
#pragma unroll
        for (int i = 0; i < 8; ++i) { const int t = wv * 8 + i, tt = t0 + t; const float o = sO[t * 64 + lane]; const float ms = wave_sum(o * o) * (1.0f / 64.0f);
            const float gt = ldcol(cols, tt, C_GLA + 512 + h * 64 + lane);
            Y[(size_t)tt * 1024 + 512 + h * 64 + lane] = (bf16)f2bf(o * (1.0f / sqrtf(ms + 1e-6f)) * ng * siluf_(gt)); }
        __syncthreads();
    }
}

__device__ __forceinline__ void sgu_unit_v1(const Params& P, int l, int n, float* lds, int tid) {
    const bf16* cols = (const bf16*)(P.ws + WS_COLS); bf16* Y = (bf16*)(P.ws + WS_Y);
    float* sVl = lds;
    const int lane = tid & 63, wv = tid >> 6, t0 = n * 128;
    const float* lg = P.in[I_SLG] + l * 256; const float* lb = P.in[I_SLB] + l * 256;
    const float* ws_ = P.in[I_SWS] + (size_t)l * 4 * 128 * 128; const float* bs_ = P.in[I_SBS] + l * 4 * 128;
    for (int i = 0; i < 16; ++i) { const int t = wv * 16 + i; float v[4]; float s = 0.f;
#pragma unroll
        for (int e = 0; e < 4; ++e) { v[e] = geluf_(ldcol(cols, t0 + t, C_SGU + 256 + lane * 4 + e)); s += v[e]; }
        const float mean = wave_sum(s) * (1.0f / 256.0f); float q = 0.f;
#pragma unroll
        for (int e = 0; e < 4; ++e) { v[e] -= mean; q += v[e] * v[e]; }
        const float rstd = 1.0f / sqrtf(wave_sum(q) * (1.0f / 256.0f) + 1e-5f);
#pragma unroll
        for (int e = 0; e < 4; ++e) sVl[t * 256 + lane * 4 + e] = v[e] * rstd * lg[lane * 4 + e] + lb[lane * 4 + e]; }
    __syncthreads();
    const int g = lane >> 4;
    for (int i = 0; i < 16; ++i) { const int t = wv + 8 * i; const float* wr = ws_ + ((size_t)g * 128 + t) * 128; f32x4 acc = {0.f, 0.f, 0.f, 0.f};
        for (int s = 0; s <= t; ++s) { const float w = wr[s]; const f32x4 vv = *(const f32x4*)(sVl + s * 256 + lane * 4); acc += vv * w; }
        const float b = bs_[g * 128 + t];
#pragma unroll
        for (int e = 0; e < 4; ++e) { const float u = geluf_(ldcol(cols, t0 + t, C_SGU + lane * 4 + e)); Y[(size_t)(t0 + t) * 1024 + 768 + lane * 4 + e] = (bf16)f2bf(u * (acc[e] + b)); } }
    __syncthreads();
}
typedef short bf16x8 __attribute__((ext_vector_type(8)));
typedef float f32x16 __attribute__((ext_vector_type(16)));
typedef unsigned u32x2 __attribute__((ext_vector_type(2)));
constexpr int TS = 72;
constexpr int TILE_B = 64 * TS * 2;
template <int KT> __device__ __forceinline__ void mm_tile(f32x16& acc, const LAS bf16* Arows, const LAS bf16* Bcols, int lane) {
    const int off = (lane & 31) * TS + (lane >> 5) * 8;
#pragma unroll
    for (int kk = 0; kk < KT; ++kk) {
        const bf16x8 a = *(const LAS bf16x8*)(Arows + off + kk * 16);
        const bf16x8 b = *(const LAS bf16x8*)(Bcols + off + kk * 16);
        acc = __builtin_amdgcn_mfma_f32_32x32x16_bf16(a, b, acc, 0, 0, 0);
    }
}
template <int KT> __device__ __forceinline__ void mm_tile_gb(f32x16& acc, const LAS bf16* Arows, int lda, const bf16* Bg, int ldb, int lane) {
    const int r = lane & 31, hh = lane >> 5;
#pragma unroll
    for (int kk = 0; kk < KT; ++kk) {
        const bf16x8 a = *(const LAS bf16x8*)(Arows + r * lda + hh * 8 + kk * 16);
        const bf16x8 b = *(const bf16x8*)(Bg + r * ldb + hh * 8 + kk * 16);
        acc = __builtin_amdgcn_mfma_f32_32x32x16_bf16(a, b, acc, 0, 0, 0);
    }
}
__device__ __forceinline__ int acc_i(int r, int hh) { return (r & 3) + 8 * (r >> 2) + 4 * hh; }
__device__ __forceinline__ void store_lane_major(LAS bf16* Z, int j0, int i0, const f32x16& acc, int lane) {
    const int c = lane & 31, hh = lane >> 5;
    LAS bf16* p = Z + (j0 + c) * TS + i0 + 4 * hh;
#pragma unroll
    for (int q = 0; q < 4; ++q) { uint2 w; w.x = pk2(acc[4 * q], acc[4 * q + 1]); w.y = pk2(acc[4 * q + 2], acc[4 * q + 3]); *(LAS u32x2*)(p + 8 * q) = (u32x2){w.x, w.y}; }
}
__device__ __forceinline__ void store_reg_major(LAS bf16* Z, int i0, int j0, const f32x16& acc, int lane) {
    const int c = lane & 31, hh = lane >> 5;
#pragma unroll
    for (int r = 0; r < 16; ++r) Z[(i0 + acc_i(r, hh)) * TS + j0 + c] = (bf16)f2bf(acc[r]);
}
__device__ __forceinline__ f32x16 zero16() { f32x16 z;
#pragma unroll
    for (int r = 0; r < 16; ++r) z[r] = 0.f; return z; }
__device__ __forceinline__ void gla_m1(const Params& P, int l, int ci, LAS unsigned char* lds, int tid) {
    const bf16* cols = (const bf16*)(P.ws + WS_COLS); bf16* Y = (bf16*)(P.ws + WS_Y);
    float* GKV = (float*)(P.ws + WS_GKV); float* GAL = (float*)(P.ws + WS_GAL); bf16* GQI = (bf16*)(P.ws + WS_GQI);
    LAS float* fLa = (LAS float*)lds; LAS float* fGd = fLa + 64 * 128; LAS unsigned char* tb0 = lds + 32768 + 4096;
    const float* gk_up = P.in[I_GKUP] + (size_t)l * 16 * 128; const float* gk_b = P.in[I_GKB] + l * 128;
    const int lane = tid & 63, wv = tid >> 6, t0 = ci * 64;
#pragma unroll
    for (int idx = tid; idx < 64 * 16; idx += NT) fGd[idx] = ldcol(cols, t0 + (idx >> 4), C_GLA + 768 + (idx & 15));
    __syncthreads();
#pragma unroll 4
    for (int idx = tid; idx < 64 * 128; idx += NT) { const int t = idx >> 7, j = idx & 127; float a = gk_b[j];
#pragma unroll
        for (int i = 0; i < 16; ++i) a += fGd[t * 16 + i] * gk_up[i * 128 + j];
        fLa[idx] = -softplusf_(-a) * (1.0f / 16.0f); }
    __syncthreads();
    if (tid < 128) { float run = 0.f;
#pragma unroll 8
        for (int t = 0; t < 64; ++t) { run += fLa[t * 128 + tid]; fLa[t * 128 + tid] = run; }
        GAL[ci * 128 + tid] = __expf(run); }
    __syncthreads();
#pragma unroll 1
    for (int hp = 0; hp < 2; ++hp) {
#pragma unroll 4
        for (int idx = tid; idx < 2 * 64 * 32; idx += NT) { const int s = idx >> 11, t = (idx >> 5) & 63, j = idx & 31, h = 2 * hp + s;
            LAS bf16* tQ = (LAS bf16*)(tb0 + s * 5 * TILE_B); LAS bf16* tK = tQ + 64 * TS; LAS bf16* tKs = tK + 64 * TS;
            const float b = fLa[t * 128 + h * 32 + j], b63 = fLa[63 * 128 + h * 32 + j];
            const float q = ldcol(cols, t0 + t, C_GLA + h * 32 + j) * 0.17677669529663687f, k = ldcol(cols, t0 + t, C_GLA + 128 + h * 32 + j);
            const bf16 qt = (bf16)f2bf(q * __expf(b));
            tQ[t * TS + j] = qt; tK[t * TS + j] = (bf16)f2bf(k * __expf(-b)); tKs[j * TS + t] = (bf16)f2bf(k * __expf(b63 - b));
            GQI[(((size_t)ci * 4 + h) * 64 + t) * 32 + j] = qt; }
#pragma unroll 8
        for (int idx = tid; idx < 2 * 64 * 64; idx += NT) { const int s = idx >> 12, t = (idx >> 6) & 63, v = idx & 63, h = 2 * hp + s;
            LAS bf16* tV = (LAS bf16*)(tb0 + s * 5 * TILE_B + 3 * TILE_B);
            tV[v * TS + t] = cols[(size_t)(t0 + t) * NPAD + C_GLA + 256 + h * 64 + v]; }
        __syncthreads();
        for (int jb = wv; jb < 12; jb += 8) { const int s = jb / 6, r = jb % 6, h = 2 * hp + s;
            LAS bf16* tQ = (LAS bf16*)(tb0 + s * 5 * TILE_B); LAS bf16* tK = tQ + 64 * TS; LAS bf16* tKs = tK + 64 * TS; LAS bf16* tV = tKs + 64 * TS; LAS bf16* tSc = tV + 64 * TS;
            f32x16 acc = zero16(); const int c = lane & 31, hh = lane >> 5;
            if (r < 4) { const int tb = (r == 0 || r == 3) ? 0 : 1, sb = (r == 0 || r == 1) ? 0 : 1;
                if (r < 3) { mm_tile<2>(acc, tK + sb * 32 * TS, tQ + tb * 32 * TS, lane);
#pragma unroll
                    for (int q = 0; q < 16; ++q) { const int sI = 32 * sb + acc_i(q, hh), tI = 32 * tb + c; if (sI > tI) acc[q] = 0.f; } }
                store_lane_major(tSc, 32 * tb, 32 * sb, acc, lane);
            } else { const int vb = r - 4; mm_tile<4>(acc, tKs, tV + vb * 32 * TS, lane);
                float* g = GKV + (((size_t)ci * 4 + h) * 32) * 64 + 32 * vb + c;
#pragma unroll
                for (int q = 0; q < 16; ++q) g[acc_i(q, hh) * 64] = acc[q]; }
        }
        __syncthreads();
        { const int s = wv >> 2, tb = (wv >> 1) & 1, vb = wv & 1, h = 2 * hp + s;
            LAS bf16* tV = (LAS bf16*)(tb0 + s * 5 * TILE_B + 3 * TILE_B); LAS bf16* tSc = tV + 64 * TS;
            f32x16 acc = zero16(); const int c = lane & 31, hh = lane >> 5;
            mm_tile<4>(acc, tSc + tb * 32 * TS, tV + vb * 32 * TS, lane);
            bf16* y = Y + (size_t)(t0 + 32 * tb) * 1024 + 512 + h * 64 + 32 * vb + c;
#pragma unroll
            for (int q = 0; q < 16; ++q) y[(size_t)acc_i(q, hh) * 1024] = (bf16)f2bf(acc[q]); }
        __syncthreads();
    }
}
__device__ __forceinline__ void gla_m2(const Params& P, int e) {
    float* GKV = (float*)(P.ws + WS_GKV); const float* GAL = (const float*)(P.ws + WS_GAL);
    const int hk = e >> 6;
    float S = 0.f;
#pragma unroll 1
    for (int c0 = 0; c0 < T / 64; c0 += 16) { float kv[16], al[16];
#pragma unroll
        for (int u = 0; u < 16; ++u) { kv[u] = GKV[(size_t)(c0 + u) * 8192 + e]; al[u] = GAL[(c0 + u) * 128 + hk]; }
#pragma unroll
        for (int u = 0; u < 16; ++u) { GKV[(size_t)(c0 + u) * 8192 + e] = S; S = al[u] * S + kv[u]; } }
}
__device__ __forceinline__ void gla_m3(const Params& P, int l, int ci, LAS unsigned char* lds, int tid) {
    const bf16* cols = (const bf16*)(P.ws + WS_COLS); bf16* Y = (bf16*)(P.ws + WS_Y);
    const float* GKV = (const float*)(P.ws + WS_GKV); const bf16* GQI = (const bf16*)(P.ws + WS_GQI);
    const float* ng = P.in[I_GLAG] + l * 64;
    const int lane = tid & 63, wv = tid >> 6, t0 = ci * 64;
#pragma unroll 8
    for (int idx = tid; idx < 4 * 32 * 64; idx += NT) { const int h = idx >> 11, k = (idx >> 6) & 31, v = idx & 63;
        ((LAS bf16*)(lds + h * TILE_B))[v * TS + k] = (bf16)f2bf(GKV[(size_t)ci * 8192 + idx]); }
    __syncthreads();
    const int h = wv >> 1, tb = wv & 1, c = lane & 31, hh = lane >> 5;
    const LAS bf16* tS = (const LAS bf16*)(lds + h * TILE_B);
    f32x16 acc[2]; acc[0] = zero16(); acc[1] = zero16();
    const bf16* qg = GQI + (((size_t)ci * 4 + h) * 64 + 32 * tb + c) * 32 + hh * 8;
#pragma unroll
    for (int kk = 0; kk < 2; ++kk) { const bf16x8 b = *(const bf16x8*)(qg + kk * 16);
#pragma unroll
        for (int vb = 0; vb < 2; ++vb) { const bf16x8 a = *(const LAS bf16x8*)(tS + (vb * 32 + c) * TS + hh * 8 + kk * 16);
            acc[vb] = __builtin_amdgcn_mfma_f32_32x32x16_bf16(a, b, acc[vb], 0, 0, 0); } }
    const size_t trow = (size_t)(t0 + 32 * tb + c);
    bf16* yrow = Y + trow * 1024 + 512 + h * 64; const bf16* grow = cols + trow * NPAD + C_GLA + 512 + h * 64;
    float ss = 0.f;
#pragma unroll
    for (int vb = 0; vb < 2; ++vb)
#pragma unroll
        for (int q = 0; q < 4; ++q) { const int v = 32 * vb + 8 * q + 4 * hh; const uint2 w = *(const uint2*)(yrow + v);
            acc[vb][4 * q] += bf2f((bf16)(w.x & 0xffff)); acc[vb][4 * q + 1] += bf2f((bf16)(w.x >> 16)); acc[vb][4 * q + 2] += bf2f((bf16)(w.y & 0xffff)); acc[vb][4 * q + 3] += bf2f((bf16)(w.y >> 16));
#pragma unroll
            for (int e = 0; e < 4; ++e) ss += acc[vb][4 * q + e] * acc[vb][4 * q + e]; }
    ss += __shfl_xor(ss, 32);
    const float rstd = 1.0f / sqrtf(ss * (1.0f / 64.0f) + 1e-6f);
#pragma unroll
    for (int vb = 0; vb < 2; ++vb)
#pragma unroll
        for (int q = 0; q < 4; ++q) { const int v = 32 * vb + 8 * q + 4 * hh; const uint2 gw = *(const uint2*)(grow + v); float o[4];
            const float g0 = bf2f((bf16)(gw.x & 0xffff)), g1 = bf2f((bf16)(gw.x >> 16)), g2 = bf2f((bf16)(gw.y & 0xffff)), g3 = bf2f((bf16)(gw.y >> 16));
            o[0] = acc[vb][4 * q] * rstd * ng[v] * siluf_(g0); o[1] = acc[vb][4 * q + 1] * rstd * ng[v + 1] * siluf_(g1);
            o[2] = acc[vb][4 * q + 2] * rstd * ng[v + 2] * siluf_(g2); o[3] = acc[vb][4 * q + 3] * rstd * ng[v + 3] * siluf_(g3);
            uint2 w; w.x = pk2(o[0], o[1]); w.y = pk2(o[2], o[3]); *(uint2*)(yrow + v) = w; }
    __syncthreads();
}
__device__ __forceinline__ void nm_square(const LAS bf16* Xr, const LAS bf16* Xc, LAS bf16* Xr_o, LAS bf16* Xc_o, int I, int J, int lane) {
    f32x16 acc = zero16();
    if (I == J) mm_tile<2>(acc, Xr + I * 32 * TS + 32 * I, Xc + J * 32 * TS + 32 * I, lane);
    else mm_tile<4>(acc, Xr + 32 * TS, Xc, lane);
    store_lane_major(Xc_o, 32 * J, 32 * I, acc, lane);
    store_reg_major(Xr_o, 32 * I, 32 * J, acc, lane);
}
__device__ __forceinline__ void nm_update(const LAS bf16* Tt, const LAS bf16* Xc, LAS bf16* Tt_o, int I, int J, int lane) {
    const int c = lane & 31, hh = lane >> 5; f32x16 acc;
#pragma unroll
    for (int q = 0; q < 4; ++q) { const u32x2 w = *(const LAS u32x2*)(Tt + (32 * I + c) * TS + 32 * J + 8 * q + 4 * hh);
        acc[4 * q] = bf2f((bf16)(w.x & 0xffff)); acc[4 * q + 1] = bf2f((bf16)(w.x >> 16)); acc[4 * q + 2] = bf2f((bf16)(w.y & 0xffff)); acc[4 * q + 3] = bf2f((bf16)(w.y >> 16)); }
    if (I == J) mm_tile<2>(acc, Xc + J * 32 * TS + 32 * I, Tt + I * 32 * TS + 32 * I, lane);
    else mm_tile<4>(acc, Xc, Tt + 32 * TS, lane);
    store_lane_major(Tt_o, 32 * I, 32 * J, acc, lane);
}
#define NM_TILE_IJ(w3, I_, J_) const int I_ = ((w3) == 0) ? 0 : 1, J_ = ((w3) == 2) ? 1 : 0
template <class Extra> __device__ __forceinline__ void neumann_solve(LAS bf16* const (&Xr)[2], LAS bf16* const (&Xc)[2], LAS bf16* const (&Tt)[2], int wv, int lane, const Extra& extra) {
    if (wv < 3) { NM_TILE_IJ(wv, I, J); nm_square(Xr[0], Xc[0], Xr[1], Xc[1], I, J, lane); }
    else if (wv >= 4) extra();
    __syncthreads();
#pragma unroll 1
    for (int k = 1; k <= 4; ++k) {
        const int xb = k & 1, tbuf = (k - 1) & 1;
        if (wv < 3) { NM_TILE_IJ(wv, I, J); nm_update(Tt[tbuf], Xc[xb], Tt[tbuf ^ 1], I, J, lane); }
        else if (wv < 6) { NM_TILE_IJ(wv - 3, I, J); nm_square(Xr[xb], Xc[xb], Xr[xb ^ 1], Xc[xb ^ 1], I, J, lane); }
        __syncthreads();
    }
    if (wv < 3) { NM_TILE_IJ(wv, I, J); nm_update(Tt[0], Xc[1], Tt[1], I, J, lane); }
    __syncthreads();
}
typedef float f32x4v __attribute__((ext_vector_type(4)));
constexpr int M2_D = 6;
constexpr int M2_SLOT = 2 * TILE_B + 256;
__device__ __forceinline__ void dplr_m2_block(const bf16* XP, bf16* XQ, const float* XG, int h, LAS unsigned char* lds, int tid) {
    const int lane = tid & 63, wv = __builtin_amdgcn_readfirstlane(tid >> 6);
    const int g = lane >> 4, n = lane & 15, v0 = wv * 16;
    const int q = tid - 256;
    f32x4v H[4];
#pragma unroll
    for (int m = 0; m < 4; ++m) H[m] = (f32x4v){0.f, 0.f, 0.f, 0.f};
    v4u ring[M2_D][5];
#define M2_ISSUE(c, R) do { const size_t ch_ = (size_t)(c) * 4 + h; const v4u* Pp = (const v4u*)(XP + ch_ * 4096); const v4u* Qp = (const v4u*)(XQ + ch_ * 4096); \
        R[0] = Pp[q]; R[1] = Pp[q + 256]; R[2] = Qp[q]; R[3] = Qp[q + 256]; if (q < 16) R[4] = ((const v4u*)(XG + ch_ * 64))[q]; } while (0)
#define M2_PUT(slot, R) do { LAS unsigned char* sp = lds + (slot) * M2_SLOT; \
        *(LAS v4u*)(sp + (q >> 3) * (TS * 2) + (q & 7) * 16) = R[0]; *(LAS v4u*)(sp + ((q >> 3) + 32) * (TS * 2) + (q & 7) * 16) = R[1]; \
        *(LAS v4u*)(sp + TILE_B + (q >> 3) * (TS * 2) + (q & 7) * 16) = R[2]; *(LAS v4u*)(sp + TILE_B + ((q >> 3) + 32) * (TS * 2) + (q & 7) * 16) = R[3]; \
        if (q < 16) *(LAS v4u*)(sp + 2 * TILE_B + q * 16) = R[4]; } while (0)
#define M2_STEP(c, slot) do { const LAS unsigned char* sp = lds + (slot) * M2_SLOT; const size_t ch_ = (size_t)(c) * 4 + h; bf16* Qg = XQ + ch_ * 4096; \
        bf16x8 bfr[2]; \
        _Pragma("unroll") for (int s = 0; s < 2; ++s) { v4u w; w.x = pk2(H[2 * s][0], H[2 * s][1]); w.y = pk2(H[2 * s][2], H[2 * s][3]); w.z = pk2(H[2 * s + 1][0], H[2 * s + 1][1]); w.w = pk2(H[2 * s + 1][2], H[2 * s + 1][3]); bfr[s] = __builtin_bit_cast(bf16x8, w); } \
        _Pragma("unroll") for (int m = 0; m < 4; ++m) { \
            const u32x2 qw = *(const LAS u32x2*)(sp + TILE_B + (v0 + n) * (TS * 2) + (16 * m + 4 * g) * 2); const f32x4v gm = *(const LAS f32x4v*)(sp + 2 * TILE_B + (16 * m + 4 * g) * 4); \
            u32x2 hw; hw.x = pk2(H[m][0], H[m][1]); hw.y = pk2(H[m][2], H[m][3]); *(u32x2*)(Qg + (v0 + n) * 64 + 16 * m + 4 * g) = hw; \
            f32x4v a; a[0] = gm[0] * H[m][0] + bf2f((bf16)(qw.x & 0xffff)); a[1] = gm[1] * H[m][1] + bf2f((bf16)(qw.x >> 16)); a[2] = gm[2] * H[m][2] + bf2f((bf16)(qw.y & 0xffff)); a[3] = gm[3] * H[m][3] + bf2f((bf16)(qw.y >> 16)); \
            _Pragma("unroll") for (int s = 0; s < 2; ++s) { const u32x2 p0 = *(const LAS u32x2*)(sp + (16 * m + n) * (TS * 2) + (32 * s + 4 * g) * 2); const u32x2 p1 = *(const LAS u32x2*)(sp + (16 * m + n) * (TS * 2) + (32 * s + 16 + 4 * g) * 2); \
                v4u w; w.x = p0.x; w.y = p0.y; w.z = p1.x; w.w = p1.y; \
                a = __builtin_amdgcn_mfma_f32_16x16x32_bf16(__builtin_bit_cast(bf16x8, w), bfr[s], a, 0, 0, 0); } \
            H[m] = a; } } while (0)
    if (wv >= 4) {
#pragma unroll
        for (int d = 0; d < M2_D; ++d) M2_ISSUE(d, ring[d]);
        M2_PUT(0, ring[0]);
        M2_ISSUE(M2_D, ring[0]);
    }
    __syncthreads();
#pragma unroll 1
    for (int c0 = 0; c0 < T / 64; c0 += M2_D) {
#pragma unroll
        for (int u = 0; u < M2_D; ++u) { const int c = c0 + u;
            if (wv < 4) { if (c < T / 64) M2_STEP(c, u & 1); }
            else if (c + 1 < T / 64) { M2_PUT((u + 1) & 1, ring[(u + 1) % M2_D]); if (c + 1 + M2_D < T / 64) M2_ISSUE(c + 1 + M2_D, ring[(u + 1) % M2_D]); }
            __syncthreads();
        }
    }
#undef M2_ISSUE
#undef M2_PUT
#undef M2_STEP
}
__device__ __forceinline__ void dplr_m3_stage(const bf16* XQ, int ci, LAS unsigned char* lds, int tid) {
#pragma unroll
    for (int i = 0; i < 4; ++i) { const int idx = tid + NT * i, h = idx >> 9, v = (idx >> 3) & 63, c8 = idx & 7;
        *(LAS v4u*)(lds + h * TILE_B + v * (TS * 2) + c8 * 16) = *(const v4u*)(XQ + (size_t)ci * 16384 + (size_t)idx * 8); }
}
__device__ __forceinline__ void dplr_m3_core(f32x16 (&acc)[2], const LAS bf16* tHT, const bf16* XRch, int tb, int lane) {
    const int c = lane & 31, hh = lane >> 5;
    const bf16* rg = XRch + (32 * tb + c) * 64 + hh * 8;
    acc[0] = zero16(); acc[1] = zero16();
#pragma unroll
    for (int kk = 0; kk < 4; ++kk) { const bf16x8 b = *(const bf16x8*)(rg + kk * 16);
#pragma unroll
        for (int vb = 0; vb < 2; ++vb) { const bf16x8 a = *(const LAS bf16x8*)(tHT + (vb * 32 + c) * TS + hh * 8 + kk * 16);
            acc[vb] = __builtin_amdgcn_mfma_f32_32x32x16_bf16(a, b, acc[vb], 0, 0, 0); } }
}
__device__ __forceinline__ void rwkv_m1(const Params& P, int l, int ci, LAS unsigned char* lds, int tid) {
    const bf16* cols = (const bf16*)(P.ws + WS_COLS); bf16* Y = (bf16*)(P.ws + WS_Y); bf16* VF = (bf16*)(P.ws + WS_VF);
    bf16* XP = (bf16*)(P.ws + WS_RP); bf16* XQ = (bf16*)(P.ws + WS_RQ); bf16* XR = (bf16*)(P.ws + WS_RR); bf16* XBV = (bf16*)(P.ws + WS_RBV); float* XG = (float*)(P.ws + WS_XG);
    LAS bf16* tA = (LAS bf16*)lds; LAS bf16* tB = tA + 64 * TS; LAS bf16* tK = tB + 64 * TS; LAS bf16* tR = tK + 64 * TS; LAS bf16* tV = tR + 64 * TS;
    LAS bf16* tAab = tV + 64 * TS; LAS bf16* tAak = tAab + 64 * TS; LAS bf16* tArb = tAak + 64 * TS; LAS bf16* tArk = tArb + 64 * TS;
    LAS bf16* tAabT = tArk + 64 * TS; LAS bf16* tX1r = tAabT + 64 * TS; LAS bf16* tX1c = tX1r + 64 * TS; LAS bf16* tT0 = tX1c + 64 * TS; LAS bf16* tT1 = tT0 + 64 * TS; LAS bf16* tAV = tT1 + 64 * TS;
    LAS bf16* tW = tAab; LAS bf16* tU = tAak; LAS bf16* tT = tT1;
    LAS float* gC = (LAS float*)(lds + 5 * TILE_B + 77824 + 16384);
    LAS bf16* xW = (LAS bf16*)(lds + 5 * TILE_B); LAS bf16* xA = xW + 64 * 72; LAS bf16* xG = xA + 64 * 72; LAS bf16* xV = xG + 64 * 136; LAS bf16* Lw = xV + 64 * 40;
    LAS float* sLw = (LAS float*)(lds + 5 * TILE_B + 77824);
    const float* mu = P.in[I_MU] + l * 1024;
#pragma unroll 1
    for (int h = 0; h < 4; ++h) {
        int tidh = tid, t0 = ci * 64; asm volatile("" : "+v"(tidh), "+s"(t0));
        const int lane = tidh & 63, wv = tidh >> 6;
        const int cc = h * 64 + lane; const size_t ch = (size_t)ci * 4 + h;
#pragma unroll 8
        for (int idx = tidh; idx < 64 * 256; idx += NT) { const int t = idx >> 8, j = idx & 255, col = 768 + j, tt = t0 + t;
            const float cur = ldcol(cols, tt, col); float prv = ldcol(cols, tt > 0 ? tt - 1 : 0, col); prv = (tt > 0) ? prv : 0.f; const float xs = cur + (prv - cur) * mu[col];
            if (j < 64) xW[t * 72 + j] = (bf16)f2bf(tanhf(xs)); else if (j < 128) xA[t * 72 + j - 64] = (bf16)f2bf(xs); else xG[t * 136 + j - 128] = (bf16)f2bf(sigmoidf_(xs)); }
        if (l > 0) {
#pragma unroll
            for (int idx = tidh; idx < 64 * 32; idx += NT) { const int t = idx >> 5, j = idx & 31; xV[t * 40 + j] = cols[(size_t)(t0 + t) * NPAD + C_VRES + j]; } }
        __syncthreads();
        { const bf16* lw = (const bf16*)(P.ws + WS_LORA) + (size_t)l * LORA_LAYER;
          for (int jb = wv; jb < (l > 0 ? 16 : 12); jb += 8) { const int which = jb >> 2, tb = (jb >> 1) & 1, cb = jb & 1; f32x16 acc = zero16();
            const int crow = h * 64 + cb * 32;
            if (which == 0) mm_tile_gb<4>(acc, xW + tb * 32 * 72, 72, lw + LORA_W + crow * 64, 64, lane);
            else if (which == 1) mm_tile_gb<4>(acc, xA + tb * 32 * 72, 72, lw + LORA_A + crow * 64, 64, lane);
            else if (which == 2) mm_tile_gb<8>(acc, xG + tb * 32 * 136, 136, lw + LORA_G + crow * 128, 128, lane);
            else mm_tile_gb<2>(acc, xV + tb * 32 * 40, 40, lw + LORA_V + crow * 32, 32, lane);
            store_lane_major(Lw + which * 64 * TS, 32 * cb, 32 * tb, acc, lane); } }
        __syncthreads();
        const float w0c = P.in[I_W0][l * 256 + cc], a0c = P.in[I_A0][l * 256 + cc], kkc = P.in[I_KK][l * 256 + cc], kac = P.in[I_KA][l * 256 + cc], rkc = P.in[I_RK][l * 256 + cc];
        const float v0c = (l > 0) ? P.in[I_V0][(l - 1) * 256 + cc] : 0.f;
        float o_lw[8], o_asig[8], o_vmix[8];
        { const v4u pw = *(const LAS v4u*)(Lw + lane * TS + wv * 8), pa = *(const LAS v4u*)(Lw + 64 * TS + lane * TS + wv * 8), pg = *(const LAS v4u*)(Lw + 2 * 64 * TS + lane * TS + wv * 8);
          v4u pv = {0u, 0u, 0u, 0u}; if (l > 0) pv = *(const LAS v4u*)(Lw + 3 * 64 * TS + lane * TS + wv * 8);
#pragma unroll
          for (int i = 0; i < 8; ++i) { const unsigned uw = (i < 2 ? pw.x : i < 4 ? pw.y : i < 6 ? pw.z : pw.w), ua = (i < 2 ? pa.x : i < 4 ? pa.y : i < 6 ? pa.z : pa.w), ug = (i < 2 ? pg.x : i < 4 ? pg.y : i < 6 ? pg.z : pg.w), uv = (i < 2 ? pv.x : i < 4 ? pv.y : i < 6 ? pv.z : pv.w);
            const float accw = bf2f((bf16)((i & 1) ? (uw >> 16) : (uw & 0xffff))), acca = bf2f((bf16)((i & 1) ? (ua >> 16) : (ua & 0xffff))), accv = bf2f((bf16)((i & 1) ? (uv >> 16) : (uv & 0xffff)));
            const bf16 gbits = (bf16)((i & 1) ? (ug >> 16) : (ug & 0xffff));
            const float wpre = w0c + accw; const float wlog = -softplusf_(-wpre) - 0.5f; o_lw[i] = -__expf(wlog);
            o_asig[i] = sigmoidf_(a0c + acca); o_vmix[i] = sigmoidf_(v0c + accv);
            Y[(size_t)(t0 + wv * 8 + i) * 1024 + 768 + cc] = gbits; } }
        float e_r[8], e_k[8], e_v[8], e_kk[8];
        {
            float raw[3][9], vfv[8];
#pragma unroll
            for (int a = 0; a < 3; ++a)
#pragma unroll
                for (int rr = 0; rr < 9; ++rr) { const int tt = t0 + wv * 8 - 1 + rr; const float v = ldcol(cols, tt < 0 ? 0 : tt, a * 256 + cc); raw[a][rr] = (tt < 0) ? 0.f : v; }
#pragma unroll
            for (int i = 0; i < 8; ++i) vfv[i] = (l > 0) ? bf2f(VF[(size_t)(t0 + wv * 8 + i) * 256 + cc]) : 0.f;
            const float mu_r = mu[cc], mu_k = mu[256 + cc], mu_v = mu[512 + cc];
#pragma unroll
            for (int i = 0; i < 8; ++i) { const int t = wv * 8 + i, tt = t0 + t;
                const float r = raw[0][i + 1] + (raw[0][i] - raw[0][i + 1]) * mu_r, k = raw[1][i + 1] + (raw[1][i] - raw[1][i + 1]) * mu_k; float v = raw[2][i + 1] + (raw[2][i] - raw[2][i + 1]) * mu_v;
                if (l == 0) VF[(size_t)tt * 256 + cc] = (bf16)f2bf(v);
                else v = v + (vfv[i] - v) * o_vmix[i];
                const float kkr = k * kkc; const float ss = wave_sum(kkr * kkr); const float kk = kkr * (1.0f / sqrtf(ss + 1e-24f));
                const float kmod = k * (1.0f + (o_asig[i] - 1.0f) * kac);
                const float bon = wave_sum(r * kmod * rkc);
                XBV[(ch * 64 + t) * 64 + lane] = (bf16)f2bf(bon * v);
                sLw[t * 64 + lane] = o_lw[i];
                e_r[i] = r; e_k[i] = kmod; e_v[i] = v; e_kk[i] = kk; }
        }
        __syncthreads();
        if (tidh < 64) { float run = 0.f;
#pragma unroll 8
            for (int t = 0; t < 64; ++t) { run += sLw[t * 64 + tidh]; sLw[t * 64 + tidh] = run; }
            const float gam = __expf(run); gC[tidh] = gam; XG[ch * 64 + tidh] = gam; }
        __syncthreads();
        float at[8], bt[8], kt[8];
#pragma unroll
        for (int i = 0; i < 8; ++i) { const int t = wv * 8 + i; const float cum = sLw[t * 64 + lane], cumm = (t > 0) ? sLw[(t - 1) * 64 + lane] : 0.f;
            const float ep = __expf(cum), en = __expf(-cum), epm = __expf(cumm);
            at[i] = -e_kk[i] * epm; bt[i] = e_kk[i] * o_asig[i] * en; kt[i] = e_k[i] * en;
            tA[t * TS + lane] = (bf16)f2bf(at[i]); tB[t * TS + lane] = (bf16)f2bf(bt[i]); tK[t * TS + lane] = (bf16)f2bf(kt[i]); tR[t * TS + lane] = (bf16)f2bf(e_r[i] * ep); }
        { v4u w; w.x = pk2(e_v[0], e_v[1]); w.y = pk2(e_v[2], e_v[3]); w.z = pk2(e_v[4], e_v[5]); w.w = pk2(e_v[6], e_v[7]); *(LAS v4u*)(tV + lane * TS + wv * 8) = w; }
        __syncthreads();
        for (int jb = wv; jb < 16; jb += 8) { const int mat = jb >> 2, r = jb & 3; const int tb = (r == 0 || r == 3) ? 0 : 1, sb = (r == 0 || r == 1) ? 0 : 1;
            f32x16 acc = zero16(); const int c = lane & 31, hh = lane >> 5;
            if (r < 3) { mm_tile<4>(acc, ((mat & 1) ? tK : tB) + sb * 32 * TS, ((mat >> 1) ? tR : tA) + tb * 32 * TS, lane);
#pragma unroll
                for (int q = 0; q < 16; ++q) { const int sI = 32 * sb + acc_i(q, hh), tI = 32 * tb + c; if ((mat < 2) ? (sI >= tI) : (sI > tI)) acc[q] = 0.f; } }
            store_lane_major(tAab + mat * 64 * TS, 32 * tb, 32 * sb, acc, lane);
            if (mat == 0) {
                if (r == 3) store_lane_major(tT1, 0, 32, acc, lane);
                else { store_reg_major(tAabT, 32 * sb, 32 * tb, acc, lane);
#pragma unroll
                    for (int q = 0; q < 16; ++q) if (32 * sb + acc_i(q, hh) == 32 * tb + c) acc[q] += 1.0f;
                    store_lane_major(tT0, 32 * tb, 32 * sb, acc, lane); } }
        }
        __syncthreads();
        { v4u w; w.x = pk2(at[0], at[1]); w.y = pk2(at[2], at[3]); w.z = pk2(at[4], at[5]); w.w = pk2(at[6], at[7]); *(LAS v4u*)(tA + lane * TS + wv * 8) = w;
          w.x = pk2(bt[0], bt[1]); w.y = pk2(bt[2], bt[3]); w.z = pk2(bt[4], bt[5]); w.w = pk2(bt[6], bt[7]); *(LAS v4u*)(tB + lane * TS + wv * 8) = w;
          w.x = pk2(kt[0], kt[1]); w.y = pk2(kt[2], kt[3]); w.z = pk2(kt[4], kt[5]); w.w = pk2(kt[6], kt[7]); *(LAS v4u*)(tK + lane * TS + wv * 8) = w; }
        { LAS bf16* const Xr[2] = {tAab, tX1r}; LAS bf16* const Xc[2] = {tAabT, tX1c}; LAS bf16* const Tb[2] = {tT0, tT1};
          neumann_solve(Xr, Xc, Tb, wv, lane, [&]() { const int sb = (wv - 4) >> 1, vb = (wv - 4) & 1; f32x16 acc = zero16();
              mm_tile<4>(acc, tAak + sb * 32 * TS, tV + vb * 32 * TS, lane); store_lane_major(tAV, 32 * vb, 32 * sb, acc, lane); }); }
        { const int which = wv >> 2, tb = (wv >> 1) & 1, jb2 = wv & 1; f32x16 acc = zero16();
            mm_tile<4>(acc, tT + tb * 32 * TS, (which ? tAV : tA) + jb2 * 32 * TS, lane);
            store_lane_major(which ? tU : tW, 32 * jb2, 32 * tb, acc, lane); }
        __syncthreads();
        for (int jb = wv; jb < 16; jb += 8) { const int out = jb >> 2, ib = (jb >> 1) & 1, jb2 = jb & 1; f32x16 acc = zero16(); const int c = lane & 31, hh = lane >> 5;
            if (out == 0) mm_tile<4>(acc, tB + ib * 32 * TS, tW + jb2 * 32 * TS, lane);
            else if (out == 1) { mm_tile<4>(acc, tB + ib * 32 * TS, tU + jb2 * 32 * TS, lane); mm_tile<4>(acc, tK + ib * 32 * TS, tV + jb2 * 32 * TS, lane); }
            else if (out == 2) mm_tile<4>(acc, tArb + ib * 32 * TS, tW + jb2 * 32 * TS, lane);
            else { mm_tile<4>(acc, tArb + ib * 32 * TS, tU + jb2 * 32 * TS, lane); mm_tile<4>(acc, tArk + ib * 32 * TS, tV + jb2 * 32 * TS, lane); }
            if (out == 0) { bf16* g = XP + ch * 4096 + 32 * jb2 + c;
#pragma unroll
                for (int q = 0; q < 16; ++q) { const int row = 32 * ib + acc_i(q, hh); g[row * 64] = (bf16)f2bf(acc[q] * gC[row]); } }
            else if (out == 1) { bf16* g = XQ + ch * 4096 + (32 * jb2 + c) * 64 + 32 * ib + 4 * hh;
#pragma unroll
                for (int q = 0; q < 4; ++q) { const int row = 32 * ib + 8 * q + 4 * hh; uint2 w; w.x = pk2(acc[4 * q] * gC[row], acc[4 * q + 1] * gC[row + 1]); w.y = pk2(acc[4 * q + 2] * gC[row + 2], acc[4 * q + 3] * gC[row + 3]); *(uint2*)(g + 8 * q) = w; } }
            else if (out == 2) { bf16* g = XR + ch * 4096 + 32 * jb2 + c;
#pragma unroll
                for (int q = 0; q < 16; ++q) { const int row = 32 * ib + acc_i(q, hh); g[row * 64] = (bf16)f2bf(acc[q] + bf2f(tR[row * TS + 32 * jb2 + c])); } }
            else { bf16* g = Y + (size_t)t0 * 1024 + h * 64 + 32 * jb2 + c;
#pragma unroll
                for (int q = 0; q < 16; ++q) { const int row = 32 * ib + acc_i(q, hh); g[(size_t)row * 1024] = (bf16)f2bf(acc[q]); } }
        }
        __syncthreads();
    }
}
__device__ __forceinline__ void rwkv_m3(const Params& P, int l, int ci, LAS unsigned char* lds, int tid) {
    bf16* Y = (bf16*)(P.ws + WS_Y); const bf16* XQ = (const bf16*)(P.ws + WS_RQ); const bf16* XR = (const bf16*)(P.ws + WS_RR); const bf16* XBV = (const bf16*)(P.ws + WS_RBV);
    const int lane = tid & 63, wv = tid >> 6, t0 = ci * 64;
    dplr_m3_stage(XQ, ci, lds, tid);
    __syncthreads();
    const int h = wv >> 1, tb = wv & 1, c = lane & 31, hh = lane >> 5; const size_t ch = (size_t)ci * 4 + h;
    f32x16 acc[2];
    dplr_m3_core(acc, (const LAS bf16*)(lds + h * TILE_B), XR + ch * 4096, tb, lane);
    const size_t trow = (size_t)(t0 + 32 * tb + c);
    bf16* yrow = Y + trow * 1024 + h * 64; const bf16* grow = Y + trow * 1024 + 768 + h * 64; const bf16* bvrow = XBV + (ch * 64 + 32 * tb + c) * 64;
    const float* lnw = P.in[I_LNW] + l * 256 + h * 64; const float* lnb = P.in[I_LNB] + l * 256 + h * 64;
    float s = 0.f;
#pragma unroll
    for (int vb = 0; vb < 2; ++vb)
#pragma unroll
        for (int q = 0; q < 4; ++q) { const int v = 32 * vb + 8 * q + 4 * hh; const uint2 w = *(const uint2*)(yrow + v);
            acc[vb][4 * q] += bf2f((bf16)(w.x & 0xffff)); acc[vb][4 * q + 1] += bf2f((bf16)(w.x >> 16)); acc[vb][4 * q + 2] += bf2f((bf16)(w.y & 0xffff)); acc[vb][4 * q + 3] += bf2f((bf16)(w.y >> 16));
            s += (acc[vb][4 * q] + acc[vb][4 * q + 1]) + (acc[vb][4 * q + 2] + acc[vb][4 * q + 3]); }
    s += __shfl_xor(s, 32);
    const float mean = s * (1.0f / 64.0f); float qq = 0.f;
#pragma unroll
    for (int vb = 0; vb < 2; ++vb)
#pragma unroll
        for (int r = 0; r < 16; ++r) { acc[vb][r] -= mean; qq += acc[vb][r] * acc[vb][r]; }
    qq += __shfl_xor(qq, 32);
    const float rstd = 1.0f / sqrtf(qq * (1.0f / 64.0f) + 64e-5f);
#pragma unroll
    for (int vb = 0; vb < 2; ++vb)
#pragma unroll
        for (int q = 0; q < 4; ++q) { const int v = 32 * vb + 8 * q + 4 * hh; const uint2 gw = *(const uint2*)(grow + v); const uint2 bw = *(const uint2*)(bvrow + v); float o[4];
            const float g4[4] = {bf2f((bf16)(gw.x & 0xffff)), bf2f((bf16)(gw.x >> 16)), bf2f((bf16)(gw.y & 0xffff)), bf2f((bf16)(gw.y >> 16))};
            const float b4[4] = {bf2f((bf16)(bw.x & 0xffff)), bf2f((bf16)(bw.x >> 16)), bf2f((bf16)(bw.y & 0xffff)), bf2f((bf16)(bw.y >> 16))};
#pragma unroll
            for (int e = 0; e < 4; ++e) o[e] = (acc[vb][4 * q + e] * rstd * lnw[v + e] + lnb[v + e] + b4[e]) * g4[e];
            uint2 w; w.x = pk2(o[0], o[1]); w.y = pk2(o[2], o[3]); *(uint2*)(yrow + v) = w; }
    __syncthreads();
}
#ifndef REP_GA
#define REP_GA 1
#endif
#ifndef REP_GS
#define REP_GS 1
#endif
#ifndef REP_G4
#define REP_G4 1
#endif
__device__ __forceinline__ void gdn_m1(const Params& P, int l, int ci, LAS unsigned char* lds, int tid) {
    const bf16* cols = (const bf16*)(P.ws + WS_COLS); bf16* Y = (bf16*)(P.ws + WS_Y);
    bf16* XP = (bf16*)(P.ws + WS_DP); bf16* XQ = (bf16*)(P.ws + WS_DQ); bf16* XR = (bf16*)(P.ws + WS_DR); float* XG = (float*)(P.ws + WS_XG) + 1024 * 64;
    LAS bf16* tKn = (LAS bf16*)lds; LAS bf16* tQn = tKn + 64 * TS; LAS bf16* tBV = tQn + 64 * TS; LAS bf16* tBK = tBV + 64 * TS; LAS bf16* tKd = tBK + 64 * TS;
    LAS bf16* tAab = tKd + 64 * TS; LAS bf16* tAabT = tAab + 64 * TS; LAS bf16* tX1r = tAabT + 64 * TS; LAS bf16* tX1c = tX1r + 64 * TS; LAS bf16* tT0 = tX1c + 64 * TS; LAS bf16* tT1 = tT0 + 64 * TS; LAS bf16* tQk = tT1 + 64 * TS;
    LAS bf16* tW = tAab; LAS bf16* tU = tAabT; LAS bf16* tT = tT1;
    LAS float* sG = (LAS float*)(lds + 12 * TILE_B); LAS float* sGc = sG + 64; LAS float* sBe = sGc + 64;
    const float* cw = P.in[I_CONV] + (size_t)l * 4 * 768;
#pragma unroll 1
    for (int h = 0; h < 4; ++h) {
        int tidh = tid, t0 = ci * 64; asm volatile("" : "+v"(tidh), "+s"(t0));
        const int lane = tidh & 63, wv = tidh >> 6; const size_t ch = (size_t)ci * 4 + h;
        const float alog = P.in[I_ALOG][l * 4 + h], dtb = P.in[I_DTB][l * 4 + h];
        float e_q[8], e_k[8], e_v[8], e_be[8]; float gcs[8], gc63;
        {
            float raw[3][11], braw[8], araw[8], cwv[3][4];
#pragma unroll
            for (int a = 0; a < 3; ++a)
#pragma unroll
                for (int r = 0; r < 11; ++r) { const int ts = t0 + wv * 8 - 3 + r; const float v = ldcol(cols, ts < 0 ? 0 : ts, C_GDN + a * 256 + h * 64 + lane); raw[a][r] = (ts < 0) ? 0.f : v; }
#pragma unroll
            for (int i = 0; i < 8; ++i) { braw[i] = ldcol(cols, t0 + wv * 8 + i, C_GDN + 1024 + h); araw[i] = ldcol(cols, t0 + wv * 8 + i, C_GDN + 1028 + h); }
#pragma unroll
            for (int a = 0; a < 3; ++a)
#pragma unroll
                for (int i = 0; i < 4; ++i) cwv[a][i] = cw[i * 768 + a * 256 + h * 64 + lane];
            float gv[8];
#pragma unroll
            for (int i = 0; i < 8; ++i) { float o3[3];
#pragma unroll
                for (int a = 0; a < 3; ++a) o3[a] = siluf_(cwv[a][0] * raw[a][i] + cwv[a][1] * raw[a][i + 1] + cwv[a][2] * raw[a][i + 2] + cwv[a][3] * raw[a][i + 3]);
                const float sq = wave_sum(o3[0] * o3[0]), sk = wave_sum(o3[1] * o3[1]);
                e_q[i] = o3[0] * (1.0f / sqrtf(sq + 1e-6f)) * 0.125f; e_k[i] = o3[1] * (1.0f / sqrtf(sk + 1e-6f)); e_v[i] = o3[2];
                e_be[i] = sigmoidf_(braw[i]); gv[i] = -__expf(alog) * softplusf_(araw[i] + dtb); }
            float gsel = gv[0], bsel = e_be[0];
#pragma unroll
            for (int i = 1; i < 8; ++i) { gsel = (lane == i) ? gv[i] : gsel; bsel = (lane == i) ? e_be[i] : bsel; }
            if (lane < 8) { sG[wv * 8 + lane] = gsel; sBe[wv * 8 + lane] = bsel; }
        }
        __syncthreads();
        { const float gl = sG[lane]; float run = gl;
#pragma unroll
            for (int o = 1; o < 64; o <<= 1) { const float up = __shfl_up(run, o); if (lane >= o) run += up; }
            gc63 = __shfl(run, 63);
#pragma unroll
            for (int i = 0; i < 8; ++i) gcs[i] = __shfl(run, wv * 8 + i);
            if (wv == 0) { sGc[lane] = run; XG[ch * 64 + lane] = __expf(gc63); } }
        float bk[8], kd[8], bv[8];
#pragma unroll
        for (int i = 0; i < 8; ++i) { const int t = wv * 8 + i;
            tKn[t * TS + lane] = (bf16)f2bf(e_k[i]); tQn[t * TS + lane] = (bf16)f2bf(e_q[i]);
            bv[i] = e_be[i] * e_v[i]; bk[i] = e_be[i] * e_k[i] * __expf(gcs[i]); kd[i] = e_k[i] * __expf(gc63 - gcs[i]); }
        { v4u w; w.x = pk2(bv[0], bv[1]); w.y = pk2(bv[2], bv[3]); w.z = pk2(bv[4], bv[5]); w.w = pk2(bv[6], bv[7]); *(LAS v4u*)(tBV + lane * TS + wv * 8) = w;
          w.x = pk2(bk[0], bk[1]); w.y = pk2(bk[2], bk[3]); w.z = pk2(bk[4], bk[5]); w.w = pk2(bk[6], bk[7]); *(LAS v4u*)(tBK + lane * TS + wv * 8) = w;
          w.x = pk2(kd[0], kd[1]); w.y = pk2(kd[2], kd[3]); w.z = pk2(kd[4], kd[5]); w.w = pk2(kd[6], kd[7]); *(LAS v4u*)(tKd + lane * TS + wv * 8) = w; }
        __syncthreads();
        for (int rpd_ = 0; rpd_ < REP_GS; ++rpd_)
        { const int mat = wv >> 2, r = wv & 3; const int tb = (r == 0 || r == 3) ? 0 : 1, sb = (r == 0 || r == 1) ? 0 : 1;
            f32x16 acc = zero16(); const int c = lane & 31, hh = lane >> 5;
            if (r < 3) { mm_tile<4>(acc, tKn + sb * 32 * TS, (mat ? tQn : tKn) + tb * 32 * TS, lane);
                const int tI = 32 * tb + c; const float gct = sGc[tI], bet = sBe[tI];
#pragma unroll
                for (int q = 0; q < 16; ++q) { const int sI = 32 * sb + acc_i(q, hh);
                    if ((mat == 0) ? (sI >= tI) : (sI > tI)) acc[q] = 0.f;
                    else { const float dcy = __expf(gct - sGc[sI]); acc[q] = (mat == 0) ? (-bet * acc[q] * dcy) : (acc[q] * dcy); } } }
            if (mat == 0) { store_lane_major(tAab, 32 * tb, 32 * sb, acc, lane);
                if (r == 3) store_lane_major(tT1, 0, 32, acc, lane);
                else { store_reg_major(tAabT, 32 * sb, 32 * tb, acc, lane);
#pragma unroll
                    for (int q = 0; q < 16; ++q) if (32 * sb + acc_i(q, hh) == 32 * tb + c) acc[q] += 1.0f;
                    store_lane_major(tT0, 32 * tb, 32 * sb, acc, lane); } }
            else store_lane_major(tQk, 32 * tb, 32 * sb, acc, lane);
        }
        __syncthreads();
        { LAS bf16* const Xr[2] = {tAab, tX1r}; LAS bf16* const Xc[2] = {tAabT, tX1c}; LAS bf16* const Tb[2] = {tT0, tT1};
          neumann_solve(Xr, Xc, Tb, wv, lane, [&]() {}); }
        { const int which = wv >> 2, tb = (wv >> 1) & 1, jb2 = wv & 1; f32x16 acc = zero16();
            mm_tile<4>(acc, tT + tb * 32 * TS, (which ? tBV : tBK) + jb2 * 32 * TS, lane);
            store_lane_major(which ? tU : tW, 32 * jb2, 32 * tb, acc, lane); }
        __syncthreads();
        for (int rpg_ = 0; rpg_ < REP_G4; ++rpg_)
        for (int jb = wv; jb < 16; jb += 8) { const int out = jb >> 2, ib = (jb >> 1) & 1, jb2 = jb & 1; f32x16 acc = zero16(); const int c = lane & 31, hh = lane >> 5;
            if (out < 2) mm_tile<4>(acc, tKd + ib * 32 * TS, (out ? tU : tW) + jb2 * 32 * TS, lane);
            else mm_tile<4>(acc, tQk + ib * 32 * TS, (out == 3 ? tU : tW) + jb2 * 32 * TS, lane);
            if (out == 0) { bf16* g = XP + ch * 4096 + 32 * jb2 + c;
#pragma unroll
                for (int q = 0; q < 16; ++q) { const int row = 32 * ib + acc_i(q, hh); g[row * 64] = (bf16)f2bf(-acc[q]); } }
            else if (out == 1) { bf16* g = XQ + ch * 4096 + (32 * jb2 + c) * 64 + 32 * ib + 4 * hh;
#pragma unroll
                for (int q = 0; q < 4; ++q) { uint2 w; w.x = pk2(acc[4 * q], acc[4 * q + 1]); w.y = pk2(acc[4 * q + 2], acc[4 * q + 3]); *(uint2*)(g + 8 * q) = w; } }
            else if (out == 2) { bf16* g = XR + ch * 4096 + 32 * jb2 + c;
#pragma unroll
                for (int q = 0; q < 16; ++q) { const int row = 32 * ib + acc_i(q, hh); g[row * 64] = (bf16)f2bf(bf2f(tQn[row * TS + 32 * jb2 + c]) * __expf(sGc[row]) - acc[q]); } }
            else { bf16* g = Y + (size_t)t0 * 1024 + 256 + h * 64 + 32 * jb2 + c;
#pragma unroll
                for (int q = 0; q < 16; ++q) { const int row = 32 * ib + acc_i(q, hh); g[(size_t)row * 1024] = (bf16)f2bf(acc[q]); } }
        }
        __syncthreads();
    }
}
__device__ __forceinline__ void gdn_m3(const Params& P, int l, int ci, LAS unsigned char* lds, int tid) {
    const bf16* cols = (const bf16*)(P.ws + WS_COLS); bf16* Y = (bf16*)(P.ws + WS_Y); const bf16* XQ = (const bf16*)(P.ws + WS_DQ); const bf16* XR = (const bf16*)(P.ws + WS_DR);
    const float* ng = P.in[I_GDNG] + l * 64;
    const int lane = tid & 63, wv = tid >> 6, t0 = ci * 64;
    dplr_m3_stage(XQ, ci, lds, tid);
    __syncthreads();
    const int h = wv >> 1, tb = wv & 1, c = lane & 31, hh = lane >> 5; const size_t ch = (size_t)ci * 4 + h;
    f32x16 acc[2];
    dplr_m3_core(acc, (const LAS bf16*)(lds + h * TILE_B), XR + ch * 4096, tb, lane);
    const size_t trow = (size_t)(t0 + 32 * tb + c);
    bf16* yrow = Y + trow * 1024 + 256 + h * 64; const bf16* zrow = cols + trow * NPAD + C_GDN + 768 + h * 64;
    float ss = 0.f;
#pragma unroll
    for (int vb = 0; vb < 2; ++vb)
#pragma unroll
        for (int q = 0; q < 4; ++q) { const int v = 32 * vb + 8 * q + 4 * hh; const uint2 w = *(const uint2*)(yrow + v);
            acc[vb][4 * q] += bf2f((bf16)(w.x & 0xffff)); acc[vb][4 * q + 1] += bf2f((bf16)(w.x >> 16)); acc[vb][4 * q + 2] += bf2f((bf16)(w.y & 0xffff)); acc[vb][4 * q + 3] += bf2f((bf16)(w.y >> 16));
#pragma unroll
            for (int e = 0; e < 4; ++e) ss += acc[vb][4 * q + e] * acc[vb][4 * q + e]; }
    ss += __shfl_xor(ss, 32);
    const float rstd = 1.0f / sqrtf(ss * (1.0f / 64.0f) + 1e-6f);
#pragma unroll
    for (int vb = 0; vb < 2; ++vb)
#pragma unroll
        for (int q = 0; q < 4; ++q) { const int v = 32 * vb + 8 * q + 4 * hh; const uint2 zw = *(const uint2*)(zrow + v); float o[4];
            const float z4[4] = {bf2f((bf16)(zw.x & 0xffff)), bf2f((bf16)(zw.x >> 16)), bf2f((bf16)(zw.y & 0xffff)), bf2f((bf16)(zw.y >> 16))};
#pragma unroll
            for (int e = 0; e < 4; ++e) o[e] = acc[vb][4 * q + e] * rstd * ng[v + e] * siluf_(z4[e]);
            uint2 w; w.x = pk2(o[0], o[1]); w.y = pk2(o[2], o[3]); *(uint2*)(yrow + v) = w; }
    __syncthreads();
}
constexpr int SGS = 136;
__device__ __forceinline__ void sgu_m3(const Params& P, int l, int ci, LAS unsigned char* lds, int tid) {
    const bf16* cols = (const bf16*)(P.ws + WS_COLS); bf16* Y = (bf16*)(P.ws + WS_Y);
    LAS bf16* VlT = (LAS bf16*)lds;
    LAS bf16* Wt = VlT + 256 * SGS;
    const int lane = tid & 63, wv = tid >> 6, half = ci & 1, tbase = (ci >> 1) * 128, ntok = half ? 128 : 64;
    const float* lg = P.in[I_SLG] + l * 256; const float* lb = P.in[I_SLB] + l * 256;
    const float* ws_ = P.in[I_SWS] + (size_t)l * 4 * 128 * 128; const float* bs_ = P.in[I_SBS] + l * 4 * 128;
    { const f32x4 g4 = *(const f32x4*)(lg + lane * 4), b4 = *(const f32x4*)(lb + lane * 4);
#pragma unroll 1
      for (int tb8 = 0; tb8 < ntok / 8; tb8 += 8) { uint2 raw[8];
#pragma unroll
        for (int i = 0; i < 8; ++i) raw[i] = *(const uint2*)(cols + (size_t)(tbase + wv + 8 * (tb8 + i)) * NPAD + C_SGU + 256 + lane * 4);
#pragma unroll
        for (int i = 0; i < 8; ++i) { const int t = wv + 8 * (tb8 + i); float v[4]; float s = 0.f;
            v[0] = geluf_(bf2f((bf16)(raw[i].x & 0xffff))); v[1] = geluf_(bf2f((bf16)(raw[i].x >> 16))); v[2] = geluf_(bf2f((bf16)(raw[i].y & 0xffff))); v[3] = geluf_(bf2f((bf16)(raw[i].y >> 16)));
            s = (v[0] + v[1]) + (v[2] + v[3]);
            const float mean = wave_sum(s) * (1.0f / 256.0f); float q = 0.f;
#pragma unroll
            for (int e = 0; e < 4; ++e) { v[e] -= mean; q += v[e] * v[e]; }
            const float rstd = 1.0f / sqrtf(wave_sum(q) * (1.0f / 256.0f) + 1e-5f);
#pragma unroll
            for (int e = 0; e < 4; ++e) VlT[(lane * 4 + e) * SGS + t] = (bf16)f2bf(v[e] * rstd * g4[e] + b4[e]); } } }
    { const int n4 = ntok / 4;
#pragma unroll 4
      for (int idx = tid; idx < 4 * 64 * n4; idx += NT) { const int s4 = idx % n4, row = idx / n4, g = row >> 6, t = row & 63, ta = 64 * half + t;
        const f32x4 w = *(const f32x4*)(ws_ + ((size_t)g * 128 + ta) * 128 + 4 * s4);
        u32x2 o; o.x = pk2(4 * s4 <= ta ? w[0] : 0.f, 4 * s4 + 1 <= ta ? w[1] : 0.f); o.y = pk2(4 * s4 + 2 <= ta ? w[2] : 0.f, 4 * s4 + 3 <= ta ? w[3] : 0.f);
        *(LAS u32x2*)(Wt + (g * 64 + t) * SGS + 4 * s4) = o; } }
    __syncthreads();
#pragma unroll 1
    for (int jb = wv; jb < 16; jb += 8) { const int g = jb >> 2, tb = (jb >> 1) & 1, cb = jb & 1; const int c = lane & 31, hh = lane >> 5;
        const int KT = 4 * half + 2 * tb + 2;
        f32x16 acc = zero16();
        const LAS bf16* Ar = Wt + (g * 64 + tb * 32 + c) * SGS + hh * 8; const LAS bf16* Br = VlT + (g * 64 + cb * 32 + c) * SGS + hh * 8;
#pragma unroll 2
        for (int kk = 0; kk < KT; ++kk) acc = __builtin_amdgcn_mfma_f32_32x32x16_bf16(*(const LAS bf16x8*)(Ar + kk * 16), *(const LAS bf16x8*)(Br + kk * 16), acc, 0, 0, 0);
        const int ch = g * 64 + cb * 32 + c; float uu[16], bb[16];
#pragma unroll
        for (int q = 0; q < 16; ++q) { const int ta = 64 * half + 32 * tb + acc_i(q, hh); uu[q] = ldcol(cols, tbase + ta, C_SGU + ch); bb[q] = bs_[g * 128 + ta]; }
#pragma unroll
        for (int q = 0; q < 16; ++q) { const int ta = 64 * half + 32 * tb + acc_i(q, hh); Y[(size_t)(tbase + ta) * 1024 + 768 + ch] = (bf16)f2bf(geluf_(uu[q]) * (acc[q] + bb[q])); } }
    __syncthreads();
}
#ifndef REP_RW
#define REP_RW 1
#endif
#ifndef REP_GD
#define REP_GD 1
#endif
#ifndef REP_M1
#define REP_M1 1
#endif
#ifndef REP_SGU
#define REP_SGU 1
#endif
#ifndef REP_G1
#define REP_G1 1
#endif
#ifndef REP_UP
#define REP_UP 1
#endif
#define GRID_SYNC() xcd_barrier(xbar)
__global__ void __launch_bounds__(NT, 2) fwd_kernel(Params P) {
    extern __shared__ __attribute__((aligned(16))) unsigned char lds_raw[];
    cg::grid_group grid = cg::this_grid();
    LAS unsigned char* ldsl = (LAS unsigned char*)lds_raw;
    const int G = gridDim.x;
    if (threadIdx.x < 16) ((LAS unsigned*)(ldsl + LDS_BYTES - 64))[threadIdx.x] = 0u;
    __syncthreads();
    const XcdBarrier xbar = xcd_barrier_post((unsigned*)(P.ws + WS_BAR), (volatile LAS unsigned*)(ldsl + LDS_BYTES - 64));
#define PHASE_TID() int tid = threadIdx.x; asm volatile("" : "+v"(tid)); const int lane = tid & 63, wave = __builtin_amdgcn_readfirstlane(tid >> 6); const int gw = blockIdx.x * NWAVES + wave, NGW = G * NWAVES; (void)lane; (void)gw; (void)NGW
    {
        PHASE_TID();
        prologue_weights(P, 0, 15, (float*)lds_raw, gw, NGW, wave, lane);
        prologue_lora(P, blockIdx.x * NT + tid, G * NT);
        prologue_rows(P, gw, NGW, lane);
    }
    grid.sync();
#pragma unroll 1
    for (int l_ = 0; l_ < DEPTH; ++l_) {
        int l = l_; asm volatile("" : "+s"(l));
        bf16* XB = (bf16*)(P.ws + WS_XB); bf16* YB = (bf16*)(P.ws + WS_Y); bf16* HB = (bf16*)(P.ws + WS_H); bf16* COLS = (bf16*)(P.ws + WS_COLS); float* SSQ = (float*)(P.ws + WS_SSQ);
        const unsigned char* wb = P.ws + WS_W;
        {
            pg8::Gemm g{XB, (const bf16*)(wb + W_IN), T, NPAD, D}; pg8::StaticOrder S; S.init(T, NPAD, G, (int)blockIdx.x);
            pg8::EpiScaleBf16<0> E{COLS, NPAD, SSQ};
            for (int rep_ = 0; rep_ < REP_G1; ++rep_) pg8::gemm_phase<pg8::EpiScaleBf16<0>, pg8::StaticOrder, true, true>(ldsl, g, S, E);
        }
        GRID_SYNC();
        {
            PHASE_TID();
            for (int rep_ = 0; rep_ < REP_M1; ++rep_)
            for (int ci = blockIdx.x; ci < T / 64; ci += G) {
#ifndef NO_RWKV1
                for (int r2_ = 0; r2_ < REP_RW; ++r2_) rwkv_m1(P, l, ci, ldsl, tid);
#endif
#ifndef NO_GDN1
                for (int r2_ = 0; r2_ < REP_GD; ++r2_) gdn_m1(P, l, ci, ldsl, tid);
#endif
#ifndef NO_GLA1
                gla_m1(P, l, ci, ldsl, tid);
#endif
            }
        }
        GRID_SYNC();
        {
            PHASE_TID();
            const int b = blockIdx.x;
#ifndef NO_M2
            if (b < 4) dplr_m2_block((const bf16*)(P.ws + WS_RP), (bf16*)(P.ws + WS_RQ), (const float*)(P.ws + WS_XG), b, ldsl, tid);
            else if (b < 8) dplr_m2_block((const bf16*)(P.ws + WS_DP), (bf16*)(P.ws + WS_DQ), (const float*)(P.ws + WS_XG) + 1024 * 64, b - 4, ldsl, tid);
            else if (b < 24) gla_m2(P, (b - 8) * NT + tid);
            else if (l == 0) prologue_weights(P, 1, 1, (float*)lds_raw, (b - 24) * NWAVES + wave, (G - 24) * NWAVES, wave, lane);
            else prologue_weights(P, 1, 14, (float*)lds_raw, (b - 24) * NWAVES + wave, (G - 24) * NWAVES, wave, lane);
#endif
        }
        GRID_SYNC();
        {
            PHASE_TID();
            for (int ci = blockIdx.x; ci < T / 64; ci += G) {
#ifndef NO_M3
                rwkv_m3(P, l, ci, ldsl, tid); gdn_m3(P, l, ci, ldsl, tid); gla_m3(P, l, ci, ldsl, tid); for (int rep_ = 0; rep_ < REP_SGU; ++rep_) sgu_m3(P, l, ci, ldsl, tid);
#endif
            }
        }
        GRID_SYNC();
        {
            pg8::Gemm g{YB, (const bf16*)(wb + W_OUT), T, D, D}; pg8::StaticOrder S; S.init(T, D, G, (int)blockIdx.x);
            pg8::EpiResid E{l == 0 ? P.in[I_X] : (const float*)P.out, P.out, XB, SSQ};
            pg8::gemm_phase<pg8::EpiResid, pg8::StaticOrder, true, true>(ldsl, g, S, E);
        }
        GRID_SYNC();
        {
            pg8::Gemm g{XB, (const bf16*)(wb + W_UP), T, FF, D}; pg8::StaticOrder S; S.init(T, FF, G, (int)blockIdx.x);
            pg8::EpiScaleBf16<2> E{HB, FF, SSQ};
            for (int rep_ = 0; rep_ < REP_UP; ++rep_) pg8::gemm_phase<pg8::EpiScaleBf16<2>, pg8::StaticOrder, true, true>(ldsl, g, S, E);
        }
        GRID_SYNC();
        {
            pg8::Gemm g{HB, (const bf16*)(wb + W_DN), T, D, FF}; pg8::StaticOrder S; S.init(T, D, G, (int)blockIdx.x);
            pg8::EpiResid E{(const float*)P.out, P.out, XB, SSQ};
            pg8::gemm_phase<pg8::EpiResid, pg8::StaticOrder, true, true>(ldsl, g, S, E);
        }
        GRID_SYNC();
    }
    { PHASE_TID(); final_norm(P, gw, NGW, lane); }
}

extern "C" void kernel_launch(void* const* d_in, const int* in_sizes, int n_in, void* d_out, int out_size, void* d_ws, size_t ws_size, hipStream_t stream) {
    static int grid_blocks = 0;
    if (!grid_blocks) {
        int dev = 0, cus = 0, per_cu = 0;
        if (n_in != 33 || out_size != T * D || ws_size < WS_END) { fprintf(stderr, "kernel_launch: unexpected shapes n_in %d out %d ws %zu\n", n_in, out_size, ws_size); grid_blocks = -1; return; }
        (void)hipGetDevice(&dev);
        (void)hipDeviceGetAttribute(&cus, hipDeviceAttributeMultiprocessorCount, dev);
        (void)hipFuncSetAttribute((const void*)fwd_kernel, hipFuncAttributeMaxDynamicSharedMemorySize, LDS_BYTES);
        (void)hipOccupancyMaxActiveBlocksPerMultiprocessor(&per_cu, (const void*)fwd_kernel, NT, LDS_BYTES);
        if (per_cu < 1) fprintf(stderr, "kernel_launch: occupancy query says %d blocks/CU\n", per_cu);
        grid_blocks = cus;
        (void)hipGetLastError();
    }
    if (grid_blocks < 0) return;
    (void)hipMemsetAsync((char*)d_ws + WS_BAR, 0, 16384, stream);
    Params p{};
    for (int i = 0; i < 33; ++i) p.in[i] = (const float*)d_in[i];
    p.out = (float*)d_out; p.ws = (unsigned char*)d_ws;
    void* args[] = {&p};
    hipError_t e = hipLaunchCooperativeKernel((void*)fwd_kernel, dim3(grid_blocks), dim3(NT), args, LDS_BYTES, stream);
    if (e != hipSuccess) fprintf(stderr, "cooperative launch failed: %s (grid %d)\n", hipGetErrorString(e), grid_blocks);
}
```

```cpp
#include <hip/hip_runtime.h>
#include <hip/hip_cooperative_groups.h>
#include <cstdio>
#include <cstdint>
namespace cg = cooperative_groups;
namespace pg8 {
#define PG8_LAS __attribute__((address_space(3)))
typedef unsigned short bf16_t;
typedef short bf16x8 __attribute__((ext_vector_type(8)));
typedef float f32x4 __attribute__((ext_vector_type(4)));
typedef unsigned u32x4 __attribute__((ext_vector_type(4)));
constexpr int BM = 256, BK = 64, HALF = 128, HTB = HALF * BK * 2  , STAGE_BYTES = 8 * HTB, NXCD = 8, WGM = 8;

__host__ __device__ __forceinline__ int lds_byte(int r, int c) { const int st = (r >> 4) * 2 + (c >> 5), rr = r & 15, cc = c & 31, ob = rr * 64 + cc * 2; return st * 1024 + (ob ^ (((ob >> 9) & 1) << 5)); }
__host__ __device__ __forceinline__ void stage_rc(int b, int& R, int& C) { const int st = b / 1024, sb = b % 1024, swz = sb ^ (((sb >> 9) & 1) << 5); R = (st >> 1) * 16 + swz / 64; C = (st & 1) * 32 + (swz % 64) / 2; }
__host__ __device__ __forceinline__ int perm32(int rho) { const int n = rho >> 4, i = rho & 15; return 8 * (i >> 2) + 4 * n + (i & 3); }

struct Unit { int pm, pn; };
struct Gemm { const bf16_t* A; const bf16_t* Bt; int M, N, K; };

struct StaticOrder {
    int nM, nN, nwg, G, c;
    __host__ __device__ void init(int M, int N, int G_, int c_) { nM = M / BM; nN = N / BM; nwg = nM * nN; G = G_; c = c_; }
    __host__ __device__ bool next(int i, Unit& u) const {
        const long L = (long)i * G + c; if (L >= nwg) return false;
        int wgid = (int)L; { const int q = nwg / NXCD, r = nwg % NXCD, xcd = wgid % NXCD, off = wgid / NXCD; wgid = (xcd < r ? xcd * (q + 1) : r * (q + 1) + (xcd - r) * q) + off; }
        const int nig = WGM * nN, gid = wgid / nig, fm = gid * WGM, gsz = (nM - fm) < WGM ? (nM - fm) : WGM;
        u.pm = fm + ((wgid % nig) % gsz); u.pn = (wgid % nig) / gsz; return true;
    }
    __device__ __forceinline__ void a_ready(const Unit&) const {}
    __device__ __forceinline__ void done(const Unit&) const {}
};

__device__ __forceinline__ unsigned cvt_pk_bf16(float lo, float hi) { unsigned r; asm volatile("v_cvt_pk_bf16_f32 %0, %1, %2" : "=v"(r) : "v"(lo), "v"(hi)); return r; }
typedef float f32x2 __attribute__((ext_vector_type(2)));
__device__ __forceinline__ float row_rstd16(const float* ssq, int row) {
    const f32x4* p = (const f32x4*)(ssq + (size_t)row * 16);
    const f32x4 a = p[0], b = p[1], c = p[2], d = p[3];
    const float s = ((a[0] + a[1]) + (a[2] + a[3])) + ((b[0] + b[1]) + (b[2] + b[3])) + ((c[0] + c[1]) + (c[2] + c[3])) + ((d[0] + d[1]) + (d[2] + d[3]));
    return 1.0f / sqrtf(s * (1.0f / 1024.0f) + 1e-6f);
}
template <int ACT> struct EpiScaleBf16 {
    static constexpr bool PERM = true, AFTER_DRAIN = false;
    bf16_t* O; int ldc; const float* ssq;
    __device__ __forceinline__ void operator()(const f32x4 (&acc)[2][2][4][2], const Unit& u, int wr, int wc, int fr, int fq) const {
        const int row0 = u.pm * BM + wr * 64 + fr; const int col0 = u.pn * BM + wc * 32 + 8 * fq;
#pragma unroll
        for (int ai = 0; ai < 2; ++ai)
#pragma unroll
            for (int m = 0; m < 4; ++m) { const int row = row0 + ai * HALF + m * 16; const float sc = row_rstd16(ssq, row); bf16_t* rowp = O + (size_t)row * ldc + col0;
#pragma unroll
                for (int bj = 0; bj < 2; ++bj) { f32x4 v0 = acc[ai][bj][m][0] * sc, v1 = acc[ai][bj][m][1] * sc;
                    if (ACT == 2) {
#pragma unroll
                        for (int e = 0; e < 4; ++e) { const float a0 = v0[e] > 0.f ? v0[e] : 0.f, a1 = v1[e] > 0.f ? v1[e] : 0.f; v0[e] = a0 * a0; v1[e] = a1 * a1; } }
                    u32x4 w; w.x = cvt_pk_bf16(v0[0], v0[1]); w.y = cvt_pk_bf16(v0[2], v0[3]); w.z = cvt_pk_bf16(v1[0], v1[1]); w.w = cvt_pk_bf16(v1[2], v1[3]);
                    *(u32x4*)(rowp + bj * HALF) = w; } }
    }
};
struct EpiResid {
    static constexpr bool PERM = false, AFTER_DRAIN = false;
    const float* base; float* out; bf16_t* xb; float* ssq; int dry;
    __device__ __forceinline__ void operator()(const f32x4 (&acc)[2][2][4][2], const Unit& u, int wr, int wc, int fr, int fq) const {
        typedef unsigned u32x2v __attribute__((ext_vector_type(2)));
        const int row0 = u.pm * BM + wr * 64 + fr; const int col0 = u.pn * BM + wc * 32 + 4 * fq;
#pragma unroll
        for (int ai = 0; ai < 2; ++ai)
#pragma unroll
            for (int m = 0; m < 4; ++m) { const int row = row0 + ai * HALF + m * 16; const size_t off = (size_t)row * 1024 + col0; float s = 0.f;
#pragma unroll
                for (int bj = 0; bj < 2; ++bj)
#pragma unroll
                    for (int n = 0; n < 2; ++n) { const f32x4 bs = *(const f32x4*)(base + off + bj * HALF + n * 16); const f32x4 o = bs + acc[ai][bj][m][n];
                        if (!dry) *(f32x4*)(out + off + bj * HALF + n * 16) = o; s += (o[0] * o[0] + o[1] * o[1]) + (o[2] * o[2] + o[3] * o[3]);
                        u32x2v w; w.x = cvt_pk_bf16(o[0], o[1]); w.y = cvt_pk_bf16(o[2], o[3]); if (!dry) *(u32x2v*)(xb + off + bj * HALF + n * 16) = w; }
                s += __shfl_xor(s, 16); s += __shfl_xor(s, 32);
                if (fq == 0 && !dry) ssq[(size_t)row * 16 + u.pn * 4 + wc] = s; }
    }
};
template <class Epi, class Sched, bool ALIGN_EPI = false, bool SP2 = false>
__device__ __forceinline__ void gemm_phase(PG8_LAS unsigned char* lds, const Gemm g, const Sched& S, const Epi& E) {
    int tid_o = threadIdx.x; asm volatile("" : "+v"(tid_o));
    const int tid = tid_o, wid = __builtin_amdgcn_readfirstlane(tid >> 6), lane = tid & 63, wr = wid >> 2, wc = wid & 3, fr = lane & 15, fq = lane >> 4;
    const int K = g.K, nt = K / BK;
    unsigned voffA[2], voffB[2];
#pragma unroll
    for (int i = 0; i < 2; ++i) { int R, C; stage_rc(tid * 16 + i * 8192, R, C); const int Rb = Epi::PERM ? ((R & ~31) + perm32(R & 31)) : R;
        voffA[i] = (unsigned)(R * K + C) * 2u; voffB[i] = (unsigned)(Rb * K + C) * 2u; }
    const size_t kstep = (size_t)(BK * 2);
    const size_t hstep = (size_t)HALF * K * 2;
    const size_t tstep = 2 * hstep;
    const unsigned ldsw = (unsigned)wid * 1024u;
    const int aoff = lds_byte(wr * 64 + fr, fq * 8), boff = lds_byte(wc * 32 + fr, fq * 8);
#define PG8_SA(b, h) (((b) * 2 + (h)) * HTB)
#define PG8_SB(b, h) ((4 + (b) * 2 + (h)) * HTB)
#define PG8_STAGE(bufoff, gbase, voff) do { _Pragma("unroll") for (int _i = 0; _i < 2; ++_i) \
        __builtin_amdgcn_global_load_lds((const unsigned*)((const char*)(gbase) + (voff)[_i]), (PG8_LAS unsigned*)(lds + (bufoff) + ldsw + _i * 8192), 16, 0, 0); } while (0)
#define PG8_LDA(dst, b, h) do { _Pragma("unroll") for (int m = 0; m < 4; ++m) _Pragma("unroll") for (int k = 0; k < 2; ++k) dst[m][k] = *(const PG8_LAS bf16x8*)(lds + PG8_SA(b, h) + aoff + m * 2048 + k * 1024); } while (0)
#define PG8_LDB(dst, b, h) do { _Pragma("unroll") for (int n = 0; n < 2; ++n) _Pragma("unroll") for (int k = 0; k < 2; ++k) dst[n][k] = *(const PG8_LAS bf16x8*)(lds + PG8_SB(b, h) + boff + n * 2048 + k * 1024); } while (0)
#define PG8_MMA(ai, bj, At, Bt) do { __builtin_amdgcn_s_setprio(1); _Pragma("unroll") for (int m = 0; m < 4; ++m) _Pragma("unroll") for (int n = 0; n < 2; ++n) _Pragma("unroll") for (int k = 0; k < 2; ++k) \
        acc[ai][bj][m][n] = __builtin_amdgcn_mfma_f32_16x16x32_bf16(Bt[n][k], At[m][k], acc[ai][bj][m][n], 0, 0, 0); __builtin_amdgcn_s_setprio(0); } while (0)
#define PG8_WAIT_V(n) asm volatile("s_waitcnt vmcnt(" #n ")" ::: "memory")
#define PG8_WAIT_L(n) asm volatile("s_waitcnt lgkmcnt(" #n ")" ::: "memory")
#define PG8_BAR __builtin_amdgcn_s_barrier()
#define PG8_SCHED __builtin_amdgcn_sched_barrier(0)
    Unit cur, nxt; int ui = 0;
    if (!S.next(0, cur)) return;
    f32x4 acc[2][2][4][2];
#pragma unroll
    for (int a = 0; a < 2; ++a)
#pragma unroll
        for (int b = 0; b < 2; ++b)
#pragma unroll
            for (int m = 0; m < 4; ++m)
#pragma unroll
                for (int n = 0; n < 2; ++n) acc[a][b][m][n] = (f32x4){0.f, 0.f, 0.f, 0.f};
    bf16x8 At[4][2], B0[2][2], B1[2][2];
    const char* cA = (const char*)g.A + (size_t)cur.pm * tstep; const char* cB = (const char*)g.Bt + (size_t)cur.pn * tstep;
    S.a_ready(cur);
    if constexpr (SP2) {
        PG8_STAGE(PG8_SB(0, 0), cB, voffB); PG8_STAGE(PG8_SB(0, 1), cB + hstep, voffB); PG8_STAGE(PG8_SA(0, 0), cA, voffA); PG8_STAGE(PG8_SA(0, 1), cA + hstep, voffA);
        if (wr == 1) PG8_BAR;
        PG8_WAIT_V(2); PG8_BAR;
        PG8_STAGE(PG8_SB(1, 0), cB + kstep, voffB); PG8_STAGE(PG8_SA(1, 0), cA + kstep, voffA); PG8_STAGE(PG8_SB(1, 1), cB + hstep + kstep, voffB);
        PG8_WAIT_V(6); PG8_BAR;
    } else {
        PG8_STAGE(PG8_SB(0, 0), cB, voffB); PG8_STAGE(PG8_SA(0, 0), cA, voffA); PG8_STAGE(PG8_SB(0, 1), cB + hstep, voffB); PG8_STAGE(PG8_SA(0, 1), cA + hstep, voffA);
        if (wr == 1) PG8_BAR;
        PG8_WAIT_V(4); PG8_BAR;
        PG8_STAGE(PG8_SB(1, 0), cB + kstep, voffB); PG8_STAGE(PG8_SA(1, 0), cA + kstep, voffA); PG8_STAGE(PG8_SB(1, 1), cB + hstep + kstep, voffB);
        PG8_WAIT_V(6); PG8_BAR;
    }
    for (;;) {
        const bool has_next = S.next(ui + 1, nxt);
        const char* nA = has_next ? (const char*)g.A + (size_t)nxt.pm * tstep : cA; const char* nB = has_next ? (const char*)g.Bt + (size_t)nxt.pn * tstep : cB;
        for (int t = 0; t < nt; t += 2) {
            const bool last = (t == nt - 2);
            const char* a1 = cA + (size_t)(t + 1) * kstep;
            const char* a2 = last ? nA : cA + (size_t)(t + 2) * kstep; const char* b2 = last ? nB : cB + (size_t)(t + 2) * kstep;
            const char* a3 = a2 + kstep; const char* b3 = b2 + kstep;
            if (last && has_next) S.a_ready(nxt);
            if constexpr (SP2) {
            PG8_LDB(B0, 0, 0); PG8_LDB(B1, 0, 1); PG8_SCHED; PG8_LDA(At, 0, 0); PG8_STAGE(PG8_SA(1, 1), a1 + hstep, voffA);
            PG8_WAIT_V(8); PG8_WAIT_L(0); PG8_BAR; PG8_MMA(0, 0, At, B0); PG8_MMA(0, 1, At, B1); PG8_BAR; PG8_SCHED;
            PG8_LDA(At, 0, 1); PG8_STAGE(PG8_SB(0, 0), b2, voffB); PG8_STAGE(PG8_SB(0, 1), b2 + hstep, voffB); PG8_STAGE(PG8_SA(0, 0), a2, voffA);
            PG8_WAIT_V(8); PG8_WAIT_L(0); PG8_BAR; PG8_MMA(1, 0, At, B0); PG8_MMA(1, 1, At, B1); PG8_BAR; PG8_SCHED;
            PG8_LDB(B0, 1, 0); PG8_LDB(B1, 1, 1); PG8_SCHED; PG8_LDA(At, 1, 0); PG8_STAGE(PG8_SA(0, 1), a2 + hstep, voffA);
            PG8_WAIT_V(8); PG8_WAIT_L(0); PG8_BAR; PG8_MMA(0, 0, At, B0); PG8_MMA(0, 1, At, B1); PG8_BAR; PG8_SCHED;
            PG8_LDA(At, 1, 1); PG8_STAGE(PG8_SB(1, 0), b3, voffB); PG8_STAGE(PG8_SB(1, 1), b3 + hstep, voffB); PG8_STAGE(PG8_SA(1, 0), a3, voffA);
            PG8_WAIT_V(8); PG8_WAIT_L(0); PG8_BAR; PG8_MMA(1, 0, At, B0); PG8_MMA(1, 1, At, B1); PG8_BAR; PG8_SCHED;
            } else {
            PG8_LDB(B0, 0, 0); PG8_SCHED; PG8_LDA(At, 0, 0); PG8_STAGE(PG8_SA(1, 1), a1 + hstep, voffA);
            PG8_WAIT_L(8); PG8_BAR; PG8_WAIT_L(0); PG8_MMA(0, 0, At, B0); PG8_BAR; PG8_SCHED;
            PG8_LDB(B1, 0, 1); PG8_STAGE(PG8_SB(0, 0), b2, voffB);
            PG8_BAR; PG8_WAIT_L(0); PG8_MMA(0, 1, At, B1); PG8_BAR;
            PG8_LDA(At, 0, 1); PG8_STAGE(PG8_SA(0, 0), a2, voffA);
            PG8_BAR; PG8_WAIT_L(0); PG8_MMA(1, 0, At, B0); PG8_BAR; PG8_SCHED;
            PG8_STAGE(PG8_SB(0, 1), b2 + hstep, voffB);
            PG8_WAIT_V(6); PG8_BAR; PG8_MMA(1, 1, At, B1); PG8_BAR;
            PG8_LDB(B0, 1, 0); PG8_SCHED; PG8_LDA(At, 1, 0); PG8_STAGE(PG8_SA(0, 1), a2 + hstep, voffA);
            PG8_WAIT_L(8); PG8_BAR; PG8_WAIT_L(0); PG8_MMA(0, 0, At, B0); PG8_BAR; PG8_SCHED;
            PG8_LDB(B1, 1, 1); PG8_STAGE(PG8_SB(1, 0), b3, voffB);
            PG8_BAR; PG8_WAIT_L(0); PG8_MMA(0, 1, At, B1); PG8_BAR;
            PG8_LDA(At, 1, 1); PG8_STAGE(PG8_SA(1, 0), a3, voffA);
            PG8_BAR; PG8_WAIT_L(0); PG8_MMA(1, 0, At, B0); PG8_BAR; PG8_SCHED;
            PG8_STAGE(PG8_SB(1, 1), b3 + hstep, voffB);
            PG8_WAIT_V(6); PG8_BAR; PG8_MMA(1, 1, At, B1); PG8_BAR;
            }
        }
        if constexpr (ALIGN_EPI) { if (wr == 0) PG8_BAR; }
        if constexpr (!Epi::AFTER_DRAIN) { E(acc, cur, wr, wc, fr, fq); S.done(cur); }
        if (!has_next) break;
#pragma unroll
        for (int a = 0; a < 2; ++a)
#pragma unroll
            for (int b = 0; b < 2; ++b)
#pragma unroll
                for (int m = 0; m < 4; ++m)
#pragma unroll
                    for (int n = 0; n < 2; ++n) acc[a][b][m][n] = (f32x4){0.f, 0.f, 0.f, 0.f};
        cur = nxt; cA = nA; cB = nB; ++ui;
        if constexpr (ALIGN_EPI) { if (wr == 1) PG8_BAR; }
    }
    PG8_WAIT_V(0);
    if constexpr (!ALIGN_EPI) { if (wr == 0) PG8_BAR; }
    PG8_BAR;
    if constexpr (Epi::AFTER_DRAIN) { E.fused(acc, cur, wr, wc, fr, fq, lds, wid, lane); S.done(cur); }
#undef PG8_SA
#undef PG8_SB
#undef PG8_STAGE
#undef PG8_LDA
#undef PG8_LDB
#undef PG8_MMA
#undef PG8_WAIT_V
#undef PG8_WAIT_L
#undef PG8_BAR
#undef PG8_SCHED
}
}
constexpr int T = 16384, D = 1024, FF = 4096, DEPTH = 2;
constexpr int NIN = 3352, NPAD = 3584;
constexpr int C_RWKV = 0, C_GDN = 1024, C_GLA = 2056, C_SGU = 2840, C_VRES = 3352;
constexpr int NT = 512, NWAVES = 8;
constexpr int LDS_BYTES = 147456;
typedef unsigned short bf16;
typedef float f32x4 __attribute__((ext_vector_type(4)));
typedef unsigned v4u __attribute__((ext_vector_type(4)));
#define LAS __attribute__((address_space(3)))

constexpr size_t MiB = 1u << 20;
constexpr size_t WS_BAR = 0;
constexpr size_t WS_SSQ = 1 * MiB;
constexpr size_t WS_GAL = 2 * MiB;
constexpr size_t WS_XG = 2 * MiB + 256 * 1024;
constexpr size_t WS_W = 3 * MiB;
constexpr size_t W_LAYER = 0, W_IN = 0, W_OUT = 7 * MiB, W_UP = 9 * MiB, W_DN = 17 * MiB;
constexpr size_t WS_XB = 30 * MiB;
constexpr size_t WS_Y = 62 * MiB;
constexpr size_t WS_H = 94 * MiB;
constexpr size_t WS_COLS = 94 * MiB;
constexpr size_t WS_VF = 222 * MiB;
constexpr size_t WS_RP = 30 * MiB, WS_RQ = 38 * MiB, WS_RR = 46 * MiB, WS_RBV = 54 * MiB;
constexpr size_t WS_DP = 206 * MiB, WS_DQ = 214 * MiB, WS_DR = 230 * MiB;
constexpr size_t WS_GKV = 238 * MiB, WS_GQI = 246 * MiB;
constexpr size_t WS_LORA = 250 * MiB;
constexpr int LORA_W = 0, LORA_A = 256 * 64, LORA_G = 2 * 256 * 64, LORA_V = 2 * 256 * 64 + 256 * 128, LORA_LAYER = LORA_V + 256 * 32;
constexpr size_t WS_END = 251 * MiB;

typedef float f32x2_t __attribute__((ext_vector_type(2))); typedef __bf16 bf16x2_t __attribute__((ext_vector_type(2)));
__device__ __forceinline__ unsigned pk2(float lo, float hi) { f32x2_t v = {lo, hi}; bf16x2_t b = __builtin_convertvector(v, bf16x2_t); return __builtin_bit_cast(unsigned, b); }
__device__ __forceinline__ unsigned f2bf(float f) { return pk2(f, f) & 0xffffu; }
__device__ __forceinline__ float bf2f(bf16 b) { return __builtin_bit_cast(float, (unsigned)b << 16); }
__device__ __forceinline__ float wave_sum(float v) {
    v += __builtin_bit_cast(float, __builtin_amdgcn_mov_dpp(__builtin_bit_cast(int, v), 0xB1, 0xF, 0xF, true));
    v += __builtin_bit_cast(float, __builtin_amdgcn_mov_dpp(__builtin_bit_cast(int, v), 0x4E, 0xF, 0xF, true));
    v += __builtin_bit_cast(float, __builtin_amdgcn_mov_dpp(__builtin_bit_cast(int, v), 0x141, 0xF, 0xF, true));
    v += __builtin_bit_cast(float, __builtin_amdgcn_mov_dpp(__builtin_bit_cast(int, v), 0x140, 0xF, 0xF, true));
    v += __shfl_xor(v, 16); v += __shfl_xor(v, 32);
    return v;
}
__device__ __forceinline__ float rcpf_(float x) { return __builtin_amdgcn_rcpf(x); }
__device__ __forceinline__ float rsqf_(float x) { return __builtin_amdgcn_rsqf(x); }
__device__ __forceinline__ float sigmoidf_(float x) { return rcpf_(1.0f + __expf(-x)); }
__device__ __forceinline__ float softplusf_(float x) { return fmaxf(x, 0.f) + __logf(1.0f + __expf(-fabsf(x))); }
__device__ __forceinline__ float siluf_(float x) { return x * sigmoidf_(x); }
__device__ __forceinline__ float tanhf_(float x) { return 1.0f - 2.0f * rcpf_(1.0f + __expf(2.0f * x)); }
__device__ __forceinline__ float geluf_(float x) { const float u = 0.7978845608028654f * (x + 0.044715f * x * x * x); return x * sigmoidf_(2.0f * u); }

struct Params { const float* in[33]; float* out; unsigned char* ws; };
enum { I_X = 0, I_WIN, I_WOUT, I_NMIX, I_NFFN, I_NFIN, I_MU, I_W0, I_WUP, I_A0, I_AUP, I_GUP, I_KK, I_KA, I_RK, I_LNW, I_LNB, I_V0, I_VDOWN, I_VUP,
       I_CONV, I_ALOG, I_DTB, I_GDNG, I_GKUP, I_GKB, I_GLAG, I_SLG, I_SLB, I_SWS, I_SBS, I_FUP, I_FDN };

__device__ __forceinline__ void transpose_item(const float* W, int K, int N, const float* gk, bf16* WT, int row_off, float* scr, int item, int lane) {
    const int nblk = (N + 31) / 32, kb = item / nblk, nb = item % nblk, k0 = 64 * kb, n0 = 32 * nb;
    const bool nok = (n0 + (lane & 31)) < N;
#pragma unroll 8
    for (int i = 0; i < 32; ++i) { const int kk = 2 * i + (lane >> 5); float v = 0.f; if (nok) v = W[(size_t)(k0 + kk) * N + n0 + (lane & 31)]; if (gk) v *= gk[k0 + kk]; scr[kk * 33 + (lane & 31)] = v; }
    __builtin_amdgcn_wave_barrier(); asm volatile("s_waitcnt lgkmcnt(0)" ::: "memory");
    const int c = lane & 7;
#pragma unroll
    for (int j = 0; j < 4; ++j) { const int n = (lane >> 3) + 8 * j; const float* s = scr + (8 * c) * 33 + n;
        v4u o; o.x = pk2(s[0 * 33], s[1 * 33]); o.y = pk2(s[2 * 33], s[3 * 33]); o.z = pk2(s[4 * 33], s[5 * 33]); o.w = pk2(s[6 * 33], s[7 * 33]);
        if (n0 + n < N) *(v4u*)(WT + (size_t)(row_off + n0 + n) * K + k0 + 8 * c) = o; }
    __builtin_amdgcn_wave_barrier(); asm volatile("s_waitcnt lgkmcnt(0)" ::: "memory");
}
__device__ __forceinline__ void prologue_weights(const Params& P, int l, int mask, float* lds, int gw, int NGW, int wave, int lane) {
    float* scr = lds + wave * 4096;
    unsigned char* wb = P.ws + WS_W;
    const int I_in = (mask & 1) ? (D / 64) * ((NIN + 31) / 32) : 0, I_vr = ((mask & 1) && l > 0) ? (D / 64) * 1 : 0, I_out = (mask & 2) ? (D / 64) * (D / 32) : 0, I_up = (mask & 4) ? (D / 64) * (FF / 32) : 0, I_dn = (mask & 8) ? (FF / 64) * (D / 32) : 0;
    const int NITEMS = I_in + I_vr + I_out + I_up + I_dn;
    for (int it = gw; it < NITEMS; it += NGW) {
        int r = it;
        if (r < I_in) { transpose_item(P.in[I_WIN] + (size_t)l * D * NIN, D, NIN, P.in[I_NMIX] + l * D, (bf16*)(wb + W_IN), 0, scr, r, lane); continue; } r -= I_in;
        if (r < I_vr) { transpose_item(P.in[I_VDOWN] + (size_t)(l - 1) * D * 32, D, 32, P.in[I_NMIX] + l * D, (bf16*)(wb + W_IN), NIN, scr, r, lane); continue; } r -= I_vr;
        if (r < I_out) { transpose_item(P.in[I_WOUT] + (size_t)l * D * D, D, D, nullptr, (bf16*)(wb + W_OUT), 0, scr, r, lane); continue; } r -= I_out;
        if (r < I_up) { transpose_item(P.in[I_FUP] + (size_t)l * D * FF, D, FF, P.in[I_NFFN] + l * D, (bf16*)(wb + W_UP), 0, scr, r, lane); continue; } r -= I_up;
        transpose_item(P.in[I_FDN] + (size_t)l * FF * D, FF, D, nullptr, (bf16*)(wb + W_DN), 0, scr, r, lane);
    }
}
__device__ __forceinline__ void prologue_lora(const Params& P, int gtid, int gsz) {
    bf16* dst = (bf16*)(P.ws + WS_LORA);
    for (int idx = gtid; idx < 2 * 288 * 256; idx += gsz) { const int l = idx / (288 * 256), r = idx % (288 * 256), j = r >> 8, c = r & 255; bf16* d = dst + (size_t)l * LORA_LAYER;
        if (j < 64) d[LORA_W + c * 64 + j] = (bf16)f2bf(P.in[I_WUP][((size_t)l * 64 + j) * 256 + c]);
        else if (j < 128) d[LORA_A + c * 64 + j - 64] = (bf16)f2bf(P.in[I_AUP][((size_t)l * 64 + j - 64) * 256 + c]);
        else if (j < 256) d[LORA_G + c * 128 + j - 128] = (bf16)f2bf(P.in[I_GUP][((size_t)l * 128 + j - 128) * 256 + c]);
        else if (l > 0) d[LORA_V + c * 32 + j - 256] = (bf16)f2bf(P.in[I_VUP][((size_t)(l - 1) * 32 + j - 256) * 256 + c]); }
}
__device__ __forceinline__ void prologue_rows(const Params& P, int gw, int NGW, int lane) {
    const float* x = P.in[I_X]; bf16* xb = (bf16*)(P.ws + WS_XB); float* ssq = (float*)(P.ws + WS_SSQ);
    for (int m = gw; m < T; m += NGW) {
        const f32x4* xr = (const f32x4*)(x + (size_t)m * D) + lane; f32x4 v[4]; float s = 0.f;
#pragma unroll
        for (int j = 0; j < 4; ++j) { v[j] = xr[64 * j]; s += (v[j][0] * v[j][0] + v[j][1] * v[j][1]) + (v[j][2] * v[j][2] + v[j][3] * v[j][3]); }
        s = wave_sum(s);
        unsigned long long* o8 = (unsigned long long*)(xb + (size_t)m * D) + lane;
#pragma unroll
        for (int j = 0; j < 4; ++j) o8[64 * j] = (unsigned long long)pk2(v[j][0], v[j][1]) | ((unsigned long long)pk2(v[j][2], v[j][3]) << 32);
        if (lane < 16) ssq[(size_t)m * 16 + lane] = (lane == 0) ? s : 0.f;
    }
}
__device__ __forceinline__ void final_norm(const Params& P, int gw, int NGW, int lane) {
    float* x = P.out; const float* ssq = (const float*)(P.ws + WS_SSQ); const f32x4* g4 = (const f32x4*)P.in[I_NFIN] + lane;
    for (int m = gw; m < T; m += NGW) {
        const float rstd = pg8::row_rstd16(ssq, m);
        f32x4* xr = (f32x4*)(x + (size_t)m * D) + lane;
#pragma unroll
        for (int j = 0; j < 4; ++j) { f32x4 v = xr[64 * j]; const f32x4 g = g4[64 * j]; v = v * rstd * g; xr[64 * j] = v; }
    }
}
typedef __attribute__((address_space(1))) unsigned gu32;
#define XB_TMO      128
#define XB_XCNT(j)  (256  + 64 * (j))
#define XB_XSUB(j)  (1280 + 64 * (j))
#define XB_XGEN(j)  (2304 + 64 * (j))
#define XB_TOP      3328
#define XB_TOPGEN   3392
#define XCD_BAR_WORDS 3456
#define XB_SPIN_CAP (1u << 18)

__device__ __forceinline__ unsigned xb_ld(unsigned* p)              { return __hip_atomic_load(p, __ATOMIC_RELAXED, __HIP_MEMORY_SCOPE_AGENT); }
__device__ __forceinline__ unsigned xb_add(unsigned* p, unsigned v) { return __hip_atomic_fetch_add(p, v, __ATOMIC_RELAXED, __HIP_MEMORY_SCOPE_AGENT); }
__device__ __forceinline__ unsigned xb_xcc_id() { return (unsigned)__builtin_amdgcn_s_getreg((3 << 11) | 20) & 0xFu; }
#define XB_SPIN(cond, bar) do { unsigned _sp = 0; while (cond) { __builtin_amdgcn_s_sleep(1); \
    if ((++_sp & 255u) == 0u) { if (xb_ld(&(bar)[XB_TMO])) break; if (_sp > XB_SPIN_CAP) { atomicAdd(&(bar)[XB_TMO], 1u); break; } } } } while (0)

struct XcdBarrier {
    unsigned* bar; unsigned x;
    volatile LAS unsigned* st;
};

__device__ __forceinline__ XcdBarrier xcd_barrier_post(unsigned* bar, volatile LAS unsigned* st) {
    XcdBarrier b; b.bar = bar; b.x = xb_xcc_id(); b.st = st;
    if (threadIdx.x == 0) (void)xb_add(&bar[XB_XCNT(b.x)], 1u);
    return b;
}
__device__ __forceinline__ void xcd_barrier_complete(unsigned* bar, unsigned x, unsigned& nloc, unsigned& nx) {
    const unsigned G = gridDim.x * gridDim.y * gridDim.z;
    unsigned sum, cnt, mine, sp = 0u;
    for (;;) {
        sum = 0u; cnt = 0u; mine = 0u;
#pragma unroll
        for (unsigned j = 0; j < 16; ++j) { const unsigned c = xb_ld(&bar[XB_XCNT(j)]); sum += c; cnt += (c > 0u) ? 1u : 0u; mine = (j == x) ? c : mine; }
        if (sum == G) break;
        __builtin_amdgcn_s_sleep(1);
        if ((++sp & 255u) == 0u) { if (xb_ld(&bar[XB_TMO])) break; if (sp > XB_SPIN_CAP) { atomicAdd(&bar[XB_TMO], 1u); break; } }
    }
    nloc = mine > 0u ? mine : 1u; nx = cnt > 0u ? cnt : 1u;
}

__device__ __forceinline__ void xcd_barrier(const XcdBarrier& b) {
    asm volatile("s_waitcnt vmcnt(0)" ::: "memory");
    __syncthreads();
    if (threadIdx.x == 0) {
        unsigned* bar = b.bar;
        __builtin_amdgcn_s_waitcnt(0);
        unsigned nloc = b.st[0], nx = b.st[1];
        if (nloc == 0u) { xcd_barrier_complete(bar, b.x, nloc, nx); b.st[0] = nloc; b.st[1] = nx; }
        const unsigned old = xb_add(&bar[XB_XSUB(b.x)], 1u);
        const unsigned gen = old / nloc;
        if (old + 1u == (gen + 1u) * nloc) {
            __builtin_amdgcn_fence(__ATOMIC_RELEASE, "agent");
            asm volatile("s_waitcnt vmcnt(0)" ::: "memory");
            const unsigned og = xb_add(&bar[XB_TOP], 1u);
            const unsigned tg = og / nx;
            if (og + 1u == (tg + 1u) * nx) xb_add(&bar[XB_TOPGEN], 1u);
            else XB_SPIN(xb_ld(&bar[XB_TOPGEN]) == tg, bar);
            __builtin_amdgcn_fence(__ATOMIC_ACQUIRE, "agent");
            xb_add(&bar[XB_XGEN(b.x)], 1u);
            asm volatile("s_waitcnt vmcnt(0)" ::: "memory");
        } else {
            XB_SPIN(xb_ld(&bar[XB_XGEN(b.x)]) == gen, bar);
            __builtin_amdgcn_fence(__ATOMIC_ACQUIRE, "agent");
            asm volatile("s_waitcnt vmcnt(0)" ::: "memory");
        }
    }
    __syncthreads();
}
__device__ __forceinline__ float ldcol(const bf16* cols, int t, int c) { return bf2f(cols[(size_t)t * NPAD + c]); }

__device__ __forceinline__ void rwkv_head_v1(const Params& P, int l, int h, float* lds, int tid) {
    const bf16* cols = (const bf16*)(P.ws + WS_COLS); bf16* Y = (bf16*)(P.ws + WS_Y); bf16* VF = (bf16*)(P.ws + WS_VF);
    float* sR = lds; float* sK = sR + 4096; float* sV = sK + 4096; float* sX = sV + 4096;
    float* sW = sX; float* sA = sX + 4096; float* sB = sX + 8192; float* sG = sX + 12288;
    float* sY = sX + 16384; float* sS = sY + 4096; float* sVr = sS + 64;
    const float* mu = P.in[I_MU] + l * 1024;
    const float* w_up = P.in[I_WUP] + (size_t)l * 64 * 256; const float* a_up = P.in[I_AUP] + (size_t)l * 64 * 256; const float* g_up = P.in[I_GUP] + (size_t)l * 128 * 256;
    const float* vr_up = P.in[I_VUP];
    const int lane = tid & 63, wv = tid >> 6, cc = h * 64 + lane;
    const float w0c = P.in[I_W0][l * 256 + cc], a0c = P.in[I_A0][l * 256 + cc], kkc = P.in[I_KK][l * 256 + cc], kac = P.in[I_KA][l * 256 + cc];
    const float rkc = P.in[I_RK][l * 256 + cc], lnw = P.in[I_LNW][l * 256 + cc], lnb = P.in[I_LNB][l * 256 + cc];
    const float v0c = (l > 0) ? P.in[I_V0][(l - 1) * 256 + cc] : 0.f;
    float S[64];
#pragma unroll
    for (int k = 0; k < 64; ++k) S[k] = 0.f;
    for (int ci = 0; ci < T / 64; ++ci) {
        const int t0 = ci * 64;
#pragma unroll 1
        for (int idx = tid; idx < 3 * 4096; idx += NT) { const int a = idx >> 12, t = (idx >> 6) & 63, c = idx & 63, col = a * 256 + h * 64 + c, tt = t0 + t;
            const float cur = ldcol(cols, tt, col), prv = (tt > 0) ? ldcol(cols, tt - 1, col) : 0.f; const float xs = cur + (prv - cur) * mu[col];
            (a == 0 ? sR : (a == 1 ? sK : sV))[t * 64 + c] = xs; }
#pragma unroll 1
        for (int idx = tid; idx < 64 * 256; idx += NT) { const int t = idx >> 8, j = idx & 255, col = 768 + j, tt = t0 + t;
            const float cur = ldcol(cols, tt, col), prv = (tt > 0) ? ldcol(cols, tt - 1, col) : 0.f; float xs = cur + (prv - cur) * mu[col];
            if (j < 64) xs = tanhf(xs); else if (j >= 128) xs = sigmoidf_(xs);
            sX[t * 256 + j] = xs; }
        if (l > 0)
#pragma unroll 1
        for (int idx = tid; idx < 64 * 32; idx += NT) { const int t = idx >> 5, j = idx & 31; sVr[idx] = ldcol(cols, t0 + t, C_VRES + j); }
        __syncthreads();
        float o_decay[8], o_asig[8], o_g[8], o_vmix[8];
#pragma unroll
        for (int hp = 0; hp < 2; ++hp) {
            float accw[4], acca[4], accg[4], accv[4];
#pragma unroll
            for (int i = 0; i < 4; ++i) { accw[i] = 0.f; acca[i] = 0.f; accg[i] = 0.f; accv[i] = 0.f; }
            const float* xb = sX + (wv * 8 + hp * 4) * 256;
#pragma unroll 2
            for (int j = 0; j < 64; ++j) { const float wvv = w_up[j * 256 + cc], avv = a_up[j * 256 + cc];
#pragma unroll
                for (int i = 0; i < 4; ++i) { accw[i] += xb[i * 256 + j] * wvv; acca[i] += xb[i * 256 + 64 + j] * avv; } }
#pragma unroll 2
            for (int j = 0; j < 128; ++j) { const float gvv = g_up[j * 256 + cc];
#pragma unroll
                for (int i = 0; i < 4; ++i) accg[i] += xb[i * 256 + 128 + j] * gvv; }
            if (l > 0) {
#pragma unroll 2
                for (int j = 0; j < 32; ++j) { const float vv = vr_up[j * 256 + cc];
#pragma unroll
                    for (int i = 0; i < 4; ++i) accv[i] += sVr[(wv * 8 + hp * 4 + i) * 32 + j] * vv; } }
#pragma unroll
            for (int i = 0; i < 4; ++i) { const float wpre = w0c + accw[i]; const float wlog = -softplusf_(-wpre) - 0.5f; o_decay[hp * 4 + i] = __expf(-__expf(wlog));
                o_asig[hp * 4 + i] = sigmoidf_(a0c + acca[i]); o_g[hp * 4 + i] = accg[i]; o_vmix[hp * 4 + i] = sigmoidf_(v0c + accv[i]); }
        }
        __syncthreads();
#pragma unroll
        for (int i = 0; i < 8; ++i) { const int t = wv * 8 + i, tt = t0 + t;
            const float r = sR[t * 64 + lane], k = sK[t * 64 + lane]; float v = sV[t * 64 + lane];
            const float asig = o_asig[i];
            if (l == 0) VF[(size_t)tt * 256 + cc] = (bf16)f2bf(v);
            else { const float vf = bf2f(VF[(size_t)tt * 256 + cc]); v = v + (vf - v) * o_vmix[i]; }
            const float kkr = k * kkc; const float ss = wave_sum(kkr * kkr); const float kk = kkr * (1.0f / sqrtf(ss + 1e-24f));
            const float kmod = k * (1.0f + (asig - 1.0f) * kac);
            const float bon = wave_sum(r * kmod * rkc);
            sW[t * 64 + lane] = o_decay[i]; sA[t * 64 + lane] = -kk; sB[t * 64 + lane] = kk * asig; sG[t * 64 + lane] = o_g[i]; sK[t * 64 + lane] = kmod; sV[t * 64 + lane] = v;
            if (lane == 0) sS[t] = bon; }
        __syncthreads();
        if (wv == 0) {
            for (int t = 0; t < 64; ++t) {
                const float vt = sV[t * 64 + lane];
                const f32x4* a4 = (const f32x4*)(sA + t * 64); const f32x4* w4 = (const f32x4*)(sW + t * 64); const f32x4* b4 = (const f32x4*)(sB + t * 64);
                const f32x4* k4 = (const f32x4*)(sK + t * 64); const f32x4* r4 = (const f32x4*)(sR + t * 64);
                float s0 = 0.f, s1 = 0.f, s2 = 0.f, s3 = 0.f;
#pragma unroll
                for (int q = 0; q < 16; ++q) { const f32x4 a = a4[q]; s0 += S[4 * q] * a[0]; s1 += S[4 * q + 1] * a[1]; s2 += S[4 * q + 2] * a[2]; s3 += S[4 * q + 3] * a[3]; }
                const float sa = (s0 + s1) + (s2 + s3);
                float y0 = 0.f, y1 = 0.f, y2 = 0.f, y3 = 0.f;
#pragma unroll
                for (int q = 0; q < 16; ++q) { const f32x4 w = w4[q], b = b4[q], kq = k4[q], rq = r4[q];
#pragma unroll
                    for (int e = 0; e < 4; ++e) S[4 * q + e] = S[4 * q + e] * w[e] + sa * b[e] + vt * kq[e];
                    y0 += S[4 * q] * rq[0]; y1 += S[4 * q + 1] * rq[1]; y2 += S[4 * q + 2] * rq[2]; y3 += S[4 * q + 3] * rq[3]; }
                sY[t * 64 + lane] = (y0 + y1) + (y2 + y3);
            }
        }
        __syncthreads();
#pragma unroll
        for (int i = 0; i < 8; ++i) { const int t = wv * 8 + i, tt = t0 + t;
            const float y = sY[t * 64 + lane]; const float mean = wave_sum(y) * (1.0f / 64.0f); const float d = y - mean; const float var = wave_sum(d * d) * (1.0f / 64.0f);
            float yn = d * (1.0f / sqrtf(var + 64e-5f)) * lnw + lnb; yn += sS[t] * sV[t * 64 + lane];
            Y[(size_t)tt * 1024 + cc] = (bf16)f2bf(yn * sG[t * 64 + lane]); }
        __syncthreads();
    }
}

__device__ __forceinline__ void gdn_head_v1(const Params& P, int l, int h, float* lds, int tid) {
    const bf16* cols = (const bf16*)(P.ws + WS_COLS); bf16* Y = (bf16*)(P.ws + WS_Y);
    float* sQ = lds; float* sK = sQ + 4096; float* sV = sK + 4096; float* sO = sV + 4096; float* sBeta = sO + 4096; float* sAl = sBeta + 64;
    const float* cw = P.in[I_CONV] + (size_t)l * 4 * 768;
    const int lane = tid & 63, wv = tid >> 6;
    const float alog = P.in[I_ALOG][l * 4 + h], dtb = P.in[I_DTB][l * 4 + h], ng = P.in[I_GDNG][l * 64 + lane];
    float S[64];
#pragma unroll
    for (int k = 0; k < 64; ++k) S[k] = 0.f;
    for (int ci = 0; ci < T / 64; ++ci) {
        const int t0 = ci * 64;
#pragma unroll 1
        for (int idx = tid; idx < 3 * 4096; idx += NT) { const int a = idx >> 12, t = (idx >> 6) & 63, c = idx & 63, ch = a * 256 + h * 64 + c, tt = t0 + t; float acc = 0.f;
#pragma unroll
            for (int i = 0; i < 4; ++i) { const int ts = tt - 3 + i; if (ts >= 0) acc += cw[i * 768 + ch] * ldcol(cols, ts, C_GDN + ch); }
            (a == 0 ? sQ : (a == 1 ? sK : sV))[t * 64 + c] = siluf_(acc); }
        if (tid < 64) { const int tt = t0 + tid; const float braw = ldcol(cols, tt, C_GDN + 1024 + h), araw = ldcol(cols, tt, C_GDN + 1028 + h);
            sBeta[tid] = sigmoidf_(braw); sAl[tid] = __expf(-__expf(alog) * softplusf_(araw + dtb)); }
        __syncthreads();
#pragma unroll
        for (int i = 0; i < 8; ++i) { const int t = wv * 8 + i; const float q = sQ[t * 64 + lane], k = sK[t * 64 + lane];
            const float sq = wave_sum(q * q), sk = wave_sum(k * k);
            sQ[t * 64 + lane] = q * (1.0f / sqrtf(sq + 1e-6f)) * 0.125f; sK[t * 64 + lane] = k * (1.0f / sqrtf(sk + 1e-6f)); }
        __syncthreads();
        if (wv == 0) {
            for (int t = 0; t < 64; ++t) {
                const float vt = sV[t * 64 + lane], beta = sBeta[t], al = sAl[t];
                const f32x4* k4 = (const f32x4*)(sK + t * 64); const f32x4* q4 = (const f32x4*)(sQ + t * 64);
                float s0 = 0.f, s1 = 0.f, s2 = 0.f, s3 = 0.f;
#pragma unroll
                for (int q = 0; q < 16; ++q) { const f32x4 kq = k4[q]; s0 += S[4 * q] * kq[0]; s1 += S[4 * q + 1] * kq[1]; s2 += S[4 * q + 2] * kq[2]; s3 += S[4 * q + 3] * kq[3]; }
                const float kS = al * ((s0 + s1) + (s2 + s3)); const float vn = beta * (vt - kS);
                float y0 = 0.f, y1 = 0.f, y2 = 0.f, y3 = 0.f;
#pragma unroll
                for (int q = 0; q < 16; ++q) { const f32x4 kq = k4[q], qq = q4[q];
#pragma unroll
                    for (int e = 0; e < 4; ++e) S[4 * q + e] = al * S[4 * q + e] + kq[e] * vn;
                    y0 += S[4 * q] * qq[0]; y1 += S[4 * q + 1] * qq[1]; y2 += S[4 * q + 2] * qq[2]; y3 += S[4 * q + 3] * qq[3]; }
                sO[t * 64 + lane] = (y0 + y1) + (y2 + y3);
            }
        }
        __syncthreads();
#pragma unroll
        for (int i = 0; i < 8; ++i) { const int t = wv * 8 + i, tt = t0 + t; const float o = sO[t * 64 + lane]; const float ms = wave_sum(o * o) * (1.0f / 64.0f);
            const float z = ldcol(cols, tt, C_GDN + 768 + h * 64 + lane);
            Y[(size_t)tt * 1024 + 256 + h * 64 + lane] = (bf16)f2bf(o * (1.0f / sqrtf(ms + 1e-6f)) * ng * siluf_(z)); }
        __syncthreads();
    }
}

__device__ __forceinline__ void gla_head_v1(const Params& P, int l, int h, float* lds, int tid) {
    const bf16* cols = (const bf16*)(P.ws + WS_COLS); bf16* Y = (bf16*)(P.ws + WS_Y);
    float* sQ = lds; float* sK = sQ + 2048; float* sAl = sK + 2048; float* sV = sAl + 2048; float* sO = sV + 4096; float* sGd = sO + 4096;
    const float* gk_up = P.in[I_GKUP] + (size_t)l * 16 * 128; const float* gk_b = P.in[I_GKB] + l * 128;
    const int lane = tid & 63, wv = tid >> 6; const float ng = P.in[I_GLAG][l * 64 + lane];
    float S[32];
#pragma unroll
    for (int k = 0; k < 32; ++k) S[k] = 0.f;
    for (int ci = 0; ci < T / 64; ++ci) {
        const int t0 = ci * 64;
#pragma unroll 1
        for (int idx = tid; idx < 64 * 32; idx += NT) { const int t = idx >> 5, j = idx & 31; sQ[idx] = ldcol(cols, t0 + t, C_GLA + h * 32 + j) * 0.17677669529663687f; sK[idx] = ldcol(cols, t0 + t, C_GLA + 128 + h * 32 + j); }
#pragma unroll 1
        for (int idx = tid; idx < 64 * 64; idx += NT) { const int t = idx >> 6, c = idx & 63; sV[idx] = ldcol(cols, t0 + t, C_GLA + 256 + h * 64 + c); }
#pragma unroll 1
        for (int idx = tid; idx < 64 * 16; idx += NT) { const int t = idx >> 4, i = idx & 15; sGd[idx] = ldcol(cols, t0 + t, C_GLA + 768 + i); }
        __syncthreads();
#pragma unroll 1
        for (int idx = tid; idx < 64 * 32; idx += NT) { const int t = idx >> 5, j = idx & 31; float a = gk_b[h * 32 + j];
#pragma unroll
            for (int i = 0; i < 16; ++i) a += sGd[t * 16 + i] * gk_up[i * 128 + h * 32 + j];
            sAl[idx] = __expf(-softplusf_(-a) * (1.0f / 16.0f)); }
        __syncthreads();
        if (wv == 0) {
            for (int t = 0; t < 64; ++t) {
                const float vt = sV[t * 64 + lane];
                const f32x4* a4 = (const f32x4*)(sAl + t * 32); const f32x4* k4 = (const f32x4*)(sK + t * 32); const f32x4* q4 = (const f32x4*)(sQ + t * 32);
                float y0 = 0.f, y1 = 0.f, y2 = 0.f, y3 = 0.f;
#pragma unroll
                for (int q = 0; q < 8; ++q) { const f32x4 a = a4[q], kq = k4[q], qq = q4[q];
#pragma unroll
                    for (int e = 0; e < 4; ++e) S[4 * q + e] = a[e] * S[4 * q + e] + kq[e] * vt;
                    y0 += S[4 * q] * qq[0]; y1 += S[4 * q + 1] * qq[1]; y2 += S[4 * q + 2] * qq[2]; y3 += S[4 * q + 3] * qq[3]; }
                sO[t * 64 + lane] = (y0 + y1) + (y2 + y3);
            }
        }
        __syncthreads();
#pragma unroll
        for (int i = 0; i < 8; ++i) { const int t = wv * 8 + i, tt = t0 + t; const float o = sO[t * 64 + lane]; const float ms = wave_sum(o * o) * (1.0f / 64.0f);
            const float gt = ldcol(cols, tt, C_GLA + 512 + h * 64 + lane);
            Y[(size_t)tt * 1024 + 512 + h * 64 + lane] = (bf16)f2bf(o * (1.0f / sqrtf(ms + 1e-6f)) * ng * siluf_(gt)); }
        __syncthreads();
    }
}

__device__ __forceinline__ void sgu_unit_v1(const Params& P, int l, int n, float* lds, int tid) {
    const bf16* cols = (const bf16*)(P.ws + WS_COLS); bf16* Y = (bf16*)(P.ws + WS_Y);
    float* sVl = lds;
    const int lane = tid & 63, wv = tid >> 6, t0 = n * 128;
    const float* lg = P.in[I_SLG] + l * 256; const float* lb = P.in[I_SLB] + l * 256;
    const float* ws_ = P.in[I_SWS] + (size_t)l * 4 * 128 * 128; const float* bs_ = P.in[I_SBS] + l * 4 * 128;
    for (int i = 0; i < 16; ++i) { const int t = wv * 16 + i; float v[4]; float s = 0.f;
#pragma unroll
        for (int e = 0; e < 4; ++e) { v[e] = geluf_(ldcol(cols, t0 + t, C_SGU + 256 + lane * 4 + e)); s += v[e]; }
        const float mean = wave_sum(s) * (1.0f / 256.0f); float q = 0.f;
#pragma unroll
        for (int e = 0; e < 4; ++e) { v[e] -= mean; q += v[e] * v[e]; }
        const float rstd = 1.0f / sqrtf(wave_sum(q) * (1.0f / 256.0f) + 1e-5f);
#pragma unroll
        for (int e = 0; e < 4; ++e) sVl[t * 256 + lane * 4 + e] = v[e] * rstd * lg[lane * 4 + e] + lb[lane * 4 + e]; }
    __syncthreads();
    const int g = lane >> 4;
    for (int i = 0; i < 16; ++i) { const int t = wv + 8 * i; const float* wr = ws_ + ((size_t)g * 128 + t) * 128; f32x4 acc = {0.f, 0.f, 0.f, 0.f};
        for (int s = 0; s <= t; ++s) { const float w = wr[s]; const f32x4 vv = *(const f32x4*)(sVl + s * 256 + lane * 4); acc += vv * w; }
        const float b = bs_[g * 128 + t];
#pragma unroll
        for (int e = 0; e < 4; ++e) { const float u = geluf_(ldcol(cols, t0 + t, C_SGU + lane * 4 + e)); Y[(size_t)(t0 + t) * 1024 + 768 + lane * 4 + e] = (bf16)f2bf(u * (acc[e] + b)); } }
    __syncthreads();
}
#define LDS_SYNC() do { asm volatile("s_waitcnt lgkmcnt(0)" ::: "memory"); __builtin_amdgcn_s_barrier(); asm volatile("" ::: "memory"); } while (0)
typedef short bf16x8 __attribute__((ext_vector_type(8)));
typedef float f32x16 __attribute__((ext_vector_type(16)));
typedef unsigned u32x2 __attribute__((ext_vector_type(2)));
constexpr int TS = 72;
constexpr int TILE_B = 64 * TS * 2;
template <int KT> __device__ __forceinline__ void mm_tile(f32x16& acc, const LAS bf16* Arows, const LAS bf16* Bcols, int lane) {
    const int off = (lane & 31) * TS + (lane >> 5) * 8;
#pragma unroll
    for (int kk = 0; kk < KT; ++kk) {
        const bf16x8 a = *(const LAS bf16x8*)(Arows + off + kk * 16);
        const bf16x8 b = *(const LAS bf16x8*)(Bcols + off + kk * 16);
        acc = __builtin_amdgcn_mfma_f32_32x32x16_bf16(a, b, acc, 0, 0, 0);
    }
}
template <int KT> __device__ __forceinline__ void mm_tile_gb(f32x16& acc, const LAS bf16* Arows, int lda, const bf16* Bg, int ldb, int lane) {
    const int r = lane & 31, hh = lane >> 5;
#pragma unroll
    for (int kk = 0; kk < KT; ++kk) {
        const bf16x8 a = *(const LAS bf16x8*)(Arows + r * lda + hh * 8 + kk * 16);
        const bf16x8 b = *(const bf16x8*)(Bg + r * ldb + hh * 8 + kk * 16);
        acc = __builtin_amdgcn_mfma_f32_32x32x16_bf16(a, b, acc, 0, 0, 0);
    }
}
__device__ __forceinline__ int acc_i(int r, int hh) { return (r & 3) + 8 * (r >> 2) + 4 * hh; }
__device__ __forceinline__ void store_lane_major(LAS bf16* Z, int j0, int i0, const f32x16& acc, int lane) {
    const int c = lane & 31, hh = lane >> 5;
    LAS bf16* p = Z + (j0 + c) * TS + i0 + 4 * hh;
#pragma unroll
    for (int q = 0; q < 4; ++q) { uint2 w; w.x = pk2(acc[4 * q], acc[4 * q + 1]); w.y = pk2(acc[4 * q + 2], acc[4 * q + 3]); *(LAS u32x2*)(p + 8 * q) = (u32x2){w.x, w.y}; }
}
__device__ __forceinline__ void store_reg_major(LAS bf16* Z, int i0, int j0, const f32x16& acc, int lane) {
    const int c = lane & 31, hh = lane >> 5;
#pragma unroll
    for (int r = 0; r < 16; ++r) Z[(i0 + acc_i(r, hh)) * TS + j0 + c] = (bf16)f2bf(acc[r]);
}
__device__ __forceinline__ f32x16 zero16() { f32x16 z;
#pragma unroll
    for (int r = 0; r < 16; ++r) z[r] = 0.f; return z; }
__device__ __forceinline__ void gla_m1(const Params& P, int l, int ci, LAS unsigned char* lds, int tid) {
    const bf16* cols = (const bf16*)(P.ws + WS_COLS); bf16* Y = (bf16*)(P.ws + WS_Y);
    float* GKV = (float*)(P.ws + WS_GKV); float* GAL = (float*)(P.ws + WS_GAL); bf16* GQI = (bf16*)(P.ws + WS_GQI);
    LAS float* fLa = (LAS float*)lds; LAS float* fGd = fLa + 64 * 128; LAS unsigned char* tb0 = lds + 32768 + 4096;
    const float* gk_up = P.in[I_GKUP] + (size_t)l * 16 * 128; const float* gk_b = P.in[I_GKB] + l * 128;
    const int lane = tid & 63, wv = tid >> 6, t0 = ci * 64;
#pragma unroll
    for (int idx = tid; idx < 64 * 16; idx += NT) fGd[idx] = ldcol(cols, t0 + (idx >> 4), C_GLA + 768 + (idx & 15));
    LDS_SYNC();
#pragma unroll 4
    for (int idx = tid; idx < 64 * 128; idx += NT) { const int t = idx >> 7, j = idx & 127; float a = gk_b[j];
#pragma unroll
        for (int i = 0; i < 16; ++i) a += fGd[t * 16 + i] * gk_up[i * 128 + j];
        fLa[idx] = -softplusf_(-a) * (1.0f / 16.0f); }
    LDS_SYNC();
    if (tid < 128) { float run = 0.f;
#pragma unroll 8
        for (int t = 0; t < 64; ++t) { run += fLa[t * 128 + tid]; fLa[t * 128 + tid] = run; }
        GAL[ci * 128 + tid] = __expf(run); }
    LDS_SYNC();
#pragma unroll 1
    for (int hp = 0; hp < 2; ++hp) {
#pragma unroll 4
        for (int idx = tid; idx < 2 * 64 * 32; idx += NT) { const int s = idx >> 11, t = (idx >> 5) & 63, j = idx & 31, h = 2 * hp + s;
            LAS bf16* tQ = (LAS bf16*)(tb0 + s * 5 * TILE_B); LAS bf16* tK = tQ + 64 * TS; LAS bf16* tKs = tK + 64 * TS;
            const float b = fLa[t * 128 + h * 32 + j], b63 = fLa[63 * 128 + h * 32 + j];
            const float q = ldcol(cols, t0 + t, C_GLA + h * 32 + j) * 0.17677669529663687f, k = ldcol(cols, t0 + t, C_GLA + 128 + h * 32 + j);
            const bf16 qt = (bf16)f2bf(q * __expf(b));
            tQ[t * TS + j] = qt; tK[t * TS + j] = (bf16)f2bf(k * __expf(-b)); tKs[j * TS + t] = (bf16)f2bf(k * __expf(b63 - b));
            GQI[(((size_t)ci * 4 + h) * 64 + t) * 32 + j] = qt; }
#pragma unroll 8
        for (int idx = tid; idx < 2 * 64 * 64; idx += NT) { const int s = idx >> 12, t = (idx >> 6) & 63, v = idx & 63, h = 2 * hp + s;
            LAS bf16* tV = (LAS bf16*)(tb0 + s * 5 * TILE_B + 3 * TILE_B);
            tV[v * TS + t] = cols[(size_t)(t0 + t) * NPAD + C_GLA + 256 + h * 64 + v]; }
        LDS_SYNC();
        for (int jb = wv; jb < 12; jb += 8) { const int s = jb / 6, r = jb % 6, h = 2 * hp + s;
            LAS bf16* tQ = (LAS bf16*)(tb0 + s * 5 * TILE_B); LAS bf16* tK = tQ + 64 * TS; LAS bf16* tKs = tK + 64 * TS; LAS bf16* tV = tKs + 64 * TS; LAS bf16* tSc = tV + 64 * TS;
            f32x16 acc = zero16(); const int c = lane & 31, hh = lane >> 5;
            if (r < 4) { const int tb = (r == 0 || r == 3) ? 0 : 1, sb = (r == 0 || r == 1) ? 0 : 1;
                if (r < 3) { mm_tile<2>(acc, tK + sb * 32 * TS, tQ + tb * 32 * TS, lane);
#pragma unroll
                    for (int q = 0; q < 16; ++q) { const int sI = 32 * sb + acc_i(q, hh), tI = 32 * tb + c; if (sI > tI) acc[q] = 0.f; } }
                store_lane_major(tSc, 32 * tb, 32 * sb, acc, lane);
            } else { const int vb = r - 4; mm_tile<4>(acc, tKs, tV + vb * 32 * TS, lane);
                float* g = GKV + (((size_t)ci * 4 + h) * 32) * 64 + 32 * vb + c;
#pragma unroll
                for (int q = 0; q < 16; ++q) g[acc_i(q, hh) * 64] = acc[q]; }
        }
        LDS_SYNC();
        { const int s = wv >> 2, tb = (wv >> 1) & 1, vb = wv & 1, h = 2 * hp + s;
            LAS bf16* tV = (LAS bf16*)(tb0 + s * 5 * TILE_B + 3 * TILE_B); LAS bf16* tSc = tV + 64 * TS;
            f32x16 acc = zero16(); const int c = lane & 31, hh = lane >> 5;
            mm_tile<4>(acc, tSc + tb * 32 * TS, tV + vb * 32 * TS, lane);
            bf16* y = Y + (size_t)(t0 + 32 * tb) * 1024 + 512 + h * 64 + 32 * vb + c;
#pragma unroll
            for (int q = 0; q < 16; ++q) y[(size_t)acc_i(q, hh) * 1024] = (bf16)f2bf(acc[q]); }
        LDS_SYNC();
    }
}
__device__ __forceinline__ void gla_m2(const Params& P, int e, bool do_store = true) {
    float* GKV = (float*)(P.ws + WS_GKV); const float* GAL = (const float*)(P.ws + WS_GAL);
    const int hk = e >> 6;
    float S = 0.f;
#pragma unroll 1
    for (int c0 = 0; c0 < T / 64; c0 += 16) { float kv[16], al[16];
#pragma unroll
        for (int u = 0; u < 16; ++u) { kv[u] = GKV[(size_t)(c0 + u) * 8192 + e]; al[u] = GAL[(c0 + u) * 128 + hk]; }
#pragma unroll
        for (int u = 0; u < 16; ++u) { if (do_store) GKV[(size_t)(c0 + u) * 8192 + e] = S; S = al[u] * S + kv[u]; } }
}
__device__ __forceinline__ void gla_m3(const Params& P, int l, int ci, LAS unsigned char* lds, int tid, bool do_store = true) {
    const bf16* cols = (const bf16*)(P.ws + WS_COLS); bf16* Y = (bf16*)(P.ws + WS_Y);
    const float* GKV = (const float*)(P.ws + WS_GKV); const bf16* GQI = (const bf16*)(P.ws + WS_GQI);
    const float* ng = P.in[I_GLAG] + l * 64;
    const int lane = tid & 63, wv = tid >> 6, t0 = ci * 64;
#pragma unroll 8
    for (int idx = tid; idx < 4 * 32 * 64; idx += NT) { const int h = idx >> 11, k = (idx >> 6) & 31, v = idx & 63;
        ((LAS bf16*)(lds + h * TILE_B))[v * TS + k] = (bf16)f2bf(GKV[(size_t)ci * 8192 + idx]); }
    LDS_SYNC();
    const int h = wv >> 1, tb = wv & 1, c = lane & 31, hh = lane >> 5;
    const LAS bf16* tS = (const LAS bf16*)(lds + h * TILE_B);
    f32x16 acc[2]; acc[0] = zero16(); acc[1] = zero16();
    const bf16* qg = GQI + (((size_t)ci * 4 + h) * 64 + 32 * tb + c) * 32 + hh * 8;
#pragma unroll
    for (int kk = 0; kk < 2; ++kk) { const bf16x8 b = *(const bf16x8*)(qg + kk * 16);
#pragma unroll
        for (int vb = 0; vb < 2; ++vb) { const bf16x8 a = *(const LAS bf16x8*)(tS + (vb * 32 + c) * TS + hh * 8 + kk * 16);
            acc[vb] = __builtin_amdgcn_mfma_f32_32x32x16_bf16(a, b, acc[vb], 0, 0, 0); } }
    const size_t trow = (size_t)(t0 + 32 * tb + c);
    bf16* yrow = Y + trow * 1024 + 512 + h * 64; const bf16* grow = cols + trow * NPAD + C_GLA + 512 + h * 64;
    float ss = 0.f;
#pragma unroll
    for (int vb = 0; vb < 2; ++vb)
#pragma unroll
        for (int q = 0; q < 4; ++q) { const int v = 32 * vb + 8 * q + 4 * hh; const uint2 w = *(const uint2*)(yrow + v);
            acc[vb][4 * q] += bf2f((bf16)(w.x & 0xffff)); acc[vb][4 * q + 1] += bf2f((bf16)(w.x >> 16)); acc[vb][4 * q + 2] += bf2f((bf16)(w.y & 0xffff)); acc[vb][4 * q + 3] += bf2f((bf16)(w.y >> 16));
#pragma unroll
            for (int e = 0; e < 4; ++e) ss += acc[vb][4 * q + e] * acc[vb][4 * q + e]; }
    ss += __shfl_xor(ss, 32);
    const float rstd = rsqf_(ss * (1.0f / 64.0f) + 1e-6f);
#pragma unroll
    for (int vb = 0; vb < 2; ++vb)
#pragma unroll
        for (int q = 0; q < 4; ++q) { const int v = 32 * vb + 8 * q + 4 * hh; const uint2 gw = *(const uint2*)(grow + v); float o[4];
            const float g0 = bf2f((bf16)(gw.x & 0xffff)), g1 = bf2f((bf16)(gw.x >> 16)), g2 = bf2f((bf16)(gw.y & 0xffff)), g3 = bf2f((bf16)(gw.y >> 16));
            o[0] = acc[vb][4 * q] * rstd * ng[v] * siluf_(g0); o[1] = acc[vb][4 * q + 1] * rstd * ng[v + 1] * siluf_(g1);
            o[2] = acc[vb][4 * q + 2] * rstd * ng[v + 2] * siluf_(g2); o[3] = acc[vb][4 * q + 3] * rstd * ng[v + 3] * siluf_(g3);
            uint2 w; w.x = pk2(o[0], o[1]); w.y = pk2(o[2], o[3]); if (do_store) *(uint2*)(yrow + v) = w; }
    LDS_SYNC();
}
__device__ __forceinline__ void nm_square(const LAS bf16* Xr, const LAS bf16* Xc, LAS bf16* Xr_o, LAS bf16* Xc_o, int I, int J, int lane) {
    f32x16 acc = zero16();
    if (I == J) mm_tile<2>(acc, Xr + I * 32 * TS + 32 * I, Xc + J * 32 * TS + 32 * I, lane);
    else mm_tile<4>(acc, Xr + 32 * TS, Xc, lane);
    store_lane_major(Xc_o, 32 * J, 32 * I, acc, lane);
    store_reg_major(Xr_o, 32 * I, 32 * J, acc, lane);
}
__device__ __forceinline__ void nm_update(const LAS bf16* Tt, const LAS bf16* Xc, LAS bf16* Tt_o, int I, int J, int lane) {
    const int c = lane & 31, hh = lane >> 5; f32x16 acc;
#pragma unroll
    for (int q = 0; q < 4; ++q) { const u32x2 w = *(const LAS u32x2*)(Tt + (32 * I + c) * TS + 32 * J + 8 * q + 4 * hh);
        acc[4 * q] = bf2f((bf16)(w.x & 0xffff)); acc[4 * q + 1] = bf2f((bf16)(w.x >> 16)); acc[4 * q + 2] = bf2f((bf16)(w.y & 0xffff)); acc[4 * q + 3] = bf2f((bf16)(w.y >> 16)); }
    if (I == J) mm_tile<2>(acc, Xc + J * 32 * TS + 32 * I, Tt + I * 32 * TS + 32 * I, lane);
    else mm_tile<4>(acc, Xc, Tt + 32 * TS, lane);
    store_lane_major(Tt_o, 32 * I, 32 * J, acc, lane);
}
#define NM_TILE_IJ(w3, I_, J_) const int I_ = ((w3) == 0) ? 0 : 1, J_ = ((w3) == 2) ? 1 : 0
template <class Extra> __device__ __forceinline__ void neumann_solve(LAS bf16* const (&Xr)[2], LAS bf16* const (&Xc)[2], LAS bf16* const (&Tt)[2], int wv, int lane, const Extra& extra) {
    if (wv < 3) { NM_TILE_IJ(wv, I, J); nm_square(Xr[0], Xc[0], Xr[1], Xc[1], I, J, lane); }
    else if (wv >= 4) extra();
    LDS_SYNC();
#pragma unroll 1
    for (int k = 1; k <= 4; ++k) {
        const int xb = k & 1, tbuf = (k - 1) & 1;
        if (wv < 3) { NM_TILE_IJ(wv, I, J); nm_update(Tt[tbuf], Xc[xb], Tt[tbuf ^ 1], I, J, lane); }
        else if (wv < 6) { NM_TILE_IJ(wv - 3, I, J); nm_square(Xr[xb], Xc[xb], Xr[xb ^ 1], Xc[xb ^ 1], I, J, lane); }
        LDS_SYNC();
    }
    if (wv < 3) { NM_TILE_IJ(wv, I, J); nm_update(Tt[0], Xc[1], Tt[1], I, J, lane); }
    LDS_SYNC();
}
typedef float f32x4v __attribute__((ext_vector_type(4)));
constexpr int M2_D = 6;
constexpr int M2_SLOT = 2 * TILE_B + 256;
__device__ __forceinline__ void dplr_m2_block(const bf16* XP, bf16* XQ, const float* XG, int h, LAS unsigned char* lds, int tid, bool do_store = true) {
    const int lane = tid & 63, wv = __builtin_amdgcn_readfirstlane(tid >> 6);
    const int g = lane >> 4, n = lane & 15, v0 = wv * 16;
    const int q = tid - 256;
    f32x4v H[4];
#pragma unroll
    for (int m = 0; m < 4; ++m) H[m] = (f32x4v){0.f, 0.f, 0.f, 0.f};
    v4u ring[M2_D][5];
#define M2_ISSUE(c, R) do { const size_t ch_ = (size_t)(c) * 4 + h; const v4u* Pp = (const v4u*)(XP + ch_ * 4096); const v4u* Qp = (const v4u*)(XQ + ch_ * 4096); \
        R[0] = Pp[q]; R[1] = Pp[q + 256]; R[2] = Qp[q]; R[3] = Qp[q + 256]; R[4] = ((const v4u*)(XG + ch_ * 64))[q & 15]; } while (0)
#define M2_PUT(slot, R) do { LAS unsigned char* sp = lds + (slot) * M2_SLOT; \
        *(LAS v4u*)(sp + (q >> 3) * (TS * 2) + (q & 7) * 16) = R[0]; *(LAS v4u*)(sp + ((q >> 3) + 32) * (TS * 2) + (q & 7) * 16) = R[1]; \
        *(LAS v4u*)(sp + TILE_B + (q >> 3) * (TS * 2) + (q & 7) * 16) = R[2]; *(LAS v4u*)(sp + TILE_B + ((q >> 3) + 32) * (TS * 2) + (q & 7) * 16) = R[3]; \
        if (q < 16) *(LAS v4u*)(sp + 2 * TILE_B + q * 16) = R[4]; } while (0)
#define M2_STEP(c, slot) do { const LAS unsigned char* sp = lds + (slot) * M2_SLOT; const size_t ch_ = (size_t)(c) * 4 + h; bf16* Qg = XQ + ch_ * 4096; \
        bf16x8 bfr[2]; \
        _Pragma("unroll") for (int s = 0; s < 2; ++s) { v4u w; w.x = pk2(H[2 * s][0], H[2 * s][1]); w.y = pk2(H[2 * s][2], H[2 * s][3]); w.z = pk2(H[2 * s + 1][0], H[2 * s + 1][1]); w.w = pk2(H[2 * s + 1][2], H[2 * s + 1][3]); bfr[s] = __builtin_bit_cast(bf16x8, w); } \
        _Pragma("unroll") for (int m = 0; m < 4; ++m) { \
            const u32x2 qw = *(const LAS u32x2*)(sp + TILE_B + (v0 + n) * (TS * 2) + (16 * m + 4 * g) * 2); const f32x4v gm = *(const LAS f32x4v*)(sp + 2 * TILE_B + (16 * m + 4 * g) * 4); \
            u32x2 hw; hw.x = pk2(H[m][0], H[m][1]); hw.y = pk2(H[m][2], H[m][3]); if (do_store) *(u32x2*)(Qg + (v0 + n) * 64 + 16 * m + 4 * g) = hw; \
            f32x4v a; a[0] = gm[0] * H[m][0] + bf2f((bf16)(qw.x & 0xffff)); a[1] = gm[1] * H[m][1] + bf2f((bf16)(qw.x >> 16)); a[2] = gm[2] * H[m][2] + bf2f((bf16)(qw.y & 0xffff)); a[3] = gm[3] * H[m][3] + bf2f((bf16)(qw.y >> 16)); \
            _Pragma("unroll") for (int s = 0; s < 2; ++s) { const u32x2 p0 = *(const LAS u32x2*)(sp + (16 * m + n) * (TS * 2) + (32 * s + 4 * g) * 2); const u32x2 p1 = *(const LAS u32x2*)(sp + (16 * m + n) * (TS * 2) + (32 * s + 16 + 4 * g) * 2); \
                v4u w; w.x = p0.x; w.y = p0.y; w.z = p1.x; w.w = p1.y; \
                a = __builtin_amdgcn_mfma_f32_16x16x32_bf16(__builtin_bit_cast(bf16x8, w), bfr[s], a, 0, 0, 0); } \
            H[m] = a; } } while (0)
#define M2_BAR() do { asm volatile("s_waitcnt lgkmcnt(0)" ::: "memory"); __builtin_amdgcn_s_barrier(); asm volatile("" ::: "memory"); } while (0)
    if (wv >= 4) {
#pragma unroll
        for (int d = 0; d < M2_D; ++d) M2_ISSUE(d, ring[d]);
        M2_PUT(0, ring[0]);
        M2_ISSUE(M2_D, ring[0]);
        M2_BAR();
#pragma unroll 1
        for (int c0 = 0; c0 < T / 64; c0 += M2_D) {
#pragma unroll
            for (int u = 0; u < M2_D; ++u) { const int cn = c0 + u + 1 + M2_D;
                M2_PUT((u + 1) & 1, ring[(u + 1) % M2_D]);
                M2_ISSUE(cn < T / 64 ? cn : T / 64 - 1, ring[(u + 1) % M2_D]);
                M2_BAR(); }
        }
    } else {
        M2_BAR();
#pragma unroll 1
        for (int c0 = 0; c0 < T / 64; c0 += M2_D) {
#pragma unroll
            for (int u = 0; u < M2_D; ++u) { const int c = c0 + u;
                if (c < T / 64) M2_STEP(c, u & 1);
                M2_BAR(); }
        }
    }
#undef M2_BAR
#undef M2_ISSUE
#undef M2_PUT
#undef M2_STEP
}
__device__ __forceinline__ void dplr_m3_stage(const bf16* XQ, int ci, LAS unsigned char* lds, int tid) {
#pragma unroll
    for (int i = 0; i < 4; ++i) { const int idx = tid + NT * i, h = idx >> 9, v = (idx >> 3) & 63, c8 = idx & 7;
        *(LAS v4u*)(lds + h * TILE_B + v * (TS * 2) + c8 * 16) = *(const v4u*)(XQ + (size_t)ci * 16384 + (size_t)idx * 8); }
}
__device__ __forceinline__ void dplr_m3_core(f32x16 (&acc)[2], const LAS bf16* tHT, const bf16* XRch, int tb, int lane) {
    const int c = lane & 31, hh = lane >> 5;
    const bf16* rg = XRch + (32 * tb + c) * 64 + hh * 8;
    acc[0] = zero16(); acc[1] = zero16();
#pragma unroll
    for (int kk = 0; kk < 4; ++kk) { const bf16x8 b = *(const bf16x8*)(rg + kk * 16);
#pragma unroll
        for (int vb = 0; vb < 2; ++vb) { const bf16x8 a = *(const LAS bf16x8*)(tHT + (vb * 32 + c) * TS + hh * 8 + kk * 16);
            acc[vb] = __builtin_amdgcn_mfma_f32_32x32x16_bf16(a, b, acc[vb], 0, 0, 0); } }
}
__device__ __forceinline__ void rwkv_m1(const Params& P, int l, int ci, LAS unsigned char* lds, int tid) {
    const bf16* cols = (const bf16*)(P.ws + WS_COLS); bf16* Y = (bf16*)(P.ws + WS_Y); bf16* VF = (bf16*)(P.ws + WS_VF);
    bf16* XP = (bf16*)(P.ws + WS_RP); bf16* XQ = (bf16*)(P.ws + WS_RQ); bf16* XR = (bf16*)(P.ws + WS_RR); bf16* XBV = (bf16*)(P.ws + WS_RBV); float* XG = (float*)(P.ws + WS_XG);
    LAS bf16* tA = (LAS bf16*)lds; LAS bf16* tB = tA + 64 * TS; LAS bf16* tK = tB + 64 * TS; LAS bf16* tR = tK + 64 * TS; LAS bf16* tV = tR + 64 * TS;
    LAS bf16* tAab = tV + 64 * TS; LAS bf16* tAak = tAab + 64 * TS; LAS bf16* tArb = tAak + 64 * TS; LAS bf16* tArk = tArb + 64 * TS;
    LAS bf16* tAabT = tArk + 64 * TS; LAS bf16* tX1r = tAabT + 64 * TS; LAS bf16* tX1c = tX1r + 64 * TS; LAS bf16* tT0 = tX1c + 64 * TS; LAS bf16* tT1 = tT0 + 64 * TS; LAS bf16* tAV = tT1 + 64 * TS;
    LAS bf16* tW = tAab; LAS bf16* tU = tAak; LAS bf16* tT = tT1;
    LAS float* gC = (LAS float*)(lds + 5 * TILE_B + 77824 + 16384);
    LAS bf16* xW = (LAS bf16*)(lds + 5 * TILE_B); LAS bf16* xA = xW + 64 * 72; LAS bf16* xG = xA + 64 * 72; LAS bf16* xV = xG + 64 * 136; LAS bf16* Lw = xV + 64 * 40;
    LAS float* sLw = (LAS float*)(lds + 5 * TILE_B + 77824);
    const float* mu = P.in[I_MU] + l * 1024;
#pragma unroll 1
    for (int h = 0; h < 4; ++h) {
        int tidh = tid, t0 = ci * 64; asm volatile("" : "+v"(tidh), "+s"(t0));
        const int lane = tidh & 63, wv = tidh >> 6;
        const int cc = h * 64 + lane; const size_t ch = (size_t)ci * 4 + h;
#pragma unroll 8
        for (int idx = tidh; idx < 64 * 256; idx += NT) { const int t = idx >> 8, j = idx & 255, col = 768 + j, tt = t0 + t;
            const float cur = ldcol(cols, tt, col); float prv = ldcol(cols, tt > 0 ? tt - 1 : 0, col); prv = (tt > 0) ? prv : 0.f; const float xs = cur + (prv - cur) * mu[col];
            if (j < 64) xW[t * 72 + j] = (bf16)f2bf(tanhf_(xs)); else if (j < 128) xA[t * 72 + j - 64] = (bf16)f2bf(xs); else xG[t * 136 + j - 128] = (bf16)f2bf(sigmoidf_(xs)); }
        if (l > 0) {
#pragma unroll
            for (int idx = tidh; idx < 64 * 32; idx += NT) { const int t = idx >> 5, j = idx & 31; xV[t * 40 + j] = cols[(size_t)(t0 + t) * NPAD + C_VRES + j]; } }
        LDS_SYNC();
        { const bf16* lw = (const bf16*)(P.ws + WS_LORA) + (size_t)l * LORA_LAYER;
          for (int jb = wv; jb < (l > 0 ? 16 : 12); jb += 8) { const int which = jb >> 2, tb = (jb >> 1) & 1, cb = jb & 1; f32x16 acc = zero16();
            const int crow = h * 64 + cb * 32;
            if (which == 0) mm_tile_gb<4>(acc, xW + tb * 32 * 72, 72, lw + LORA_W + crow * 64, 64, lane);
            else if (which == 1) mm_tile_gb<4>(acc, xA + tb * 32 * 72, 72, lw + LORA_A + crow * 64, 64, lane);
            else if (which == 2) mm_tile_gb<8>(acc, xG + tb * 32 * 136, 136, lw + LORA_G + crow * 128, 128, lane);
            else mm_tile_gb<2>(acc, xV + tb * 32 * 40, 40, lw + LORA_V + crow * 32, 32, lane);
            store_lane_major(Lw + which * 64 * TS, 32 * cb, 32 * tb, acc, lane); } }
        LDS_SYNC();
        const float w0c = P.in[I_W0][l * 256 + cc], a0c = P.in[I_A0][l * 256 + cc], kkc = P.in[I_KK][l * 256 + cc], kac = P.in[I_KA][l * 256 + cc], rkc = P.in[I_RK][l * 256 + cc];
        const float v0c = (l > 0) ? P.in[I_V0][(l - 1) * 256 + cc] : 0.f;
        float o_lw[8], o_asig[8], o_vmix[8];
        { const v4u pw = *(const LAS v4u*)(Lw + lane * TS + wv * 8), pa = *(const LAS v4u*)(Lw + 64 * TS + lane * TS + wv * 8), pg = *(const LAS v4u*)(Lw + 2 * 64 * TS + lane * TS + wv * 8);
          v4u pv = {0u, 0u, 0u, 0u}; if (l > 0) pv = *(const LAS v4u*)(Lw + 3 * 64 * TS + lane * TS + wv * 8);
#pragma unroll
          for (int i = 0; i < 8; ++i) { const unsigned uw = (i < 2 ? pw.x : i < 4 ? pw.y : i < 6 ? pw.z : pw.w), ua = (i < 2 ? pa.x : i < 4 ? pa.y : i < 6 ? pa.z : pa.w), ug = (i < 2 ? pg.x : i < 4 ? pg.y : i < 6 ? pg.z : pg.w), uv = (i < 2 ? pv.x : i < 4 ? pv.y : i < 6 ? pv.z : pv.w);
            const float accw = bf2f((bf16)((i & 1) ? (uw >> 16) : (uw & 0xffff))), acca = bf2f((bf16)((i & 1) ? (ua >> 16) : (ua & 0xffff))), accv = bf2f((bf16)((i & 1) ? (uv >> 16) : (uv & 0xffff)));
            const bf16 gbits = (bf16)((i & 1) ? (ug >> 16) : (ug & 0xffff));
            const float wpre = w0c + accw; const float wlog = -softplusf_(-wpre) - 0.5f; o_lw[i] = -__expf(wlog);
            o_asig[i] = sigmoidf_(a0c + acca); o_vmix[i] = sigmoidf_(v0c + accv);
            Y[(size_t)(t0 + wv * 8 + i) * 1024 + 768 + cc] = gbits; } }
        float e_r[8], e_k[8], e_v[8], e_kk[8];
        {
            float raw[3][9], vfv[8];
#pragma unroll
            for (int a = 0; a < 3; ++a)
#pragma unroll
                for (int rr = 0; rr < 9; ++rr) { const int tt = t0 + wv * 8 - 1 + rr; const float v = ldcol(cols, tt < 0 ? 0 : tt, a * 256 + cc); raw[a][rr] = (tt < 0) ? 0.f : v; }
#pragma unroll
            for (int i = 0; i < 8; ++i) vfv[i] = (l > 0) ? bf2f(VF[(size_t)(t0 + wv * 8 + i) * 256 + cc]) : 0.f;
            const float mu_r = mu[cc], mu_k = mu[256 + cc], mu_v = mu[512 + cc];
#pragma unroll
            for (int i = 0; i < 8; ++i) { const int t = wv * 8 + i, tt = t0 + t;
                const float r = raw[0][i + 1] + (raw[0][i] - raw[0][i + 1]) * mu_r, k = raw[1][i + 1] + (raw[1][i] - raw[1][i + 1]) * mu_k; float v = raw[2][i + 1] + (raw[2][i] - raw[2][i + 1]) * mu_v;
                if (l == 0) VF[(size_t)tt * 256 + cc] = (bf16)f2bf(v);
                else v = v + (vfv[i] - v) * o_vmix[i];
                const float kkr = k * kkc; const float ss = wave_sum(kkr * kkr); const float kk = kkr * rsqf_(ss + 1e-24f);
                const float kmod = k * (1.0f + (o_asig[i] - 1.0f) * kac);
                const float bon = wave_sum(r * kmod * rkc);
                XBV[(ch * 64 + t) * 64 + lane] = (bf16)f2bf(bon * v);
                sLw[t * 64 + lane] = o_lw[i];
                e_r[i] = r; e_k[i] = kmod; e_v[i] = v; e_kk[i] = kk; }
        }
        LDS_SYNC();
        if (tidh < 64) { float run = 0.f;
#pragma unroll 8
            for (int t = 0; t < 64; ++t) { run += sLw[t * 64 + tidh]; sLw[t * 64 + tidh] = run; }
            const float gam = __expf(run); gC[tidh] = gam; XG[ch * 64 + tidh] = gam; }
        LDS_SYNC();
        float at[8], bt[8], kt[8];
#pragma unroll
        for (int i = 0; i < 8; ++i) { const int t = wv * 8 + i; const float cum = sLw[t * 64 + lane], cumm = (t > 0) ? sLw[(t - 1) * 64 + lane] : 0.f;
            const float ep = __expf(cum), en = __expf(-cum), epm = __expf(cumm);
            at[i] = -e_kk[i] * epm; bt[i] = e_kk[i] * o_asig[i] * en; kt[i] = e_k[i] * en;
            tA[t * TS + lane] = (bf16)f2bf(at[i]); tB[t * TS + lane] = (bf16)f2bf(bt[i]); tK[t * TS + lane] = (bf16)f2bf(kt[i]); tR[t * TS + lane] = (bf16)f2bf(e_r[i] * ep); }
        { v4u w; w.x = pk2(e_v[0], e_v[1]); w.y = pk2(e_v[2], e_v[3]); w.z = pk2(e_v[4], e_v[5]); w.w = pk2(e_v[6], e_v[7]); *(LAS v4u*)(tV + lane * TS + wv * 8) = w; }
        LDS_SYNC();
        for (int jb = wv; jb < 16; jb += 8) { const int mat = jb >> 2, r = jb & 3; const int tb = (r == 0 || r == 3) ? 0 : 1, sb = (r == 0 || r == 1) ? 0 : 1;
            f32x16 acc = zero16(); const int c = lane & 31, hh = lane >> 5;
            if (r < 3) { mm_tile<4>(acc, ((mat & 1) ? tK : tB) + sb * 32 * TS, ((mat >> 1) ? tR : tA) + tb * 32 * TS, lane);
#pragma unroll
                for (int q = 0; q < 16; ++q) { const int sI = 32 * sb + acc_i(q, hh), tI = 32 * tb + c; if ((mat < 2) ? (sI >= tI) : (sI > tI)) acc[q] = 0.f; } }
            store_lane_major(tAab + mat * 64 * TS, 32 * tb, 32 * sb, acc, lane);
            if (mat == 0) {
                if (r == 3) store_lane_major(tT1, 0, 32, acc, lane);
                else { store_reg_major(tAabT, 32 * sb, 32 * tb, acc, lane);
#pragma unroll
                    for (int q = 0; q < 16; ++q) if (32 * sb + acc_i(q, hh) == 32 * tb + c) acc[q] += 1.0f;
                    store_lane_major(tT0, 32 * tb, 32 * sb, acc, lane); } }
        }
        LDS_SYNC();
        { v4u w; w.x = pk2(at[0], at[1]); w.y = pk2(at[2], at[3]); w.z = pk2(at[4], at[5]); w.w = pk2(at[6], at[7]); *(LAS v4u*)(tA + lane * TS + wv * 8) = w;
          w.x = pk2(bt[0], bt[1]); w.y = pk2(bt[2], bt[3]); w.z = pk2(bt[4], bt[5]); w.w = pk2(bt[6], bt[7]); *(LAS v4u*)(tB + lane * TS + wv * 8) = w;
          w.x = pk2(kt[0], kt[1]); w.y = pk2(kt[2], kt[3]); w.z = pk2(kt[4], kt[5]); w.w = pk2(kt[6], kt[7]); *(LAS v4u*)(tK + lane * TS + wv * 8) = w; }
        { LAS bf16* const Xr[2] = {tAab, tX1r}; LAS bf16* const Xc[2] = {tAabT, tX1c}; LAS bf16* const Tb[2] = {tT0, tT1};
          neumann_solve(Xr, Xc, Tb, wv, lane, [&]() { const int sb = (wv - 4) >> 1, vb = (wv - 4) & 1; f32x16 acc = zero16();
              mm_tile<4>(acc, tAak + sb * 32 * TS, tV + vb * 32 * TS, lane); store_lane_major(tAV, 32 * vb, 32 * sb, acc, lane); }); }
        { const int which = wv >> 2, tb = (wv >> 1) & 1, jb2 = wv & 1; f32x16 acc = zero16();
            mm_tile<4>(acc, tT + tb * 32 * TS, (which ? tAV : tA) + jb2 * 32 * TS, lane);
            store_lane_major(which ? tU : tW, 32 * jb2, 32 * tb, acc, lane); }
        LDS_SYNC();
        for (int jb = wv; jb < 16; jb += 8) { const int out = jb >> 2, ib = (jb >> 1) & 1, jb2 = jb & 1; f32x16 acc = zero16(); const int c = lane & 31, hh = lane >> 5;
            if (out == 0) mm_tile<4>(acc, tB + ib * 32 * TS, tW + jb2 * 32 * TS, lane);
            else if (out == 1) { mm_tile<4>(acc, tB + ib * 32 * TS, tU + jb2 * 32 * TS, lane); mm_tile<4>(acc, tK + ib * 32 * TS, tV + jb2 * 32 * TS, lane); }
            else if (out == 2) mm_tile<4>(acc, tArb + ib * 32 * TS, tW + jb2 * 32 * TS, lane);
            else { mm_tile<4>(acc, tArb + ib * 32 * TS, tU + jb2 * 32 * TS, lane); mm_tile<4>(acc, tArk + ib * 32 * TS, tV + jb2 * 32 * TS, lane); }
            if (out == 0) { bf16* g = XP + ch * 4096 + 32 * jb2 + c;
#pragma unroll
                for (int q = 0; q < 16; ++q) { const int row = 32 * ib + acc_i(q, hh); g[row * 64] = (bf16)f2bf(acc[q] * gC[row]); } }
            else if (out == 1) { bf16* g = XQ + ch * 4096 + (32 * jb2 + c) * 64 + 32 * ib + 4 * hh;
#pragma unroll
                for (int q = 0; q < 4; ++q) { const int row = 32 * ib + 8 * q + 4 * hh; uint2 w; w.x = pk2(acc[4 * q] * gC[row], acc[4 * q + 1] * gC[row + 1]); w.y = pk2(acc[4 * q + 2] * gC[row + 2], acc[4 * q + 3] * gC[row + 3]); *(uint2*)(g + 8 * q) = w; } }
            else if (out == 2) { bf16* g = XR + ch * 4096 + 32 * jb2 + c;
#pragma unroll
                for (int q = 0; q < 16; ++q) { const int row = 32 * ib + acc_i(q, hh); g[row * 64] = (bf16)f2bf(acc[q] + bf2f(tR[row * TS + 32 * jb2 + c])); } }
            else { bf16* g = Y + (size_t)t0 * 1024 + h * 64 + 32 * jb2 + c;
#pragma unroll
                for (int q = 0; q < 16; ++q) { const int row = 32 * ib + acc_i(q, hh); g[(size_t)row * 1024] = (bf16)f2bf(acc[q]); } }
        }
        LDS_SYNC();
    }
}
__device__ __forceinline__ void rwkv_m3(const Params& P, int l, int ci, LAS unsigned char* lds, int tid, bool do_store = true) {
    bf16* Y = (bf16*)(P.ws + WS_Y); const bf16* XQ = (const bf16*)(P.ws + WS_RQ); const bf16* XR = (const bf16*)(P.ws + WS_RR); const bf16* XBV = (const bf16*)(P.ws + WS_RBV);
    const int lane = tid & 63, wv = tid >> 6, t0 = ci * 64;
    dplr_m3_stage(XQ, ci, lds, tid);
    LDS_SYNC();
    const int h = wv >> 1, tb = wv & 1, c = lane & 31, hh = lane >> 5; const size_t ch = (size_t)ci * 4 + h;
    f32x16 acc[2];
    dplr_m3_core(acc, (const LAS bf16*)(lds + h * TILE_B), XR + ch * 4096, tb, lane);
    const size_t trow = (size_t)(t0 + 32 * tb + c);
    bf16* yrow = Y + trow * 1024 + h * 64; const bf16* grow = Y + trow * 1024 + 768 + h * 64; const bf16* bvrow = XBV + (ch * 64 + 32 * tb + c) * 64;
    const float* lnw = P.in[I_LNW] + l * 256 + h * 64; const float* lnb = P.in[I_LNB] + l * 256 + h * 64;
    float s = 0.f;
#pragma unroll
    for (int vb = 0; vb < 2; ++vb)
#pragma unroll
        for (int q = 0; q < 4; ++q) { const int v = 32 * vb + 8 * q + 4 * hh; const uint2 w = *(const uint2*)(yrow + v);
            acc[vb][4 * q] += bf2f((bf16)(w.x & 0xffff)); acc[vb][4 * q + 1] += bf2f((bf16)(w.x >> 16)); acc[vb][4 * q + 2] += bf2f((bf16)(w.y & 0xffff)); acc[vb][4 * q + 3] += bf2f((bf16)(w.y >> 16));
            s += (acc[vb][4 * q] + acc[vb][4 * q + 1]) + (acc[vb][4 * q + 2] + acc[vb][4 * q + 3]); }
    s += __shfl_xor(s, 32);
    const float mean = s * (1.0f / 64.0f); float qq = 0.f;
#pragma unroll
    for (int vb = 0; vb < 2; ++vb)
#pragma unroll
        for (int r = 0; r < 16; ++r) { acc[vb][r] -= mean; qq += acc[vb][r] * acc[vb][r]; }
    qq += __shfl_xor(qq, 32);
    const float rstd = rsqf_(qq * (1.0f / 64.0f) + 64e-5f);
#pragma unroll
    for (int vb = 0; vb < 2; ++vb)
#pragma unroll
        for (int q = 0; q < 4; ++q) { const int v = 32 * vb + 8 * q + 4 * hh; const uint2 gw = *(const uint2*)(grow + v); const uint2 bw = *(const uint2*)(bvrow + v); float o[4];
            const float g4[4] = {bf2f((bf16)(gw.x & 0xffff)), bf2f((bf16)(gw.x >> 16)), bf2f((bf16)(gw.y & 0xffff)), bf2f((bf16)(gw.y >> 16))};
            const float b4[4] = {bf2f((bf16)(bw.x & 0xffff)), bf2f((bf16)(bw.x >> 16)), bf2f((bf16)(bw.y & 0xffff)), bf2f((bf16)(bw.y >> 16))};
#pragma unroll
            for (int e = 0; e < 4; ++e) o[e] = (acc[vb][4 * q + e] * rstd * lnw[v + e] + lnb[v + e] + b4[e]) * g4[e];
            uint2 w; w.x = pk2(o[0], o[1]); w.y = pk2(o[2], o[3]); if (do_store) *(uint2*)(yrow + v) = w; }
    LDS_SYNC();
}
#ifndef REP_GA
#define REP_GA 1
#endif
#ifndef REP_GS
#define REP_GS 1
#endif
#ifndef REP_G4
#define REP_G4 1
#endif
__device__ __forceinline__ void gdn_m1(const Params& P, int l, int ci, LAS unsigned char* lds, int tid) {
    const bf16* cols = (const bf16*)(P.ws + WS_COLS); bf16* Y = (bf16*)(P.ws + WS_Y);
    bf16* XP = (bf16*)(P.ws + WS_DP); bf16* XQ = (bf16*)(P.ws + WS_DQ); bf16* XR = (bf16*)(P.ws + WS_DR); float* XG = (float*)(P.ws + WS_XG) + 1024 * 64;
    LAS bf16* tKn = (LAS bf16*)lds; LAS bf16* tQn = tKn + 64 * TS; LAS bf16* tBV = tQn + 64 * TS; LAS bf16* tBK = tBV + 64 * TS; LAS bf16* tKd = tBK + 64 * TS;
    LAS bf16* tAab = tKd + 64 * TS; LAS bf16* tAabT = tAab + 64 * TS; LAS bf16* tX1r = tAabT + 64 * TS; LAS bf16* tX1c = tX1r + 64 * TS; LAS bf16* tT0 = tX1c + 64 * TS; LAS bf16* tT1 = tT0 + 64 * TS; LAS bf16* tQk = tT1 + 64 * TS;
    LAS bf16* tW = tAab; LAS bf16* tU = tAabT; LAS bf16* tT = tT1;
    LAS float* sG = (LAS float*)(lds + 12 * TILE_B); LAS float* sGc = sG + 64; LAS float* sBe = sGc + 64;
    const float* cw = P.in[I_CONV] + (size_t)l * 4 * 768;
#pragma unroll 1
    for (int h = 0; h < 4; ++h) {
        int tidh = tid, t0 = ci * 64; asm volatile("" : "+v"(tidh), "+s"(t0));
        const int lane = tidh & 63, wv = tidh >> 6; const size_t ch = (size_t)ci * 4 + h;
        const float alog = P.in[I_ALOG][l * 4 + h], dtb = P.in[I_DTB][l * 4 + h];
        float e_q[8], e_k[8], e_v[8], e_be[8]; float gcs[8], gc63;
        {
            float raw[3][11], braw[8], araw[8], cwv[3][4];
#pragma unroll
            for (int a = 0; a < 3; ++a)
#pragma unroll
                for (int r = 0; r < 11; ++r) { const int ts = t0 + wv * 8 - 3 + r; const float v = ldcol(cols, ts < 0 ? 0 : ts, C_GDN + a * 256 + h * 64 + lane); raw[a][r] = (ts < 0) ? 0.f : v; }
#pragma unroll
            for (int i = 0; i < 8; ++i) { braw[i] = ldcol(cols, t0 + wv * 8 + i, C_GDN + 1024 + h); araw[i] = ldcol(cols, t0 + wv * 8 + i, C_GDN + 1028 + h); }
#pragma unroll
            for (int a = 0; a < 3; ++a)
#pragma unroll
                for (int i = 0; i < 4; ++i) cwv[a][i] = cw[i * 768 + a * 256 + h * 64 + lane];
            float gv[8];
#pragma unroll
            for (int i = 0; i < 8; ++i) { float o3[3];
#pragma unroll
                for (int a = 0; a < 3; ++a) o3[a] = siluf_(cwv[a][0] * raw[a][i] + cwv[a][1] * raw[a][i + 1] + cwv[a][2] * raw[a][i + 2] + cwv[a][3] * raw[a][i + 3]);
                const float sq = wave_sum(o3[0] * o3[0]), sk = wave_sum(o3[1] * o3[1]);
                e_q[i] = o3[0] * rsqf_(sq + 1e-6f) * 0.125f; e_k[i] = o3[1] * rsqf_(sk + 1e-6f); e_v[i] = o3[2];
                e_be[i] = sigmoidf_(braw[i]); gv[i] = -__expf(alog) * softplusf_(araw[i] + dtb); }
            float gsel = gv[0], bsel = e_be[0];
#pragma unroll
            for (int i = 1; i < 8; ++i) { gsel = (lane == i) ? gv[i] : gsel; bsel = (lane == i) ? e_be[i] : bsel; }
            if (lane < 8) { sG[wv * 8 + lane] = gsel; sBe[wv * 8 + lane] = bsel; }
        }
        LDS_SYNC();
        { const float gl = sG[lane]; float run = gl;
#pragma unroll
            for (int o = 1; o < 64; o <<= 1) { const float up = __shfl_up(run, o); if (lane >= o) run += up; }
            gc63 = __shfl(run, 63);
#pragma unroll
            for (int i = 0; i < 8; ++i) gcs[i] = __shfl(run, wv * 8 + i);
            if (wv == 0) { sGc[lane] = run; XG[ch * 64 + lane] = __expf(gc63); } }
        float bk[8], kd[8], bv[8];
#pragma unroll
        for (int i = 0; i < 8; ++i) { const int t = wv * 8 + i;
            tKn[t * TS + lane] = (bf16)f2bf(e_k[i]); tQn[t * TS + lane] = (bf16)f2bf(e_q[i]);
            bv[i] = e_be[i] * e_v[i]; bk[i] = e_be[i] * e_k[i] * __expf(gcs[i]); kd[i] = e_k[i] * __expf(gc63 - gcs[i]); }
        { v4u w; w.x = pk2(bv[0], bv[1]); w.y = pk2(bv[2], bv[3]); w.z = pk2(bv[4], bv[5]); w.w = pk2(bv[6], bv[7]); *(LAS v4u*)(tBV + lane * TS + wv * 8) = w;
          w.x = pk2(bk[0], bk[1]); w.y = pk2(bk[2], bk[3]); w.z = pk2(bk[4], bk[5]); w.w = pk2(bk[6], bk[7]); *(LAS v4u*)(tBK + lane * TS + wv * 8) = w;
          w.x = pk2(kd[0], kd[1]); w.y = pk2(kd[2], kd[3]); w.z = pk2(kd[4], kd[5]); w.w = pk2(kd[6], kd[7]); *(LAS v4u*)(tKd + lane * TS + wv * 8) = w; }
        LDS_SYNC();
        for (int rpd_ = 0; rpd_ < REP_GS; ++rpd_)
        { const int mat = wv >> 2, r = wv & 3; const int tb = (r == 0 || r == 3) ? 0 : 1, sb = (r == 0 || r == 1) ? 0 : 1;
            f32x16 acc = zero16(); const int c = lane & 31, hh = lane >> 5;
            if (r < 3) { mm_tile<4>(acc, tKn + sb * 32 * TS, (mat ? tQn : tKn) + tb * 32 * TS, lane);
                const int tI = 32 * tb + c; const float gct = sGc[tI], bet = sBe[tI];
#pragma unroll
                for (int q = 0; q < 16; ++q) { const int sI = 32 * sb + acc_i(q, hh);
                    if ((mat == 0) ? (sI >= tI) : (sI > tI)) acc[q] = 0.f;
                    else { const float dcy = __expf(gct - sGc[sI]); acc[q] = (mat == 0) ? (-bet * acc[q] * dcy) : (acc[q] * dcy); } } }
            if (mat == 0) { store_lane_major(tAab, 32 * tb, 32 * sb, acc, lane);
                if (r == 3) store_lane_major(tT1, 0, 32, acc, lane);
                else { store_reg_major(tAabT, 32 * sb, 32 * tb, acc, lane);
#pragma unroll
                    for (int q = 0; q < 16; ++q) if (32 * sb + acc_i(q, hh) == 32 * tb + c) acc[q] += 1.0f;
                    store_lane_major(tT0, 32 * tb, 32 * sb, acc, lane); } }
            else store_lane_major(tQk, 32 * tb, 32 * sb, acc, lane);
        }
        LDS_SYNC();
        { LAS bf16* const Xr[2] = {tAab, tX1r}; LAS bf16* const Xc[2] = {tAabT, tX1c}; LAS bf16* const Tb[2] = {tT0, tT1};
          neumann_solve(Xr, Xc, Tb, wv, lane, [&]() {}); }
        { const int which = wv >> 2, tb = (wv >> 1) & 1, jb2 = wv & 1; f32x16 acc = zero16();
            mm_tile<4>(acc, tT + tb * 32 * TS, (which ? tBV : tBK) + jb2 * 32 * TS, lane);
            store_lane_major(which ? tU : tW, 32 * jb2, 32 * tb, acc, lane); }
        LDS_SYNC();
        for (int rpg_ = 0; rpg_ < REP_G4; ++rpg_)
        for (int jb = wv; jb < 16; jb += 8) { const int out = jb >> 2, ib = (jb >> 1) & 1, jb2 = jb & 1; f32x16 acc = zero16(); const int c = lane & 31, hh = lane >> 5;
            if (out < 2) mm_tile<4>(acc, tKd + ib * 32 * TS, (out ? tU : tW) + jb2 * 32 * TS, lane);
            else mm_tile<4>(acc, tQk + ib * 32 * TS, (out == 3 ? tU : tW) + jb2 * 32 * TS, lane);
            if (out == 0) { bf16* g = XP + ch * 4096 + 32 * jb2 + c;
#pragma unroll
                for (int q = 0; q < 16; ++q) { const int row = 32 * ib + acc_i(q, hh); g[row * 64] = (bf16)f2bf(-acc[q]); } }
            else if (out == 1) { bf16* g = XQ + ch * 4096 + (32 * jb2 + c) * 64 + 32 * ib + 4 * hh;
#pragma unroll
                for (int q = 0; q < 4; ++q) { uint2 w; w.x = pk2(acc[4 * q], acc[4 * q + 1]); w.y = pk2(acc[4 * q + 2], acc[4 * q + 3]); *(uint2*)(g + 8 * q) = w; } }
            else if (out == 2) { bf16* g = XR + ch * 4096 + 32 * jb2 + c;
#pragma unroll
                for (int q = 0; q < 16; ++q) { const int row = 32 * ib + acc_i(q, hh); g[row * 64] = (bf16)f2bf(bf2f(tQn[row * TS + 32 * jb2 + c]) * __expf(sGc[row]) - acc[q]); } }
            else { bf16* g = Y + (size_t)t0 * 1024 + 256 + h * 64 + 32 * jb2 + c;
#pragma unroll
                for (int q = 0; q < 16; ++q) { const int row = 32 * ib + acc_i(q, hh); g[(size_t)row * 1024] = (bf16)f2bf(acc[q]); } }
        }
        LDS_SYNC();
    }
}
__device__ __forceinline__ void gdn_m3(const Params& P, int l, int ci, LAS unsigned char* lds, int tid, bool do_store = true) {
    const bf16* cols = (const bf16*)(P.ws + WS_COLS); bf16* Y = (bf16*)(P.ws + WS_Y); const bf16* XQ = (const bf16*)(P.ws + WS_DQ); const bf16* XR = (const bf16*)(P.ws + WS_DR);
    const float* ng = P.in[I_GDNG] + l * 64;
    const int lane = tid & 63, wv = tid >> 6, t0 = ci * 64;
    dplr_m3_stage(XQ, ci, lds, tid);
    LDS_SYNC();
    const int h = wv >> 1, tb = wv & 1, c = lane & 31, hh = lane >> 5; const size_t ch = (size_t)ci * 4 + h;
    f32x16 acc[2];
    dplr_m3_core(acc, (const LAS bf16*)(lds + h * TILE_B), XR + ch * 4096, tb, lane);
    const size_t trow = (size_t)(t0 + 32 * tb + c);
    bf16* yrow = Y + trow * 1024 + 256 + h * 64; const bf16* zrow = cols + trow * NPAD + C_GDN + 768 + h * 64;
    float ss = 0.f;
#pragma unroll
    for (int vb = 0; vb < 2; ++vb)
#pragma unroll
        for (int q = 0; q < 4; ++q) { const int v = 32 * vb + 8 * q + 4 * hh; const uint2 w = *(const uint2*)(yrow + v);
            acc[vb][4 * q] += bf2f((bf16)(w.x & 0xffff)); acc[vb][4 * q + 1] += bf2f((bf16)(w.x >> 16)); acc[vb][4 * q + 2] += bf2f((bf16)(w.y & 0xffff)); acc[vb][4 * q + 3] += bf2f((bf16)(w.y >> 16));
#pragma unroll
            for (int e = 0; e < 4; ++e) ss += acc[vb][4 * q + e] * acc[vb][4 * q + e]; }
    ss += __shfl_xor(ss, 32);
    const float rstd = rsqf_(ss * (1.0f / 64.0f) + 1e-6f);
#pragma unroll
    for (int vb = 0; vb < 2; ++vb)
#pragma unroll
        for (int q = 0; q < 4; ++q) { const int v = 32 * vb + 8 * q + 4 * hh; const uint2 zw = *(const uint2*)(zrow + v); float o[4];
            const float z4[4] = {bf2f((bf16)(zw.x & 0xffff)), bf2f((bf16)(zw.x >> 16)), bf2f((bf16)(zw.y & 0xffff)), bf2f((bf16)(zw.y >> 16))};
#pragma unroll
            for (int e = 0; e < 4; ++e) o[e] = acc[vb][4 * q + e] * rstd * ng[v + e] * siluf_(z4[e]);
            uint2 w; w.x = pk2(o[0], o[1]); w.y = pk2(o[2], o[3]); if (do_store) *(uint2*)(yrow + v) = w; }
    LDS_SYNC();
}
constexpr int SGS = 136;
__device__ __forceinline__ void sgu_m3(const Params& P, int l, int ci, LAS unsigned char* lds, int tid) {
    const bf16* cols = (const bf16*)(P.ws + WS_COLS); bf16* Y = (bf16*)(P.ws + WS_Y);
    LAS bf16* VlT = (LAS bf16*)lds;
    LAS bf16* Wt = VlT + 256 * SGS;
    const int lane = tid & 63, wv = tid >> 6, half = ci & 1, tbase = (ci >> 1) * 128, ntok = half ? 128 : 64;
    const float* lg = P.in[I_SLG] + l * 256; const float* lb = P.in[I_SLB] + l * 256;
    const float* ws_ = P.in[I_SWS] + (size_t)l * 4 * 128 * 128; const float* bs_ = P.in[I_SBS] + l * 4 * 128;
    { const f32x4 g4 = *(const f32x4*)(lg + lane * 4), b4 = *(const f32x4*)(lb + lane * 4);
#pragma unroll 1
      for (int tb8 = 0; tb8 < ntok / 8; tb8 += 8) { uint2 raw[8];
#pragma unroll
        for (int i = 0; i < 8; ++i) raw[i] = *(const uint2*)(cols + (size_t)(tbase + wv + 8 * (tb8 + i)) * NPAD + C_SGU + 256 + lane * 4);
#pragma unroll
        for (int i = 0; i < 8; ++i) { const int t = wv + 8 * (tb8 + i); float v[4]; float s = 0.f;
            v[0] = geluf_(bf2f((bf16)(raw[i].x & 0xffff))); v[1] = geluf_(bf2f((bf16)(raw[i].x >> 16))); v[2] = geluf_(bf2f((bf16)(raw[i].y & 0xffff))); v[3] = geluf_(bf2f((bf16)(raw[i].y >> 16)));
            s = (v[0] + v[1]) + (v[2] + v[3]);
            const float mean = wave_sum(s) * (1.0f / 256.0f); float q = 0.f;
#pragma unroll
            for (int e = 0; e < 4; ++e) { v[e] -= mean; q += v[e] * v[e]; }
            const float rstd = rsqf_(wave_sum(q) * (1.0f / 256.0f) + 1e-5f);
#pragma unroll
            for (int e = 0; e < 4; ++e) VlT[(lane * 4 + e) * SGS + t] = (bf16)f2bf(v[e] * rstd * g4[e] + b4[e]); } } }
    { const int n4 = ntok / 4;
#pragma unroll 4
      for (int idx = tid; idx < 4 * 64 * n4; idx += NT) { const int s4 = idx % n4, row = idx / n4, g = row >> 6, t = row & 63, ta = 64 * half + t;
        const f32x4 w = *(const f32x4*)(ws_ + ((size_t)g * 128 + ta) * 128 + 4 * s4);
        u32x2 o; o.x = pk2(4 * s4 <= ta ? w[0] : 0.f, 4 * s4 + 1 <= ta ? w[1] : 0.f); o.y = pk2(4 * s4 + 2 <= ta ? w[2] : 0.f, 4 * s4 + 3 <= ta ? w[3] : 0.f);
        *(LAS u32x2*)(Wt + (g * 64 + t) * SGS + 4 * s4) = o; } }
    LDS_SYNC();
#pragma unroll 1
    for (int jb = wv; jb < 16; jb += 8) { const int g = jb >> 2, tb = (jb >> 1) & 1, cb = jb & 1; const int c = lane & 31, hh = lane >> 5;
        const int KT = 4 * half + 2 * tb + 2;
        f32x16 acc = zero16();
        const LAS bf16* Ar = Wt + (g * 64 + tb * 32 + c) * SGS + hh * 8; const LAS bf16* Br = VlT + (g * 64 + cb * 32 + c) * SGS + hh * 8;
#pragma unroll 2
        for (int kk = 0; kk < KT; ++kk) acc = __builtin_amdgcn_mfma_f32_32x32x16_bf16(*(const LAS bf16x8*)(Ar + kk * 16), *(const LAS bf16x8*)(Br + kk * 16), acc, 0, 0, 0);
        const int ch = g * 64 + cb * 32 + c; float uu[16], bb[16];
#pragma unroll
        for (int q = 0; q < 16; ++q) { const int ta = 64 * half + 32 * tb + acc_i(q, hh); uu[q] = ldcol(cols, tbase + ta, C_SGU + ch); bb[q] = bs_[g * 128 + ta]; }
#pragma unroll
        for (int q = 0; q < 16; ++q) { const int ta = 64 * half + 32 * tb + acc_i(q, hh); Y[(size_t)(tbase + ta) * 1024 + 768 + ch] = (bf16)f2bf(geluf_(uu[q]) * (acc[q] + bb[q])); } }
    LDS_SYNC();
}
#ifndef REP_G2
#define REP_G2 1
#endif
#ifndef REP_DN
#define REP_DN 1
#endif
#ifndef REP_M2
#define REP_M2 1
#endif
#ifndef REP_M3
#define REP_M3 1
#endif
#ifndef REP_RW
#define REP_RW 1
#endif
#ifndef REP_GD
#define REP_GD 1
#endif
#ifndef REP_M1
#define REP_M1 1
#endif
#ifndef REP_SGU
#define REP_SGU 1
#endif
#ifndef REP_G1
#define REP_G1 1
#endif
#ifndef REP_UP
#define REP_UP 1
#endif
#define GRID_SYNC() xcd_barrier(xbar)
__global__ void __launch_bounds__(NT, 2) fwd_kernel(Params P) {
    extern __shared__ __attribute__((aligned(16))) unsigned char lds_raw[];
    cg::grid_group grid = cg::this_grid();
    LAS unsigned char* ldsl = (LAS unsigned char*)lds_raw;
    const int G = gridDim.x;
    if (threadIdx.x < 16) ((LAS unsigned*)(ldsl + LDS_BYTES - 64))[threadIdx.x] = 0u;
    __syncthreads();
    const XcdBarrier xbar = xcd_barrier_post((unsigned*)(P.ws + WS_BAR), (volatile LAS unsigned*)(ldsl + LDS_BYTES - 64));
#define PHASE_TID() int tid = threadIdx.x; asm volatile("" : "+v"(tid)); const int lane = tid & 63, wave = __builtin_amdgcn_readfirstlane(tid >> 6); const int gw = blockIdx.x * NWAVES + wave, NGW = G * NWAVES; (void)lane; (void)gw; (void)NGW
    {
        PHASE_TID();
        prologue_weights(P, 0, 15, (float*)lds_raw, gw, NGW, wave, lane);
        prologue_lora(P, blockIdx.x * NT + tid, G * NT);
        prologue_rows(P, gw, NGW, lane);
    }
    grid.sync();
#pragma unroll 1
    for (int l_ = 0; l_ < DEPTH; ++l_) {
        int l = l_; asm volatile("" : "+s"(l));
        bf16* XB = (bf16*)(P.ws + WS_XB); bf16* YB = (bf16*)(P.ws + WS_Y); bf16* HB = (bf16*)(P.ws + WS_H); bf16* COLS = (bf16*)(P.ws + WS_COLS); float* SSQ = (float*)(P.ws + WS_SSQ);
        const unsigned char* wb = P.ws + WS_W;
        {
            pg8::Gemm g{XB, (const bf16*)(wb + W_IN), T, NPAD, D}; pg8::StaticOrder S; S.init(T, NPAD, G, (int)blockIdx.x);
            pg8::EpiScaleBf16<0> E{COLS, NPAD, SSQ};
            for (int rep_ = 0; rep_ < REP_G1; ++rep_) pg8::gemm_phase<pg8::EpiScaleBf16<0>, pg8::StaticOrder, true, true>(ldsl, g, S, E);
        }
        GRID_SYNC();
        {
            PHASE_TID();
            for (int rep_ = 0; rep_ < REP_M1; ++rep_)
            for (int ci = blockIdx.x; ci < T / 64; ci += G) {
#ifndef NO_RWKV1
                for (int r2_ = 0; r2_ < REP_RW; ++r2_) rwkv_m1(P, l, ci, ldsl, tid);
#endif
#ifndef NO_GDN1
                for (int r2_ = 0; r2_ < REP_GD; ++r2_) gdn_m1(P, l, ci, ldsl, tid);
#endif
#ifndef NO_GLA1
                gla_m1(P, l, ci, ldsl, tid);
#endif
            }
        }
        GRID_SYNC();
#if REP_M2 > 1
        {
            PHASE_TID(); int sti = 0; asm volatile("" : "+v"(sti)); const bool dry_st = sti != 0;
            const int b = blockIdx.x;
#ifndef NO_M2
            if (b < 4) dplr_m2_block((const bf16*)(P.ws + WS_RP), (bf16*)(P.ws + WS_RQ), (const float*)(P.ws + WS_XG), b, ldsl, tid, dry_st);
            else if (b < 8) dplr_m2_block((const bf16*)(P.ws + WS_DP), (bf16*)(P.ws + WS_DQ), (const float*)(P.ws + WS_XG) + 1024 * 64, b - 4, ldsl, tid, dry_st);
            else if (b < 24) gla_m2(P, (b - 8) * NT + tid, dry_st);
            if (b < 24) {}
#if 0
            else if (l == 0) prologue_weights(P, 1, 1, (float*)lds_raw, (b - 24) * NWAVES + wave, (G - 24) * NWAVES, wave, lane);
            else prologue_weights(P, 1, 14, (float*)lds_raw, (b - 24) * NWAVES + wave, (G - 24) * NWAVES, wave, lane);
#endif
#endif
        }
        GRID_SYNC();
#endif
        {
            PHASE_TID();
            const int b = blockIdx.x;
#ifndef NO_M2
            if (b < 4) dplr_m2_block((const bf16*)(P.ws + WS_RP), (bf16*)(P.ws + WS_RQ), (const float*)(P.ws + WS_XG), b, ldsl, tid, true);
            else if (b < 8) dplr_m2_block((const bf16*)(P.ws + WS_DP), (bf16*)(P.ws + WS_DQ), (const float*)(P.ws + WS_XG) + 1024 * 64, b - 4, ldsl, tid, true);
            else if (b < 24) gla_m2(P, (b - 8) * NT + tid, true);
            if (b < 24) {}
            else if (l == 0) prologue_weights(P, 1, 1, (float*)lds_raw, (b - 24) * NWAVES + wave, (G - 24) * NWAVES, wave, lane);
            else prologue_weights(P, 1, 14, (float*)lds_raw, (b - 24) * NWAVES + wave, (G - 24) * NWAVES, wave, lane);
#endif
        }
        GRID_SYNC();
        {
            PHASE_TID();
            for (int ci = blockIdx.x; ci < T / 64; ci += G) {
#ifndef NO_M3
                for (int rep_ = REP_M3 - 1; rep_ >= 0; --rep_) { int sti = (rep_ == 0) ? 1 : 0; asm volatile("" : "+v"(sti)); const bool st = sti != 0; rwkv_m3(P, l, ci, ldsl, tid, st); gdn_m3(P, l, ci, ldsl, tid, st); gla_m3(P, l, ci, ldsl, tid, st); }
                for (int rep_ = 0; rep_ < REP_SGU; ++rep_) sgu_m3(P, l, ci, ldsl, tid);
#endif
            }
        }
        GRID_SYNC();
        {
            pg8::Gemm g{YB, (const bf16*)(wb + W_OUT), T, D, D}; pg8::StaticOrder S; S.init(T, D, G, (int)blockIdx.x);
            for (int rep_ = REP_G2 - 1; rep_ >= 0; --rep_) { int dry = rep_; asm volatile("" : "+v"(dry));
            pg8::EpiResid E{l == 0 ? P.in[I_X] : (const float*)P.out, P.out, XB, SSQ, dry};
            pg8::gemm_phase<pg8::EpiResid, pg8::StaticOrder, true, true>(ldsl, g, S, E); }
        }
        GRID_SYNC();
        {
            pg8::Gemm g{XB, (const bf16*)(wb + W_UP), T, FF, D}; pg8::StaticOrder S; S.init(T, FF, G, (int)blockIdx.x);
            pg8::EpiScaleBf16<2> E{HB, FF, SSQ};
            for (int rep_ = 0; rep_ < REP_UP; ++rep_) pg8::gemm_phase<pg8::EpiScaleBf16<2>, pg8::StaticOrder, true, true>(ldsl, g, S, E);
        }
        GRID_SYNC();
        {
            pg8::Gemm g{HB, (const bf16*)(wb + W_DN), T, D, FF}; pg8::StaticOrder S; S.init(T, D, G, (int)blockIdx.x);
            for (int rep_ = REP_DN - 1; rep_ >= 0; --rep_) { int dry = rep_; asm volatile("" : "+v"(dry));
            pg8::EpiResid E{(const float*)P.out, P.out, XB, SSQ, dry};
            pg8::gemm_phase<pg8::EpiResid, pg8::StaticOrder, true, true>(ldsl, g, S, E); }
        }
        GRID_SYNC();
    }
    { PHASE_TID(); final_norm(P, gw, NGW, lane); }
}

extern "C" void kernel_launch(void* const* d_in, const int* in_sizes, int n_in, void* d_out, int out_size, void* d_ws, size_t ws_size, hipStream_t stream) {
    static int grid_blocks = 0;
    if (!grid_blocks) {
        int dev = 0, cus = 0, per_cu = 0;
        if (n_in != 33 || out_size != T * D || ws_size < WS_END) { fprintf(stderr, "kernel_launch: unexpected shapes n_in %d out %d ws %zu\n", n_in, out_size, ws_size); grid_blocks = -1; return; }
        (void)hipGetDevice(&dev);
        (void)hipDeviceGetAttribute(&cus, hipDeviceAttributeMultiprocessorCount, dev);
        (void)hipFuncSetAttribute((const void*)fwd_kernel, hipFuncAttributeMaxDynamicSharedMemorySize, LDS_BYTES);
        (void)hipOccupancyMaxActiveBlocksPerMultiprocessor(&per_cu, (const void*)fwd_kernel, NT, LDS_BYTES);
        if (per_cu < 1) fprintf(stderr, "kernel_launch: occupancy query says %d blocks/CU\n", per_cu);
        grid_blocks = cus;
        (void)hipGetLastError();
    }
    if (grid_blocks < 0) return;
    (void)hipMemsetAsync((char*)d_ws + WS_BAR, 0, 16384, stream);
    Params p{};
    for (int i = 0; i < 33; ++i) p.in[i] = (const float*)d_in[i];
    p.out = (float*)d_out; p.ws = (unsigned char*)d_ws;
    void* args[] = {&p};
    hipError_t e = hipLaunchCooperativeKernel((void*)fwd_kernel, dim3(grid_blocks), dim3(NT), args, LDS_BYTES, stream);
    if (e != hipSuccess) fprintf(stderr, "cooperative launch failed: %s (grid %d)\n", hipGetErrorString(e), grid_blocks);
}
```

```cpp
#include <hip/hip_runtime.h>
#include <hip/hip_cooperative_groups.h>
#include <cstdio>
#include <cstdint>
namespace cg = cooperative_groups;
namespace pg8 {
#define PG8_LAS __attribute__((address_space(3)))
typedef unsigned short bf16_t;
typedef short bf16x8 __attribute__((ext_vector_type(8)));
typedef float f32x4 __attribute__((ext_vector_type(4)));
typedef unsigned u32x4 __attribute__((ext_vector_type(4)));
constexpr int BM = 256, BK = 64, HALF = 128, HTB = HALF * BK * 2  , STAGE_BYTES = 8 * HTB, NXCD = 8, WGM = 8;

__host__ __device__ __forceinline__ int lds_byte(int r, int c) { const int st = (r >> 4) * 2 + (c >> 5), rr = r & 15, cc = c & 31, ob = rr * 64 + cc * 2; return st * 1024 + (ob ^ (((ob >> 9) & 1) << 5)); }
__host__ __device__ __forceinline__ void stage_rc(int b, int& R, int& C) { const int st = b / 1024, sb = b % 1024, swz = sb ^ (((sb >> 9) & 1) << 5); R = (st >> 1) * 16 + swz / 64; C = (st & 1) * 32 + (swz % 64) / 2; }
__host__ __device__ __forceinline__ int perm32(int rho) { const int n = rho >> 4, i = rho & 15; return 8 * (i >> 2) + 4 * n + (i & 3); }

struct Unit { int pm, pn; };
struct Gemm { const bf16_t* A; const bf16_t* Bt; int M, N, K; };

struct StaticOrder {
    int nM, nN, nwg, G, c;
    __host__ __device__ void init(int M, int N, int G_, int c_) { nM = M / BM; nN = N / BM; nwg = nM * nN; G = G_; c = c_; }
    __host__ __device__ bool next(int i, Unit& u) const {
        const long L = (long)i * G + c; if (L >= nwg) return false;
        int wgid = (int)L; { const int q = nwg / NXCD, r = nwg % NXCD, xcd = wgid % NXCD, off = wgid / NXCD; wgid = (xcd < r ? xcd * (q + 1) : r * (q + 1) + (xcd - r) * q) + off; }
        const int nig = WGM * nN, gid = wgid / nig, fm = gid * WGM, gsz = (nM - fm) < WGM ? (nM - fm) : WGM;
        u.pm = fm + ((wgid % nig) % gsz); u.pn = (wgid % nig) / gsz; return true;
    }
    __device__ __forceinline__ void a_ready(const Unit&) const {}
    __device__ __forceinline__ void done(const Unit&) const {}
};

__device__ __forceinline__ unsigned cvt_pk_bf16(float lo, float hi) { unsigned r; asm volatile("v_cvt_pk_bf16_f32 %0, %1, %2" : "=v"(r) : "v"(lo), "v"(hi)); return r; }
typedef float f32x2 __attribute__((ext_vector_type(2)));
__device__ __forceinline__ float row_rstd16(const float* ssq, int row) {
    const f32x4* p = (const f32x4*)(ssq + (size_t)row * 16);
    const f32x4 a = p[0], b = p[1], c = p[2], d = p[3];
    const float s = ((a[0] + a[1]) + (a[2] + a[3])) + ((b[0] + b[1]) + (b[2] + b[3])) + ((c[0] + c[1]) + (c[2] + c[3])) + ((d[0] + d[1]) + (d[2] + d[3]));
    return 1.0f / sqrtf(s * (1.0f / 1024.0f) + 1e-6f);
}
template <int ACT> struct EpiScaleBf16 {
    static constexpr bool PERM = true, AFTER_DRAIN = false;
    bf16_t* O; int ldc; const float* ssq;
    __device__ __forceinline__ void operator()(const f32x4 (&acc)[2][2][4][2], const Unit& u, int wr, int wc, int fr, int fq) const {
        const int row0 = u.pm * BM + wr * 64 + fr; const int col0 = u.pn * BM + wc * 32 + 8 * fq;
#pragma unroll
        for (int ai = 0; ai < 2; ++ai)
#pragma unroll
            for (int m = 0; m < 4; ++m) { const int row = row0 + ai * HALF + m * 16; const float sc = row_rstd16(ssq, row); bf16_t* rowp = O + (size_t)row * ldc + col0;
#pragma unroll
                for (int bj = 0; bj < 2; ++bj) { f32x4 v0 = acc[ai][bj][m][0] * sc, v1 = acc[ai][bj][m][1] * sc;
                    if (ACT == 2) {
#pragma unroll
                        for (int e = 0; e < 4; ++e) { const float a0 = v0[e] > 0.f ? v0[e] : 0.f, a1 = v1[e] > 0.f ? v1[e] : 0.f; v0[e] = a0 * a0; v1[e] = a1 * a1; } }
                    u32x4 w; w.x = cvt_pk_bf16(v0[0], v0[1]); w.y = cvt_pk_bf16(v0[2], v0[3]); w.z = cvt_pk_bf16(v1[0], v1[1]); w.w = cvt_pk_bf16(v1[2], v1[3]);
                    *(u32x4*)(rowp + bj * HALF) = w; } }
    }
};
struct EpiResid {
    static constexpr bool PERM = false, AFTER_DRAIN = false;
    const float* base; float* out; bf16_t* xb; float* ssq; int dry;
    __device__ __forceinline__ void operator()(const f32x4 (&acc)[2][2][4][2], const Unit& u, int wr, int wc, int fr, int fq) const {
        typedef unsigned u32x2v __attribute__((ext_vector_type(2)));
        const int row0 = u.pm * BM + wr * 64 + fr; const int col0 = u.pn * BM + wc * 32 + 4 * fq;
#pragma unroll
        for (int ai = 0; ai < 2; ++ai)
#pragma unroll
            for (int m = 0; m < 4; ++m) { const int row = row0 + ai * HALF + m * 16; const size_t off = (size_t)row * 1024 + col0; float s = 0.f;
#pragma unroll
                for (int bj = 0; bj < 2; ++bj)
#pragma unroll
                    for (int n = 0; n < 2; ++n) { const f32x4 bs = *(const f32x4*)(base + off + bj * HALF + n * 16); const f32x4 o = bs + acc[ai][bj][m][n];
                        if (!dry) *(f32x4*)(out + off + bj * HALF + n * 16) = o; s += (o[0] * o[0] + o[1] * o[1]) + (o[2] * o[2] + o[3] * o[3]);
                        u32x2v w; w.x = cvt_pk_bf16(o[0], o[1]); w.y = cvt_pk_bf16(o[2], o[3]); if (!dry) *(u32x2v*)(xb + off + bj * HALF + n * 16) = w; }
                s += __shfl_xor(s, 16); s += __shfl_xor(s, 32);
                if (fq == 0 && !dry) ssq[(size_t)row * 16 + u.pn * 4 + wc] = s; }
    }
};
template <class Epi, class Sched, bool ALIGN_EPI = false, bool SP2 = false>
__device__ __forceinline__ void gemm_phase(PG8_LAS unsigned char* lds, const Gemm g, const Sched& S, const Epi& E) {
    int tid_o = threadIdx.x; asm volatile("" : "+v"(tid_o));
    const int tid = tid_o, wid = __builtin_amdgcn_readfirstlane(tid >> 6), lane = tid & 63, wr = wid >> 2, wc = wid & 3, fr = lane & 15, fq = lane >> 4;
    const int K = g.K, nt = K / BK;
    unsigned voffA[2], voffB[2];
#pragma unroll
    for (int i = 0; i < 2; ++i) { int R, C; stage_rc(tid * 16 + i * 8192, R, C); const int Rb = Epi::PERM ? ((R & ~31) + perm32(R & 31)) : R;
        voffA[i] = (unsigned)(R * K + C) * 2u; voffB[i] = (unsigned)(Rb * K + C) * 2u; }
    const size_t kstep = (size_t)(BK * 2);
    const size_t hstep = (size_t)HALF * K * 2;
    const size_t tstep = 2 * hstep;
    const unsigned ldsw = (unsigned)wid * 1024u;
    const int aoff = lds_byte(wr * 64 + fr, fq * 8), boff = lds_byte(wc * 32 + fr, fq * 8);
#define PG8_SA(b, h) (((b) * 2 + (h)) * HTB)
#define PG8_SB(b, h) ((4 + (b) * 2 + (h)) * HTB)
#define PG8_STAGE(bufoff, gbase, voff) do { _Pragma("unroll") for (int _i = 0; _i < 2; ++_i) \
        __builtin_amdgcn_global_load_lds((const unsigned*)((const char*)(gbase) + (voff)[_i]), (PG8_LAS unsigned*)(lds + (bufoff) + ldsw + _i * 8192), 16, 0, 0); } while (0)
#define PG8_LDA(dst, b, h) do { _Pragma("unroll") for (int m = 0; m < 4; ++m) _Pragma("unroll") for (int k = 0; k < 2; ++k) dst[m][k] = *(const PG8_LAS bf16x8*)(lds + PG8_SA(b, h) + aoff + m * 2048 + k * 1024); } while (0)
#define PG8_LDB(dst, b, h) do { _Pragma("unroll") for (int n = 0; n < 2; ++n) _Pragma("unroll") for (int k = 0; k < 2; ++k) dst[n][k] = *(const PG8_LAS bf16x8*)(lds + PG8_SB(b, h) + boff + n * 2048 + k * 1024); } while (0)
#define PG8_MMA(ai, bj, At, Bt) do { __builtin_amdgcn_s_setprio(1); _Pragma("unroll") for (int m = 0; m < 4; ++m) _Pragma("unroll") for (int n = 0; n < 2; ++n) _Pragma("unroll") for (int k = 0; k < 2; ++k) \
        acc[ai][bj][m][n] = __builtin_amdgcn_mfma_f32_16x16x32_bf16(Bt[n][k], At[m][k], acc[ai][bj][m][n], 0, 0, 0); __builtin_amdgcn_s_setprio(0); } while (0)
#define PG8_WAIT_V(n) asm volatile("s_waitcnt vmcnt(" #n ")" ::: "memory")
#define PG8_WAIT_L(n) asm volatile("s_waitcnt lgkmcnt(" #n ")" ::: "memory")
#define PG8_BAR __builtin_amdgcn_s_barrier()
#define PG8_SCHED __builtin_amdgcn_sched_barrier(0)
    Unit cur, nxt; int ui = 0;
    if (!S.next(0, cur)) return;
    f32x4 acc[2][2][4][2];
#pragma unroll
    for (int a = 0; a < 2; ++a)
#pragma unroll
        for (int b = 0; b < 2; ++b)
#pragma unroll
            for (int m = 0; m < 4; ++m)
#pragma unroll
                for (int n = 0; n < 2; ++n) acc[a][b][m][n] = (f32x4){0.f, 0.f, 0.f, 0.f};
    bf16x8 At[4][2], B0[2][2], B1[2][2];
    const char* cA = (const char*)g.A + (size_t)cur.pm * tstep; const char* cB = (const char*)g.Bt + (size_t)cur.pn * tstep;
    S.a_ready(cur);
    if constexpr (SP2) {
        PG8_STAGE(PG8_SB(0, 0), cB, voffB); PG8_STAGE(PG8_SB(0, 1), cB + hstep, voffB); PG8_STAGE(PG8_SA(0, 0), cA, voffA); PG8_STAGE(PG8_SA(0, 1), cA + hstep, voffA);
        if (wr == 1) PG8_BAR;
        PG8_WAIT_V(2); PG8_BAR;
        PG8_STAGE(PG8_SB(1, 0), cB + kstep, voffB); PG8_STAGE(PG8_SA(1, 0), cA + kstep, voffA); PG8_STAGE(PG8_SB(1, 1), cB + hstep + kstep, voffB);
        PG8_WAIT_V(6); PG8_BAR;
    } else {
        PG8_STAGE(PG8_SB(0, 0), cB, voffB); PG8_STAGE(PG8_SA(0, 0), cA, voffA); PG8_STAGE(PG8_SB(0, 1), cB + hstep, voffB); PG8_STAGE(PG8_SA(0, 1), cA + hstep, voffA);
        if (wr == 1) PG8_BAR;
        PG8_WAIT_V(4); PG8_BAR;
        PG8_STAGE(PG8_SB(1, 0), cB + kstep, voffB); PG8_STAGE(PG8_SA(1, 0), cA + kstep, voffA); PG8_STAGE(PG8_SB(1, 1), cB + hstep + kstep, voffB);
        PG8_WAIT_V(6); PG8_BAR;
    }
    for (;;) {
        const bool has_next = S.next(ui + 1, nxt);
        const char* nA = has_next ? (const char*)g.A + (size_t)nxt.pm * tstep : cA; const char* nB = has_next ? (const char*)g.Bt + (size_t)nxt.pn * tstep : cB;
        for (int t = 0; t < nt; t += 2) {
            const bool last = (t == nt - 2);
            const char* a1 = cA + (size_t)(t + 1) * kstep;
            const char* a2 = last ? nA : cA + (size_t)(t + 2) * kstep; const char* b2 = last ? nB : cB + (size_t)(t + 2) * kstep;
            const char* a3 = a2 + kstep; const char* b3 = b2 + kstep;
            if (last && has_next) S.a_ready(nxt);
            if constexpr (SP2) {
            PG8_LDB(B0, 0, 0); PG8_LDB(B1, 0, 1); PG8_SCHED; PG8_LDA(At, 0, 0); PG8_STAGE(PG8_SA(1, 1), a1 + hstep, voffA);
            PG8_WAIT_V(8); PG8_WAIT_L(0); PG8_BAR; PG8_MMA(0, 0, At, B0); PG8_MMA(0, 1, At, B1); PG8_BAR; PG8_SCHED;
            PG8_LDA(At, 0, 1); PG8_STAGE(PG8_SB(0, 0), b2, voffB); PG8_STAGE(PG8_SB(0, 1), b2 + hstep, voffB); PG8_STAGE(PG8_SA(0, 0), a2, voffA);
            PG8_WAIT_V(8); PG8_WAIT_L(0); PG8_BAR; PG8_MMA(1, 0, At, B0); PG8_MMA(1, 1, At, B1); PG8_BAR; PG8_SCHED;
            PG8_LDB(B0, 1, 0); PG8_LDB(B1, 1, 1); PG8_SCHED; PG8_LDA(At, 1, 0); PG8_STAGE(PG8_SA(0, 1), a2 + hstep, voffA);
            PG8_WAIT_V(8); PG8_WAIT_L(0); PG8_BAR; PG8_MMA(0, 0, At, B0); PG8_MMA(0, 1, At, B1); PG8_BAR; PG8_SCHED;
            PG8_LDA(At, 1, 1); PG8_STAGE(PG8_SB(1, 0), b3, voffB); PG8_STAGE(PG8_SB(1, 1), b3 + hstep, voffB); PG8_STAGE(PG8_SA(1, 0), a3, voffA);
            PG8_WAIT_V(8); PG8_WAIT_L(0); PG8_BAR; PG8_MMA(1, 0, At, B0); PG8_MMA(1, 1, At, B1); PG8_BAR; PG8_SCHED;
            } else {
            PG8_LDB(B0, 0, 0); PG8_SCHED; PG8_LDA(At, 0, 0); PG8_STAGE(PG8_SA(1, 1), a1 + hstep, voffA);
            PG8_WAIT_L(8); PG8_BAR; PG8_WAIT_L(0); PG8_MMA(0, 0, At, B0); PG8_BAR; PG8_SCHED;
            PG8_LDB(B1, 0, 1); PG8_STAGE(PG8_SB(0, 0), b2, voffB);
            PG8_BAR; PG8_WAIT_L(0); PG8_MMA(0, 1, At, B1); PG8_BAR;
            PG8_LDA(At, 0, 1); PG8_STAGE(PG8_SA(0, 0), a2, voffA);
            PG8_BAR; PG8_WAIT_L(0); PG8_MMA(1, 0, At, B0); PG8_BAR; PG8_SCHED;
            PG8_STAGE(PG8_SB(0, 1), b2 + hstep, voffB);
            PG8_WAIT_V(6); PG8_BAR; PG8_MMA(1, 1, At, B1); PG8_BAR;
            PG8_LDB(B0, 1, 0); PG8_SCHED; PG8_LDA(At, 1, 0); PG8_STAGE(PG8_SA(0, 1), a2 + hstep, voffA);
            PG8_WAIT_L(8); PG8_BAR; PG8_WAIT_L(0); PG8_MMA(0, 0, At, B0); PG8_BAR; PG8_SCHED;
            PG8_LDB(B1, 1, 1); PG8_STAGE(PG8_SB(1, 0), b3, voffB);
            PG8_BAR; PG8_WAIT_L(0); PG8_MMA(0, 1, At, B1); PG8_BAR;
            PG8_LDA(At, 1, 1); PG8_STAGE(PG8_SA(1, 0), a3, voffA);
            PG8_BAR; PG8_WAIT_L(0); PG8_MMA(1, 0, At, B0); PG8_BAR; PG8_SCHED;
            PG8_STAGE(PG8_SB(1, 1), b3 + hstep, voffB);
            PG8_WAIT_V(6); PG8_BAR; PG8_MMA(1, 1, At, B1); PG8_BAR;
            }
        }
        if constexpr (ALIGN_EPI) { if (wr == 0) PG8_BAR; }
        if constexpr (!Epi::AFTER_DRAIN) { E(acc, cur, wr, wc, fr, fq); S.done(cur); }
        if (!has_next) break;
#pragma unroll
        for (int a = 0; a < 2; ++a)
#pragma unroll
            for (int b = 0; b < 2; ++b)
#pragma unroll
                for (int m = 0; m < 4; ++m)
#pragma unroll
                    for (int n = 0; n < 2; ++n) acc[a][b][m][n] = (f32x4){0.f, 0.f, 0.f, 0.f};
        cur = nxt; cA = nA; cB = nB; ++ui;
        if constexpr (ALIGN_EPI) { if (wr == 1) PG8_BAR; }
    }
    PG8_WAIT_V(0);
    if constexpr (!ALIGN_EPI) { if (wr == 0) PG8_BAR; }
    PG8_BAR;
    if constexpr (Epi::AFTER_DRAIN) { E.fused(acc, cur, wr, wc, fr, fq, lds, wid, lane); S.done(cur); }
#undef PG8_SA
#undef PG8_SB
#undef PG8_STAGE
#undef PG8_LDA
#undef PG8_LDB
#undef PG8_MMA
#undef PG8_WAIT_V
#undef PG8_WAIT_L
#undef PG8_BAR
#undef PG8_SCHED
}
}
constexpr int T = 16384, D = 1024, FF = 4096, DEPTH = 2;
constexpr int NIN = 3352, NPAD = 3584;
constexpr int C_RWKV = 0, C_GDN = 1024, C_GLA = 2056, C_SGU = 2840, C_VRES = 3352;
constexpr int NT = 512, NWAVES = 8;
constexpr int LDS_BYTES = 147456;
typedef unsigned short bf16;
typedef float f32x4 __attribute__((ext_vector_type(4)));
typedef unsigned v4u __attribute__((ext_vector_type(4)));
#define LAS __attribute__((address_space(3)))

constexpr size_t MiB = 1u << 20;
constexpr size_t WS_BAR = 0;
constexpr size_t WS_SSQ = 1 * MiB;
constexpr size_t WS_GAL = 2 * MiB;
constexpr size_t WS_XG = 2 * MiB + 256 * 1024;
constexpr size_t WS_W = 3 * MiB;
constexpr size_t W_LAYER = 0, W_IN = 0, W_OUT = 7 * MiB, W_UP = 9 * MiB, W_DN = 17 * MiB;
constexpr size_t WS_XB = 30 * MiB;
constexpr size_t WS_Y = 62 * MiB;
constexpr size_t WS_H = 94 * MiB;
constexpr size_t WS_COLS = 94 * MiB;
constexpr size_t WS_VF = 222 * MiB;
constexpr size_t WS_RP = 30 * MiB, WS_RQ = 38 * MiB, WS_RR = 46 * MiB, WS_RBV = 54 * MiB;
constexpr size_t WS_DP = 206 * MiB, WS_DQ = 214 * MiB, WS_DR = 230 * MiB;
constexpr size_t WS_GKV = 238 * MiB, WS_GQI = 246 * MiB;
constexpr size_t WS_LORA = 250 * MiB;
constexpr int LORA_W = 0, LORA_A = 256 * 64, LORA_G = 2 * 256 * 64, LORA_V = 2 * 256 * 64 + 256 * 128, LORA_LAYER = LORA_V + 256 * 32;
constexpr size_t WS_SN = 251 * MiB, WS_SQ = 252 * MiB, WS_SG = 253 * MiB, WS_GSB = 253 * MiB + 64 * 1024, WS_GSA = 254 * MiB;
constexpr size_t WS_END = 255 * MiB;

typedef float f32x2_t __attribute__((ext_vector_type(2))); typedef __bf16 bf16x2_t __attribute__((ext_vector_type(2)));
__device__ __forceinline__ unsigned pk2(float lo, float hi) { f32x2_t v = {lo, hi}; bf16x2_t b = __builtin_convertvector(v, bf16x2_t); return __builtin_bit_cast(unsigned, b); }
__device__ __forceinline__ unsigned f2bf(float f) { return pk2(f, f) & 0xffffu; }
__device__ __forceinline__ float bf2f(bf16 b) { return __builtin_bit_cast(float, (unsigned)b << 16); }
__device__ __forceinline__ float wave_sum(float v) {
    v += __builtin_bit_cast(float, __builtin_amdgcn_mov_dpp(__builtin_bit_cast(int, v), 0xB1, 0xF, 0xF, true));
    v += __builtin_bit_cast(float, __builtin_amdgcn_mov_dpp(__builtin_bit_cast(int, v), 0x4E, 0xF, 0xF, true));
    v += __builtin_bit_cast(float, __builtin_amdgcn_mov_dpp(__builtin_bit_cast(int, v), 0x141, 0xF, 0xF, true));
    v += __builtin_bit_cast(float, __builtin_amdgcn_mov_dpp(__builtin_bit_cast(int, v), 0x140, 0xF, 0xF, true));
    v += __shfl_xor(v, 16); v += __shfl_xor(v, 32);
    return v;
}
__device__ __forceinline__ float rcpf_(float x) { return __builtin_amdgcn_rcpf(x); }
__device__ __forceinline__ float rsqf_(float x) { return __builtin_amdgcn_rsqf(x); }
__device__ __forceinline__ float sigmoidf_(float x) { return rcpf_(1.0f + __expf(-x)); }
__device__ __forceinline__ float softplusf_(float x) { return fmaxf(x, 0.f) + __logf(1.0f + __expf(-fabsf(x))); }
__device__ __forceinline__ float siluf_(float x) { return x * sigmoidf_(x); }
__device__ __forceinline__ float tanhf_(float x) { return 1.0f - 2.0f * rcpf_(1.0f + __expf(2.0f * x)); }
__device__ __forceinline__ float geluf_(float x) { const float u = 0.7978845608028654f * (x + 0.044715f * x * x * x); return x * sigmoidf_(2.0f * u); }

struct Params { const float* in[33]; float* out; unsigned char* ws; };
enum { I_X = 0, I_WIN, I_WOUT, I_NMIX, I_NFFN, I_NFIN, I_MU, I_W0, I_WUP, I_A0, I_AUP, I_GUP, I_KK, I_KA, I_RK, I_LNW, I_LNB, I_V0, I_VDOWN, I_VUP,
       I_CONV, I_ALOG, I_DTB, I_GDNG, I_GKUP, I_GKB, I_GLAG, I_SLG, I_SLB, I_SWS, I_SBS, I_FUP, I_FDN };

__device__ __forceinline__ void transpose_item(const float* W, int K, int N, const float* gk, bf16* WT, int row_off, float* scr, int item, int lane) {
    const int nblk = (N + 31) / 32, kb = item / nblk, nb = item % nblk, k0 = 64 * kb, n0 = 32 * nb;
    const bool nok = (n0 + (lane & 31)) < N;
#pragma unroll 8
    for (int i = 0; i < 32; ++i) { const int kk = 2 * i + (lane >> 5); float v = 0.f; if (nok) v = W[(size_t)(k0 + kk) * N + n0 + (lane & 31)]; if (gk) v *= gk[k0 + kk]; scr[kk * 33 + (lane & 31)] = v; }
    __builtin_amdgcn_wave_barrier(); asm volatile("s_waitcnt lgkmcnt(0)" ::: "memory");
    const int c = lane & 7;
#pragma unroll
    for (int j = 0; j < 4; ++j) { const int n = (lane >> 3) + 8 * j; const float* s = scr + (8 * c) * 33 + n;
        v4u o; o.x = pk2(s[0 * 33], s[1 * 33]); o.y = pk2(s[2 * 33], s[3 * 33]); o.z = pk2(s[4 * 33], s[5 * 33]); o.w = pk2(s[6 * 33], s[7 * 33]);
        if (n0 + n < N) *(v4u*)(WT + (size_t)(row_off + n0 + n) * K + k0 + 8 * c) = o; }
    __builtin_amdgcn_wave_barrier(); asm volatile("s_waitcnt lgkmcnt(0)" ::: "memory");
}
__device__ __forceinline__ void prologue_weights(const Params& P, int l, int mask, float* lds, int gw, int NGW, int wave, int lane) {
    float* scr = lds + wave * 4096;
    unsigned char* wb = P.ws + WS_W;
    const int I_in = (mask & 1) ? (D / 64) * ((NIN + 31) / 32) : 0, I_vr = ((mask & 1) && l > 0) ? (D / 64) * 1 : 0, I_out = (mask & 2) ? (D / 64) * (D / 32) : 0, I_up = (mask & 4) ? (D / 64) * (FF / 32) : 0, I_dn = (mask & 8) ? (FF / 64) * (D / 32) : 0;
    const int NITEMS = I_in + I_vr + I_out + I_up + I_dn;
    for (int it = gw; it < NITEMS; it += NGW) {
        int r = it;
        if (r < I_in) { transpose_item(P.in[I_WIN] + (size_t)l * D * NIN, D, NIN, P.in[I_NMIX] + l * D, (bf16*)(wb + W_IN), 0, scr, r, lane); continue; } r -= I_in;
        if (r < I_vr) { transpose_item(P.in[I_VDOWN] + (size_t)(l - 1) * D * 32, D, 32, P.in[I_NMIX] + l * D, (bf16*)(wb + W_IN), NIN, scr, r, lane); continue; } r -= I_vr;
        if (r < I_out) { transpose_item(P.in[I_WOUT] + (size_t)l * D * D, D, D, nullptr, (bf16*)(wb + W_OUT), 0, scr, r, lane); continue; } r -= I_out;
        if (r < I_up) { transpose_item(P.in[I_FUP] + (size_t)l * D * FF, D, FF, P.in[I_NFFN] + l * D, (bf16*)(wb + W_UP), 0, scr, r, lane); continue; } r -= I_up;
        transpose_item(P.in[I_FDN] + (size_t)l * FF * D, FF, D, nullptr, (bf16*)(wb + W_DN), 0, scr, r, lane);
    }
}
__device__ __forceinline__ void prologue_lora(const Params& P, int gtid, int gsz) {
    bf16* dst = (bf16*)(P.ws + WS_LORA);
    for (int idx = gtid; idx < 2 * 288 * 256; idx += gsz) { const int l = idx / (288 * 256), r = idx % (288 * 256), j = r >> 8, c = r & 255; bf16* d = dst + (size_t)l * LORA_LAYER;
        if (j < 64) d[LORA_W + c * 64 + j] = (bf16)f2bf(P.in[I_WUP][((size_t)l * 64 + j) * 256 + c]);
        else if (j < 128) d[LORA_A + c * 64 + j - 64] = (bf16)f2bf(P.in[I_AUP][((size_t)l * 64 + j - 64) * 256 + c]);
        else if (j < 256) d[LORA_G + c * 128 + j - 128] = (bf16)f2bf(P.in[I_GUP][((size_t)l * 128 + j - 128) * 256 + c]);
        else if (l > 0) d[LORA_V + c * 32 + j - 256] = (bf16)f2bf(P.in[I_VUP][((size_t)(l - 1) * 32 + j - 256) * 256 + c]); }
}
__device__ __forceinline__ void prologue_rows(const Params& P, int gw, int NGW, int lane) {
    const float* x = P.in[I_X]; bf16* xb = (bf16*)(P.ws + WS_XB); float* ssq = (float*)(P.ws + WS_SSQ);
    for (int m = gw; m < T; m += NGW) {
        const f32x4* xr = (const f32x4*)(x + (size_t)m * D) + lane; f32x4 v[4]; float s = 0.f;
#pragma unroll
        for (int j = 0; j < 4; ++j) { v[j] = xr[64 * j]; s += (v[j][0] * v[j][0] + v[j][1] * v[j][1]) + (v[j][2] * v[j][2] + v[j][3] * v[j][3]); }
        s = wave_sum(s);
        unsigned long long* o8 = (unsigned long long*)(xb + (size_t)m * D) + lane;
#pragma unroll
        for (int j = 0; j < 4; ++j) o8[64 * j] = (unsigned long long)pk2(v[j][0], v[j][1]) | ((unsigned long long)pk2(v[j][2], v[j][3]) << 32);
        if (lane < 16) ssq[(size_t)m * 16 + lane] = (lane == 0) ? s : 0.f;
    }
}
__device__ __forceinline__ void final_norm(const Params& P, int gw, int NGW, int lane, int dry = 0) {
    float* x = P.out; const float* ssq = (const float*)(P.ws + WS_SSQ); const f32x4* g4 = (const f32x4*)P.in[I_NFIN] + lane;
    for (int m = gw; m < T; m += NGW) {
        const float rstd = pg8::row_rstd16(ssq, m);
        f32x4* xr = (f32x4*)(x + (size_t)m * D) + lane;
#pragma unroll
        for (int j = 0; j < 4; ++j) { f32x4 v = xr[64 * j]; const f32x4 g = g4[64 * j]; v = v * rstd * g; if (!dry) xr[64 * j] = v; }
    }
}
typedef __attribute__((address_space(1))) unsigned gu32;
#define XB_TMO      128
#define XB_XCNT(j)  (256  + 64 * (j))
#define XB_XSUB(j)  (1280 + 64 * (j))
#define XB_XGEN(j)  (2304 + 64 * (j))
#define XB_TOP      3328
#define XB_TOPGEN   3392
#define XCD_BAR_WORDS 3456
#define XB_SPIN_CAP (1u << 18)

__device__ __forceinline__ unsigned xb_ld(unsigned* p)              { return __hip_atomic_load(p, __ATOMIC_RELAXED, __HIP_MEMORY_SCOPE_AGENT); }
__device__ __forceinline__ unsigned xb_add(unsigned* p, unsigned v) { return __hip_atomic_fetch_add(p, v, __ATOMIC_RELAXED, __HIP_MEMORY_SCOPE_AGENT); }
__device__ __forceinline__ unsigned xb_xcc_id() { return (unsigned)__builtin_amdgcn_s_getreg((3 << 11) | 20) & 0xFu; }
#define XB_SPIN(cond, bar) do { unsigned _sp = 0; while (cond) { __builtin_amdgcn_s_sleep(1); \
    if ((++_sp & 255u) == 0u) { if (xb_ld(&(bar)[XB_TMO])) break; if (_sp > XB_SPIN_CAP) { atomicAdd(&(bar)[XB_TMO], 1u); break; } } } } while (0)

struct XcdBarrier {
    unsigned* bar; unsigned x;
    volatile LAS unsigned* st;
};

__device__ __forceinline__ XcdBarrier xcd_barrier_post(unsigned* bar, volatile LAS unsigned* st) {
    XcdBarrier b; b.bar = bar; b.x = xb_xcc_id(); b.st = st;
    if (threadIdx.x == 0) (void)xb_add(&bar[XB_XCNT(b.x)], 1u);
    return b;
}
__device__ __forceinline__ void xcd_barrier_complete(unsigned* bar, unsigned x, unsigned& nloc, unsigned& nx) {
    const unsigned G = gridDim.x * gridDim.y * gridDim.z;
    unsigned sum, cnt, mine, sp = 0u;
    for (;;) {
        sum = 0u; cnt = 0u; mine = 0u;
#pragma unroll
        for (unsigned j = 0; j < 16; ++j) { const unsigned c = xb_ld(&bar[XB_XCNT(j)]); sum += c; cnt += (c > 0u) ? 1u : 0u; mine = (j == x) ? c : mine; }
        if (sum == G) break;
        __builtin_amdgcn_s_sleep(1);
        if ((++sp & 255u) == 0u) { if (xb_ld(&bar[XB_TMO])) break; if (sp > XB_SPIN_CAP) { atomicAdd(&bar[XB_TMO], 1u); break; } }
    }
    nloc = mine > 0u ? mine : 1u; nx = cnt > 0u ? cnt : 1u;
}

__device__ __forceinline__ void xcd_barrier(const XcdBarrier& b) {
    asm volatile("s_waitcnt vmcnt(0)" ::: "memory");
    __syncthreads();
    if (threadIdx.x == 0) {
        unsigned* bar = b.bar;
        __builtin_amdgcn_s_waitcnt(0);
        unsigned nloc = b.st[0], nx = b.st[1];
        if (nloc == 0u) { xcd_barrier_complete(bar, b.x, nloc, nx); b.st[0] = nloc; b.st[1] = nx; }
        const unsigned old = xb_add(&bar[XB_XSUB(b.x)], 1u);
        const unsigned gen = old / nloc;
        if (old + 1u == (gen + 1u) * nloc) {
            __builtin_amdgcn_fence(__ATOMIC_RELEASE, "agent");
            asm volatile("s_waitcnt vmcnt(0)" ::: "memory");
            const unsigned og = xb_add(&bar[XB_TOP], 1u);
            const unsigned tg = og / nx;
            if (og + 1u == (tg + 1u) * nx) xb_add(&bar[XB_TOPGEN], 1u);
            else XB_SPIN(xb_ld(&bar[XB_TOPGEN]) == tg, bar);
            __builtin_amdgcn_fence(__ATOMIC_ACQUIRE, "agent");
            xb_add(&bar[XB_XGEN(b.x)], 1u);
            asm volatile("s_waitcnt vmcnt(0)" ::: "memory");
        } else {
            XB_SPIN(xb_ld(&bar[XB_XGEN(b.x)]) == gen, bar);
            __builtin_amdgcn_fence(__ATOMIC_ACQUIRE, "agent");
            asm volatile("s_waitcnt vmcnt(0)" ::: "memory");
        }
    }
    __syncthreads();
}
__device__ __forceinline__ float ldcol(const bf16* cols, int t, int c) { return bf2f(cols[(size_t)t * NPAD + c]); }

__device__ __forceinline__ void rwkv_head_v1(const Params& P, int l, int h, float* lds, int tid) {
    const bf16* cols = (const bf16*)(P.ws + WS_COLS); bf16* Y = (bf16*)(P.ws + WS_Y); bf16* VF = (bf16*)(P.ws + WS_VF);
    float* sR = lds; float* sK = sR + 4096; float* sV = sK + 4096; float* sX = sV + 4096;
    float* sW = sX; float* sA = sX + 4096; float* sB = sX + 8192; float* sG = sX + 12288;
    float* sY = sX + 16384; float* sS = sY + 4096; float* sVr = sS + 64;
    const float* mu = P.in[I_MU] + l * 1024;
    const float* w_up = P.in[I_WUP] + (size_t)l * 64 * 256; const float* a_up = P.in[I_AUP] + (size_t)l * 64 * 256; const float* g_up = P.in[I_GUP] + (size_t)l * 128 * 256;
    const float* vr_up = P.in[I_VUP];
    const int lane = tid & 63, wv = tid >> 6, cc = h * 64 + lane;
    const float w0c = P.in[I_W0][l * 256 + cc], a0c = P.in[I_A0][l * 256 + cc], kkc = P.in[I_KK][l * 256 + cc], kac = P.in[I_KA][l * 256 + cc];
    const float rkc = P.in[I_RK][l * 256 + cc], lnw = P.in[I_LNW][l * 256 + cc], lnb = P.in[I_LNB][l * 256 + cc];
    const float v0c = (l > 0) ? P.in[I_V0][(l - 1) * 256 + cc] : 0.f;
    float S[64];
#pragma unroll
    for (int k = 0; k < 64; ++k) S[k] = 0.f;
    for (int ci = 0; ci < T / 64; ++ci) {
        const int t0 = ci * 64;
#pragma unroll 1
        for (int idx = tid; idx < 3 * 4096; idx += NT) { const int a = idx >> 12, t = (idx >> 6) & 63, c = idx & 63, col = a * 256 + h * 64 + c, tt = t0 + t;
            const float cur = ldcol(cols, tt, col), prv = (tt > 0) ? ldcol(cols, tt - 1, col) : 0.f; const float xs = cur + (prv - cur) * mu[col];
            (a == 0 ? sR : (a == 1 ? sK : sV))[t * 64 + c] = xs; }
#pragma unroll 1
        for (int idx = tid; idx < 64 * 256; idx += NT) { const int t = idx >> 8, j = idx & 255, col = 768 + j, tt = t0 + t;
            const float cur = ldcol(cols, tt, col), prv = (tt > 0) ? ldcol(cols, tt - 1, col) : 0.f; float xs = cur + (prv - cur) * mu[col];
            if (j < 64) xs = tanhf(xs); else if (j >= 128) xs = sigmoidf_(xs);
            sX[t * 256 + j] = xs; }
        if (l > 0)
#pragma unroll 1
        for (int idx = tid; idx < 64 * 32; idx += NT) { const int t = idx >> 5, j = idx & 31; sVr[idx] = ldcol(cols, t0 + t, C_VRES + j); }
        __syncthreads();
        float o_decay[8], o_asig[8], o_g[8], o_vmix[8];
#pragma unroll
        for (int hp = 0; hp < 2; ++hp) {
            float accw[4], acca[4], accg[4], accv[4];
#pragma unroll
            for (int i = 0; i < 4; ++i) { accw[i] = 0.f; acca[i] = 0.f; accg[i] = 0.f; accv[i] = 0.f; }
            const float* xb = sX + (wv * 8 + hp * 4) * 256;
#pragma unroll 2
            for (int j = 0; j < 64; ++j) { const float wvv = w_up[j * 256 + cc], avv = a_up[j * 256 + cc];
#pragma unroll
                for (int i = 0; i < 4; ++i) { accw[i] += xb[i * 256 + j] * wvv; acca[i] += xb[i * 256 + 64 + j] * avv; } }
#pragma unroll 2
            for (int j = 0; j < 128; ++j) { const float gvv = g_up[j * 256 + cc];
#pragma unroll
                for (int i = 0; i < 4; ++i) accg[i] += xb[i * 256 + 128 + j] * gvv; }
            if (l > 0) {
#pragma unroll 2
                for (int j = 0; j < 32; ++j) { const float vv = vr_up[j * 256 + cc];
#pragma unroll
                    for (int i = 0; i < 4; ++i) accv[i] += sVr[(wv * 8 + hp * 4 + i) * 32 + j] * vv; } }
#pragma unroll
            for (int i = 0; i < 4; ++i) { const float wpre = w0c + accw[i]; const float wlog = -softplusf_(-wpre) - 0.5f; o_decay[hp * 4 + i] = __expf(-__expf(wlog));
                o_asig[hp * 4 + i] = sigmoidf_(a0c + acca[i]); o_g[hp * 4 + i] = accg[i]; o_vmix[hp * 4 + i] = sigmoidf_(v0c + accv[i]); }
        }
        __syncthreads();
#pragma unroll
        for (int i = 0; i < 8; ++i) { const int t = wv * 8 + i, tt = t0 + t;
            const float r = sR[t * 64 + lane], k = sK[t * 64 + lane]; float v = sV[t * 64 + lane];
            const float asig = o_asig[i];
            if (l == 0) VF[(size_t)tt * 256 + cc] = (bf16)f2bf(v);
            else { const float vf = bf2f(VF[(size_t)tt * 256 + cc]); v = v + (vf - v) * o_vmix[i]; }
            const float kkr = k * kkc; const float ss = wave_sum(kkr * kkr); const float kk = kkr * (1.0f / sqrtf(ss + 1e-24f));
            const float kmod = k * (1.0f + (asig - 1.0f) * kac);
            const float bon = wave_sum(r * kmod * rkc);
            sW[t * 64 + lane] = o_decay[i]; sA[t * 64 + lane] = -kk; sB[t * 64 + lane] = kk * asig; sG[t * 64 + lane] = o_g[i]; sK[t * 64 + lane] = kmod; sV[t * 64 + lane] = v;
            if (lane == 0) sS[t] = bon; }
        __syncthreads();
        if (wv == 0) {
            for (int t = 0; t < 64; ++t) {
                const float vt = sV[t * 64 + lane];
                const f32x4* a4 = (const f32x4*)(sA + t * 64); const f32x4* w4 = (const f32x4*)(sW + t * 64); const f32x4* b4 = (const f32x4*)(sB + t * 64);
                const f32x4* k4 = (const f32x4*)(sK + t * 64); const f32x4* r4 = (const f32x4*)(sR + t * 64);
                float s0 = 0.f, s1 = 0.f, s2 = 0.f, s3 = 0.f;
#pragma unroll
                for (int q = 0; q < 16; ++q) { const f32x4 a = a4[q]; s0 += S[4 * q] * a[0]; s1 += S[4 * q + 1] * a[1]; s2 += S[4 * q + 2] * a[2]; s3 += S[4 * q + 3] * a[3]; }
                const float sa = (s0 + s1) + (s2 + s3);
                float y0 = 0.f, y1 = 0.f, y2 = 0.f, y3 = 0.f;
#pragma unroll
                for (int q = 0; q < 16; ++q) { const f32x4 w = w4[q], b = b4[q], kq = k4[q], rq = r4[q];
#pragma unroll
                    for (int e = 0; e < 4; ++e) S[4 * q + e] = S[4 * q + e] * w[e] + sa * b[e] + vt * kq[e];
                    y0 += S[4 * q] * rq[0]; y1 += S[4 * q + 1] * rq[1]; y2 += S[4 * q + 2] * rq[2]; y3 += S[4 * q + 3] * rq[3]; }
                sY[t * 64 + lane] = (y0 + y1) + (y2 + y3);
            }
        }
        __syncthreads();
#pragma unroll
        for (int i = 0; i < 8; ++i) { const int t = wv * 8 + i, tt = t0 + t;
            const float y = sY[t * 64 + lane]; const float mean = wave_sum(y) * (1.0f / 64.0f); const float d = y - mean; const float var = wave_sum(d * d) * (1.0f / 64.0f);
            float yn = d * (1.0f / sqrtf(var + 64e-5f)) * lnw + lnb; yn += sS[t] * sV[t * 64 + lane];
            Y[(size_t)tt * 1024 + cc] = (bf16)f2bf(yn * sG[t * 64 + lane]); }
        __syncthreads();
    }
}

__device__ __forceinline__ void gdn_head_v1(const Params& P, int l, int h, float* lds, int tid) {
    const bf16* cols = (const bf16*)(P.ws + WS_COLS); bf16* Y = (bf16*)(P.ws + WS_Y);
    float* sQ = lds; float* sK = sQ + 4096; float* sV = sK + 4096; float* sO = sV + 4096; float* sBeta = sO + 4096; float* sAl = sBeta + 64;
    const float* cw = P.in[I_CONV] + (size_t)l * 4 * 768;
    const int lane = tid & 63, wv = tid >> 6;
    const float alog = P.in[I_ALOG][l * 4 + h], dtb = P.in[I_DTB][l * 4 + h], ng = P.in[I_GDNG][l * 64 + lane];
    float S[64];
#pragma unroll
    for (int k = 0; k < 64; ++k) S[k] = 0.f;
    for (int ci = 0; ci < T / 64; ++ci) {
        const int t0 = ci * 64;
#pragma unroll 1
        for (int idx = tid; idx < 3 * 4096; idx += NT) { const int a = idx >> 12, t = (idx >> 6) & 63, c = idx & 63, ch = a * 256 + h * 64 + c, tt = t0 + t; float acc = 0.f;
#pragma unroll
            for (int i = 0; i < 4; ++i) { const int ts = tt - 3 + i; if (ts >= 0) acc += cw[i * 768 + ch] * ldcol(cols, ts, C_GDN + ch); }
            (a == 0 ? sQ : (a == 1 ? sK : sV))[t * 64 + c] = siluf_(acc); }
        if (tid < 64) { const int tt = t0 + tid; const float braw = ldcol(cols, tt, C_GDN + 1024 + h), araw = ldcol(cols, tt, C_GDN + 1028 + h);
            sBeta[tid] = sigmoidf_(braw); sAl[tid] = __expf(-__expf(alog) * softplusf_(araw + dtb)); }
        __syncthreads();
#pragma unroll
        for (int i = 0; i < 8; ++i) { const int t = wv * 8 + i; const float q = sQ[t * 64 + lane], k = sK[t * 64 + lane];
            const float sq = wave_sum(q * q), sk = wave_sum(k * k);
            sQ[t * 64 + lane] = q * (1.0f / sqrtf(sq + 1e-6f)) * 0.125f; sK[t * 64 + lane] = k * (1.0f / sqrtf(sk + 1e-6f)); }
        __syncthreads();
        if (wv == 0) {
            for (int t = 0; t < 64; ++t) {
                const float vt = sV[t * 64 + lane], beta = sBeta[t], al = sAl[t];
                const f32x4* k4 = (const f32x4*)(sK + t * 64); const f32x4* q4 = (const f32x4*)(sQ + t * 64);
                float s0 = 0.f, s1 = 0.f, s2 = 0.f, s3 = 0.f;
#pragma unroll
                for (int q = 0; q < 16; ++q) { const f32x4 kq = k4[q]; s0 += S[4 * q] * kq[0]; s1 += S[4 * q + 1] * kq[1]; s2 += S[4 * q + 2] * kq[2]; s3 += S[4 * q + 3] * kq[3]; }
                const float kS = al * ((s0 + s1) + (s2 + s3)); const float vn = beta * (vt - kS);
                float y0 = 0.f, y1 = 0.f, y2 = 0.f, y3 = 0.f;
#pragma unroll
                for (int q = 0; q < 16; ++q) { const f32x4 kq = k4[q], qq = q4[q];
#pragma unroll
                    for (int e = 0; e < 4; ++e) S[4 * q + e] = al * S[4 * q + e] + kq[e] * vn;
                    y0 += S[4 * q] * qq[0]; y1 += S[4 * q + 1] * qq[1]; y2 += S[4 * q + 2] * qq[2]; y3 += S[4 * q + 3] * qq[3]; }
                sO[t * 64 + lane] = (y0 + y1) + (y2 + y3);
            }
        }
        __syncthreads();
#pragma unroll
        for (int i = 0; i < 8; ++i) { const int t = wv * 8 + i, tt = t0 + t; const float o = sO[t * 64 + lane]; const float ms = wave_sum(o * o) * (1.0f / 64.0f);
            const float z = ldcol(cols, tt, C_GDN + 768 + h * 64 + lane);
            Y[(size_t)tt * 1024 + 256 + h * 64 + lane] = (bf16)f2bf(o * (1.0f / sqrtf(ms + 1e-6f)) * ng * siluf_(z)); }
        __syncthreads();
    }
}

__device__ __forceinline__ void gla_head_v1(const Params& P, int l, int h, float* lds, int tid) {
    const bf16* cols = (const bf16*)(P.ws + WS_COLS); bf16* Y = (bf16*)(P.ws + WS_Y);
    float* sQ = lds; float* sK = sQ + 2048; float* sAl = sK + 2048; float* sV = sAl + 2048; float* sO = sV + 4096; float* sGd = sO + 4096;
    const float* gk_up = P.in[I_GKUP] + (size_t)l * 16 * 128; const float* gk_b = P.in[I_GKB] + l * 128;
    const int lane = tid & 63, wv = tid >> 6; const float ng = P.in[I_GLAG][l * 64 + lane];
    float S[32];
#pragma unroll
    for (int k = 0; k < 32; ++k) S[k] = 0.f;
    for (int ci = 0; ci < T / 64; ++ci) {
        const int t0 = ci * 64;
#pragma unroll 1
        for (int idx = tid; idx < 64 * 32; idx += NT) { const int t = idx >> 5, j = idx & 31; sQ[idx] = ldcol(cols, t0 + t, C_GLA + h * 32 + j) * 0.17677669529663687f; sK[idx] = ldcol(cols, t0 + t, C_GLA + 128 + h * 32 + j); }
#pragma unroll 1
        for (int idx = tid; idx < 64 * 64; idx += NT) { const int t = idx >> 6, c = idx & 63; sV[idx] = ldcol(cols, t0 + t, C_GLA + 256 + h * 64 + c); }
#pragma unroll 1
        for (int idx = tid; idx < 64 * 16; idx += NT) { const int t = idx >> 4, i = idx & 15; sGd[idx] = ldcol(cols, t0 + t, C_GLA + 768 + i); }
        __syncthreads();
#pragma unroll 1
        for (int idx = tid; idx < 64 * 32; idx += NT) { const int t = idx >> 5, j = idx & 31; float a = gk_b[h * 32 + j];
#pragma unroll
            for (int i = 0; i < 16; ++i) a += sGd[t * 16 + i] * gk_up[i * 128 + h * 32 + j];
            sAl[idx] = __expf(-softplusf_(-a) * (1.0f / 16.0f)); }
        __syncthreads();
        if (wv == 0) {
            for (int t = 0; t < 64; ++t) {
                const float vt = sV[t * 64 + lane];
                const f32x4* a4 = (const f32x4*)(sAl + t * 32); const f32x4* k4 = (const f32x4*)(sK + t * 32); const f32x4* q4 = (const f32x4*)(sQ + t * 32);
                float y0 = 0.f, y1 = 0.f, y2 = 0.f, y3 = 0.f;
#pragma unroll
                for (int q = 0; q < 8; ++q) { const f32x4 a = a4[q], kq = k4[q], qq = q4[q];
#pragma unroll
                    for (int e = 0; e < 4; ++e) S[4 * q + e] = a[e] * S[4 * q + e] + kq[e] * vt;
                    y0 += S[4 * q] * qq[0]; y1 += S[4 * q + 1] * qq[1]; y2 += S[4 * q + 2] * qq[2]; y3 += S[4 * q + 3] * qq[3]; }
                sO[t * 64 + lane] = (y0 + y1) + (y2 + y3);
            }
        }
        __syncthreads();
#pragma unroll
        for (int i = 0; i < 8; ++i) { const int t = wv * 8 + i, tt = t0 + t; const float o = sO[t * 64 + lane]; const float ms = wave_sum(o * o) * (1.0f / 64.0f);
            const float gt = ldcol(cols, tt, C_GLA + 512 + h * 64 + lane);
            Y[(size_t)tt * 1024 + 512 + h * 64 + lane] = (bf16)f2bf(o * (1.0f / sqrtf(ms + 1e-6f)) * ng * siluf_(gt)); }
        __syncthreads();
    }
}

__device__ __forceinline__ void sgu_unit_v1(const Params& P, int l, int n, float* lds, int tid) {
    const bf16* cols = (const bf16*)(P.ws + WS_COLS); bf16* Y = (bf16*)(P.ws + WS_Y);
    float* sVl = lds;
    const int lane = tid & 63, wv = tid >> 6, t0 = n * 128;
    const float* lg = P.in[I_SLG] + l * 256; const float* lb = P.in[I_SLB] + l * 256;
    const float* ws_ = P.in[I_SWS] + (size_t)l * 4 * 128 * 128; const float* bs_ = P.in[I_SBS] + l * 4 * 128;
    for (int i = 0; i < 16; ++i) { const int t = wv * 16 + i; float v[4]; float s = 0.f;
#pragma unroll
        for (int e = 0; e < 4; ++e) { v[e] = geluf_(ldcol(cols, t0 + t, C_SGU + 256 + lane * 4 + e)); s += v[e]; }
        const float mean = wave_sum(s) * (1.0f / 256.0f); float q = 0.f;
#pragma unroll
        for (int e = 0; e < 4; ++e) { v[e] -= mean; q += v[e] * v[e]; }
        const float rstd = 1.0f / sqrtf(wave_sum(q) * (1.0f / 256.0f) + 1e-5f);
#pragma unroll
        for (int e = 0; e < 4; ++e) sVl[t * 256 + lane * 4 + e] = v[e] * rstd * lg[lane * 4 + e] + lb[lane * 4 + e]; }
    __syncthreads();
    const int g = lane >> 4;
    for (int i = 0; i < 16; ++i) { const int t = wv + 8 * i; const float* wr = ws_ + ((size_t)g * 128 + t) * 128; f32x4 acc = {0.f, 0.f, 0.f, 0.f};
        for (int s = 0; s <= t; ++s) { const float w = wr[s]; const f32x4 vv = *(const f32x4*)(sVl + s * 256 + lane * 4); acc += vv * w; }
        const float b = bs_[g * 128 + t];
#pragma unroll
        for (int e = 0; e < 4; ++e) { const float u = geluf_(ldcol(cols, t0 + t, C_SGU + lane * 4 + e)); Y[(size_t)(t0 + t) * 1024 + 768 + lane * 4 + e] = (bf16)f2bf(u * (acc[e] + b)); } }
    __syncthreads();
}
#define LDS_SYNC() do { asm volatile("s_waitcnt lgkmcnt(0)" ::: "memory"); __builtin_amdgcn_s_barrier(); asm volatile("" ::: "memory"); } while (0)
typedef short bf16x8 __attribute__((ext_vector_type(8)));
typedef float f32x16 __attribute__((ext_vector_type(16)));
typedef unsigned u32x2 __attribute__((ext_vector_type(2)));
constexpr int TS = 72;
constexpr int TILE_B = 64 * TS * 2;
template <int KT> __device__ __forceinline__ void mm_tile(f32x16& acc, const LAS bf16* Arows, const LAS bf16* Bcols, int lane) {
    const int off = (lane & 31) * TS + (lane >> 5) * 8;
#pragma unroll
    for (int kk = 0; kk < KT; ++kk) {
        const bf16x8 a = *(const LAS bf16x8*)(Arows + off + kk * 16);
        const bf16x8 b = *(const LAS bf16x8*)(Bcols + off + kk * 16);
        acc = __builtin_amdgcn_mfma_f32_32x32x16_bf16(a, b, acc, 0, 0, 0);
    }
}
template <int KT> __device__ __forceinline__ void mm_tile_gb(f32x16& acc, const LAS bf16* Arows, int lda, const bf16* Bg, int ldb, int lane) {
    const int r = lane & 31, hh = lane >> 5;
#pragma unroll
    for (int kk = 0; kk < KT; ++kk) {
        const bf16x8 a = *(const LAS bf16x8*)(Arows + r * lda + hh * 8 + kk * 16);
        const bf16x8 b = *(const bf16x8*)(Bg + r * ldb + hh * 8 + kk * 16);
        acc = __builtin_amdgcn_mfma_f32_32x32x16_bf16(a, b, acc, 0, 0, 0);
    }
}
__device__ __forceinline__ int acc_i(int r, int hh) { return (r & 3) + 8 * (r >> 2) + 4 * hh; }
__device__ __forceinline__ void store_lane_major(LAS bf16* Z, int j0, int i0, const f32x16& acc, int lane) {
    const int c = lane & 31, hh = lane >> 5;
    LAS bf16* p = Z + (j0 + c) * TS + i0 + 4 * hh;
#pragma unroll
    for (int q = 0; q < 4; ++q) { uint2 w; w.x = pk2(acc[4 * q], acc[4 * q + 1]); w.y = pk2(acc[4 * q + 2], acc[4 * q + 3]); *(LAS u32x2*)(p + 8 * q) = (u32x2){w.x, w.y}; }
}
__device__ __forceinline__ void store_reg_major(LAS bf16* Z, int i0, int j0, const f32x16& acc, int lane) {
    const int c = lane & 31, hh = lane >> 5;
#pragma unroll
    for (int r = 0; r < 16; ++r) Z[(i0 + acc_i(r, hh)) * TS + j0 + c] = (bf16)f2bf(acc[r]);
}
__device__ __forceinline__ f32x16 zero16() { f32x16 z;
#pragma unroll
    for (int r = 0; r < 16; ++r) z[r] = 0.f; return z; }
__device__ __forceinline__ void gla_m1(const Params& P, int l, int ci, LAS unsigned char* lds, int tid) {
    const bf16* cols = (const bf16*)(P.ws + WS_COLS); bf16* Y = (bf16*)(P.ws + WS_Y);
    float* GKV = (float*)(P.ws + WS_GKV); float* GAL = (float*)(P.ws + WS_GAL); bf16* GQI = (bf16*)(P.ws + WS_GQI);
    LAS float* fLa = (LAS float*)lds; LAS float* fGd = fLa + 64 * 128; LAS unsigned char* tb0 = lds + 32768 + 4096;
    const float* gk_up = P.in[I_GKUP] + (size_t)l * 16 * 128; const float* gk_b = P.in[I_GKB] + l * 128;
    const int lane = tid & 63, wv = __builtin_amdgcn_readfirstlane(tid >> 6), t0 = ci * 64;
#pragma unroll
    for (int idx = tid; idx < 64 * 16; idx += NT) fGd[idx] = ldcol(cols, t0 + (idx >> 4), C_GLA + 768 + (idx & 15));
    LDS_SYNC();
#pragma unroll 4
    for (int idx = tid; idx < 64 * 128; idx += NT) { const int t = idx >> 7, j = idx & 127; float a = gk_b[j];
#pragma unroll
        for (int i = 0; i < 16; ++i) a += fGd[t * 16 + i] * gk_up[i * 128 + j];
        fLa[idx] = -softplusf_(-a) * (1.0f / 16.0f); }
    LDS_SYNC();
    if (tid < 128) { float run = 0.f;
#pragma unroll 8
        for (int t = 0; t < 64; ++t) { run += fLa[t * 128 + tid]; fLa[t * 128 + tid] = run; }
        GAL[ci * 128 + tid] = __expf(run); }
    LDS_SYNC();
#pragma unroll 1
    for (int hp = 0; hp < 2; ++hp) {
#pragma unroll 4
        for (int idx = tid; idx < 2 * 64 * 32; idx += NT) { const int s = idx >> 11, t = (idx >> 5) & 63, j = idx & 31, h = 2 * hp + s;
            LAS bf16* tQ = (LAS bf16*)(tb0 + s * 5 * TILE_B); LAS bf16* tK = tQ + 64 * TS; LAS bf16* tKs = tK + 64 * TS;
            const float b = fLa[t * 128 + h * 32 + j], b63 = fLa[63 * 128 + h * 32 + j];
            const float q = ldcol(cols, t0 + t, C_GLA + h * 32 + j) * 0.17677669529663687f, k = ldcol(cols, t0 + t, C_GLA + 128 + h * 32 + j);
            const bf16 qt = (bf16)f2bf(q * __expf(b));
            tQ[t * TS + j] = qt; tK[t * TS + j] = (bf16)f2bf(k * __expf(-b)); tKs[j * TS + t] = (bf16)f2bf(k * __expf(b63 - b));
            GQI[(((size_t)ci * 4 + h) * 64 + t) * 32 + j] = qt; }
#pragma unroll 8
        for (int idx = tid; idx < 2 * 64 * 64; idx += NT) { const int s = idx >> 12, t = (idx >> 6) & 63, v = idx & 63, h = 2 * hp + s;
            LAS bf16* tV = (LAS bf16*)(tb0 + s * 5 * TILE_B + 3 * TILE_B);
            tV[v * TS + t] = cols[(size_t)(t0 + t) * NPAD + C_GLA + 256 + h * 64 + v]; }
        LDS_SYNC();
        for (int jb = wv; jb < 12; jb += 8) { const int s = jb / 6, r = jb % 6, h = 2 * hp + s;
            LAS bf16* tQ = (LAS bf16*)(tb0 + s * 5 * TILE_B); LAS bf16* tK = tQ + 64 * TS; LAS bf16* tKs = tK + 64 * TS; LAS bf16* tV = tKs + 64 * TS; LAS bf16* tSc = tV + 64 * TS;
            f32x16 acc = zero16(); const int c = lane & 31, hh = lane >> 5;
            if (r < 4) { const int tb = (r == 0 || r == 3) ? 0 : 1, sb = (r == 0 || r == 1) ? 0 : 1;
                if (r < 3) { mm_tile<2>(acc, tK + sb * 32 * TS, tQ + tb * 32 * TS, lane);
#pragma unroll
                    for (int q = 0; q < 16; ++q) { const int sI = 32 * sb + acc_i(q, hh), tI = 32 * tb + c; if (sI > tI) acc[q] = 0.f; } }
                store_lane_major(tSc, 32 * tb, 32 * sb, acc, lane);
            } else { const int vb = r - 4; mm_tile<4>(acc, tKs, tV + vb * 32 * TS, lane);
                float* g = GKV + (((size_t)ci * 4 + h) * 32) * 64 + 32 * vb + c;
#pragma unroll
                for (int q = 0; q < 16; ++q) g[acc_i(q, hh) * 64] = acc[q]; }
        }
        LDS_SYNC();
        { const int s = wv >> 2, tb = (wv >> 1) & 1, vb = wv & 1, h = 2 * hp + s;
            LAS bf16* tV = (LAS bf16*)(tb0 + s * 5 * TILE_B + 3 * TILE_B); LAS bf16* tSc = tV + 64 * TS;
            f32x16 acc = zero16(); const int c = lane & 31, hh = lane >> 5;
            mm_tile<4>(acc, tSc + tb * 32 * TS, tV + vb * 32 * TS, lane);
            bf16* y = Y + (size_t)(t0 + 32 * tb) * 1024 + 512 + h * 64 + 32 * vb + c;
#pragma unroll
            for (int q = 0; q < 16; ++q) y[(size_t)acc_i(q, hh) * 1024] = (bf16)f2bf(acc[q]); }
        LDS_SYNC();
    }
}
__device__ __forceinline__ void gla_m2_A(const Params& P, int seg, int e) {
    const float* GKV = (const float*)(P.ws + WS_GKV); const float* GAL = (const float*)(P.ws + WS_GAL); float* GSB = (float*)(P.ws + WS_GSB); float* GSA = (float*)(P.ws + WS_GSA);
    const int hk = e >> 6; float kv[16], al[16];
#pragma unroll
    for (int u = 0; u < 16; ++u) { kv[u] = GKV[(size_t)(seg * 16 + u) * 8192 + e]; al[u] = GAL[(seg * 16 + u) * 128 + hk]; }
    float S = 0.f, A = 1.f;
#pragma unroll
    for (int u = 0; u < 16; ++u) { S = al[u] * S + kv[u]; A *= al[u]; }
    GSB[seg * 8192 + e] = S; if ((e & 63) == 0) GSA[seg * 128 + hk] = A;
}
__device__ __forceinline__ void gla_m2_B(const Params& P, int e) {
    float* GSB = (float*)(P.ws + WS_GSB); const float* GSA = (const float*)(P.ws + WS_GSA);
    const int hk = e >> 6; float b[16], a[16];
#pragma unroll
    for (int s = 0; s < 16; ++s) { b[s] = GSB[s * 8192 + e]; a[s] = GSA[s * 128 + hk]; }
    float S = 0.f;
#pragma unroll
    for (int s = 0; s < 16; ++s) { GSB[s * 8192 + e] = S; S = a[s] * S + b[s]; }
}
__device__ __forceinline__ void gla_m2_C(const Params& P, int seg, int e) {
    float* GKV = (float*)(P.ws + WS_GKV); const float* GAL = (const float*)(P.ws + WS_GAL); const float* GSB = (const float*)(P.ws + WS_GSB);
    const int hk = e >> 6; float kv[16], al[16];
#pragma unroll
    for (int u = 0; u < 16; ++u) { kv[u] = GKV[(size_t)(seg * 16 + u) * 8192 + e]; al[u] = GAL[(seg * 16 + u) * 128 + hk]; }
    float S = GSB[seg * 8192 + e];
#pragma unroll
    for (int u = 0; u < 16; ++u) { GKV[(size_t)(seg * 16 + u) * 8192 + e] = S; S = al[u] * S + kv[u]; }
}
__device__ __forceinline__ void gla_m3(const Params& P, int l, int ci, LAS unsigned char* lds, int tid, bool do_store = true) {
    const bf16* cols = (const bf16*)(P.ws + WS_COLS); bf16* Y = (bf16*)(P.ws + WS_Y);
    const float* GKV = (const float*)(P.ws + WS_GKV); const bf16* GQI = (const bf16*)(P.ws + WS_GQI);
    const float* ng = P.in[I_GLAG] + l * 64;
    const int lane = tid & 63, wv = __builtin_amdgcn_readfirstlane(tid >> 6), t0 = ci * 64;
#pragma unroll 8
    for (int idx = tid; idx < 4 * 32 * 64; idx += NT) { const int h = idx >> 11, k = (idx >> 6) & 31, v = idx & 63;
        ((LAS bf16*)(lds + h * TILE_B))[v * TS + k] = (bf16)f2bf(GKV[(size_t)ci * 8192 + idx]); }
    LDS_SYNC();
    const int h = wv >> 1, tb = wv & 1, c = lane & 31, hh = lane >> 5;
    const LAS bf16* tS = (const LAS bf16*)(lds + h * TILE_B);
    f32x16 acc[2]; acc[0] = zero16(); acc[1] = zero16();
    const bf16* qg = GQI + (((size_t)ci * 4 + h) * 64 + 32 * tb + c) * 32 + hh * 8;
#pragma unroll
    for (int kk = 0; kk < 2; ++kk) { const bf16x8 b = *(const bf16x8*)(qg + kk * 16);
#pragma unroll
        for (int vb = 0; vb < 2; ++vb) { const bf16x8 a = *(const LAS bf16x8*)(tS + (vb * 32 + c) * TS + hh * 8 + kk * 16);
            acc[vb] = __builtin_amdgcn_mfma_f32_32x32x16_bf16(a, b, acc[vb], 0, 0, 0); } }
    const size_t trow = (size_t)(t0 + 32 * tb + c);
    bf16* yrow = Y + trow * 1024 + 512 + h * 64; const bf16* grow = cols + trow * NPAD + C_GLA + 512 + h * 64;
    float ss = 0.f;
#pragma unroll
    for (int vb = 0; vb < 2; ++vb)
#pragma unroll
        for (int q = 0; q < 4; ++q) { const int v = 32 * vb + 8 * q + 4 * hh; const uint2 w = *(const uint2*)(yrow + v);
            acc[vb][4 * q] += bf2f((bf16)(w.x & 0xffff)); acc[vb][4 * q + 1] += bf2f((bf16)(w.x >> 16)); acc[vb][4 * q + 2] += bf2f((bf16)(w.y & 0xffff)); acc[vb][4 * q + 3] += bf2f((bf16)(w.y >> 16));
#pragma unroll
            for (int e = 0; e < 4; ++e) ss += acc[vb][4 * q + e] * acc[vb][4 * q + e]; }
    ss += __shfl_xor(ss, 32);
    const float rstd = rsqf_(ss * (1.0f / 64.0f) + 1e-6f);
#pragma unroll
    for (int vb = 0; vb < 2; ++vb)
#pragma unroll
        for (int q = 0; q < 4; ++q) { const int v = 32 * vb + 8 * q + 4 * hh; const uint2 gw = *(const uint2*)(grow + v); float o[4];
            const float g0 = bf2f((bf16)(gw.x & 0xffff)), g1 = bf2f((bf16)(gw.x >> 16)), g2 = bf2f((bf16)(gw.y & 0xffff)), g3 = bf2f((bf16)(gw.y >> 16));
            o[0] = acc[vb][4 * q] * rstd * ng[v] * siluf_(g0); o[1] = acc[vb][4 * q + 1] * rstd * ng[v + 1] * siluf_(g1);
            o[2] = acc[vb][4 * q + 2] * rstd * ng[v + 2] * siluf_(g2); o[3] = acc[vb][4 * q + 3] * rstd * ng[v + 3] * siluf_(g3);
            uint2 w; w.x = pk2(o[0], o[1]); w.y = pk2(o[2], o[3]); if (do_store) *(uint2*)(yrow + v) = w; }
    LDS_SYNC();
}
__device__ __forceinline__ void nm_square(const LAS bf16* Xr, const LAS bf16* Xc, LAS bf16* Xr_o, LAS bf16* Xc_o, int I, int J, int lane) {
    f32x16 acc = zero16();
    if (I == J) mm_tile<2>(acc, Xr + I * 32 * TS + 32 * I, Xc + J * 32 * TS + 32 * I, lane);
    else mm_tile<4>(acc, Xr + 32 * TS, Xc, lane);
    store_lane_major(Xc_o, 32 * J, 32 * I, acc, lane);
    store_reg_major(Xr_o, 32 * I, 32 * J, acc, lane);
}
__device__ __forceinline__ void nm_update(const LAS bf16* Tt, const LAS bf16* Xc, LAS bf16* Tt_o, int I, int J, int lane) {
    const int c = lane & 31, hh = lane >> 5; f32x16 acc;
#pragma unroll
    for (int q = 0; q < 4; ++q) { const u32x2 w = *(const LAS u32x2*)(Tt + (32 * I + c) * TS + 32 * J + 8 * q + 4 * hh);
        acc[4 * q] = bf2f((bf16)(w.x & 0xffff)); acc[4 * q + 1] = bf2f((bf16)(w.x >> 16)); acc[4 * q + 2] = bf2f((bf16)(w.y & 0xffff)); acc[4 * q + 3] = bf2f((bf16)(w.y >> 16)); }
    if (I == J) mm_tile<2>(acc, Xc + J * 32 * TS + 32 * I, Tt + I * 32 * TS + 32 * I, lane);
    else mm_tile<4>(acc, Xc, Tt + 32 * TS, lane);
    store_lane_major(Tt_o, 32 * I, 32 * J, acc, lane);
}
#define NM_TILE_IJ(w3, I_, J_) const int I_ = ((w3) == 0) ? 0 : 1, J_ = ((w3) == 2) ? 1 : 0
template <class Extra> __device__ __forceinline__ void neumann_solve(LAS bf16* const (&Xr)[2], LAS bf16* const (&Xc)[2], LAS bf16* const (&Tt)[2], int wv, int lane, const Extra& extra) {
    if (wv < 3) { NM_TILE_IJ(wv, I, J); nm_square(Xr[0], Xc[0], Xr[1], Xc[1], I, J, lane); }
    else if (wv >= 4) extra();
    LDS_SYNC();
#pragma unroll 1
    for (int k = 1; k <= 4; ++k) {
        const int xb = k & 1, tbuf = (k - 1) & 1;
        if (wv < 3) { NM_TILE_IJ(wv, I, J); nm_update(Tt[tbuf], Xc[xb], Tt[tbuf ^ 1], I, J, lane); }
        else if (wv < 6) { NM_TILE_IJ(wv - 3, I, J); nm_square(Xr[xb], Xc[xb], Xr[xb ^ 1], Xc[xb ^ 1], I, J, lane); }
        LDS_SYNC();
    }
    if (wv < 3) { NM_TILE_IJ(wv, I, J); nm_update(Tt[0], Xc[1], Tt[1], I, J, lane); }
    LDS_SYNC();
}
typedef float f32x4v __attribute__((ext_vector_type(4)));
constexpr int M2_D = 6;
constexpr int M2_SLOT = 2 * TILE_B + 256;
template <bool NMODE, bool STORE_EACH> __device__ __forceinline__ void dplr_chain(const bf16* XP, bf16* XQ, const float* XG, int pstride, int gstride, int nsteps, const bf16* initH, bf16* outF, float* outG, LAS unsigned char* lds, int tid) {
    const int lane = tid & 63, wv = __builtin_amdgcn_readfirstlane(tid >> 6);
    const int g = lane >> 4, n = lane & 15, v0 = wv * 16;
    const int q = tid - 256;
#define M2_BAR() do { asm volatile("s_waitcnt lgkmcnt(0)" ::: "memory"); __builtin_amdgcn_s_barrier(); asm volatile("" ::: "memory"); } while (0)
    if (wv >= 4) {
        v4u ring[M2_D][5];
#define M2_ISSUE(c, R) do { const int c_ = (c) < nsteps ? (c) : nsteps - 1; const v4u* Pp = (const v4u*)(XP + (size_t)c_ * pstride); \
        R[0] = Pp[q]; R[1] = Pp[q + 256]; if (!NMODE) { const v4u* Qp = (const v4u*)(XQ + (size_t)c_ * pstride); R[2] = Qp[q]; R[3] = Qp[q + 256]; } R[4] = ((const v4u*)(XG + (size_t)c_ * gstride))[q & 15]; } while (0)
#define M2_PUT(slot, R) do { LAS unsigned char* sp = lds + (slot) * M2_SLOT; \
        *(LAS v4u*)(sp + (q >> 3) * (TS * 2) + (q & 7) * 16) = R[0]; *(LAS v4u*)(sp + ((q >> 3) + 32) * (TS * 2) + (q & 7) * 16) = R[1]; \
        if (!NMODE) { *(LAS v4u*)(sp + TILE_B + (q >> 3) * (TS * 2) + (q & 7) * 16) = R[2]; *(LAS v4u*)(sp + TILE_B + ((q >> 3) + 32) * (TS * 2) + (q & 7) * 16) = R[3]; } \
        if (q < 16) *(LAS v4u*)(sp + 2 * TILE_B + q * 16) = R[4]; } while (0)
#pragma unroll
        for (int d = 0; d < M2_D; ++d) M2_ISSUE(d, ring[d]);
        M2_PUT(0, ring[0]);
        M2_ISSUE(M2_D, ring[0]);
        M2_BAR();
#pragma unroll 1
        for (int c0 = 0; c0 < nsteps; c0 += M2_D) {
#pragma unroll
            for (int u = 0; u < M2_D; ++u) {
                M2_PUT((u + 1) & 1, ring[(u + 1) % M2_D]);
                M2_ISSUE(c0 + u + 1 + M2_D, ring[(u + 1) % M2_D]);
                M2_BAR(); }
        }
#undef M2_ISSUE
#undef M2_PUT
    } else {
        f32x4v H[4], Gam[4];
#pragma unroll
        for (int m = 0; m < 4; ++m) { H[m] = (f32x4v){0.f, 0.f, 0.f, 0.f}; Gam[m] = (f32x4v){1.f, 1.f, 1.f, 1.f}; }
        if (!NMODE && initH) {
#pragma unroll
            for (int m = 0; m < 4; ++m) { const uint2 w = *(const uint2*)(initH + (v0 + n) * 64 + 16 * m + 4 * g);
                H[m][0] = bf2f((bf16)(w.x & 0xffff)); H[m][1] = bf2f((bf16)(w.x >> 16)); H[m][2] = bf2f((bf16)(w.y & 0xffff)); H[m][3] = bf2f((bf16)(w.y >> 16)); } }
        M2_BAR();
#pragma unroll 1
        for (int c0 = 0; c0 < nsteps; c0 += M2_D) {
#pragma unroll
            for (int u = 0; u < M2_D; ++u) { const int c = c0 + u;
                if (c < nsteps) { const LAS unsigned char* sp = lds + (u & 1) * M2_SLOT; bf16* Qg = XQ + (size_t)c * pstride;
                    bf16x8 bfr[2];
#pragma unroll
                    for (int s = 0; s < 2; ++s) { f32x4v b0 = H[2 * s], b1 = H[2 * s + 1];
                        if (NMODE) {
#pragma unroll
                            for (int i = 0; i < 4; ++i) { if (2 * s == wv && 4 * g + i == n) b0[i] += Gam[2 * s][i]; if (2 * s + 1 == wv && 4 * g + i == n) b1[i] += Gam[2 * s + 1][i]; } }
                        v4u w; w.x = pk2(b0[0], b0[1]); w.y = pk2(b0[2], b0[3]); w.z = pk2(b1[0], b1[1]); w.w = pk2(b1[2], b1[3]); bfr[s] = __builtin_bit_cast(bf16x8, w); }
#pragma unroll
                    for (int m = 0; m < 4; ++m) {
                        const f32x4v gm = *(const LAS f32x4v*)(sp + 2 * TILE_B + (16 * m + 4 * g) * 4); f32x4v a;
                        if (NMODE) { a = gm * H[m]; Gam[m] = Gam[m] * gm; }
                        else { const u32x2 qw = *(const LAS u32x2*)(sp + TILE_B + (v0 + n) * (TS * 2) + (16 * m + 4 * g) * 2);
                            if (STORE_EACH) { u32x2 hw; hw.x = pk2(H[m][0], H[m][1]); hw.y = pk2(H[m][2], H[m][3]); *(u32x2*)(Qg + (v0 + n) * 64 + 16 * m + 4 * g) = hw; }
                            a[0] = gm[0] * H[m][0] + bf2f((bf16)(qw.x & 0xffff)); a[1] = gm[1] * H[m][1] + bf2f((bf16)(qw.x >> 16)); a[2] = gm[2] * H[m][2] + bf2f((bf16)(qw.y & 0xffff)); a[3] = gm[3] * H[m][3] + bf2f((bf16)(qw.y >> 16)); }
#pragma unroll
                        for (int s = 0; s < 2; ++s) { const u32x2 p0 = *(const LAS u32x2*)(sp + (16 * m + n) * (TS * 2) + (32 * s + 4 * g) * 2); const u32x2 p1 = *(const LAS u32x2*)(sp + (16 * m + n) * (TS * 2) + (32 * s + 16 + 4 * g) * 2);
                            v4u w; w.x = p0.x; w.y = p0.y; w.z = p1.x; w.w = p1.y;
                            a = __builtin_amdgcn_mfma_f32_16x16x32_bf16(__builtin_bit_cast(bf16x8, w), bfr[s], a, 0, 0, 0); }
                        H[m] = a; } }
                M2_BAR(); }
        }
        if (outF) {
            if (NMODE) {
#pragma unroll
                for (int m = 0; m < 4; ++m)
#pragma unroll
                    for (int i = 0; i < 4; ++i) outF[(16 * m + 4 * g + i) * 64 + v0 + n] = (bf16)f2bf(H[m][i]);
                if (wv == 0 && n == 0) {
#pragma unroll
                    for (int m = 0; m < 4; ++m) *(f32x4v*)(outG + 16 * m + 4 * g) = Gam[m]; }
            } else {
#pragma unroll
                for (int m = 0; m < 4; ++m) { u32x2 hw; hw.x = pk2(H[m][0], H[m][1]); hw.y = pk2(H[m][2], H[m][3]); *(u32x2*)(outF + (v0 + n) * 64 + 16 * m + 4 * g) = hw; } }
        }
    }
#undef M2_BAR
}
__device__ __forceinline__ void dplr_m3_stage(const bf16* XQ, int ci, LAS unsigned char* lds, int tid) {
#pragma unroll
    for (int i = 0; i < 4; ++i) { const int idx = tid + NT * i, h = idx >> 9, v = (idx >> 3) & 63, c8 = idx & 7;
        *(LAS v4u*)(lds + h * TILE_B + v * (TS * 2) + c8 * 16) = *(const v4u*)(XQ + (size_t)ci * 16384 + (size_t)idx * 8); }
}
__device__ __forceinline__ void dplr_m3_core(f32x16 (&acc)[2], const LAS bf16* tHT, const bf16* XRch, int tb, int lane) {
    const int c = lane & 31, hh = lane >> 5;
    const bf16* rg = XRch + (32 * tb + c) * 64 + hh * 8;
    acc[0] = zero16(); acc[1] = zero16();
#pragma unroll
    for (int kk = 0; kk < 4; ++kk) { const bf16x8 b = *(const bf16x8*)(rg + kk * 16);
#pragma unroll
        for (int vb = 0; vb < 2; ++vb) { const bf16x8 a = *(const LAS bf16x8*)(tHT + (vb * 32 + c) * TS + hh * 8 + kk * 16);
            acc[vb] = __builtin_amdgcn_mfma_f32_32x32x16_bf16(a, b, acc[vb], 0, 0, 0); } }
}
__device__ __forceinline__ void rwkv_m1(const Params& P, int l, int ci, LAS unsigned char* lds, int tid) {
    const bf16* cols = (const bf16*)(P.ws + WS_COLS); bf16* Y = (bf16*)(P.ws + WS_Y); bf16* VF = (bf16*)(P.ws + WS_VF);
    bf16* XP = (bf16*)(P.ws + WS_RP); bf16* XQ = (bf16*)(P.ws + WS_RQ); bf16* XR = (bf16*)(P.ws + WS_RR); bf16* XBV = (bf16*)(P.ws + WS_RBV); float* XG = (float*)(P.ws + WS_XG);
    LAS bf16* tA = (LAS bf16*)lds; LAS bf16* tB = tA + 64 * TS; LAS bf16* tK = tB + 64 * TS; LAS bf16* tR = tK + 64 * TS; LAS bf16* tV = tR + 64 * TS;
    LAS bf16* tAab = tV + 64 * TS; LAS bf16* tAak = tAab + 64 * TS; LAS bf16* tArb = tAak + 64 * TS; LAS bf16* tArk = tArb + 64 * TS;
    LAS bf16* tAabT = tArk + 64 * TS; LAS bf16* tX1r = tAabT + 64 * TS; LAS bf16* tX1c = tX1r + 64 * TS; LAS bf16* tT0 = tX1c + 64 * TS; LAS bf16* tT1 = tT0 + 64 * TS; LAS bf16* tAV = tT1 + 64 * TS;
    LAS bf16* tW = tAab; LAS bf16* tU = tAak; LAS bf16* tT = tT1;
    LAS float* gC = (LAS float*)(lds + 5 * TILE_B + 77824 + 16384);
    LAS bf16* xW = (LAS bf16*)(lds + 5 * TILE_B); LAS bf16* xA = xW + 64 * 72; LAS bf16* xG = xA + 64 * 72; LAS bf16* xV = xG + 64 * 136; LAS bf16* Lw = xV + 64 * 40;
    LAS float* sLw = (LAS float*)(lds + 5 * TILE_B + 77824);
    const float* mu = P.in[I_MU] + l * 1024;
#pragma unroll 1
    for (int h = 0; h < 4; ++h) {
        int tidh = tid, t0 = ci * 64; asm volatile("" : "+v"(tidh), "+s"(t0));
        const int lane = tidh & 63, wv = __builtin_amdgcn_readfirstlane(tidh >> 6);
        const int cc = h * 64 + lane; const size_t ch = (size_t)ci * 4 + h;
#pragma unroll 8
        for (int idx = tidh; idx < 64 * 256; idx += NT) { const int t = idx >> 8, j = idx & 255, col = 768 + j, tt = t0 + t;
            const float cur = ldcol(cols, tt, col); float prv = ldcol(cols, tt > 0 ? tt - 1 : 0, col); prv = (tt > 0) ? prv : 0.f; const float xs = cur + (prv - cur) * mu[col];
            if (j < 64) xW[t * 72 + j] = (bf16)f2bf(tanhf_(xs)); else if (j < 128) xA[t * 72 + j - 64] = (bf16)f2bf(xs); else xG[t * 136 + j - 128] = (bf16)f2bf(sigmoidf_(xs)); }
        if (l > 0) {
#pragma unroll
            for (int idx = tidh; idx < 64 * 32; idx += NT) { const int t = idx >> 5, j = idx & 31; xV[t * 40 + j] = cols[(size_t)(t0 + t) * NPAD + C_VRES + j]; } }
        LDS_SYNC();
        { const bf16* lw = (const bf16*)(P.ws + WS_LORA) + (size_t)l * LORA_LAYER;
          for (int jb = wv; jb < (l > 0 ? 16 : 12); jb += 8) { const int which = jb >> 2, tb = (jb >> 1) & 1, cb = jb & 1; f32x16 acc = zero16();
            const int crow = h * 64 + cb * 32;
            if (which == 0) mm_tile_gb<4>(acc, xW + tb * 32 * 72, 72, lw + LORA_W + crow * 64, 64, lane);
            else if (which == 1) mm_tile_gb<4>(acc, xA + tb * 32 * 72, 72, lw + LORA_A + crow * 64, 64, lane);
            else if (which == 2) mm_tile_gb<8>(acc, xG + tb * 32 * 136, 136, lw + LORA_G + crow * 128, 128, lane);
            else mm_tile_gb<2>(acc, xV + tb * 32 * 40, 40, lw + LORA_V + crow * 32, 32, lane);
            store_lane_major(Lw + which * 64 * TS, 32 * cb, 32 * tb, acc, lane); } }
        LDS_SYNC();
        const float w0c = P.in[I_W0][l * 256 + cc], a0c = P.in[I_A0][l * 256 + cc], kkc = P.in[I_KK][l * 256 + cc], kac = P.in[I_KA][l * 256 + cc], rkc = P.in[I_RK][l * 256 + cc];
        const float v0c = (l > 0) ? P.in[I_V0][(l - 1) * 256 + cc] : 0.f;
        float o_lw[8], o_asig[8], o_vmix[8];
        { const v4u pw = *(const LAS v4u*)(Lw + lane * TS + wv * 8), pa = *(const LAS v4u*)(Lw + 64 * TS + lane * TS + wv * 8), pg = *(const LAS v4u*)(Lw + 2 * 64 * TS + lane * TS + wv * 8);
          v4u pv = {0u, 0u, 0u, 0u}; if (l > 0) pv = *(const LAS v4u*)(Lw + 3 * 64 * TS + lane * TS + wv * 8);
#pragma unroll
          for (int i = 0; i < 8; ++i) { const unsigned uw = (i < 2 ? pw.x : i < 4 ? pw.y : i < 6 ? pw.z : pw.w), ua = (i < 2 ? pa.x : i < 4 ? pa.y : i < 6 ? pa.z : pa.w), ug = (i < 2 ? pg.x : i < 4 ? pg.y : i < 6 ? pg.z : pg.w), uv = (i < 2 ? pv.x : i < 4 ? pv.y : i < 6 ? pv.z : pv.w);
            const float accw = bf2f((bf16)((i & 1) ? (uw >> 16) : (uw & 0xffff))), acca = bf2f((bf16)((i & 1) ? (ua >> 16) : (ua & 0xffff))), accv = bf2f((bf16)((i & 1) ? (uv >> 16) : (uv & 0xffff)));
            const bf16 gbits = (bf16)((i & 1) ? (ug >> 16) : (ug & 0xffff));
            const float wpre = w0c + accw; const float wlog = -softplusf_(-wpre) - 0.5f; o_lw[i] = -__expf(wlog);
            o_asig[i] = sigmoidf_(a0c + acca); o_vmix[i] = sigmoidf_(v0c + accv);
            Y[(size_t)(t0 + wv * 8 + i) * 1024 + 768 + cc] = gbits; } }
        float e_r[8], e_k[8], e_v[8], e_kk[8];
        {
            float raw[3][9], vfv[8];
#pragma unroll
            for (int a = 0; a < 3; ++a)
#pragma unroll
                for (int rr = 0; rr < 9; ++rr) { const int tt = t0 + wv * 8 - 1 + rr; const float v = ldcol(cols, tt < 0 ? 0 : tt, a * 256 + cc); raw[a][rr] = (tt < 0) ? 0.f : v; }
#pragma unroll
            for (int i = 0; i < 8; ++i) vfv[i] = (l > 0) ? bf2f(VF[(size_t)(t0 + wv * 8 + i) * 256 + cc]) : 0.f;
            const float mu_r = mu[cc], mu_k = mu[256 + cc], mu_v = mu[512 + cc];
#pragma unroll
            for (int i = 0; i < 8; ++i) { const int t = wv * 8 + i, tt = t0 + t;
                const float r = raw[0][i + 1] + (raw[0][i] - raw[0][i + 1]) * mu_r, k = raw[1][i + 1] + (raw[1][i] - raw[1][i + 1]) * mu_k; float v = raw[2][i + 1] + (raw[2][i] - raw[2][i + 1]) * mu_v;
                if (l == 0) VF[(size_t)tt * 256 + cc] = (bf16)f2bf(v);
                else v = v + (vfv[i] - v) * o_vmix[i];
                const float kkr = k * kkc; const float ss = wave_sum(kkr * kkr); const float kk = kkr * rsqf_(ss + 1e-24f);
                const float kmod = k * (1.0f + (o_asig[i] - 1.0f) * kac);
                const float bon = wave_sum(r * kmod * rkc);
                XBV[(ch * 64 + t) * 64 + lane] = (bf16)f2bf(bon * v);
                sLw[t * 64 + lane] = o_lw[i];
                e_r[i] = r; e_k[i] = kmod; e_v[i] = v; e_kk[i] = kk; }
        }
        LDS_SYNC();
        if (tidh < 64) { float run = 0.f;
#pragma unroll 8
            for (int t = 0; t < 64; ++t) { run += sLw[t * 64 + tidh]; sLw[t * 64 + tidh] = run; }
            const float gam = __expf(run); gC[tidh] = gam; XG[ch * 64 + tidh] = gam; }
        LDS_SYNC();
        float at[8], bt[8], kt[8];
#pragma unroll
        for (int i = 0; i < 8; ++i) { const int t = wv * 8 + i; const float cum = sLw[t * 64 + lane], cumm = (t > 0) ? sLw[(t - 1) * 64 + lane] : 0.f;
            const float ep = __expf(cum), en = __expf(-cum), epm = __expf(cumm);
            at[i] = -e_kk[i] * epm; bt[i] = e_kk[i] * o_asig[i] * en; kt[i] = e_k[i] * en;
            tA[t * TS + lane] = (bf16)f2bf(at[i]); tB[t * TS + lane] = (bf16)f2bf(bt[i]); tK[t * TS + lane] = (bf16)f2bf(kt[i]); tR[t * TS + lane] = (bf16)f2bf(e_r[i] * ep); }
        { v4u w; w.x = pk2(e_v[0], e_v[1]); w.y = pk2(e_v[2], e_v[3]); w.z = pk2(e_v[4], e_v[5]); w.w = pk2(e_v[6], e_v[7]); *(LAS v4u*)(tV + lane * TS + wv * 8) = w; }
        LDS_SYNC();
        for (int jb = wv; jb < 16; jb += 8) { const int mat = jb >> 2, r = jb & 3; const int tb = (r == 0 || r == 3) ? 0 : 1, sb = (r == 0 || r == 1) ? 0 : 1;
            f32x16 acc = zero16(); const int c = lane & 31, hh = lane >> 5;
            if (r < 3) { mm_tile<4>(acc, ((mat & 1) ? tK : tB) + sb * 32 * TS, ((mat >> 1) ? tR : tA) + tb * 32 * TS, lane);
#pragma unroll
                for (int q = 0; q < 16; ++q) { const int sI = 32 * sb + acc_i(q, hh), tI = 32 * tb + c; if ((mat < 2) ? (sI >= tI) : (sI > tI)) acc[q] = 0.f; } }
            store_lane_major(tAab + mat * 64 * TS, 32 * tb, 32 * sb, acc, lane);
            if (mat == 0) {
                if (r == 3) store_lane_major(tT1, 0, 32, acc, lane);
                else { store_reg_major(tAabT, 32 * sb, 32 * tb, acc, lane);
#pragma unroll
                    for (int q = 0; q < 16; ++q) if (32 * sb + acc_i(q, hh) == 32 * tb + c) acc[q] += 1.0f;
                    store_lane_major(tT0, 32 * tb, 32 * sb, acc, lane); } }
        }
        LDS_SYNC();
        { v4u w; w.x = pk2(at[0], at[1]); w.y = pk2(at[2], at[3]); w.z = pk2(at[4], at[5]); w.w = pk2(at[6], at[7]); *(LAS v4u*)(tA + lane * TS + wv * 8) = w;
          w.x = pk2(bt[0], bt[1]); w.y = pk2(bt[2], bt[3]); w.z = pk2(bt[4], bt[5]); w.w = pk2(bt[6], bt[7]); *(LAS v4u*)(tB + lane * TS + wv * 8) = w;
          w.x = pk2(kt[0], kt[1]); w.y = pk2(kt[2], kt[3]); w.z = pk2(kt[4], kt[5]); w.w = pk2(kt[6], kt[7]); *(LAS v4u*)(tK + lane * TS + wv * 8) = w; }
        { LAS bf16* const Xr[2] = {tAab, tX1r}; LAS bf16* const Xc[2] = {tAabT, tX1c}; LAS bf16* const Tb[2] = {tT0, tT1};
          neumann_solve(Xr, Xc, Tb, wv, lane, [&]() { const int sb = (wv - 4) >> 1, vb = (wv - 4) & 1; f32x16 acc = zero16();
              mm_tile<4>(acc, tAak + sb * 32 * TS, tV + vb * 32 * TS, lane); store_lane_major(tAV, 32 * vb, 32 * sb, acc, lane); }); }
        { const int which = wv >> 2, tb = (wv >> 1) & 1, jb2 = wv & 1; f32x16 acc = zero16();
            mm_tile<4>(acc, tT + tb * 32 * TS, (which ? tAV : tA) + jb2 * 32 * TS, lane);
            store_lane_major(which ? tU : tW, 32 * jb2, 32 * tb, acc, lane); }
        LDS_SYNC();
        for (int jb = wv; jb < 16; jb += 8) { const int out = jb >> 2, ib = (jb >> 1) & 1, jb2 = jb & 1; f32x16 acc = zero16(); const int c = lane & 31, hh = lane >> 5;
            if (out == 0) mm_tile<4>(acc, tB + ib * 32 * TS, tW + jb2 * 32 * TS, lane);
            else if (out == 1) { mm_tile<4>(acc, tB + ib * 32 * TS, tU + jb2 * 32 * TS, lane); mm_tile<4>(acc, tK + ib * 32 * TS, tV + jb2 * 32 * TS, lane); }
            else if (out == 2) mm_tile<4>(acc, tArb + ib * 32 * TS, tW + jb2 * 32 * TS, lane);
            else { mm_tile<4>(acc, tArb + ib * 32 * TS, tU + jb2 * 32 * TS, lane); mm_tile<4>(acc, tArk + ib * 32 * TS, tV + jb2 * 32 * TS, lane); }
            if (out == 0) { bf16* g = XP + ch * 4096 + 32 * jb2 + c;
#pragma unroll
                for (int q = 0; q < 16; ++q) { const int row = 32 * ib + acc_i(q, hh); g[row * 64] = (bf16)f2bf(acc[q] * gC[row]); } }
            else if (out == 1) { bf16* g = XQ + ch * 4096 + (32 * jb2 + c) * 64 + 32 * ib + 4 * hh;
#pragma unroll
                for (int q = 0; q < 4; ++q) { const int row = 32 * ib + 8 * q + 4 * hh; uint2 w; w.x = pk2(acc[4 * q] * gC[row], acc[4 * q + 1] * gC[row + 1]); w.y = pk2(acc[4 * q + 2] * gC[row + 2], acc[4 * q + 3] * gC[row + 3]); *(uint2*)(g + 8 * q) = w; } }
            else if (out == 2) { bf16* g = XR + ch * 4096 + 32 * jb2 + c;
#pragma unroll
                for (int q = 0; q < 16; ++q) { const int row = 32 * ib + acc_i(q, hh); g[row * 64] = (bf16)f2bf(acc[q] + bf2f(tR[row * TS + 32 * jb2 + c])); } }
            else { bf16* g = Y + (size_t)t0 * 1024 + h * 64 + 32 * jb2 + c;
#pragma unroll
                for (int q = 0; q < 16; ++q) { const int row = 32 * ib + acc_i(q, hh); g[(size_t)row * 1024] = (bf16)f2bf(acc[q]); } }
        }
        LDS_SYNC();
    }
}
__device__ __forceinline__ void rwkv_m3(const Params& P, int l, int ci, LAS unsigned char* lds, int tid, bool do_store = true) {
    bf16* Y = (bf16*)(P.ws + WS_Y); const bf16* XQ = (const bf16*)(P.ws + WS_RQ); const bf16* XR = (const bf16*)(P.ws + WS_RR); const bf16* XBV = (const bf16*)(P.ws + WS_RBV);
    const int lane = tid & 63, wv = __builtin_amdgcn_readfirstlane(tid >> 6), t0 = ci * 64;
    dplr_m3_stage(XQ, ci, lds, tid);
    LDS_SYNC();
    const int h = wv >> 1, tb = wv & 1, c = lane & 31, hh = lane >> 5; const size_t ch = (size_t)ci * 4 + h;
    f32x16 acc[2];
    dplr_m3_core(acc, (const LAS bf16*)(lds + h * TILE_B), XR + ch * 4096, tb, lane);
    const size_t trow = (size_t)(t0 + 32 * tb + c);
    bf16* yrow = Y + trow * 1024 + h * 64; const bf16* grow = Y + trow * 1024 + 768 + h * 64; const bf16* bvrow = XBV + (ch * 64 + 32 * tb + c) * 64;
    const float* lnw = P.in[I_LNW] + l * 256 + h * 64; const float* lnb = P.in[I_LNB] + l * 256 + h * 64;
    float s = 0.f;
#pragma unroll
    for (int vb = 0; vb < 2; ++vb)
#pragma unroll
        for (int q = 0; q < 4; ++q) { const int v = 32 * vb + 8 * q + 4 * hh; const uint2 w = *(const uint2*)(yrow + v);
            acc[vb][4 * q] += bf2f((bf16)(w.x & 0xffff)); acc[vb][4 * q + 1] += bf2f((bf16)(w.x >> 16)); acc[vb][4 * q + 2] += bf2f((bf16)(w.y & 0xffff)); acc[vb][4 * q + 3] += bf2f((bf16)(w.y >> 16));
            s += (acc[vb][4 * q] + acc[vb][4 * q + 1]) + (acc[vb][4 * q + 2] + acc[vb][4 * q + 3]); }
    s += __shfl_xor(s, 32);
    const float mean = s * (1.0f / 64.0f); float qq = 0.f;
#pragma unroll
    for (int vb = 0; vb < 2; ++vb)
#pragma unroll
        for (int r = 0; r < 16; ++r) { acc[vb][r] -= mean; qq += acc[vb][r] * acc[vb][r]; }
    qq += __shfl_xor(qq, 32);
    const float rstd = rsqf_(qq * (1.0f / 64.0f) + 64e-5f);
#pragma unroll
    for (int vb = 0; vb < 2; ++vb)
#pragma unroll
        for (int q = 0; q < 4; ++q) { const int v = 32 * vb + 8 * q + 4 * hh; const uint2 gw = *(const uint2*)(grow + v); const uint2 bw = *(const uint2*)(bvrow + v); float o[4];
            const float g4[4] = {bf2f((bf16)(gw.x & 0xffff)), bf2f((bf16)(gw.x >> 16)), bf2f((bf16)(gw.y & 0xffff)), bf2f((bf16)(gw.y >> 16))};
            const float b4[4] = {bf2f((bf16)(bw.x & 0xffff)), bf2f((bf16)(bw.x >> 16)), bf2f((bf16)(bw.y & 0xffff)), bf2f((bf16)(bw.y >> 16))};
#pragma unroll
            for (int e = 0; e < 4; ++e) o[e] = (acc[vb][4 * q + e] * rstd * lnw[v + e] + lnb[v + e] + b4[e]) * g4[e];
            uint2 w; w.x = pk2(o[0], o[1]); w.y = pk2(o[2], o[3]); if (do_store) *(uint2*)(yrow + v) = w; }
    LDS_SYNC();
}
#ifndef REP_GA
#define REP_GA 1
#endif
#ifndef REP_GS
#define REP_GS 1
#endif
#ifndef REP_G4
#define REP_G4 1
#endif
__device__ __forceinline__ void gdn_m1(const Params& P, int l, int ci, LAS unsigned char* lds, int tid) {
    const bf16* cols = (const bf16*)(P.ws + WS_COLS); bf16* Y = (bf16*)(P.ws + WS_Y);
    bf16* XP = (bf16*)(P.ws + WS_DP); bf16* XQ = (bf16*)(P.ws + WS_DQ); bf16* XR = (bf16*)(P.ws + WS_DR); float* XG = (float*)(P.ws + WS_XG) + 1024 * 64;
    LAS bf16* tKn = (LAS bf16*)lds; LAS bf16* tQn = tKn + 64 * TS; LAS bf16* tBV = tQn + 64 * TS; LAS bf16* tBK = tBV + 64 * TS; LAS bf16* tKd = tBK + 64 * TS;
    LAS bf16* tAab = tKd + 64 * TS; LAS bf16* tAabT = tAab + 64 * TS; LAS bf16* tX1r = tAabT + 64 * TS; LAS bf16* tX1c = tX1r + 64 * TS; LAS bf16* tT0 = tX1c + 64 * TS; LAS bf16* tT1 = tT0 + 64 * TS; LAS bf16* tQk = tT1 + 64 * TS;
    LAS bf16* tW = tAab; LAS bf16* tU = tAabT; LAS bf16* tT = tT1;
    LAS float* sG = (LAS float*)(lds + 12 * TILE_B); LAS float* sGc = sG + 64; LAS float* sBe = sGc + 64;
    const float* cw = P.in[I_CONV] + (size_t)l * 4 * 768;
#pragma unroll 1
    for (int h = 0; h < 4; ++h) {
        int tidh = tid, t0 = ci * 64; asm volatile("" : "+v"(tidh), "+s"(t0));
        const int lane = tidh & 63, wv = __builtin_amdgcn_readfirstlane(tidh >> 6); const size_t ch = (size_t)ci * 4 + h;
        const float alog = P.in[I_ALOG][l * 4 + h], dtb = P.in[I_DTB][l * 4 + h];
        float e_q[8], e_k[8], e_v[8], e_be[8]; float gcs[8], gc63;
        {
            float raw[3][11], braw[8], araw[8], cwv[3][4];
#pragma unroll
            for (int a = 0; a < 3; ++a)
#pragma unroll
                for (int r = 0; r < 11; ++r) { const int ts = t0 + wv * 8 - 3 + r; const float v = ldcol(cols, ts < 0 ? 0 : ts, C_GDN + a * 256 + h * 64 + lane); raw[a][r] = (ts < 0) ? 0.f : v; }
#pragma unroll
            for (int i = 0; i < 8; ++i) { braw[i] = ldcol(cols, t0 + wv * 8 + i, C_GDN + 1024 + h); araw[i] = ldcol(cols, t0 + wv * 8 + i, C_GDN + 1028 + h); }
#pragma unroll
            for (int a = 0; a < 3; ++a)
#pragma unroll
                for (int i = 0; i < 4; ++i) cwv[a][i] = cw[i * 768 + a * 256 + h * 64 + lane];
            float gv[8];
#pragma unroll
            for (int i = 0; i < 8; ++i) { float o3[3];
#pragma unroll
                for (int a = 0; a < 3; ++a) o3[a] = siluf_(cwv[a][0] * raw[a][i] + cwv[a][1] * raw[a][i + 1] + cwv[a][2] * raw[a][i + 2] + cwv[a][3] * raw[a][i + 3]);
                const float sq = wave_sum(o3[0] * o3[0]), sk = wave_sum(o3[1] * o3[1]);
                e_q[i] = o3[0] * rsqf_(sq + 1e-6f) * 0.125f; e_k[i] = o3[1] * rsqf_(sk + 1e-6f); e_v[i] = o3[2];
                e_be[i] = sigmoidf_(braw[i]); gv[i] = -__expf(alog) * softplusf_(araw[i] + dtb); }
            float gsel = gv[0], bsel = e_be[0];
#pragma unroll
            for (int i = 1; i < 8; ++i) { gsel = (lane == i) ? gv[i] : gsel; bsel = (lane == i) ? e_be[i] : bsel; }
            if (lane < 8) { sG[wv * 8 + lane] = gsel; sBe[wv * 8 + lane] = bsel; }
        }
        LDS_SYNC();
        { const float gl = sG[lane]; float run = gl;
#pragma unroll
            for (int o = 1; o < 64; o <<= 1) { const float up = __shfl_up(run, o); if (lane >= o) run += up; }
            gc63 = __shfl(run, 63);
#pragma unroll
            for (int i = 0; i < 8; ++i) gcs[i] = __shfl(run, wv * 8 + i);
            if (wv == 0) { sGc[lane] = run; XG[ch * 64 + lane] = __expf(gc63); } }
        float bk[8], kd[8], bv[8];
#pragma unroll
        for (int i = 0; i < 8; ++i) { const int t = wv * 8 + i;
            tKn[t * TS + lane] = (bf16)f2bf(e_k[i]); tQn[t * TS + lane] = (bf16)f2bf(e_q[i]);
            bv[i] = e_be[i] * e_v[i]; bk[i] = e_be[i] * e_k[i] * __expf(gcs[i]); kd[i] = e_k[i] * __expf(gc63 - gcs[i]); }
        { v4u w; w.x = pk2(bv[0], bv[1]); w.y = pk2(bv[2], bv[3]); w.z = pk2(bv[4], bv[5]); w.w = pk2(bv[6], bv[7]); *(LAS v4u*)(tBV + lane * TS + wv * 8) = w;
          w.x = pk2(bk[0], bk[1]); w.y = pk2(bk[2], bk[3]); w.z = pk2(bk[4], bk[5]); w.w = pk2(bk[6], bk[7]); *(LAS v4u*)(tBK + lane * TS + wv * 8) = w;
          w.x = pk2(kd[0], kd[1]); w.y = pk2(kd[2], kd[3]); w.z = pk2(kd[4], kd[5]); w.w = pk2(kd[6], kd[7]); *(LAS v4u*)(tKd + lane * TS + wv * 8) = w; }
        LDS_SYNC();
        for (int rpd_ = 0; rpd_ < REP_GS; ++rpd_)
        { const int mat = wv >> 2, r = wv & 3; const int tb = (r == 0 || r == 3) ? 0 : 1, sb = (r == 0 || r == 1) ? 0 : 1;
            f32x16 acc = zero16(); const int c = lane & 31, hh = lane >> 5;
            if (r < 3) { mm_tile<4>(acc, tKn + sb * 32 * TS, (mat ? tQn : tKn) + tb * 32 * TS, lane);
                const int tI = 32 * tb + c; const float gct = sGc[tI], bet = sBe[tI];
#pragma unroll
                for (int q = 0; q < 16; ++q) { const int sI = 32 * sb + acc_i(q, hh);
                    if ((mat == 0) ? (sI >= tI) : (sI > tI)) acc[q] = 0.f;
                    else { const float dcy = __expf(gct - sGc[sI]); acc[q] = (mat == 0) ? (-bet * acc[q] * dcy) : (acc[q] * dcy); } } }
            if (mat == 0) { store_lane_major(tAab, 32 * tb, 32 * sb, acc, lane);
                if (r == 3) store_lane_major(tT1, 0, 32, acc, lane);
                else { store_reg_major(tAabT, 32 * sb, 32 * tb, acc, lane);
#pragma unroll
                    for (int q = 0; q < 16; ++q) if (32 * sb + acc_i(q, hh) == 32 * tb + c) acc[q] += 1.0f;
                    store_lane_major(tT0, 32 * tb, 32 * sb, acc, lane); } }
            else store_lane_major(tQk, 32 * tb, 32 * sb, acc, lane);
        }
        LDS_SYNC();
        { LAS bf16* const Xr[2] = {tAab, tX1r}; LAS bf16* const Xc[2] = {tAabT, tX1c}; LAS bf16* const Tb[2] = {tT0, tT1};
          neumann_solve(Xr, Xc, Tb, wv, lane, [&]() {}); }
        { const int which = wv >> 2, tb = (wv >> 1) & 1, jb2 = wv & 1; f32x16 acc = zero16();
            mm_tile<4>(acc, tT + tb * 32 * TS, (which ? tBV : tBK) + jb2 * 32 * TS, lane);
            store_lane_major(which ? tU : tW, 32 * jb2, 32 * tb, acc, lane); }
        LDS_SYNC();
        for (int rpg_ = 0; rpg_ < REP_G4; ++rpg_)
        for (int jb = wv; jb < 16; jb += 8) { const int out = jb >> 2, ib = (jb >> 1) & 1, jb2 = jb & 1; f32x16 acc = zero16(); const int c = lane & 31, hh = lane >> 5;
            if (out < 2) mm_tile<4>(acc, tKd + ib * 32 * TS, (out ? tU : tW) + jb2 * 32 * TS, lane);
            else mm_tile<4>(acc, tQk + ib * 32 * TS, (out == 3 ? tU : tW) + jb2 * 32 * TS, lane);
            if (out == 0) { bf16* g = XP + ch * 4096 + 32 * jb2 + c;
#pragma unroll
                for (int q = 0; q < 16; ++q) { const int row = 32 * ib + acc_i(q, hh); g[row * 64] = (bf16)f2bf(-acc[q]); } }
            else if (out == 1) { bf16* g = XQ + ch * 4096 + (32 * jb2 + c) * 64 + 32 * ib + 4 * hh;
#pragma unroll
                for (int q = 0; q < 4; ++q) { uint2 w; w.x = pk2(acc[4 * q], acc[4 * q + 1]); w.y = pk2(acc[4 * q + 2], acc[4 * q + 3]); *(uint2*)(g + 8 * q) = w; } }
            else if (out == 2) { bf16* g = XR + ch * 4096 + 32 * jb2 + c;
#pragma unroll
                for (int q = 0; q < 16; ++q) { const int row = 32 * ib + acc_i(q, hh); g[row * 64] = (bf16)f2bf(bf2f(tQn[row * TS + 32 * jb2 + c]) * __expf(sGc[row]) - acc[q]); } }
            else { bf16* g = Y + (size_t)t0 * 1024 + 256 + h * 64 + 32 * jb2 + c;
#pragma unroll
                for (int q = 0; q < 16; ++q) { const int row = 32 * ib + acc_i(q, hh); g[(size_t)row * 1024] = (bf16)f2bf(acc[q]); } }
        }
        LDS_SYNC();
    }
}
__device__ __forceinline__ void gdn_m3(const Params& P, int l, int ci, LAS unsigned char* lds, int tid, bool do_store = true) {
    const bf16* cols = (const bf16*)(P.ws + WS_COLS); bf16* Y = (bf16*)(P.ws + WS_Y); const bf16* XQ = (const bf16*)(P.ws + WS_DQ); const bf16* XR = (const bf16*)(P.ws + WS_DR);
    const float* ng = P.in[I_GDNG] + l * 64;
    const int lane = tid & 63, wv = __builtin_amdgcn_readfirstlane(tid >> 6), t0 = ci * 64;
    dplr_m3_stage(XQ, ci, lds, tid);
    LDS_SYNC();
    const int h = wv >> 1, tb = wv & 1, c = lane & 31, hh = lane >> 5; const size_t ch = (size_t)ci * 4 + h;
    f32x16 acc[2];
    dplr_m3_core(acc, (const LAS bf16*)(lds + h * TILE_B), XR + ch * 4096, tb, lane);
    const size_t trow = (size_t)(t0 + 32 * tb + c);
    bf16* yrow = Y + trow * 1024 + 256 + h * 64; const bf16* zrow = cols + trow * NPAD + C_GDN + 768 + h * 64;
    float ss = 0.f;
#pragma unroll
    for (int vb = 0; vb < 2; ++vb)
#pragma unroll
        for (int q = 0; q < 4; ++q) { const int v = 32 * vb + 8 * q + 4 * hh; const uint2 w = *(const uint2*)(yrow + v);
            acc[vb][4 * q] += bf2f((bf16)(w.x & 0xffff)); acc[vb][4 * q + 1] += bf2f((bf16)(w.x >> 16)); acc[vb][4 * q + 2] += bf2f((bf16)(w.y & 0xffff)); acc[vb][4 * q + 3] += bf2f((bf16)(w.y >> 16));
#pragma unroll
            for (int e = 0; e < 4; ++e) ss += acc[vb][4 * q + e] * acc[vb][4 * q + e]; }
    ss += __shfl_xor(ss, 32);
    const float rstd = rsqf_(ss * (1.0f / 64.0f) + 1e-6f);
#pragma unroll
    for (int vb = 0; vb < 2; ++vb)
#pragma unroll
        for (int q = 0; q < 4; ++q) { const int v = 32 * vb + 8 * q + 4 * hh; const uint2 zw = *(const uint2*)(zrow + v); float o[4];
            const float z4[4] = {bf2f((bf16)(zw.x & 0xffff)), bf2f((bf16)(zw.x >> 16)), bf2f((bf16)(zw.y & 0xffff)), bf2f((bf16)(zw.y >> 16))};
#pragma unroll
            for (int e = 0; e < 4; ++e) o[e] = acc[vb][4 * q + e] * rstd * ng[v + e] * siluf_(z4[e]);
            uint2 w; w.x = pk2(o[0], o[1]); w.y = pk2(o[2], o[3]); if (do_store) *(uint2*)(yrow + v) = w; }
    LDS_SYNC();
}
constexpr int SGS = 136;
__device__ __forceinline__ void sgu_m3(const Params& P, int l, int ci, LAS unsigned char* lds, int tid) {
    const bf16* cols = (const bf16*)(P.ws + WS_COLS); bf16* Y = (bf16*)(P.ws + WS_Y);
    LAS bf16* VlT = (LAS bf16*)lds;
    LAS bf16* Wt = VlT + 256 * SGS;
    const int lane = tid & 63, wv = __builtin_amdgcn_readfirstlane(tid >> 6), half = ci & 1, tbase = (ci >> 1) * 128, ntok = half ? 128 : 64;
    const float* lg = P.in[I_SLG] + l * 256; const float* lb = P.in[I_SLB] + l * 256;
    const float* ws_ = P.in[I_SWS] + (size_t)l * 4 * 128 * 128; const float* bs_ = P.in[I_SBS] + l * 4 * 128;
    { const f32x4 g4 = *(const f32x4*)(lg + lane * 4), b4 = *(const f32x4*)(lb + lane * 4);
#pragma unroll 1
      for (int tb8 = 0; tb8 < ntok / 8; tb8 += 8) { uint2 raw[8];
#pragma unroll
        for (int i = 0; i < 8; ++i) raw[i] = *(const uint2*)(cols + (size_t)(tbase + wv + 8 * (tb8 + i)) * NPAD + C_SGU + 256 + lane * 4);
#pragma unroll
        for (int i = 0; i < 8; ++i) { const int t = wv + 8 * (tb8 + i); float v[4]; float s = 0.f;
            v[0] = geluf_(bf2f((bf16)(raw[i].x & 0xffff))); v[1] = geluf_(bf2f((bf16)(raw[i].x >> 16))); v[2] = geluf_(bf2f((bf16)(raw[i].y & 0xffff))); v[3] = geluf_(bf2f((bf16)(raw[i].y >> 16)));
            s = (v[0] + v[1]) + (v[2] + v[3]);
            const float mean = wave_sum(s) * (1.0f / 256.0f); float q = 0.f;
#pragma unroll
            for (int e = 0; e < 4; ++e) { v[e] -= mean; q += v[e] * v[e]; }
            const float rstd = rsqf_(wave_sum(q) * (1.0f / 256.0f) + 1e-5f);
#pragma unroll
            for (int e = 0; e < 4; ++e) VlT[(lane * 4 + e) * SGS + t] = (bf16)f2bf(v[e] * rstd * g4[e] + b4[e]); } } }
    { const int n4 = ntok / 4;
#pragma unroll 4
      for (int idx = tid; idx < 4 * 64 * n4; idx += NT) { const int s4 = idx % n4, row = idx / n4, g = row >> 6, t = row & 63, ta = 64 * half + t;
        const f32x4 w = *(const f32x4*)(ws_ + ((size_t)g * 128 + ta) * 128 + 4 * s4);
        u32x2 o; o.x = pk2(4 * s4 <= ta ? w[0] : 0.f, 4 * s4 + 1 <= ta ? w[1] : 0.f); o.y = pk2(4 * s4 + 2 <= ta ? w[2] : 0.f, 4 * s4 + 3 <= ta ? w[3] : 0.f);
        *(LAS u32x2*)(Wt + (g * 64 + t) * SGS + 4 * s4) = o; } }
    LDS_SYNC();
#pragma unroll 1
    for (int jb = wv; jb < 16; jb += 8) { const int g = jb >> 2, tb = (jb >> 1) & 1, cb = jb & 1; const int c = lane & 31, hh = lane >> 5;
        const int KT = 4 * half + 2 * tb + 2;
        f32x16 acc = zero16();
        const LAS bf16* Ar = Wt + (g * 64 + tb * 32 + c) * SGS + hh * 8; const LAS bf16* Br = VlT + (g * 64 + cb * 32 + c) * SGS + hh * 8;
#pragma unroll 2
        for (int kk = 0; kk < KT; ++kk) acc = __builtin_amdgcn_mfma_f32_32x32x16_bf16(*(const LAS bf16x8*)(Ar + kk * 16), *(const LAS bf16x8*)(Br + kk * 16), acc, 0, 0, 0);
        const int ch = g * 64 + cb * 32 + c; float uu[16], bb[16];
#pragma unroll
        for (int q = 0; q < 16; ++q) { const int ta = 64 * half + 32 * tb + acc_i(q, hh); uu[q] = ldcol(cols, tbase + ta, C_SGU + ch); bb[q] = bs_[g * 128 + ta]; }
#pragma unroll
        for (int q = 0; q < 16; ++q) { const int ta = 64 * half + 32 * tb + acc_i(q, hh); Y[(size_t)(tbase + ta) * 1024 + 768 + ch] = (bf16)f2bf(geluf_(uu[q]) * (acc[q] + bb[q])); } }
    LDS_SYNC();
}
#ifndef REP_P0
#define REP_P0 1
#endif
#ifndef REP_FN
#define REP_FN 1
#endif
#ifndef REP_G2
#define REP_G2 1
#endif
#ifndef REP_DN
#define REP_DN 1
#endif
#ifndef REP_M2
#define REP_M2 1
#endif
#ifndef REP_M3
#define REP_M3 1
#endif
#ifndef REP_RW
#define REP_RW 1
#endif
#ifndef REP_GD
#define REP_GD 1
#endif
#ifndef REP_M1
#define REP_M1 1
#endif
#ifndef REP_SGU
#define REP_SGU 1
#endif
#ifndef REP_G1
#define REP_G1 1
#endif
#ifndef REP_UP
#define REP_UP 1
#endif
#define GRID_SYNC() xcd_barrier(xbar)
__global__ void __launch_bounds__(NT, 2) fwd_kernel(Params P) {
    extern __shared__ __attribute__((aligned(16))) unsigned char lds_raw[];
    cg::grid_group grid = cg::this_grid();
    LAS unsigned char* ldsl = (LAS unsigned char*)lds_raw;
    const int G = gridDim.x;
    if (threadIdx.x < 16) ((LAS unsigned*)(ldsl + LDS_BYTES - 64))[threadIdx.x] = 0u;
    __syncthreads();
    const XcdBarrier xbar = xcd_barrier_post((unsigned*)(P.ws + WS_BAR), (volatile LAS unsigned*)(ldsl + LDS_BYTES - 64));
#define PHASE_TID() int tid = threadIdx.x; asm volatile("" : "+v"(tid)); const int lane = tid & 63, wave = __builtin_amdgcn_readfirstlane(tid >> 6); const int gw = blockIdx.x * NWAVES + wave, NGW = G * NWAVES; (void)lane; (void)gw; (void)NGW
    {
        PHASE_TID();
        for (int rep_ = 0; rep_ < REP_P0; ++rep_) {
        prologue_weights(P, 0, 1, (float*)lds_raw, gw, NGW, wave, lane);
        prologue_lora(P, blockIdx.x * NT + tid, G * NT);
        prologue_rows(P, gw, NGW, lane); }
    }
    grid.sync();
#pragma unroll 1
    for (int l_ = 0; l_ < DEPTH; ++l_) {
        int l = l_; asm volatile("" : "+s"(l));
        bf16* XB = (bf16*)(P.ws + WS_XB); bf16* YB = (bf16*)(P.ws + WS_Y); bf16* HB = (bf16*)(P.ws + WS_H); bf16* COLS = (bf16*)(P.ws + WS_COLS); float* SSQ = (float*)(P.ws + WS_SSQ);
        const unsigned char* wb = P.ws + WS_W;
        {
            pg8::Gemm g{XB, (const bf16*)(wb + W_IN), T, NPAD, D}; pg8::StaticOrder S; S.init(T, NPAD, G, (int)blockIdx.x);
            pg8::EpiScaleBf16<0> E{COLS, NPAD, SSQ};
            for (int rep_ = 0; rep_ < REP_G1; ++rep_) pg8::gemm_phase<pg8::EpiScaleBf16<0>, pg8::StaticOrder, true, true>(ldsl, g, S, E);
        }
        GRID_SYNC();
        {
            PHASE_TID();
            for (int rep_ = 0; rep_ < REP_M1; ++rep_)
            for (int ci = blockIdx.x; ci < T / 64; ci += G) {
#ifndef NO_RWKV1
                for (int r2_ = 0; r2_ < REP_RW; ++r2_) rwkv_m1(P, l, ci, ldsl, tid);
#endif
#ifndef NO_GDN1
                for (int r2_ = 0; r2_ < REP_GD; ++r2_) gdn_m1(P, l, ci, ldsl, tid);
#endif
#ifndef NO_GLA1
                gla_m1(P, l, ci, ldsl, tid);
#endif
            }
        }
        GRID_SYNC();
        {
            PHASE_TID();
            const int b = blockIdx.x, seg = b >> 4, mh = (b >> 1) & 7, hh_ = mh & 3; const bool gdn = mh >= 4;
            const bf16* XP = (const bf16*)(P.ws + (gdn ? WS_DP : WS_RP)) + ((size_t)seg * 64 + hh_) * 4096; bf16* XQ = (bf16*)(P.ws + (gdn ? WS_DQ : WS_RQ)) + ((size_t)seg * 64 + hh_) * 4096;
            const float* XG = (const float*)(P.ws + WS_XG) + (gdn ? 1024 * 64 : 0) + ((size_t)seg * 64 + hh_) * 64;
            bf16* SN = (bf16*)(P.ws + WS_SN) + ((size_t)seg * 8 + mh) * 4096; bf16* SQ = (bf16*)(P.ws + WS_SQ) + ((size_t)seg * 8 + mh) * 4096; float* SG = (float*)(P.ws + WS_SG) + ((size_t)seg * 8 + mh) * 64;
            if (b & 1) dplr_chain<true, false>(XP, XQ, XG, 4 * 4096, 4 * 64, 16, nullptr, SN, SG, ldsl, tid);
            else dplr_chain<false, false>(XP, XQ, XG, 4 * 4096, 4 * 64, 16, nullptr, SQ, nullptr, ldsl, tid);
            gla_m2_A(P, b >> 4, (b & 15) * NT + tid);
        }
        GRID_SYNC();
        {
            PHASE_TID();
            const int b = blockIdx.x;
            if (b < 8) dplr_chain<false, true>((const bf16*)(P.ws + WS_SN) + (size_t)b * 4096, (bf16*)(P.ws + WS_SQ) + (size_t)b * 4096, (const float*)(P.ws + WS_SG) + b * 64, 8 * 4096, 8 * 64, 16, nullptr, nullptr, nullptr, ldsl, tid);
            else if (b < 24) gla_m2_B(P, (b - 8) * NT + tid);
            else prologue_weights(P, l, 12, (float*)lds_raw, (b - 24) * NWAVES + wave, (G - 24) * NWAVES, wave, lane);
        }
        GRID_SYNC();
        {
            PHASE_TID();
            const int b = blockIdx.x;
            if (b < 128) { const int seg = b >> 3, mh = b & 7, hh_ = mh & 3; const bool gdn = mh >= 4;
                const bf16* XP = (const bf16*)(P.ws + (gdn ? WS_DP : WS_RP)) + ((size_t)seg * 64 + hh_) * 4096; bf16* XQ = (bf16*)(P.ws + (gdn ? WS_DQ : WS_RQ)) + ((size_t)seg * 64 + hh_) * 4096;
                const float* XG = (const float*)(P.ws + WS_XG) + (gdn ? 1024 * 64 : 0) + ((size_t)seg * 64 + hh_) * 64;
                dplr_chain<false, true>(XP, XQ, XG, 4 * 4096, 4 * 64, 16, (const bf16*)(P.ws + WS_SQ) + ((size_t)seg * 8 + mh) * 4096, nullptr, nullptr, ldsl, tid); }
            else { const int gw2 = (b - 128) * NWAVES + wave, ngw2 = (G - 128) * NWAVES;
                prologue_weights(P, l, 2, (float*)lds_raw, gw2, ngw2, wave, lane);
                if (l == 0) prologue_weights(P, 1, 1, (float*)lds_raw, gw2, ngw2, wave, lane); }
            gla_m2_C(P, b >> 4, (b & 15) * NT + tid);
        }
        GRID_SYNC();
        {
            PHASE_TID();
            for (int ci = blockIdx.x; ci < T / 64; ci += G) {
#ifndef NO_M3
                for (int rep_ = REP_M3 - 1; rep_ >= 0; --rep_) { int sti = (rep_ == 0) ? 1 : 0; asm volatile("" : "+v"(sti)); const bool st = sti != 0; rwkv_m3(P, l, ci, ldsl, tid, st); gdn_m3(P, l, ci, ldsl, tid, st); gla_m3(P, l, ci, ldsl, tid, st); }
                for (int rep_ = 0; rep_ < REP_SGU; ++rep_) sgu_m3(P, l, ci, ldsl, tid);
#endif
            }
        }
        GRID_SYNC();
        {
            pg8::Gemm g{YB, (const bf16*)(wb + W_OUT), T, D, D}; pg8::StaticOrder S; S.init(T, D, G, (int)blockIdx.x);
            for (int rep_ = REP_G2 - 1; rep_ >= 0; --rep_) { int dry = rep_; asm volatile("" : "+v"(dry));
            pg8::EpiResid E{l == 0 ? P.in[I_X] : (const float*)P.out, P.out, XB, SSQ, dry};
            pg8::gemm_phase<pg8::EpiResid, pg8::StaticOrder, true, true>(ldsl, g, S, E); }
        }
        GRID_SYNC();
        {
            pg8::Gemm g{XB, (const bf16*)(wb + W_UP), T, FF, D}; pg8::StaticOrder S; S.init(T, FF, G, (int)blockIdx.x);
            pg8::EpiScaleBf16<2> E{HB, FF, SSQ};
            for (int rep_ = 0; rep_ < REP_UP; ++rep_) pg8::gemm_phase<pg8::EpiScaleBf16<2>, pg8::StaticOrder, true, true>(ldsl, g, S, E);
        }
        GRID_SYNC();
        {
            pg8::Gemm g{HB, (const bf16*)(wb + W_DN), T, D, FF}; pg8::StaticOrder S; S.init(T, D, G, (int)blockIdx.x);
            for (int rep_ = REP_DN - 1; rep_ >= 0; --rep_) { int dry = rep_; asm volatile("" : "+v"(dry));
            pg8::EpiResid E{(const float*)P.out, P.out, XB, SSQ, dry};
            pg8::gemm_phase<pg8::EpiResid, pg8::StaticOrder, true, true>(ldsl, g, S, E); }
        }
        GRID_SYNC();
    }
    { PHASE_TID(); for (int rep_ = REP_FN - 1; rep_ >= 0; --rep_) { int dry = rep_; asm volatile("" : "+v"(dry)); final_norm(P, gw, NGW, lane, dry); } }
}

extern "C" void kernel_launch(void* const* d_in, const int* in_sizes, int n_in, void* d_out, int out_size, void* d_ws, size_t ws_size, hipStream_t stream) {
    static int grid_blocks = 0;
    if (!grid_blocks) {
        int dev = 0, cus = 0, per_cu = 0;
        if (n_in != 33 || out_size != T * D || ws_size < WS_END) { fprintf(stderr, "kernel_launch: unexpected shapes n_in %d out %d ws %zu\n", n_in, out_size, ws_size); grid_blocks = -1; return; }
        (void)hipGetDevice(&dev);
        (void)hipDeviceGetAttribute(&cus, hipDeviceAttributeMultiprocessorCount, dev);
        (void)hipFuncSetAttribute((const void*)fwd_kernel, hipFuncAttributeMaxDynamicSharedMemorySize, LDS_BYTES);
        (void)hipOccupancyMaxActiveBlocksPerMultiprocessor(&per_cu, (const void*)fwd_kernel, NT, LDS_BYTES);
        if (per_cu < 1) fprintf(stderr, "kernel_launch: occupancy query says %d blocks/CU\n", per_cu);
        grid_blocks = cus;
        (void)hipGetLastError();
    }
    if (grid_blocks < 0) return;
    (void)hipMemsetAsync((char*)d_ws + WS_BAR, 0, 16384, stream);
    Params p{};
    for (int i = 0; i < 33; ++i) p.in[i] = (const float*)d_in[i];
    p.out = (float*)d_out; p.ws = (unsigned char*)d_ws;
    void* args[] = {&p};
    hipError_t e = hipLaunchCooperativeKernel((void*)fwd_kernel, dim3(grid_blocks), dim3(NT), args, LDS_BYTES, stream);
    if (e != hipSuccess) fprintf(stderr, "cooperative launch failed: %s (grid %d)\n", hipGetErrorString(e), grid_blocks);
}
```

```cpp
#include <hip/hip_runtime.h>
#include <hip/hip_cooperative_groups.h>
#include <cstdio>
#include <cstdint>
namespace cg = cooperative_groups;
namespace pg8 {
#define PG8_LAS __attribute__((address_space(3)))
typedef unsigned short bf16_t;
typedef short bf16x8 __attribute__((ext_vector_type(8)));
typedef float f32x4 __attribute__((ext_vector_type(4)));
typedef unsigned u32x4 __attribute__((ext_vector_type(4)));
constexpr int BM = 256, BK = 64, HALF = 128, HTB = HALF * BK * 2  , STAGE_BYTES = 8 * HTB, NXCD = 8, WGM = 8;

__host__ __device__ __forceinline__ int lds_byte(int r, int c) { const int st = (r >> 4) * 2 + (c >> 5), rr = r & 15, cc = c & 31, ob = rr * 64 + cc * 2; return st * 1024 + (ob ^ (((ob >> 9) & 1) << 5)); }
__host__ __device__ __forceinline__ void stage_rc(int b, int& R, int& C) { const int st = b / 1024, sb = b % 1024, swz = sb ^ (((sb >> 9) & 1) << 5); R = (st >> 1) * 16 + swz / 64; C = (st & 1) * 32 + (swz % 64) / 2; }
__host__ __device__ __forceinline__ int perm32(int rho) { const int n = rho >> 4, i = rho & 15; return 8 * (i >> 2) + 4 * n + (i & 3); }

struct Unit { int pm, pn; };
struct Gemm { const bf16_t* A; const bf16_t* Bt; int M, N, K; };

struct StaticOrder {
    int nM, nN, nwg, G, c;
    __host__ __device__ void init(int M, int N, int G_, int c_) { nM = M / BM; nN = N / BM; nwg = nM * nN; G = G_; c = c_; }
    __host__ __device__ bool next(int i, Unit& u) const {
        const long L = (long)i * G + c; if (L >= nwg) return false;
        int wgid = (int)L; { const int q = nwg / NXCD, r = nwg % NXCD, xcd = wgid % NXCD, off = wgid / NXCD; wgid = (xcd < r ? xcd * (q + 1) : r * (q + 1) + (xcd - r) * q) + off; }
        const int nig = WGM * nN, gid = wgid / nig, fm = gid * WGM, gsz = (nM - fm) < WGM ? (nM - fm) : WGM;
        u.pm = fm + ((wgid % nig) % gsz); u.pn = (wgid % nig) / gsz; return true;
    }
    __device__ __forceinline__ void a_ready(const Unit&) const {}
    __device__ __forceinline__ void done(const Unit&) const {}
};

__device__ __forceinline__ unsigned cvt_pk_bf16(float lo, float hi) { unsigned r; asm volatile("v_cvt_pk_bf16_f32 %0, %1, %2" : "=v"(r) : "v"(lo), "v"(hi)); return r; }
typedef float f32x2 __attribute__((ext_vector_type(2)));
__device__ __forceinline__ float row_rstd16(const float* ssq, int row) {
    const f32x4* p = (const f32x4*)(ssq + (size_t)row * 16);
    const f32x4 a = p[0], b = p[1], c = p[2], d = p[3];
    const float s = ((a[0] + a[1]) + (a[2] + a[3])) + ((b[0] + b[1]) + (b[2] + b[3])) + ((c[0] + c[1]) + (c[2] + c[3])) + ((d[0] + d[1]) + (d[2] + d[3]));
    return 1.0f / sqrtf(s * (1.0f / 1024.0f) + 1e-6f);
}
template <int ACT> struct EpiScaleBf16 {
    static constexpr bool PERM = true, AFTER_DRAIN = false;
    bf16_t* O; int ldc; const float* ssq;
    __device__ __forceinline__ void operator()(const f32x4 (&acc)[2][2][4][2], const Unit& u, int wr, int wc, int fr, int fq) const {
        const int row0 = u.pm * BM + wr * 64 + fr; const int col0 = u.pn * BM + wc * 32 + 8 * fq;
#pragma unroll
        for (int ai = 0; ai < 2; ++ai)
#pragma unroll
            for (int m = 0; m < 4; ++m) { const int row = row0 + ai * HALF + m * 16; const float sc = row_rstd16(ssq, row); bf16_t* rowp = O + (size_t)row * ldc + col0;
#pragma unroll
                for (int bj = 0; bj < 2; ++bj) { f32x4 v0 = acc[ai][bj][m][0] * sc, v1 = acc[ai][bj][m][1] * sc;
                    if (ACT == 2) {
#pragma unroll
                        for (int e = 0; e < 4; ++e) { const float a0 = v0[e] > 0.f ? v0[e] : 0.f, a1 = v1[e] > 0.f ? v1[e] : 0.f; v0[e] = a0 * a0; v1[e] = a1 * a1; } }
                    u32x4 w; w.x = cvt_pk_bf16(v0[0], v0[1]); w.y = cvt_pk_bf16(v0[2], v0[3]); w.z = cvt_pk_bf16(v1[0], v1[1]); w.w = cvt_pk_bf16(v1[2], v1[3]);
                    *(u32x4*)(rowp + bj * HALF) = w; } }
    }
};
struct EpiResid {
    static constexpr bool PERM = false, AFTER_DRAIN = false;
    const float* base; float* out; bf16_t* xb; float* ssq; int dry;
    __device__ __forceinline__ void operator()(const f32x4 (&acc)[2][2][4][2], const Unit& u, int wr, int wc, int fr, int fq) const {
        typedef unsigned u32x2v __attribute__((ext_vector_type(2)));
        const int row0 = u.pm * BM + wr * 64 + fr; const int col0 = u.pn * BM + wc * 32 + 4 * fq;
#pragma unroll
        for (int ai = 0; ai < 2; ++ai)
#pragma unroll
            for (int m = 0; m < 4; ++m) { const int row = row0 + ai * HALF + m * 16; const size_t off = (size_t)row * 1024 + col0; float s = 0.f;
#pragma unroll
                for (int bj = 0; bj < 2; ++bj)
#pragma unroll
                    for (int n = 0; n < 2; ++n) { const f32x4 bs = *(const f32x4*)(base + off + bj * HALF + n * 16); const f32x4 o = bs + acc[ai][bj][m][n];
                        if (!dry) *(f32x4*)(out + off + bj * HALF + n * 16) = o; s += (o[0] * o[0] + o[1] * o[1]) + (o[2] * o[2] + o[3] * o[3]);
                        u32x2v w; w.x = cvt_pk_bf16(o[0], o[1]); w.y = cvt_pk_bf16(o[2], o[3]); if (!dry) *(u32x2v*)(xb + off + bj * HALF + n * 16) = w; }
                s += __shfl_xor(s, 16); s += __shfl_xor(s, 32);
                if (fq == 0 && !dry) ssq[(size_t)row * 16 + u.pn * 4 + wc] = s; }
    }
};
template <class Epi, class Sched, bool ALIGN_EPI = false, bool SP2 = false>
__device__ __forceinline__ void gemm_phase(PG8_LAS unsigned char* lds, const Gemm g, const Sched& S, const Epi& E) {
    int tid_o = threadIdx.x; asm volatile("" : "+v"(tid_o));
    const int tid = tid_o, wid = __builtin_amdgcn_readfirstlane(tid >> 6), lane = tid & 63, wr = wid >> 2, wc = wid & 3, fr = lane & 15, fq = lane >> 4;
    const int K = g.K, nt = K / BK;
    unsigned voffA[2], voffB[2];
#pragma unroll
    for (int i = 0; i < 2; ++i) { int R, C; stage_rc(tid * 16 + i * 8192, R, C); const int Rb = Epi::PERM ? ((R & ~31) + perm32(R & 31)) : R;
        voffA[i] = (unsigned)(R * K + C) * 2u; voffB[i] = (unsigned)(Rb * K + C) * 2u; }
    const size_t kstep = (size_t)(BK * 2);
    const size_t hstep = (size_t)HALF * K * 2;
    const size_t tstep = 2 * hstep;
    const unsigned ldsw = (unsigned)wid * 1024u;
    const int aoff = lds_byte(wr * 64 + fr, fq * 8), boff = lds_byte(wc * 32 + fr, fq * 8);
#define PG8_SA(b, h) (((b) * 2 + (h)) * HTB)
#define PG8_SB(b, h) ((4 + (b) * 2 + (h)) * HTB)
#define PG8_STAGE(bufoff, gbase, voff) do { _Pragma("unroll") for (int _i = 0; _i < 2; ++_i) \
        __builtin_amdgcn_global_load_lds((const unsigned*)((const char*)(gbase) + (voff)[_i]), (PG8_LAS unsigned*)(lds + (bufoff) + ldsw + _i * 8192), 16, 0, 0); } while (0)
#define PG8_LDA(dst, b, h) do { _Pragma("unroll") for (int m = 0; m < 4; ++m) _Pragma("unroll") for (int k = 0; k < 2; ++k) dst[m][k] = *(const PG8_LAS bf16x8*)(lds + PG8_SA(b, h) + aoff + m * 2048 + k * 1024); } while (0)
#define PG8_LDB(dst, b, h) do { _Pragma("unroll") for (int n = 0; n < 2; ++n) _Pragma("unroll") for (int k = 0; k < 2; ++k) dst[n][k] = *(const PG8_LAS bf16x8*)(lds + PG8_SB(b, h) + boff + n * 2048 + k * 1024); } while (0)
#define PG8_MMA(ai, bj, At, Bt) do { __builtin_amdgcn_s_setprio(1); _Pragma("unroll") for (int m = 0; m < 4; ++m) _Pragma("unroll") for (int n = 0; n < 2; ++n) _Pragma("unroll") for (int k = 0; k < 2; ++k) \
        acc[ai][bj][m][n] = __builtin_amdgcn_mfma_f32_16x16x32_bf16(Bt[n][k], At[m][k], acc[ai][bj][m][n], 0, 0, 0); __builtin_amdgcn_s_setprio(0); } while (0)
#define PG8_WAIT_V(n) asm volatile("s_waitcnt vmcnt(" #n ")" ::: "memory")
#define PG8_WAIT_L(n) asm volatile("s_waitcnt lgkmcnt(" #n ")" ::: "memory")
#define PG8_BAR __builtin_amdgcn_s_barrier()
#define PG8_SCHED __builtin_amdgcn_sched_barrier(0)
    Unit cur, nxt; int ui = 0;
    if (!S.next(0, cur)) return;
    f32x4 acc[2][2][4][2];
#pragma unroll
    for (int a = 0; a < 2; ++a)
#pragma unroll
        for (int b = 0; b < 2; ++b)
#pragma unroll
            for (int m = 0; m < 4; ++m)
#pragma unroll
                for (int n = 0; n < 2; ++n) acc[a][b][m][n] = (f32x4){0.f, 0.f, 0.f, 0.f};
    bf16x8 At[4][2], B0[2][2], B1[2][2];
    const char* cA = (const char*)g.A + (size_t)cur.pm * tstep; const char* cB = (const char*)g.Bt + (size_t)cur.pn * tstep;
    S.a_ready(cur);
    if constexpr (SP2) {
        PG8_STAGE(PG8_SB(0, 0), cB, voffB); PG8_STAGE(PG8_SB(0, 1), cB + hstep, voffB); PG8_STAGE(PG8_SA(0, 0), cA, voffA); PG8_STAGE(PG8_SA(0, 1), cA + hstep, voffA);
        if (wr == 1) PG8_BAR;
        PG8_WAIT_V(2); PG8_BAR;
        PG8_STAGE(PG8_SB(1, 0), cB + kstep, voffB); PG8_STAGE(PG8_SA(1, 0), cA + kstep, voffA); PG8_STAGE(PG8_SB(1, 1), cB + hstep + kstep, voffB);
        PG8_WAIT_V(6); PG8_BAR;
    } else {
        PG8_STAGE(PG8_SB(0, 0), cB, voffB); PG8_STAGE(PG8_SA(0, 0), cA, voffA); PG8_STAGE(PG8_SB(0, 1), cB + hstep, voffB); PG8_STAGE(PG8_SA(0, 1), cA + hstep, voffA);
        if (wr == 1) PG8_BAR;
        PG8_WAIT_V(4); PG8_BAR;
        PG8_STAGE(PG8_SB(1, 0), cB + kstep, voffB); PG8_STAGE(PG8_SA(1, 0), cA + kstep, voffA); PG8_STAGE(PG8_SB(1, 1), cB + hstep + kstep, voffB);
        PG8_WAIT_V(6); PG8_BAR;
    }
    for (;;) {
        const bool has_next = S.next(ui + 1, nxt);
        const char* nA = has_next ? (const char*)g.A + (size_t)nxt.pm * tstep : cA; const char* nB = has_next ? (const char*)g.Bt + (size_t)nxt.pn * tstep : cB;
        for (int t = 0; t < nt; t += 2) {
            const bool last = (t == nt - 2);
            const char* a1 = cA + (size_t)(t + 1) * kstep;
            const char* a2 = last ? nA : cA + (size_t)(t + 2) * kstep; const char* b2 = last ? nB : cB + (size_t)(t + 2) * kstep;
            const char* a3 = a2 + kstep; const char* b3 = b2 + kstep;
            if (last && has_next) S.a_ready(nxt);
            if constexpr (SP2) {
            PG8_LDB(B0, 0, 0); PG8_LDB(B1, 0, 1); PG8_SCHED; PG8_LDA(At, 0, 0); PG8_STAGE(PG8_SA(1, 1), a1 + hstep, voffA);
            PG8_WAIT_V(8); PG8_WAIT_L(0); PG8_BAR; PG8_MMA(0, 0, At, B0); PG8_MMA(0, 1, At, B1); PG8_BAR; PG8_SCHED;
            PG8_LDA(At, 0, 1); PG8_STAGE(PG8_SB(0, 0), b2, voffB); PG8_STAGE(PG8_SB(0, 1), b2 + hstep, voffB); PG8_STAGE(PG8_SA(0, 0), a2, voffA);
            PG8_WAIT_V(8); PG8_WAIT_L(0); PG8_BAR; PG8_MMA(1, 0, At, B0); PG8_MMA(1, 1, At, B1); PG8_BAR; PG8_SCHED;
            PG8_LDB(B0, 1, 0); PG8_LDB(B1, 1, 1); PG8_SCHED; PG8_LDA(At, 1, 0); PG8_STAGE(PG8_SA(0, 1), a2 + hstep, voffA);
            PG8_WAIT_V(8); PG8_WAIT_L(0); PG8_BAR; PG8_MMA(0, 0, At, B0); PG8_MMA(0, 1, At, B1); PG8_BAR; PG8_SCHED;
            PG8_LDA(At, 1, 1); PG8_STAGE(PG8_SB(1, 0), b3, voffB); PG8_STAGE(PG8_SB(1, 1), b3 + hstep, voffB); PG8_STAGE(PG8_SA(1, 0), a3, voffA);
            PG8_WAIT_V(8); PG8_WAIT_L(0); PG8_BAR; PG8_MMA(1, 0, At, B0); PG8_MMA(1, 1, At, B1); PG8_BAR; PG8_SCHED;
            } else {
            PG8_LDB(B0, 0, 0); PG8_SCHED; PG8_LDA(At, 0, 0); PG8_STAGE(PG8_SA(1, 1), a1 + hstep, voffA);
            PG8_WAIT_L(8); PG8_BAR; PG8_WAIT_L(0); PG8_MMA(0, 0, At, B0); PG8_BAR; PG8_SCHED;
            PG8_LDB(B1, 0, 1); PG8_STAGE(PG8_SB(0, 0), b2, voffB);
            PG8_BAR; PG8_WAIT_L(0); PG8_MMA(0, 1, At, B1); PG8_BAR;
            PG8_LDA(At, 0, 1); PG8_STAGE(PG8_SA(0, 0), a2, voffA);
            PG8_BAR; PG8_WAIT_L(0); PG8_MMA(1, 0, At, B0); PG8_BAR; PG8_SCHED;
            PG8_STAGE(PG8_SB(0, 1), b2 + hstep, voffB);
            PG8_WAIT_V(6); PG8_BAR; PG8_MMA(1, 1, At, B1); PG8_BAR;
            PG8_LDB(B0, 1, 0); PG8_SCHED; PG8_LDA(At, 1, 0); PG8_STAGE(PG8_SA(0, 1), a2 + hstep, voffA);
            PG8_WAIT_L(8); PG8_BAR; PG8_WAIT_L(0); PG8_MMA(0, 0, At, B0); PG8_BAR; PG8_SCHED;
            PG8_LDB(B1, 1, 1); PG8_STAGE(PG8_SB(1, 0), b3, voffB);
            PG8_BAR; PG8_WAIT_L(0); PG8_MMA(0, 1, At, B1); PG8_BAR;
            PG8_LDA(At, 1, 1); PG8_STAGE(PG8_SA(1, 0), a3, voffA);
            PG8_BAR; PG8_WAIT_L(0); PG8_MMA(1, 0, At, B0); PG8_BAR; PG8_SCHED;
            PG8_STAGE(PG8_SB(1, 1), b3 + hstep, voffB);
            PG8_WAIT_V(6); PG8_BAR; PG8_MMA(1, 1, At, B1); PG8_BAR;
            }
        }
        if constexpr (ALIGN_EPI) { if (wr == 0) PG8_BAR; }
        if constexpr (!Epi::AFTER_DRAIN) { E(acc, cur, wr, wc, fr, fq); S.done(cur); }
        if (!has_next) break;
#pragma unroll
        for (int a = 0; a < 2; ++a)
#pragma unroll
            for (int b = 0; b < 2; ++b)
#pragma unroll
                for (int m = 0; m < 4; ++m)
#pragma unroll
                    for (int n = 0; n < 2; ++n) acc[a][b][m][n] = (f32x4){0.f, 0.f, 0.f, 0.f};
        cur = nxt; cA = nA; cB = nB; ++ui;
        if constexpr (ALIGN_EPI) { if (wr == 1) PG8_BAR; }
    }
    PG8_WAIT_V(0);
    if constexpr (!ALIGN_EPI) { if (wr == 0) PG8_BAR; }
    PG8_BAR;
    if constexpr (Epi::AFTER_DRAIN) { E.fused(acc, cur, wr, wc, fr, fq, lds, wid, lane); S.done(cur); }
#undef PG8_SA
#undef PG8_SB
#undef PG8_STAGE
#undef PG8_LDA
#undef PG8_LDB
#undef PG8_MMA
#undef PG8_WAIT_V
#undef PG8_WAIT_L
#undef PG8_BAR
#undef PG8_SCHED
}
}
constexpr int T = 16384, D = 1024, FF = 4096, DEPTH = 2;
constexpr int NIN = 3352, NPAD = 3584;
constexpr int C_RWKV = 0, C_GDN = 1024, C_GLA = 2056, C_SGU = 2840, C_VRES = 3352;
constexpr int NT = 512, NWAVES = 8;
constexpr int LDS_BYTES = 147456;
typedef unsigned short bf16;
typedef float f32x4 __attribute__((ext_vector_type(4)));
typedef unsigned v4u __attribute__((ext_vector_type(4)));
#define LAS __attribute__((address_space(3)))

constexpr size_t MiB = 1u << 20;
constexpr size_t WS_BAR = 0;
constexpr size_t WS_SSQ = 1 * MiB;
constexpr size_t WS_GAL = 2 * MiB;
constexpr size_t WS_XG = 2 * MiB + 256 * 1024;
constexpr size_t WS_W = 3 * MiB;
constexpr size_t W_LAYER = 0, W_IN = 0, W_OUT = 7 * MiB, W_UP = 9 * MiB, W_DN = 17 * MiB;
constexpr size_t WS_XB = 30 * MiB;
constexpr size_t WS_Y = 62 * MiB;
constexpr size_t WS_H = 94 * MiB;
constexpr size_t WS_COLS = 94 * MiB;
constexpr size_t WS_VF = 222 * MiB;
constexpr size_t WS_RP = 30 * MiB, WS_RQ = 38 * MiB, WS_RR = 46 * MiB, WS_RBV = 54 * MiB;
constexpr size_t WS_DP = 206 * MiB, WS_DQ = 214 * MiB, WS_DR = 230 * MiB;
constexpr size_t WS_GKV = 238 * MiB, WS_GQI = 246 * MiB;
constexpr size_t WS_LORA = 250 * MiB;
constexpr int LORA_W = 0, LORA_A = 256 * 64, LORA_G = 2 * 256 * 64, LORA_V = 2 * 256 * 64 + 256 * 128, LORA_LAYER = LORA_V + 256 * 32;
constexpr size_t WS_SN = 251 * MiB, WS_SQ = 252 * MiB, WS_SG = 253 * MiB, WS_GSB = 253 * MiB + 64 * 1024, WS_GSA = 254 * MiB;
constexpr size_t WS_END = 255 * MiB;

typedef float f32x2_t __attribute__((ext_vector_type(2))); typedef __bf16 bf16x2_t __attribute__((ext_vector_type(2)));
__device__ __forceinline__ unsigned pk2(float lo, float hi) { f32x2_t v = {lo, hi}; bf16x2_t b = __builtin_convertvector(v, bf16x2_t); return __builtin_bit_cast(unsigned, b); }
__device__ __forceinline__ unsigned f2bf(float f) { return pk2(f, f) & 0xffffu; }
__device__ __forceinline__ float bf2f(bf16 b) { return __builtin_bit_cast(float, (unsigned)b << 16); }
__device__ __forceinline__ float wave_sum(float v) {
    v += __builtin_bit_cast(float, __builtin_amdgcn_mov_dpp(__builtin_bit_cast(int, v), 0xB1, 0xF, 0xF, true));
    v += __builtin_bit_cast(float, __builtin_amdgcn_mov_dpp(__builtin_bit_cast(int, v), 0x4E, 0xF, 0xF, true));
    v += __builtin_bit_cast(float, __builtin_amdgcn_mov_dpp(__builtin_bit_cast(int, v), 0x141, 0xF, 0xF, true));
    v += __builtin_bit_cast(float, __builtin_amdgcn_mov_dpp(__builtin_bit_cast(int, v), 0x140, 0xF, 0xF, true));
    v += __shfl_xor(v, 16); v += __shfl_xor(v, 32);
    return v;
}
__device__ __forceinline__ float rcpf_(float x) { return __builtin_amdgcn_rcpf(x); }
__device__ __forceinline__ float rsqf_(float x) { return __builtin_amdgcn_rsqf(x); }
__device__ __forceinline__ float sigmoidf_(float x) { return rcpf_(1.0f + __expf(-x)); }
__device__ __forceinline__ float softplusf_(float x) { return fmaxf(x, 0.f) + __logf(1.0f + __expf(-fabsf(x))); }
__device__ __forceinline__ float siluf_(float x) { return x * sigmoidf_(x); }
__device__ __forceinline__ float tanhf_(float x) { return 1.0f - 2.0f * rcpf_(1.0f + __expf(2.0f * x)); }
__device__ __forceinline__ float geluf_(float x) { const float u = 0.7978845608028654f * (x + 0.044715f * x * x * x); return x * sigmoidf_(2.0f * u); }

struct Params { const float* in[33]; float* out; unsigned char* ws; };
enum { I_X = 0, I_WIN, I_WOUT, I_NMIX, I_NFFN, I_NFIN, I_MU, I_W0, I_WUP, I_A0, I_AUP, I_GUP, I_KK, I_KA, I_RK, I_LNW, I_LNB, I_V0, I_VDOWN, I_VUP,
       I_CONV, I_ALOG, I_DTB, I_GDNG, I_GKUP, I_GKB, I_GLAG, I_SLG, I_SLB, I_SWS, I_SBS, I_FUP, I_FDN };

__device__ __forceinline__ void transpose_item(const float* W, int K, int N, const float* gk, bf16* WT, int row_off, float* scr, int item, int lane) {
    const int nblk = (N + 31) / 32, kb = item / nblk, nb = item % nblk, k0 = 64 * kb, n0 = 32 * nb;
    const bool nok = (n0 + (lane & 31)) < N;
#pragma unroll 8
    for (int i = 0; i < 32; ++i) { const int kk = 2 * i + (lane >> 5); float v = 0.f; if (nok) v = W[(size_t)(k0 + kk) * N + n0 + (lane & 31)]; if (gk) v *= gk[k0 + kk]; scr[kk * 33 + (lane & 31)] = v; }
    __builtin_amdgcn_wave_barrier(); asm volatile("s_waitcnt lgkmcnt(0)" ::: "memory");
    const int c = lane & 7;
#pragma unroll
    for (int j = 0; j < 4; ++j) { const int n = (lane >> 3) + 8 * j; const float* s = scr + (8 * c) * 33 + n;
        v4u o; o.x = pk2(s[0 * 33], s[1 * 33]); o.y = pk2(s[2 * 33], s[3 * 33]); o.z = pk2(s[4 * 33], s[5 * 33]); o.w = pk2(s[6 * 33], s[7 * 33]);
        if (n0 + n < N) *(v4u*)(WT + (size_t)(row_off + n0 + n) * K + k0 + 8 * c) = o; }
    __builtin_amdgcn_wave_barrier(); asm volatile("s_waitcnt lgkmcnt(0)" ::: "memory");
}
__device__ __forceinline__ void prologue_weights(const Params& P, int l, int mask, float* lds, int gw, int NGW, int wave, int lane) {
    float* scr = lds + wave * 4096;
    unsigned char* wb = P.ws + WS_W;
    const int I_in = (mask & 1) ? (D / 64) * ((NIN + 31) / 32) : 0, I_vr = ((mask & 1) && l > 0) ? (D / 64) * 1 : 0, I_out = (mask & 2) ? (D / 64) * (D / 32) : 0, I_up = (mask & 4) ? (D / 64) * (FF / 32) : 0, I_dn = (mask & 8) ? (FF / 64) * (D / 32) : 0;
    const int NITEMS = I_in + I_vr + I_out + I_up + I_dn;
    for (int it = gw; it < NITEMS; it += NGW) {
        int r = it;
        if (r < I_in) { transpose_item(P.in[I_WIN] + (size_t)l * D * NIN, D, NIN, P.in[I_NMIX] + l * D, (bf16*)(wb + W_IN), 0, scr, r, lane); continue; } r -= I_in;
        if (r < I_vr) { transpose_item(P.in[I_VDOWN] + (size_t)(l - 1) * D * 32, D, 32, P.in[I_NMIX] + l * D, (bf16*)(wb + W_IN), NIN, scr, r, lane); continue; } r -= I_vr;
        if (r < I_out) { transpose_item(P.in[I_WOUT] + (size_t)l * D * D, D, D, nullptr, (bf16*)(wb + W_OUT), 0, scr, r, lane); continue; } r -= I_out;
        if (r < I_up) { transpose_item(P.in[I_FUP] + (size_t)l * D * FF, D, FF, P.in[I_NFFN] + l * D, (bf16*)(wb + W_UP), 0, scr, r, lane); continue; } r -= I_up;
        transpose_item(P.in[I_FDN] + (size_t)l * FF * D, FF, D, nullptr, (bf16*)(wb + W_DN), 0, scr, r, lane);
    }
}
__device__ __forceinline__ void prologue_lora(const Params& P, int gtid, int gsz) {
    bf16* dst = (bf16*)(P.ws + WS_LORA);
    for (int idx = gtid; idx < 2 * 288 * 256; idx += gsz) { const int l = idx / (288 * 256), r = idx % (288 * 256), j = r >> 8, c = r & 255; bf16* d = dst + (size_t)l * LORA_LAYER;
        if (j < 64) d[LORA_W + c * 64 + j] = (bf16)f2bf(P.in[I_WUP][((size_t)l * 64 + j) * 256 + c]);
        else if (j < 128) d[LORA_A + c * 64 + j - 64] = (bf16)f2bf(P.in[I_AUP][((size_t)l * 64 + j - 64) * 256 + c]);
        else if (j < 256) d[LORA_G + c * 128 + j - 128] = (bf16)f2bf(P.in[I_GUP][((size_t)l * 128 + j - 128) * 256 + c]);
        else if (l > 0) d[LORA_V + c * 32 + j - 256] = (bf16)f2bf(P.in[I_VUP][((size_t)(l - 1) * 32 + j - 256) * 256 + c]); }
}
__device__ __forceinline__ void prologue_rows(const Params& P, int gw, int NGW, int lane) {
    const float* x = P.in[I_X]; bf16* xb = (bf16*)(P.ws + WS_XB); float* ssq = (float*)(P.ws + WS_SSQ);
    for (int m0 = gw; m0 < T; m0 += 2 * NGW) { f32x4 v[2][4];
#pragma unroll
        for (int r = 0; r < 2; ++r) { const int m = m0 + r * NGW; const f32x4* xr = (const f32x4*)(x + (size_t)(m < T ? m : 0) * D) + lane;
#pragma unroll
            for (int j = 0; j < 4; ++j) v[r][j] = xr[64 * j]; }
#pragma unroll
        for (int r = 0; r < 2; ++r) { const int m = m0 + r * NGW; if (m >= T) break; float s = 0.f;
#pragma unroll
            for (int j = 0; j < 4; ++j) s += (v[r][j][0] * v[r][j][0] + v[r][j][1] * v[r][j][1]) + (v[r][j][2] * v[r][j][2] + v[r][j][3] * v[r][j][3]);
            s = wave_sum(s);
            unsigned long long* o8 = (unsigned long long*)(xb + (size_t)m * D) + lane;
#pragma unroll
            for (int j = 0; j < 4; ++j) o8[64 * j] = (unsigned long long)pk2(v[r][j][0], v[r][j][1]) | ((unsigned long long)pk2(v[r][j][2], v[r][j][3]) << 32);
            if (lane < 16) ssq[(size_t)m * 16 + lane] = (lane == 0) ? s : 0.f; } }
}
__device__ __forceinline__ void final_norm(const Params& P, int gw, int NGW, int lane, int dry = 0) {
    float* x = P.out; const float* ssq = (const float*)(P.ws + WS_SSQ); const f32x4* g4 = (const f32x4*)P.in[I_NFIN] + lane;
    f32x4 g[4];
#pragma unroll
    for (int j = 0; j < 4; ++j) g[j] = g4[64 * j];
    for (int m0 = gw; m0 < T; m0 += 2 * NGW) { f32x4 v[2][4]; float rs[2];
#pragma unroll
        for (int r = 0; r < 2; ++r) { const int m = m0 + r * NGW, mc = m < T ? m : 0; const f32x4* xr = (const f32x4*)(x + (size_t)mc * D) + lane; rs[r] = pg8::row_rstd16(ssq, mc);
#pragma unroll
            for (int j = 0; j < 4; ++j) v[r][j] = xr[64 * j]; }
#pragma unroll
        for (int r = 0; r < 2; ++r) { const int m = m0 + r * NGW; if (m >= T) break; f32x4* xr = (f32x4*)(x + (size_t)m * D) + lane;
#pragma unroll
            for (int j = 0; j < 4; ++j) { const f32x4 o = v[r][j] * rs[r] * g[j]; if (!dry) xr[64 * j] = o; } } }
}
typedef __attribute__((address_space(1))) unsigned gu32;
#define XB_TMO      128
#define XB_XCNT(j)  (256  + 64 * (j))
#define XB_XSUB(j)  (1280 + 64 * (j))
#define XB_XGEN(j)  (2304 + 64 * (j))
#define XB_TOP      3328
#define XB_TOPGEN   3392
#define XCD_BAR_WORDS 3456
#define XB_SPIN_CAP (1u << 18)

__device__ __forceinline__ unsigned xb_ld(unsigned* p)              { return __hip_atomic_load(p, __ATOMIC_RELAXED, __HIP_MEMORY_SCOPE_AGENT); }
__device__ __forceinline__ unsigned xb_add(unsigned* p, unsigned v) { return __hip_atomic_fetch_add(p, v, __ATOMIC_RELAXED, __HIP_MEMORY_SCOPE_AGENT); }
__device__ __forceinline__ unsigned xb_xcc_id() { return (unsigned)__builtin_amdgcn_s_getreg((3 << 11) | 20) & 0xFu; }
#define XB_SPIN(cond, bar) do { unsigned _sp = 0; while (cond) { __builtin_amdgcn_s_sleep(1); \
    if ((++_sp & 255u) == 0u) { if (xb_ld(&(bar)[XB_TMO])) break; if (_sp > XB_SPIN_CAP) { atomicAdd(&(bar)[XB_TMO], 1u); break; } } } } while (0)

struct XcdBarrier {
    unsigned* bar; unsigned x;
    volatile LAS unsigned* st;
};

__device__ __forceinline__ XcdBarrier xcd_barrier_post(unsigned* bar, volatile LAS unsigned* st) {
    XcdBarrier b; b.bar = bar; b.x = xb_xcc_id(); b.st = st;
    if (threadIdx.x == 0) (void)xb_add(&bar[XB_XCNT(b.x)], 1u);
    return b;
}
__device__ __forceinline__ void xcd_barrier_complete(unsigned* bar, unsigned x, unsigned& nloc, unsigned& nx) {
    const unsigned G = gridDim.x * gridDim.y * gridDim.z;
    unsigned sum, cnt, mine, sp = 0u;
    for (;;) {
        sum = 0u; cnt = 0u; mine = 0u;
#pragma unroll
        for (unsigned j = 0; j < 16; ++j) { const unsigned c = xb_ld(&bar[XB_XCNT(j)]); sum += c; cnt += (c > 0u) ? 1u : 0u; mine = (j == x) ? c : mine; }
        if (sum == G) break;
        __builtin_amdgcn_s_sleep(1);
        if ((++sp & 255u) == 0u) { if (xb_ld(&bar[XB_TMO])) break; if (sp > XB_SPIN_CAP) { atomicAdd(&bar[XB_TMO], 1u); break; } }
    }
    nloc = mine > 0u ? mine : 1u; nx = cnt > 0u ? cnt : 1u;
}

__device__ __forceinline__ void xcd_barrier(const XcdBarrier& b) {
    asm volatile("s_waitcnt vmcnt(0)" ::: "memory");
    __syncthreads();
    if (threadIdx.x == 0) {
        unsigned* bar = b.bar;
        __builtin_amdgcn_s_waitcnt(0);
        unsigned nloc = b.st[0], nx = b.st[1];
        if (nloc == 0u) { xcd_barrier_complete(bar, b.x, nloc, nx); b.st[0] = nloc; b.st[1] = nx; }
        const unsigned old = xb_add(&bar[XB_XSUB(b.x)], 1u);
        const unsigned gen = old / nloc;
        if (old + 1u == (gen + 1u) * nloc) {
            __builtin_amdgcn_fence(__ATOMIC_RELEASE, "agent");
            asm volatile("s_waitcnt vmcnt(0)" ::: "memory");
            const unsigned og = xb_add(&bar[XB_TOP], 1u);
            const unsigned tg = og / nx;
            if (og + 1u == (tg + 1u) * nx) xb_add(&bar[XB_TOPGEN], 1u);
            else XB_SPIN(xb_ld(&bar[XB_TOPGEN]) == tg, bar);
            __builtin_amdgcn_fence(__ATOMIC_ACQUIRE, "agent");
            xb_add(&bar[XB_XGEN(b.x)], 1u);
            asm volatile("s_waitcnt vmcnt(0)" ::: "memory");
        } else {
            XB_SPIN(xb_ld(&bar[XB_XGEN(b.x)]) == gen, bar);
            __builtin_amdgcn_fence(__ATOMIC_ACQUIRE, "agent");
            asm volatile("s_waitcnt vmcnt(0)" ::: "memory");
        }
    }
    __syncthreads();
}
__device__ __forceinline__ float ldcol(const bf16* cols, int t, int c) { return bf2f(cols[(size_t)t * NPAD + c]); }

__device__ __forceinline__ void rwkv_head_v1(const Params& P, int l, int h, float* lds, int tid) {
    const bf16* cols = (const bf16*)(P.ws + WS_COLS); bf16* Y = (bf16*)(P.ws + WS_Y); bf16* VF = (bf16*)(P.ws + WS_VF);
    float* sR = lds; float* sK = sR + 4096; float* sV = sK + 4096; float* sX = sV + 4096;
    float* sW = sX; float* sA = sX + 4096; float* sB = sX + 8192; float* sG = sX + 12288;
    float* sY = sX + 16384; float* sS = sY + 4096; float* sVr = sS + 64;
    const float* mu = P.in[I_MU] + l * 1024;
    const float* w_up = P.in[I_WUP] + (size_t)l * 64 * 256; const float* a_up = P.in[I_AUP] + (size_t)l * 64 * 256; const float* g_up = P.in[I_GUP] + (size_t)l * 128 * 256;
    const float* vr_up = P.in[I_VUP];
    const int lane = tid & 63, wv = tid >> 6, cc = h * 64 + lane;
    const float w0c = P.in[I_W0][l * 256 + cc], a0c = P.in[I_A0][l * 256 + cc], kkc = P.in[I_KK][l * 256 + cc], kac = P.in[I_KA][l * 256 + cc];
    const float rkc = P.in[I_RK][l * 256 + cc], lnw = P.in[I_LNW][l * 256 + cc], lnb = P.in[I_LNB][l * 256 + cc];
    const float v0c = (l > 0) ? P.in[I_V0][(l - 1) * 256 + cc] : 0.f;
    float S[64];
#pragma unroll
    for (int k = 0; k < 64; ++k) S[k] = 0.f;
    for (int ci = 0; ci < T / 64; ++ci) {
        const int t0 = ci * 64;
#pragma unroll 1
        for (int idx = tid; idx < 3 * 4096; idx += NT) { const int a = idx >> 12, t = (idx >> 6) & 63, c = idx & 63, col = a * 256 + h * 64 + c, tt = t0 + t;
            const float cur = ldcol(cols, tt, col), prv = (tt > 0) ? ldcol(cols, tt - 1, col) : 0.f; const float xs = cur + (prv - cur) * mu[col];
            (a == 0 ? sR : (a == 1 ? sK : sV))[t * 64 + c] = xs; }
#pragma unroll 1
        for (int idx = tid; idx < 64 * 256; idx += NT) { const int t = idx >> 8, j = idx & 255, col = 768 + j, tt = t0 + t;
            const float cur = ldcol(cols, tt, col), prv = (tt > 0) ? ldcol(cols, tt - 1, col) : 0.f; float xs = cur + (prv - cur) * mu[col];
            if (j < 64) xs = tanhf(xs); else if (j >= 128) xs = sigmoidf_(xs);
            sX[t * 256 + j] = xs; }
        if (l > 0)
#pragma unroll 1
        for (int idx = tid; idx < 64 * 32; idx += NT) { const int t = idx >> 5, j = idx & 31; sVr[idx] = ldcol(cols, t0 + t, C_VRES + j); }
        __syncthreads();
        float o_decay[8], o_asig[8], o_g[8], o_vmix[8];
#pragma unroll
        for (int hp = 0; hp < 2; ++hp) {
            float accw[4], acca[4], accg[4], accv[4];
#pragma unroll
            for (int i = 0; i < 4; ++i) { accw[i] = 0.f; acca[i] = 0.f; accg[i] = 0.f; accv[i] = 0.f; }
            const float* xb = sX + (wv * 8 + hp * 4) * 256;
#pragma unroll 2
            for (int j = 0; j < 64; ++j) { const float wvv = w_up[j * 256 + cc], avv = a_up[j * 256 + cc];
#pragma unroll
                for (int i = 0; i < 4; ++i) { accw[i] += xb[i * 256 + j] * wvv; acca[i] += xb[i * 256 + 64 + j] * avv; } }
#pragma unroll 2
            for (int j = 0; j < 128; ++j) { const float gvv = g_up[j * 256 + cc];
#pragma unroll
                for (int i = 0; i < 4; ++i) accg[i] += xb[i * 256 + 128 + j] * gvv; }
            if (l > 0) {
#pragma unroll 2
                for (int j = 0; j < 32; ++j) { const float vv = vr_up[j * 256 + cc];
#pragma unroll
                    for (int i = 0; i < 4; ++i) accv[i] += sVr[(wv * 8 + hp * 4 + i) * 32 + j] * vv; } }
#pragma unroll
            for (int i = 0; i < 4; ++i) { const float wpre = w0c + accw[i]; const float wlog = -softplusf_(-wpre) - 0.5f; o_decay[hp * 4 + i] = __expf(-__expf(wlog));
                o_asig[hp * 4 + i] = sigmoidf_(a0c + acca[i]); o_g[hp * 4 + i] = accg[i]; o_vmix[hp * 4 + i] = sigmoidf_(v0c + accv[i]); }
        }
        __syncthreads();
#pragma unroll
        for (int i = 0; i < 8; ++i) { const int t = wv * 8 + i, tt = t0 + t;
            const float r = sR[t * 64 + lane], k = sK[t * 64 + lane]; float v = sV[t * 64 + lane];
            const float asig = o_asig[i];
            if (l == 0) VF[(size_t)tt * 256 + cc] = (bf16)f2bf(v);
            else { const float vf = bf2f(VF[(size_t)tt * 256 + cc]); v = v + (vf - v) * o_vmix[i]; }
            const float kkr = k * kkc; const float ss = wave_sum(kkr * kkr); const float kk = kkr * (1.0f / sqrtf(ss + 1e-24f));
            const float kmod = k * (1.0f + (asig - 1.0f) * kac);
            const float bon = wave_sum(r * kmod * rkc);
            sW[t * 64 + lane] = o_decay[i]; sA[t * 64 + lane] = -kk; sB[t * 64 + lane] = kk * asig; sG[t * 64 + lane] = o_g[i]; sK[t * 64 + lane] = kmod; sV[t * 64 + lane] = v;
            if (lane == 0) sS[t] = bon; }
        __syncthreads();
        if (wv == 0) {
            for (int t = 0; t < 64; ++t) {
                const float vt = sV[t * 64 + lane];
                const f32x4* a4 = (const f32x4*)(sA + t * 64); const f32x4* w4 = (const f32x4*)(sW + t * 64); const f32x4* b4 = (const f32x4*)(sB + t * 64);
                const f32x4* k4 = (const f32x4*)(sK + t * 64); const f32x4* r4 = (const f32x4*)(sR + t * 64);
                float s0 = 0.f, s1 = 0.f, s2 = 0.f, s3 = 0.f;
#pragma unroll
                for (int q = 0; q < 16; ++q) { const f32x4 a = a4[q]; s0 += S[4 * q] * a[0]; s1 += S[4 * q + 1] * a[1]; s2 += S[4 * q + 2] * a[2]; s3 += S[4 * q + 3] * a[3]; }
                const float sa = (s0 + s1) + (s2 + s3);
                float y0 = 0.f, y1 = 0.f, y2 = 0.f, y3 = 0.f;
#pragma unroll
                for (int q = 0; q < 16; ++q) { const f32x4 w = w4[q], b = b4[q], kq = k4[q], rq = r4[q];
#pragma unroll
                    for (int e = 0; e < 4; ++e) S[4 * q + e] = S[4 * q + e] * w[e] + sa * b[e] + vt * kq[e];
                    y0 += S[4 * q] * rq[0]; y1 += S[4 * q + 1] * rq[1]; y2 += S[4 * q + 2] * rq[2]; y3 += S[4 * q + 3] * rq[3]; }
                sY[t * 64 + lane] = (y0 + y1) + (y2 + y3);
            }
        }
        __syncthreads();
#pragma unroll
        for (int i = 0; i < 8; ++i) { const int t = wv * 8 + i, tt = t0 + t;
            const float y = sY[t * 64 + lane]; const float mean = wave_sum(y) * (1.0f / 64.0f); const float d = y - mean; const float var = wave_sum(d * d) * (1.0f / 64.0f);
            float yn = d * (1.0f / sqrtf(var + 64e-5f)) * lnw + lnb; yn += sS[t] * sV[t * 64 + lane];
            Y[(size_t)tt * 1024 + cc] = (bf16)f2bf(yn * sG[t * 64 + lane]); }
        __syncthreads();
    }
}

__device__ __forceinline__ void gdn_head_v1(const Params& P, int l, int h, float* lds, int tid) {
    const bf16* cols = (const bf16*)(P.ws + WS_COLS); bf16* Y = (bf16*)(P.ws + WS_Y);
    float* sQ = lds; float* sK = sQ + 4096; float* sV = sK + 4096; float* sO = sV + 4096; float* sBeta = sO + 4096; float* sAl = sBeta + 64;
    const float* cw = P.in[I_CONV] + (size_t)l * 4 * 768;
    const int lane = tid & 63, wv = tid >> 6;
    const float alog = P.in[I_ALOG][l * 4 + h], dtb = P.in[I_DTB][l * 4 + h], ng = P.in[I_GDNG][l * 64 + lane];
    float S[64];
#pragma unroll
    for (int k = 0; k < 64; ++k) S[k] = 0.f;
    for (int ci = 0; ci < T / 64; ++ci) {
        const int t0 = ci * 64;
#pragma unroll 1
        for (int idx = tid; idx < 3 * 4096; idx += NT) { const int a = idx >> 12, t = (idx >> 6) & 63, c = idx & 63, ch = a * 256 + h * 64 + c, tt = t0 + t; float acc = 0.f;
#pragma unroll
            for (int i = 0; i < 4; ++i) { const int ts = tt - 3 + i; if (ts >= 0) acc += cw[i * 768 + ch] * ldcol(cols, ts, C_GDN + ch); }
            (a == 0 ? sQ : (a == 1 ? sK : sV))[t * 64 + c] = siluf_(acc); }
        if (tid < 64) { const int tt = t0 + tid; const float braw = ldcol(cols, tt, C_GDN + 1024 + h), araw = ldcol(cols, tt, C_GDN + 1028 + h);
            sBeta[tid] = sigmoidf_(braw); sAl[tid] = __expf(-__expf(alog) * softplusf_(araw + dtb)); }
        __syncthreads();
#pragma unroll
        for (int i = 0; i < 8; ++i) { const int t = wv * 8 + i; const float q = sQ[t * 64 + lane], k = sK[t * 64 + lane];
            const float sq = wave_sum(q * q), sk = wave_sum(k * k);
            sQ[t * 64 + lane] = q * (1.0f / sqrtf(sq + 1e-6f)) * 0.125f; sK[t * 64 + lane] = k * (1.0f / sqrtf(sk + 1e-6f)); }
        __syncthreads();
        if (wv == 0) {
            for (int t = 0; t < 64; ++t) {
                const float vt = sV[t * 64 + lane], beta = sBeta[t], al = sAl[t];
                const f32x4* k4 = (const f32x4*)(sK + t * 64); const f32x4* q4 = (const f32x4*)(sQ + t * 64);
                float s0 = 0.f, s1 = 0.f, s2 = 0.f, s3 = 0.f;
#pragma unroll
                for (int q = 0; q < 16; ++q) { const f32x4 kq = k4[q]; s0 += S[4 * q] * kq[0]; s1 += S[4 * q + 1] * kq[1]; s2 += S[4 * q + 2] * kq[2]; s3 += S[4 * q + 3] * kq[3]; }
                const float kS = al * ((s0 + s1) + (s2 + s3)); const float vn = beta * (vt - kS);
                float y0 = 0.f, y1 = 0.f, y2 = 0.f, y3 = 0.f;
#pragma unroll
                for (int q = 0; q < 16; ++q) { const f32x4 kq = k4[q], qq = q4[q];
#pragma unroll
                    for (int e = 0; e < 4; ++e) S[4 * q + e] = al * S[4 * q + e] + kq[e] * vn;
                    y0 += S[4 * q] * qq[0]; y1 += S[4 * q + 1] * qq[1]; y2 += S[4 * q + 2] * qq[2]; y3 += S[4 * q + 3] * qq[3]; }
                sO[t * 64 + lane] = (y0 + y1) + (y2 + y3);
            }
        }
        __syncthreads();
#pragma unroll
        for (int i = 0; i < 8; ++i) { const int t = wv * 8 + i, tt = t0 + t; const float o = sO[t * 64 + lane]; const float ms = wave_sum(o * o) * (1.0f / 64.0f);
            const float z = ldcol(cols, tt, C_GDN + 768 + h * 64 + lane);
            Y[(size_t)tt * 1024 + 256 + h * 64 + lane] = (bf16)f2bf(o * (1.0f / sqrtf(ms + 1e-6f)) * ng * siluf_(z)); }
        __syncthreads();
    }
}

__device__ __forceinline__ void gla_head_v1(const Params& P, int l, int h, float* lds, int tid) {
    const bf16* cols = (const bf16*)(P.ws + WS_COLS); bf16* Y = (bf16*)(P.ws + WS_Y);
    float* sQ = lds; float* sK = sQ + 2048; float* sAl = sK + 2048; float* sV = sAl + 2048; float* sO = sV + 4096; float* sGd = sO + 4096;
    const float* gk_up = P.in[I_GKUP] + (size_t)l * 16 * 128; const float* gk_b = P.in[I_GKB] + l * 128;
    const int lane = tid & 63, wv = tid >> 6; const float ng = P.in[I_GLAG][l * 64 + lane];
    float S[32];
#pragma unroll
    for (int k = 0; k < 32; ++k) S[k] = 0.f;
    for (int ci = 0; ci < T / 64; ++ci) {
        const int t0 = ci * 64;
#pragma unroll 1
        for (int idx = tid; idx < 64 * 32; idx += NT) { const int t = idx >> 5, j = idx & 31; sQ[idx] = ldcol(cols, t0 + t, C_GLA + h * 32 + j) * 0.17677669529663687f; sK[idx] = ldcol(cols, t0 + t, C_GLA + 128 + h * 32 + j); }
#pragma unroll 1
        for (int idx = tid; idx < 64 * 64; idx += NT) { const int t = idx >> 6, c = idx & 63; sV[idx] = ldcol(cols, t0 + t, C_GLA + 256 + h * 64 + c); }
#pragma unroll 1
        for (int idx = tid; idx < 64 * 16; idx += NT) { const int t = idx >> 4, i = idx & 15; sGd[idx] = ldcol(cols, t0 + t, C_GLA + 768 + i); }
        __syncthreads();
#pragma unroll 1
        for (int idx = tid; idx < 64 * 32; idx += NT) { const int t = idx >> 5, j = idx & 31; float a = gk_b[h * 32 + j];
#pragma unroll
            for (int i = 0; i < 16; ++i) a += sGd[t * 16 + i] * gk_up[i * 128 + h * 32 + j];
            sAl[idx] = __expf(-softplusf_(-a) * (1.0f / 16.0f)); }
        __syncthreads();
        if (wv == 0) {
            for (int t = 0; t < 64; ++t) {
                const float vt = sV[t * 64 + lane];
                const f32x4* a4 = (const f32x4*)(sAl + t * 32); const f32x4* k4 = (const f32x4*)(sK + t * 32); const f32x4* q4 = (const f32x4*)(sQ + t * 32);
                float y0 = 0.f, y1 = 0.f, y2 = 0.f, y3 = 0.f;
#pragma unroll
                for (int q = 0; q < 8; ++q) { const f32x4 a = a4[q], kq = k4[q], qq = q4[q];
#pragma unroll
                    for (int e = 0; e < 4; ++e) S[4 * q + e] = a[e] * S[4 * q + e] + kq[e] * vt;
                    y0 += S[4 * q] * qq[0]; y1 += S[4 * q + 1] * qq[1]; y2 += S[4 * q + 2] * qq[2]; y3 += S[4 * q + 3] * qq[3]; }
                sO[t * 64 + lane] = (y0 + y1) + (y2 + y3);
            }
        }
        __syncthreads();
#pragma unroll
        for (int i = 0; i < 8; ++i) { const int t = wv * 8 + i, tt = t0 + t; const float o = sO[t * 64 + lane]; const float ms = wave_sum(o * o) * (1.0f / 64.0f);
            const float gt = ldcol(cols, tt, C_GLA + 512 + h * 64 + lane);
            Y[(size_t)tt * 1024 + 512 + h * 64 + lane] = (bf16)f2bf(o * (1.0f / sqrtf(ms + 1e-6f)) * ng * siluf_(gt)); }
        __syncthreads();
    }
}

__device__ __forceinline__ void sgu_unit_v1(const Params& P, int l, int n, float* lds, int tid) {
    const bf16* cols = (const bf16*)(P.ws + WS_COLS); bf16* Y = (bf16*)(P.ws + WS_Y);
    float* sVl = lds;
    const int lane = tid & 63, wv = tid >> 6, t0 = n * 128;
    const float* lg = P.in[I_SLG] + l * 256; const float* lb = P.in[I_SLB] + l * 256;
    const float* ws_ = P.in[I_SWS] + (size_t)l * 4 * 128 * 128; const float* bs_ = P.in[I_SBS] + l * 4 * 128;
    for (int i = 0; i < 16; ++i) { const int t = wv * 16 + i; float v[4]; float s = 0.f;
#pragma unroll
        for (int e = 0; e < 4; ++e) { v[e] = geluf_(ldcol(cols, t0 + t, C_SGU + 256 + lane * 4 + e)); s += v[e]; }
        const float mean = wave_sum(s) * (1.0f / 256.0f); float q = 0.f;
#pragma unroll
        for (int e = 0; e < 4; ++e) { v[e] -= mean; q += v[e] * v[e]; }
        const float rstd = 1.0f / sqrtf(wave_sum(q) * (1.0f / 256.0f) + 1e-5f);
#pragma unroll
        for (int e = 0; e < 4; ++e) sVl[t * 256 + lane * 4 + e] = v[e] * rstd * lg[lane * 4 + e] + lb[lane * 4 + e]; }
    __syncthreads();
    const int g = lane >> 4;
    for (int i = 0; i < 16; ++i) { const int t = wv + 8 * i; const float* wr = ws_ + ((size_t)g * 128 + t) * 128; f32x4 acc = {0.f, 0.f, 0.f, 0.f};
        for (int s = 0; s <= t; ++s) { const float w = wr[s]; const f32x4 vv = *(const f32x4*)(sVl + s * 256 + lane * 4); acc += vv * w; }
        const float b = bs_[g * 128 + t];
#pragma unroll
        for (int e = 0; e < 4; ++e) { const float u = geluf_(ldcol(cols, t0 + t, C_SGU + lane * 4 + e)); Y[(size_t)(t0 + t) * 1024 + 768 + lane * 4 + e] = (bf16)f2bf(u * (acc[e] + b)); } }
    __syncthreads();
}
#define LDS_SYNC() do { asm volatile("s_waitcnt lgkmcnt(0)" ::: "memory"); __builtin_amdgcn_s_barrier(); asm volatile("" ::: "memory"); } while (0)
typedef short bf16x8 __attribute__((ext_vector_type(8)));
typedef float f32x16 __attribute__((ext_vector_type(16)));
typedef unsigned u32x2 __attribute__((ext_vector_type(2)));
constexpr int TS = 72;
constexpr int TILE_B = 64 * TS * 2;
template <int KT> __device__ __forceinline__ void mm_tile(f32x16& acc, const LAS bf16* Arows, const LAS bf16* Bcols, int lane) {
    const int off = (lane & 31) * TS + (lane >> 5) * 8;
#pragma unroll
    for (int kk = 0; kk < KT; ++kk) {
        const bf16x8 a = *(const LAS bf16x8*)(Arows + off + kk * 16);
        const bf16x8 b = *(const LAS bf16x8*)(Bcols + off + kk * 16);
        acc = __builtin_amdgcn_mfma_f32_32x32x16_bf16(a, b, acc, 0, 0, 0);
    }
}
template <int KT> __device__ __forceinline__ void mm_tile_gb(f32x16& acc, const LAS bf16* Arows, int lda, const bf16* Bg, int ldb, int lane) {
    const int r = lane & 31, hh = lane >> 5;
#pragma unroll
    for (int kk = 0; kk < KT; ++kk) {
        const bf16x8 a = *(const LAS bf16x8*)(Arows + r * lda + hh * 8 + kk * 16);
        const bf16x8 b = *(const bf16x8*)(Bg + r * ldb + hh * 8 + kk * 16);
        acc = __builtin_amdgcn_mfma_f32_32x32x16_bf16(a, b, acc, 0, 0, 0);
    }
}
__device__ __forceinline__ int acc_i(int r, int hh) { return (r & 3) + 8 * (r >> 2) + 4 * hh; }
__device__ __forceinline__ void store_lane_major(LAS bf16* Z, int j0, int i0, const f32x16& acc, int lane) {
    const int c = lane & 31, hh = lane >> 5;
    LAS bf16* p = Z + (j0 + c) * TS + i0 + 4 * hh;
#pragma unroll
    for (int q = 0; q < 4; ++q) { uint2 w; w.x = pk2(acc[4 * q], acc[4 * q + 1]); w.y = pk2(acc[4 * q + 2], acc[4 * q + 3]); *(LAS u32x2*)(p + 8 * q) = (u32x2){w.x, w.y}; }
}
__device__ __forceinline__ void store_reg_major(LAS bf16* Z, int i0, int j0, const f32x16& acc, int lane) {
    const int c = lane & 31, hh = lane >> 5;
#pragma unroll
    for (int r = 0; r < 16; ++r) Z[(i0 + acc_i(r, hh)) * TS + j0 + c] = (bf16)f2bf(acc[r]);
}
__device__ __forceinline__ f32x16 zero16() { f32x16 z;
#pragma unroll
    for (int r = 0; r < 16; ++r) z[r] = 0.f; return z; }
__device__ __forceinline__ void gla_m1(const Params& P, int l, int ci, LAS unsigned char* lds, int tid) {
    const bf16* cols = (const bf16*)(P.ws + WS_COLS); bf16* Y = (bf16*)(P.ws + WS_Y);
    float* GKV = (float*)(P.ws + WS_GKV); float* GAL = (float*)(P.ws + WS_GAL); bf16* GQI = (bf16*)(P.ws + WS_GQI);
    LAS float* fLa = (LAS float*)lds; LAS float* fGd = fLa + 64 * 128; LAS unsigned char* tb0 = lds + 32768 + 4096;
    const float* gk_up = P.in[I_GKUP] + (size_t)l * 16 * 128; const float* gk_b = P.in[I_GKB] + l * 128;
    const int lane = tid & 63, wv = __builtin_amdgcn_readfirstlane(tid >> 6), t0 = ci * 64;
#pragma unroll
    for (int idx = tid; idx < 64 * 16; idx += NT) fGd[idx] = ldcol(cols, t0 + (idx >> 4), C_GLA + 768 + (idx & 15));
    LDS_SYNC();
#pragma unroll 4
    for (int idx = tid; idx < 64 * 128; idx += NT) { const int t = idx >> 7, j = idx & 127; float a = gk_b[j];
#pragma unroll
        for (int i = 0; i < 16; ++i) a += fGd[t * 16 + i] * gk_up[i * 128 + j];
        fLa[idx] = -softplusf_(-a) * (1.0f / 16.0f); }
    LDS_SYNC();
    if (tid < 128) { float run = 0.f;
#pragma unroll 8
        for (int t = 0; t < 64; ++t) { run += fLa[t * 128 + tid]; fLa[t * 128 + tid] = run; }
        GAL[ci * 128 + tid] = __expf(run); }
    LDS_SYNC();
#pragma unroll 1
    for (int hp = 0; hp < 2; ++hp) {
#pragma unroll 4
        for (int idx = tid; idx < 2 * 64 * 32; idx += NT) { const int s = idx >> 11, t = (idx >> 5) & 63, j = idx & 31, h = 2 * hp + s;
            LAS bf16* tQ = (LAS bf16*)(tb0 + s * 5 * TILE_B); LAS bf16* tK = tQ + 64 * TS; LAS bf16* tKs = tK + 64 * TS;
            const float b = fLa[t * 128 + h * 32 + j], b63 = fLa[63 * 128 + h * 32 + j];
            const float q = ldcol(cols, t0 + t, C_GLA + h * 32 + j) * 0.17677669529663687f, k = ldcol(cols, t0 + t, C_GLA + 128 + h * 32 + j);
            const bf16 qt = (bf16)f2bf(q * __expf(b));
            tQ[t * TS + j] = qt; tK[t * TS + j] = (bf16)f2bf(k * __expf(-b)); tKs[j * TS + t] = (bf16)f2bf(k * __expf(b63 - b));
            GQI[(((size_t)ci * 4 + h) * 64 + t) * 32 + j] = qt; }
#pragma unroll 8
        for (int idx = tid; idx < 2 * 64 * 64; idx += NT) { const int s = idx >> 12, t = (idx >> 6) & 63, v = idx & 63, h = 2 * hp + s;
            LAS bf16* tV = (LAS bf16*)(tb0 + s * 5 * TILE_B + 3 * TILE_B);
            tV[v * TS + t] = cols[(size_t)(t0 + t) * NPAD + C_GLA + 256 + h * 64 + v]; }
        LDS_SYNC();
        for (int jb = wv; jb < 12; jb += 8) { const int s = jb / 6, r = jb % 6, h = 2 * hp + s;
            LAS bf16* tQ = (LAS bf16*)(tb0 + s * 5 * TILE_B); LAS bf16* tK = tQ + 64 * TS; LAS bf16* tKs = tK + 64 * TS; LAS bf16* tV = tKs + 64 * TS; LAS bf16* tSc = tV + 64 * TS;
            f32x16 acc = zero16(); const int c = lane & 31, hh = lane >> 5;
            if (r < 4) { const int tb = (r == 0 || r == 3) ? 0 : 1, sb = (r == 0 || r == 1) ? 0 : 1;
                if (r < 3) { mm_tile<2>(acc, tK + sb * 32 * TS, tQ + tb * 32 * TS, lane);
#pragma unroll
                    for (int q = 0; q < 16; ++q) { const int sI = 32 * sb + acc_i(q, hh), tI = 32 * tb + c; if (sI > tI) acc[q] = 0.f; } }
                store_lane_major(tSc, 32 * tb, 32 * sb, acc, lane);
            } else { const int vb = r - 4; mm_tile<4>(acc, tKs, tV + vb * 32 * TS, lane);
                float* g = GKV + (((size_t)ci * 4 + h) * 32) * 64 + 32 * vb + c;
#pragma unroll
                for (int q = 0; q < 16; ++q) g[acc_i(q, hh) * 64] = acc[q]; }
        }
        LDS_SYNC();
        { const int s = wv >> 2, tb = (wv >> 1) & 1, vb = wv & 1, h = 2 * hp + s;
            LAS bf16* tV = (LAS bf16*)(tb0 + s * 5 * TILE_B + 3 * TILE_B); LAS bf16* tSc = tV + 64 * TS;
            f32x16 acc = zero16(); const int c = lane & 31, hh = lane >> 5;
            mm_tile<4>(acc, tSc + tb * 32 * TS, tV + vb * 32 * TS, lane);
            bf16* y = Y + (size_t)(t0 + 32 * tb) * 1024 + 512 + h * 64 + 32 * vb + c;
#pragma unroll
            for (int q = 0; q < 16; ++q) y[(size_t)acc_i(q, hh) * 1024] = (bf16)f2bf(acc[q]); }
        LDS_SYNC();
    }
}
__device__ __forceinline__ void gla_m2_A(const Params& P, int seg, int e) {
    const float* GKV = (const float*)(P.ws + WS_GKV); const float* GAL = (const float*)(P.ws + WS_GAL); float* GSB = (float*)(P.ws + WS_GSB); float* GSA = (float*)(P.ws + WS_GSA);
    const int hk = e >> 6; float kv[16], al[16];
#pragma unroll
    for (int u = 0; u < 16; ++u) { kv[u] = GKV[(size_t)(seg * 16 + u) * 8192 + e]; al[u] = GAL[(seg * 16 + u) * 128 + hk]; }
    float S = 0.f, A = 1.f;
#pragma unroll
    for (int u = 0; u < 16; ++u) { S = al[u] * S + kv[u]; A *= al[u]; }
    GSB[seg * 8192 + e] = S; if ((e & 63) == 0) GSA[seg * 128 + hk] = A;
}
__device__ __forceinline__ void gla_m2_B(const Params& P, int e) {
    float* GSB = (float*)(P.ws + WS_GSB); const float* GSA = (const float*)(P.ws + WS_GSA);
    const int hk = e >> 6; float b[16], a[16];
#pragma unroll
    for (int s = 0; s < 16; ++s) { b[s] = GSB[s * 8192 + e]; a[s] = GSA[s * 128 + hk]; }
    float S = 0.f;
#pragma unroll
    for (int s = 0; s < 16; ++s) { GSB[s * 8192 + e] = S; S = a[s] * S + b[s]; }
}
__device__ __forceinline__ void gla_m2_C(const Params& P, int seg, int e) {
    float* GKV = (float*)(P.ws + WS_GKV); const float* GAL = (const float*)(P.ws + WS_GAL); const float* GSB = (const float*)(P.ws + WS_GSB);
    const int hk = e >> 6; float kv[16], al[16];
#pragma unroll
    for (int u = 0; u < 16; ++u) { kv[u] = GKV[(size_t)(seg * 16 + u) * 8192 + e]; al[u] = GAL[(seg * 16 + u) * 128 + hk]; }
    float S = GSB[seg * 8192 + e];
#pragma unroll
    for (int u = 0; u < 16; ++u) { GKV[(size_t)(seg * 16 + u) * 8192 + e] = S; S = al[u] * S + kv[u]; }
}
__device__ __forceinline__ void gla_m3(const Params& P, int l, int ci, LAS unsigned char* lds, int tid, bool do_store = true) {
    const bf16* cols = (const bf16*)(P.ws + WS_COLS); bf16* Y = (bf16*)(P.ws + WS_Y);
    const float* GKV = (const float*)(P.ws + WS_GKV); const bf16* GQI = (const bf16*)(P.ws + WS_GQI);
    const float* ng = P.in[I_GLAG] + l * 64;
    const int lane = tid & 63, wv = __builtin_amdgcn_readfirstlane(tid >> 6), t0 = ci * 64;
#pragma unroll 8
    for (int idx = tid; idx < 4 * 32 * 64; idx += NT) { const int h = idx >> 11, k = (idx >> 6) & 31, v = idx & 63;
        ((LAS bf16*)(lds + h * TILE_B))[v * TS + k] = (bf16)f2bf(GKV[(size_t)ci * 8192 + idx]); }
    LDS_SYNC();
    const int h = wv >> 1, tb = wv & 1, c = lane & 31, hh = lane >> 5;
    const LAS bf16* tS = (const LAS bf16*)(lds + h * TILE_B);
    f32x16 acc[2]; acc[0] = zero16(); acc[1] = zero16();
    const bf16* qg = GQI + (((size_t)ci * 4 + h) * 64 + 32 * tb + c) * 32 + hh * 8;
#pragma unroll
    for (int kk = 0; kk < 2; ++kk) { const bf16x8 b = *(const bf16x8*)(qg + kk * 16);
#pragma unroll
        for (int vb = 0; vb < 2; ++vb) { const bf16x8 a = *(const LAS bf16x8*)(tS + (vb * 32 + c) * TS + hh * 8 + kk * 16);
            acc[vb] = __builtin_amdgcn_mfma_f32_32x32x16_bf16(a, b, acc[vb], 0, 0, 0); } }
    const size_t trow = (size_t)(t0 + 32 * tb + c);
    bf16* yrow = Y + trow * 1024 + 512 + h * 64; const bf16* grow = cols + trow * NPAD + C_GLA + 512 + h * 64;
    float ss = 0.f;
#pragma unroll
    for (int vb = 0; vb < 2; ++vb)
#pragma unroll
        for (int q = 0; q < 4; ++q) { const int v = 32 * vb + 8 * q + 4 * hh; const uint2 w = *(const uint2*)(yrow + v);
            acc[vb][4 * q] += bf2f((bf16)(w.x & 0xffff)); acc[vb][4 * q + 1] += bf2f((bf16)(w.x >> 16)); acc[vb][4 * q + 2] += bf2f((bf16)(w.y & 0xffff)); acc[vb][4 * q + 3] += bf2f((bf16)(w.y >> 16));
#pragma unroll
            for (int e = 0; e < 4; ++e) ss += acc[vb][4 * q + e] * acc[vb][4 * q + e]; }
    ss += __shfl_xor(ss, 32);
    const float rstd = rsqf_(ss * (1.0f / 64.0f) + 1e-6f);
#pragma unroll
    for (int vb = 0; vb < 2; ++vb)
#pragma unroll
        for (int q = 0; q < 4; ++q) { const int v = 32 * vb + 8 * q + 4 * hh; const uint2 gw = *(const uint2*)(grow + v); float o[4];
            const float g0 = bf2f((bf16)(gw.x & 0xffff)), g1 = bf2f((bf16)(gw.x >> 16)), g2 = bf2f((bf16)(gw.y & 0xffff)), g3 = bf2f((bf16)(gw.y >> 16));
            o[0] = acc[vb][4 * q] * rstd * ng[v] * siluf_(g0); o[1] = acc[vb][4 * q + 1] * rstd * ng[v + 1] * siluf_(g1);
            o[2] = acc[vb][4 * q + 2] * rstd * ng[v + 2] * siluf_(g2); o[3] = acc[vb][4 * q + 3] * rstd * ng[v + 3] * siluf_(g3);
            uint2 w; w.x = pk2(o[0], o[1]); w.y = pk2(o[2], o[3]); if (do_store) *(uint2*)(yrow + v) = w; }
    LDS_SYNC();
}
__device__ __forceinline__ void nm_square(const LAS bf16* Xr, const LAS bf16* Xc, LAS bf16* Xr_o, LAS bf16* Xc_o, int I, int J, int lane) {
    f32x16 acc = zero16();
    if (I == J) mm_tile<2>(acc, Xr + I * 32 * TS + 32 * I, Xc + J * 32 * TS + 32 * I, lane);
    else mm_tile<4>(acc, Xr + 32 * TS, Xc, lane);
    store_lane_major(Xc_o, 32 * J, 32 * I, acc, lane);
    store_reg_major(Xr_o, 32 * I, 32 * J, acc, lane);
}
__device__ __forceinline__ void nm_update(const LAS bf16* Tt, const LAS bf16* Xc, LAS bf16* Tt_o, int I, int J, int lane) {
    const int c = lane & 31, hh = lane >> 5; f32x16 acc;
#pragma unroll
    for (int q = 0; q < 4; ++q) { const u32x2 w = *(const LAS u32x2*)(Tt + (32 * I + c) * TS + 32 * J + 8 * q + 4 * hh);
        acc[4 * q] = bf2f((bf16)(w.x & 0xffff)); acc[4 * q + 1] = bf2f((bf16)(w.x >> 16)); acc[4 * q + 2] = bf2f((bf16)(w.y & 0xffff)); acc[4 * q + 3] = bf2f((bf16)(w.y >> 16)); }
    if (I == J) mm_tile<2>(acc, Xc + J * 32 * TS + 32 * I, Tt + I * 32 * TS + 32 * I, lane);
    else mm_tile<4>(acc, Xc, Tt + 32 * TS, lane);
    store_lane_major(Tt_o, 32 * I, 32 * J, acc, lane);
}
#define NM_TILE_IJ(w3, I_, J_) const int I_ = ((w3) == 0) ? 0 : 1, J_ = ((w3) == 2) ? 1 : 0
template <class Extra> __device__ __forceinline__ void neumann_solve(LAS bf16* const (&Xr)[2], LAS bf16* const (&Xc)[2], LAS bf16* const (&Tt)[2], int wv, int lane, const Extra& extra) {
    if (wv < 3) { NM_TILE_IJ(wv, I, J); nm_square(Xr[0], Xc[0], Xr[1], Xc[1], I, J, lane); }
    else if (wv >= 4) extra();
    LDS_SYNC();
#pragma unroll 1
    for (int k = 1; k <= 4; ++k) {
        const int xb = k & 1, tbuf = (k - 1) & 1;
        if (wv < 3) { NM_TILE_IJ(wv, I, J); nm_update(Tt[tbuf], Xc[xb], Tt[tbuf ^ 1], I, J, lane); }
        else if (wv < 6) { NM_TILE_IJ(wv - 3, I, J); nm_square(Xr[xb], Xc[xb], Xr[xb ^ 1], Xc[xb ^ 1], I, J, lane); }
        LDS_SYNC();
    }
    if (wv < 3) { NM_TILE_IJ(wv, I, J); nm_update(Tt[0], Xc[1], Tt[1], I, J, lane); }
    LDS_SYNC();
}
typedef float f32x4v __attribute__((ext_vector_type(4)));
constexpr int M2_D = 6;
constexpr int M2_SLOT = 2 * TILE_B + 256;
template <bool NMODE, bool STORE_EACH> __device__ __forceinline__ void dplr_chain(const bf16* XP, bf16* XQ, const float* XG, int pstride, int gstride, int nsteps, const bf16* initH, bf16* outF, float* outG, LAS unsigned char* lds, int tid) {
    const int lane = tid & 63, wv = __builtin_amdgcn_readfirstlane(tid >> 6);
    const int g = lane >> 4, n = lane & 15, v0 = wv * 16;
    const int q = tid - 256;
#define M2_BAR() do { asm volatile("s_waitcnt lgkmcnt(0)" ::: "memory"); __builtin_amdgcn_s_barrier(); asm volatile("" ::: "memory"); } while (0)
    if (wv >= 4) {
        v4u ring[M2_D][5];
#define M2_ISSUE(c, R) do { const int c_ = (c) < nsteps ? (c) : nsteps - 1; const v4u* Pp = (const v4u*)(XP + (size_t)c_ * pstride); \
        R[0] = Pp[q]; R[1] = Pp[q + 256]; if (!NMODE) { const v4u* Qp = (const v4u*)(XQ + (size_t)c_ * pstride); R[2] = Qp[q]; R[3] = Qp[q + 256]; } R[4] = ((const v4u*)(XG + (size_t)c_ * gstride))[q & 15]; } while (0)
#define M2_PUT(slot, R) do { LAS unsigned char* sp = lds + (slot) * M2_SLOT; \
        *(LAS v4u*)(sp + (q >> 3) * (TS * 2) + (q & 7) * 16) = R[0]; *(LAS v4u*)(sp + ((q >> 3) + 32) * (TS * 2) + (q & 7) * 16) = R[1]; \
        if (!NMODE) { *(LAS v4u*)(sp + TILE_B + (q >> 3) * (TS * 2) + (q & 7) * 16) = R[2]; *(LAS v4u*)(sp + TILE_B + ((q >> 3) + 32) * (TS * 2) + (q & 7) * 16) = R[3]; } \
        if (q < 16) *(LAS v4u*)(sp + 2 * TILE_B + q * 16) = R[4]; } while (0)
#pragma unroll
        for (int d = 0; d < M2_D; ++d) M2_ISSUE(d, ring[d]);
        M2_PUT(0, ring[0]);
        M2_ISSUE(M2_D, ring[0]);
        M2_BAR();
#pragma unroll 1
        for (int c0 = 0; c0 < nsteps; c0 += M2_D) {
#pragma unroll
            for (int u = 0; u < M2_D; ++u) {
                M2_PUT((u + 1) & 1, ring[(u + 1) % M2_D]);
                M2_ISSUE(c0 + u + 1 + M2_D, ring[(u + 1) % M2_D]);
                M2_BAR(); }
        }
#undef M2_ISSUE
#undef M2_PUT
    } else {
        f32x4v H[4], Gam[4];
#pragma unroll
        for (int m = 0; m < 4; ++m) { H[m] = (f32x4v){0.f, 0.f, 0.f, 0.f}; Gam[m] = (f32x4v){1.f, 1.f, 1.f, 1.f}; }
        if (!NMODE && initH) {
#pragma unroll
            for (int m = 0; m < 4; ++m) { const uint2 w = *(const uint2*)(initH + (v0 + n) * 64 + 16 * m + 4 * g);
                H[m][0] = bf2f((bf16)(w.x & 0xffff)); H[m][1] = bf2f((bf16)(w.x >> 16)); H[m][2] = bf2f((bf16)(w.y & 0xffff)); H[m][3] = bf2f((bf16)(w.y >> 16)); } }
        M2_BAR();
#pragma unroll 1
        for (int c0 = 0; c0 < nsteps; c0 += M2_D) {
#pragma unroll
            for (int u = 0; u < M2_D; ++u) { const int c = c0 + u;
                if (c < nsteps) { const LAS unsigned char* sp = lds + (u & 1) * M2_SLOT; bf16* Qg = XQ + (size_t)c * pstride;
                    bf16x8 bfr[2];
#pragma unroll
                    for (int s = 0; s < 2; ++s) { f32x4v b0 = H[2 * s], b1 = H[2 * s + 1];
                        if (NMODE) {
#pragma unroll
                            for (int i = 0; i < 4; ++i) { if (2 * s == wv && 4 * g + i == n) b0[i] += Gam[2 * s][i]; if (2 * s + 1 == wv && 4 * g + i == n) b1[i] += Gam[2 * s + 1][i]; } }
                        v4u w; w.x = pk2(b0[0], b0[1]); w.y = pk2(b0[2], b0[3]); w.z = pk2(b1[0], b1[1]); w.w = pk2(b1[2], b1[3]); bfr[s] = __builtin_bit_cast(bf16x8, w); }
#pragma unroll
                    for (int m = 0; m < 4; ++m) {
                        const f32x4v gm = *(const LAS f32x4v*)(sp + 2 * TILE_B + (16 * m + 4 * g) * 4); f32x4v a;
                        if (NMODE) { a = gm * H[m]; Gam[m] = Gam[m] * gm; }
                        else { const u32x2 qw = *(const LAS u32x2*)(sp + TILE_B + (v0 + n) * (TS * 2) + (16 * m + 4 * g) * 2);
                            if (STORE_EACH) { u32x2 hw; hw.x = pk2(H[m][0], H[m][1]); hw.y = pk2(H[m][2], H[m][3]); *(u32x2*)(Qg + (v0 + n) * 64 + 16 * m + 4 * g) = hw; }
                            a[0] = gm[0] * H[m][0] + bf2f((bf16)(qw.x & 0xffff)); a[1] = gm[1] * H[m][1] + bf2f((bf16)(qw.x >> 16)); a[2] = gm[2] * H[m][2] + bf2f((bf16)(qw.y & 0xffff)); a[3] = gm[3] * H[m][3] + bf2f((bf16)(qw.y >> 16)); }
#pragma unroll
                        for (int s = 0; s < 2; ++s) { const u32x2 p0 = *(const LAS u32x2*)(sp + (16 * m + n) * (TS * 2) + (32 * s + 4 * g) * 2); const u32x2 p1 = *(const LAS u32x2*)(sp + (16 * m + n) * (TS * 2) + (32 * s + 16 + 4 * g) * 2);
                            v4u w; w.x = p0.x; w.y = p0.y; w.z = p1.x; w.w = p1.y;
                            a = __builtin_amdgcn_mfma_f32_16x16x32_bf16(__builtin_bit_cast(bf16x8, w), bfr[s], a, 0, 0, 0); }
                        H[m] = a; } }
                M2_BAR(); }
        }
        if (outF) {
            if (NMODE) {
#pragma unroll
                for (int m = 0; m < 4; ++m)
#pragma unroll
                    for (int i = 0; i < 4; ++i) outF[(16 * m + 4 * g + i) * 64 + v0 + n] = (bf16)f2bf(H[m][i]);
                if (wv == 0 && n == 0) {
#pragma unroll
                    for (int m = 0; m < 4; ++m) *(f32x4v*)(outG + 16 * m + 4 * g) = Gam[m]; }
            } else {
#pragma unroll
                for (int m = 0; m < 4; ++m) { u32x2 hw; hw.x = pk2(H[m][0], H[m][1]); hw.y = pk2(H[m][2], H[m][3]); *(u32x2*)(outF + (v0 + n) * 64 + 16 * m + 4 * g) = hw; } }
        }
    }
#undef M2_BAR
}
__device__ __forceinline__ void dplr_m3_stage(const bf16* XQ, int ci, LAS unsigned char* lds, int tid) {
#pragma unroll
    for (int i = 0; i < 4; ++i) { const int idx = tid + NT * i, h = idx >> 9, v = (idx >> 3) & 63, c8 = idx & 7;
        *(LAS v4u*)(lds + h * TILE_B + v * (TS * 2) + c8 * 16) = *(const v4u*)(XQ + (size_t)ci * 16384 + (size_t)idx * 8); }
}
__device__ __forceinline__ void dplr_m3_core(f32x16 (&acc)[2], const LAS bf16* tHT, const bf16* XRch, int tb, int lane) {
    const int c = lane & 31, hh = lane >> 5;
    const bf16* rg = XRch + (32 * tb + c) * 64 + hh * 8;
    acc[0] = zero16(); acc[1] = zero16();
#pragma unroll
    for (int kk = 0; kk < 4; ++kk) { const bf16x8 b = *(const bf16x8*)(rg + kk * 16);
#pragma unroll
        for (int vb = 0; vb < 2; ++vb) { const bf16x8 a = *(const LAS bf16x8*)(tHT + (vb * 32 + c) * TS + hh * 8 + kk * 16);
            acc[vb] = __builtin_amdgcn_mfma_f32_32x32x16_bf16(a, b, acc[vb], 0, 0, 0); } }
}
__device__ __forceinline__ void rwkv_m1(const Params& P, int l, int ci, LAS unsigned char* lds, int tid) {
    const bf16* cols = (const bf16*)(P.ws + WS_COLS); bf16* Y = (bf16*)(P.ws + WS_Y); bf16* VF = (bf16*)(P.ws + WS_VF);
    bf16* XP = (bf16*)(P.ws + WS_RP); bf16* XQ = (bf16*)(P.ws + WS_RQ); bf16* XR = (bf16*)(P.ws + WS_RR); bf16* XBV = (bf16*)(P.ws + WS_RBV); float* XG = (float*)(P.ws + WS_XG);
    LAS bf16* tA = (LAS bf16*)lds; LAS bf16* tB = tA + 64 * TS; LAS bf16* tK = tB + 64 * TS; LAS bf16* tR = tK + 64 * TS; LAS bf16* tV = tR + 64 * TS;
    LAS bf16* tAab = tV + 64 * TS; LAS bf16* tAak = tAab + 64 * TS; LAS bf16* tArb = tAak + 64 * TS; LAS bf16* tArk = tArb + 64 * TS;
    LAS bf16* tAabT = tArk + 64 * TS; LAS bf16* tX1r = tAabT + 64 * TS; LAS bf16* tX1c = tX1r + 64 * TS; LAS bf16* tT0 = tX1c + 64 * TS; LAS bf16* tT1 = tT0 + 64 * TS; LAS bf16* tAV = tT1 + 64 * TS;
    LAS bf16* tW = tAab; LAS bf16* tU = tAak; LAS bf16* tT = tT1;
    LAS float* gC = (LAS float*)(lds + 5 * TILE_B + 77824 + 16384);
    LAS bf16* xW = (LAS bf16*)(lds + 5 * TILE_B); LAS bf16* xA = xW + 64 * 72; LAS bf16* xG = xA + 64 * 72; LAS bf16* xV = xG + 64 * 136; LAS bf16* Lw = xV + 64 * 40;
    LAS float* sLw = (LAS float*)(lds + 5 * TILE_B + 77824);
    const float* mu = P.in[I_MU] + l * 1024;
    {   int tid0 = tid, t0 = ci * 64; asm volatile("" : "+v"(tid0), "+s"(t0));
        const int lane = tid0 & 63, wv = __builtin_amdgcn_readfirstlane(tid0 >> 6);
        {
            const int c8 = tid0 & 31, tg = tid0 >> 5; v4u raw[5];
#pragma unroll
            for (int k = 0; k < 5; ++k) { const int tt = t0 + 4 * tg - 1 + k; raw[k] = *(const v4u*)(cols + (size_t)(tt < 0 ? 0 : tt) * NPAD + 768 + 8 * c8); if (tt < 0) raw[k] = (v4u){0u, 0u, 0u, 0u}; }
            const f32x4 m0 = *(const f32x4*)(mu + 768 + 8 * c8), m1 = *(const f32x4*)(mu + 768 + 8 * c8 + 4);
            const float mu8[8] = {m0[0], m0[1], m0[2], m0[3], m1[0], m1[1], m1[2], m1[3]};
#pragma unroll
            for (int k = 1; k < 5; ++k) { const int t = 4 * tg + k - 1; float o[8];
#pragma unroll
                for (int e = 0; e < 8; ++e) { const unsigned uc = (e < 2 ? raw[k].x : e < 4 ? raw[k].y : e < 6 ? raw[k].z : raw[k].w), up = (e < 2 ? raw[k - 1].x : e < 4 ? raw[k - 1].y : e < 6 ? raw[k - 1].z : raw[k - 1].w);
                    const float cur = bf2f((bf16)((e & 1) ? (uc >> 16) : (uc & 0xffff))), prv = bf2f((bf16)((e & 1) ? (up >> 16) : (up & 0xffff))); const float xs = cur + (prv - cur) * mu8[e];
                    o[e] = (c8 < 8) ? tanhf_(xs) : ((c8 < 16) ? xs : sigmoidf_(xs)); }
                v4u w; w.x = pk2(o[0], o[1]); w.y = pk2(o[2], o[3]); w.z = pk2(o[4], o[5]); w.w = pk2(o[6], o[7]);
                LAS bf16* dst = (c8 < 8) ? (xW + t * 72 + 8 * c8) : ((c8 < 16) ? (xA + t * 72 + 8 * (c8 - 8)) : (xG + t * 136 + 8 * (c8 - 16)));
                *(LAS v4u*)dst = w; }
            if (l > 0 && tid0 < 256) { const int t = tid0 >> 2, c4 = tid0 & 3; *(LAS v4u*)(xV + t * 40 + 8 * c4) = *(const v4u*)(cols + (size_t)(t0 + t) * NPAD + C_VRES + 8 * c4); }
        }
        LDS_SYNC();
        {
            const bf16* lw = (const bf16*)(P.ws + WS_LORA) + (size_t)l * LORA_LAYER; const int c = lane & 31, hh = lane >> 5;
#pragma unroll
            for (int u = 0; u < 8; ++u) { const int which = u >> 1; if (which == 3 && l == 0) continue;
                const int hd = 2 * (u & 1) + (wv >> 2), tb = (wv >> 1) & 1, cb = wv & 1, crow = hd * 64 + cb * 32; f32x16 acc = zero16();
                if (which == 0) mm_tile_gb<4>(acc, xW + tb * 32 * 72, 72, lw + LORA_W + crow * 64, 64, lane);
                else if (which == 1) mm_tile_gb<4>(acc, xA + tb * 32 * 72, 72, lw + LORA_A + crow * 64, 64, lane);
                else if (which == 2) mm_tile_gb<8>(acc, xG + tb * 32 * 136, 136, lw + LORA_G + crow * 128, 128, lane);
                else mm_tile_gb<2>(acc, xV + tb * 32 * 40, 40, lw + LORA_V + crow * 32, 32, lane);
                const size_t chd = (size_t)ci * 4 + hd;
                if (which == 2) { bf16* g = Y + (size_t)(t0 + 32 * tb) * 1024 + 768 + crow + c;
#pragma unroll
                    for (int q = 0; q < 16; ++q) g[(size_t)acc_i(q, hh) * 1024] = (bf16)f2bf(acc[q]); }
                else { bf16* g = (which == 0 ? XP : (which == 1 ? XQ : XR)) + chd * 4096 + (cb * 32 + c) * 64 + 32 * tb + 4 * hh;
#pragma unroll
                    for (int q = 0; q < 4; ++q) { uint2 w; w.x = pk2(acc[4 * q], acc[4 * q + 1]); w.y = pk2(acc[4 * q + 2], acc[4 * q + 3]); *(uint2*)(g + 8 * q) = w; } }
                if (u & 1) asm volatile("" ::: "memory"); }
        }
        __syncthreads();
    }
    v4u pf_w, pf_a, pf_v; unsigned pf_raw[3][5]; unsigned pf_vf[4];
#define RW_PREFETCH(hn) do { const int lane_ = tid & 63, wv_ = tid >> 6, cc_ = (hn) * 64 + lane_; const size_t ch_ = (size_t)ci * 4 + (hn); const int t0_ = ci * 64; \
        pf_w = *(const v4u*)(XP + ch_ * 4096 + lane_ * 64 + wv_ * 8); pf_a = *(const v4u*)(XQ + ch_ * 4096 + lane_ * 64 + wv_ * 8); pf_v = (l > 0) ? *(const v4u*)(XR + ch_ * 4096 + lane_ * 64 + wv_ * 8) : (v4u){0u, 0u, 0u, 0u}; \
        _Pragma("unroll") for (int a_ = 0; a_ < 3; ++a_) _Pragma("unroll") for (int j_ = 0; j_ < 5; ++j_) { const int t0r_ = t0_ + wv_ * 8 - 1 + 2 * j_, t1r_ = t0r_ + 1; \
            unsigned lo_ = cols[(size_t)(t0r_ < 0 ? 0 : t0r_) * NPAD + a_ * 256 + cc_]; if (t0r_ < 0) lo_ = 0u; const unsigned hi_ = (j_ < 4) ? (unsigned)cols[(size_t)t1r_ * NPAD + a_ * 256 + cc_] : 0u; pf_raw[a_][j_] = lo_ | (hi_ << 16); } \
        _Pragma("unroll") for (int j_ = 0; j_ < 4; ++j_) pf_vf[j_] = (l > 0) ? ((unsigned)VF[(size_t)(t0_ + wv_ * 8 + 2 * j_) * 256 + cc_] | ((unsigned)VF[(size_t)(t0_ + wv_ * 8 + 2 * j_ + 1) * 256 + cc_] << 16)) : 0u; } while (0)
#define PF_RAW(a, rr) bf2f((bf16)(((rr) & 1) ? (pf_raw[a][(rr) >> 1] >> 16) : (pf_raw[a][(rr) >> 1] & 0xffffu)))
#define PF_VF(i) bf2f((bf16)(((i) & 1) ? (pf_vf[(i) >> 1] >> 16) : (pf_vf[(i) >> 1] & 0xffffu)))
    RW_PREFETCH(0);
#pragma unroll 1
    for (int h = 0; h < 4; ++h) {
        int tidh = tid, t0 = ci * 64; asm volatile("" : "+v"(tidh), "+s"(t0));
        const int lane = tidh & 63, wv = __builtin_amdgcn_readfirstlane(tidh >> 6);
        const int cc = h * 64 + lane; const size_t ch = (size_t)ci * 4 + h;
        const float w0c = P.in[I_W0][l * 256 + cc], a0c = P.in[I_A0][l * 256 + cc], kkc = P.in[I_KK][l * 256 + cc], kac = P.in[I_KA][l * 256 + cc], rkc = P.in[I_RK][l * 256 + cc];
        const float v0c = (l > 0) ? P.in[I_V0][(l - 1) * 256 + cc] : 0.f;
        const float mu_r = mu[cc], mu_k = mu[256 + cc], mu_v = mu[512 + cc];
        float o_asig[8]; float e_r[8], e_k[8], e_v[8], e_kk[8];
#pragma unroll
        for (int i = 0; i < 8; ++i) { const int t = wv * 8 + i, tt = t0 + t;
            const unsigned uw = (i < 2 ? pf_w.x : i < 4 ? pf_w.y : i < 6 ? pf_w.z : pf_w.w), ua = (i < 2 ? pf_a.x : i < 4 ? pf_a.y : i < 6 ? pf_a.z : pf_a.w), uv = (i < 2 ? pf_v.x : i < 4 ? pf_v.y : i < 6 ? pf_v.z : pf_v.w);
            const float accw = bf2f((bf16)((i & 1) ? (uw >> 16) : (uw & 0xffff))), acca = bf2f((bf16)((i & 1) ? (ua >> 16) : (ua & 0xffff))), accv = bf2f((bf16)((i & 1) ? (uv >> 16) : (uv & 0xffff)));
            const float wlog = -softplusf_(-(w0c + accw)) - 0.5f; const float lwv = -__expf(wlog);
            const float asig = sigmoidf_(a0c + acca); o_asig[i] = asig;
            const float r0 = PF_RAW(0, i + 1), r1 = PF_RAW(0, i), k0 = PF_RAW(1, i + 1), k1 = PF_RAW(1, i), vv0 = PF_RAW(2, i + 1), vv1 = PF_RAW(2, i);
            const float r = r0 + (r1 - r0) * mu_r, k = k0 + (k1 - k0) * mu_k; float v = vv0 + (vv1 - vv0) * mu_v;
            if (l == 0) VF[(size_t)tt * 256 + cc] = (bf16)f2bf(v);
            else v = v + (PF_VF(i) - v) * sigmoidf_(v0c + accv);
            const float kkr = k * kkc; const float ss = wave_sum(kkr * kkr); const float kk = kkr * rsqf_(ss + 1e-24f);
            const float kmod = k * (1.0f + (asig - 1.0f) * kac);
            const float bon = wave_sum(r * kmod * rkc);
            XBV[(ch * 64 + t) * 64 + lane] = (bf16)f2bf(bon * v);
            sLw[t * 64 + lane] = lwv;
            e_r[i] = r; e_k[i] = kmod; e_v[i] = v; e_kk[i] = kk; }
        LDS_SYNC();
        if (tidh < 64) { float run = 0.f;
#pragma unroll 8
            for (int t = 0; t < 64; ++t) { run += sLw[t * 64 + tidh]; sLw[t * 64 + tidh] = run; }
            const float gam = __expf(run); gC[tidh] = gam; XG[ch * 64 + tidh] = gam; }
        LDS_SYNC();
        float at[8], bt[8], kt[8];
#pragma unroll
        for (int i = 0; i < 8; ++i) { const int t = wv * 8 + i; const float cum = sLw[t * 64 + lane], cumm = (t > 0) ? sLw[(t - 1) * 64 + lane] : 0.f;
            const float ep = __expf(cum), en = __expf(-cum), epm = __expf(cumm);
            at[i] = -e_kk[i] * epm; bt[i] = e_kk[i] * o_asig[i] * en; kt[i] = e_k[i] * en;
            tA[t * TS + lane] = (bf16)f2bf(at[i]); tB[t * TS + lane] = (bf16)f2bf(bt[i]); tK[t * TS + lane] = (bf16)f2bf(kt[i]); tR[t * TS + lane] = (bf16)f2bf(e_r[i] * ep); }
        { v4u w; w.x = pk2(e_v[0], e_v[1]); w.y = pk2(e_v[2], e_v[3]); w.z = pk2(e_v[4], e_v[5]); w.w = pk2(e_v[6], e_v[7]); *(LAS v4u*)(tV + lane * TS + wv * 8) = w; }
        LDS_SYNC();
        if (h < 3) RW_PREFETCH(h + 1);
        for (int jb = wv; jb < 16; jb += 8) { const int mat = jb >> 2, r = jb & 3; const int tb = (r == 0 || r == 3) ? 0 : 1, sb = (r == 0 || r == 1) ? 0 : 1;
            f32x16 acc = zero16(); const int c = lane & 31, hh = lane >> 5;
            if (r < 3) { mm_tile<4>(acc, ((mat & 1) ? tK : tB) + sb * 32 * TS, ((mat >> 1) ? tR : tA) + tb * 32 * TS, lane);
#pragma unroll
                for (int q = 0; q < 16; ++q) { const int sI = 32 * sb + acc_i(q, hh), tI = 32 * tb + c; if ((mat < 2) ? (sI >= tI) : (sI > tI)) acc[q] = 0.f; } }
            store_lane_major(tAab + mat * 64 * TS, 32 * tb, 32 * sb, acc, lane);
            if (mat == 0) {
                if (r == 3) store_lane_major(tT1, 0, 32, acc, lane);
                else { store_reg_major(tAabT, 32 * sb, 32 * tb, acc, lane);
#pragma unroll
                    for (int q = 0; q < 16; ++q) if (32 * sb + acc_i(q, hh) == 32 * tb + c) acc[q] += 1.0f;
                    store_lane_major(tT0, 32 * tb, 32 * sb, acc, lane); } }
        }
        LDS_SYNC();
        { v4u w; w.x = pk2(at[0], at[1]); w.y = pk2(at[2], at[3]); w.z = pk2(at[4], at[5]); w.w = pk2(at[6], at[7]); *(LAS v4u*)(tA + lane * TS + wv * 8) = w;
          w.x = pk2(bt[0], bt[1]); w.y = pk2(bt[2], bt[3]); w.z = pk2(bt[4], bt[5]); w.w = pk2(bt[6], bt[7]); *(LAS v4u*)(tB + lane * TS + wv * 8) = w;
          w.x = pk2(kt[0], kt[1]); w.y = pk2(kt[2], kt[3]); w.z = pk2(kt[4], kt[5]); w.w = pk2(kt[6], kt[7]); *(LAS v4u*)(tK + lane * TS + wv * 8) = w; }
        { LAS bf16* const Xr[2] = {tAab, tX1r}; LAS bf16* const Xc[2] = {tAabT, tX1c}; LAS bf16* const Tb[2] = {tT0, tT1};
          neumann_solve(Xr, Xc, Tb, wv, lane, [&]() { const int sb = (wv - 4) >> 1, vb = (wv - 4) & 1; f32x16 acc = zero16();
              mm_tile<4>(acc, tAak + sb * 32 * TS, tV + vb * 32 * TS, lane); store_lane_major(tAV, 32 * vb, 32 * sb, acc, lane); }); }
        { const int which = wv >> 2, tb = (wv >> 1) & 1, jb2 = wv & 1; f32x16 acc = zero16();
            mm_tile<4>(acc, tT + tb * 32 * TS, (which ? tAV : tA) + jb2 * 32 * TS, lane);
            store_lane_major(which ? tU : tW, 32 * jb2, 32 * tb, acc, lane); }
        LDS_SYNC();
        for (int jb = wv; jb < 16; jb += 8) { const int out = jb >> 2, ib = (jb >> 1) & 1, jb2 = jb & 1; f32x16 acc = zero16(); const int c = lane & 31, hh = lane >> 5;
            if (out == 0) mm_tile<4>(acc, tB + ib * 32 * TS, tW + jb2 * 32 * TS, lane);
            else if (out == 1) { mm_tile<4>(acc, tB + ib * 32 * TS, tU + jb2 * 32 * TS, lane); mm_tile<4>(acc, tK + ib * 32 * TS, tV + jb2 * 32 * TS, lane); }
            else if (out == 2) mm_tile<4>(acc, tArb + ib * 32 * TS, tW + jb2 * 32 * TS, lane);
            else { mm_tile<4>(acc, tArb + ib * 32 * TS, tU + jb2 * 32 * TS, lane); mm_tile<4>(acc, tArk + ib * 32 * TS, tV + jb2 * 32 * TS, lane); }
            if (out == 0) { bf16* g = XP + ch * 4096 + 32 * jb2 + c;
#pragma unroll
                for (int q = 0; q < 16; ++q) { const int row = 32 * ib + acc_i(q, hh); g[row * 64] = (bf16)f2bf(acc[q] * gC[row]); } }
            else if (out == 1) { bf16* g = XQ + ch * 4096 + (32 * jb2 + c) * 64 + 32 * ib + 4 * hh;
#pragma unroll
                for (int q = 0; q < 4; ++q) { const int row = 32 * ib + 8 * q + 4 * hh; uint2 w; w.x = pk2(acc[4 * q] * gC[row], acc[4 * q + 1] * gC[row + 1]); w.y = pk2(acc[4 * q + 2] * gC[row + 2], acc[4 * q + 3] * gC[row + 3]); *(uint2*)(g + 8 * q) = w; } }
            else if (out == 2) { bf16* g = XR + ch * 4096 + 32 * jb2 + c;
#pragma unroll
                for (int q = 0; q < 16; ++q) { const int row = 32 * ib + acc_i(q, hh); g[row * 64] = (bf16)f2bf(acc[q] + bf2f(tR[row * TS + 32 * jb2 + c])); } }
            else { bf16* g = Y + (size_t)t0 * 1024 + h * 64 + 32 * jb2 + c;
#pragma unroll
                for (int q = 0; q < 16; ++q) { const int row = 32 * ib + acc_i(q, hh); g[(size_t)row * 1024] = (bf16)f2bf(acc[q]); } }
        }
        LDS_SYNC();
    }
}
__device__ __forceinline__ void rwkv_m3(const Params& P, int l, int ci, LAS unsigned char* lds, int tid, bool do_store = true) {
    bf16* Y = (bf16*)(P.ws + WS_Y); const bf16* XQ = (const bf16*)(P.ws + WS_RQ); const bf16* XR = (const bf16*)(P.ws + WS_RR); const bf16* XBV = (const bf16*)(P.ws + WS_RBV);
    const int lane = tid & 63, wv = __builtin_amdgcn_readfirstlane(tid >> 6), t0 = ci * 64;
    dplr_m3_stage(XQ, ci, lds, tid);
    LDS_SYNC();
    const int h = wv >> 1, tb = wv & 1, c = lane & 31, hh = lane >> 5; const size_t ch = (size_t)ci * 4 + h;
    f32x16 acc[2];
    dplr_m3_core(acc, (const LAS bf16*)(lds + h * TILE_B), XR + ch * 4096, tb, lane);
    const size_t trow = (size_t)(t0 + 32 * tb + c);
    bf16* yrow = Y + trow * 1024 + h * 64; const bf16* grow = Y + trow * 1024 + 768 + h * 64; const bf16* bvrow = XBV + (ch * 64 + 32 * tb + c) * 64;
    const float* lnw = P.in[I_LNW] + l * 256 + h * 64; const float* lnb = P.in[I_LNB] + l * 256 + h * 64;
    float s = 0.f;
#pragma unroll
    for (int vb = 0; vb < 2; ++vb)
#pragma unroll
        for (int q = 0; q < 4; ++q) { const int v = 32 * vb + 8 * q + 4 * hh; const uint2 w = *(const uint2*)(yrow + v);
            acc[vb][4 * q] += bf2f((bf16)(w.x & 0xffff)); acc[vb][4 * q + 1] += bf2f((bf16)(w.x >> 16)); acc[vb][4 * q + 2] += bf2f((bf16)(w.y & 0xffff)); acc[vb][4 * q + 3] += bf2f((bf16)(w.y >> 16));
            s += (acc[vb][4 * q] + acc[vb][4 * q + 1]) + (acc[vb][4 * q + 2] + acc[vb][4 * q + 3]); }
    s += __shfl_xor(s, 32);
    const float mean = s * (1.0f / 64.0f); float qq = 0.f;
#pragma unroll
    for (int vb = 0; vb < 2; ++vb)
#pragma unroll
        for (int r = 0; r < 16; ++r) { acc[vb][r] -= mean; qq += acc[vb][r] * acc[vb][r]; }
    qq += __shfl_xor(qq, 32);
    const float rstd = rsqf_(qq * (1.0f / 64.0f) + 64e-5f);
#pragma unroll
    for (int vb = 0; vb < 2; ++vb)
#pragma unroll
        for (int q = 0; q < 4; ++q) { const int v = 32 * vb + 8 * q + 4 * hh; const uint2 gw = *(const uint2*)(grow + v); const uint2 bw = *(const uint2*)(bvrow + v); float o[4];
            const float g4[4] = {bf2f((bf16)(gw.x & 0xffff)), bf2f((bf16)(gw.x >> 16)), bf2f((bf16)(gw.y & 0xffff)), bf2f((bf16)(gw.y >> 16))};
            const float b4[4] = {bf2f((bf16)(bw.x & 0xffff)), bf2f((bf16)(bw.x >> 16)), bf2f((bf16)(bw.y & 0xffff)), bf2f((bf16)(bw.y >> 16))};
#pragma unroll
            for (int e = 0; e < 4; ++e) o[e] = (acc[vb][4 * q + e] * rstd * lnw[v + e] + lnb[v + e] + b4[e]) * g4[e];
            uint2 w; w.x = pk2(o[0], o[1]); w.y = pk2(o[2], o[3]); if (do_store) *(uint2*)(yrow + v) = w; }
    LDS_SYNC();
}
#ifndef REP_GA
#define REP_GA 1
#endif
#ifndef REP_GS
#define REP_GS 1
#endif
#ifndef REP_G4
#define REP_G4 1
#endif
__device__ __forceinline__ void gdn_m1(const Params& P, int l, int ci, LAS unsigned char* lds, int tid) {
    const bf16* cols = (const bf16*)(P.ws + WS_COLS); bf16* Y = (bf16*)(P.ws + WS_Y);
    bf16* XP = (bf16*)(P.ws + WS_DP); bf16* XQ = (bf16*)(P.ws + WS_DQ); bf16* XR = (bf16*)(P.ws + WS_DR); float* XG = (float*)(P.ws + WS_XG) + 1024 * 64;
    LAS bf16* tKn = (LAS bf16*)lds; LAS bf16* tQn = tKn + 64 * TS; LAS bf16* tBV = tQn + 64 * TS; LAS bf16* tBK = tBV + 64 * TS; LAS bf16* tKd = tBK + 64 * TS;
    LAS bf16* tAab = tKd + 64 * TS; LAS bf16* tAabT = tAab + 64 * TS; LAS bf16* tX1r = tAabT + 64 * TS; LAS bf16* tX1c = tX1r + 64 * TS; LAS bf16* tT0 = tX1c + 64 * TS; LAS bf16* tT1 = tT0 + 64 * TS; LAS bf16* tQk = tT1 + 64 * TS;
    LAS bf16* tW = tAab; LAS bf16* tU = tAabT; LAS bf16* tT = tT1;
    LAS float* sG = (LAS float*)(lds + 12 * TILE_B); LAS float* sGc = sG + 64; LAS float* sBe = sGc + 64;
    const float* cw = P.in[I_CONV] + (size_t)l * 4 * 768;
#pragma unroll 1
    for (int h = 0; h < 4; ++h) {
        int tidh = tid, t0 = ci * 64; asm volatile("" : "+v"(tidh), "+s"(t0));
        const int lane = tidh & 63, wv = __builtin_amdgcn_readfirstlane(tidh >> 6); const size_t ch = (size_t)ci * 4 + h;
        const float alog = P.in[I_ALOG][l * 4 + h], dtb = P.in[I_DTB][l * 4 + h];
        float e_q[8], e_k[8], e_v[8], e_be[8]; float gcs[8], gc63;
        {
            float raw[3][11], braw[8], araw[8], cwv[3][4];
#pragma unroll
            for (int a = 0; a < 3; ++a)
#pragma unroll
                for (int r = 0; r < 11; ++r) { const int ts = t0 + wv * 8 - 3 + r; const float v = ldcol(cols, ts < 0 ? 0 : ts, C_GDN + a * 256 + h * 64 + lane); raw[a][r] = (ts < 0) ? 0.f : v; }
#pragma unroll
            for (int i = 0; i < 8; ++i) { braw[i] = ldcol(cols, t0 + wv * 8 + i, C_GDN + 1024 + h); araw[i] = ldcol(cols, t0 + wv * 8 + i, C_GDN + 1028 + h); }
#pragma unroll
            for (int a = 0; a < 3; ++a)
#pragma unroll
                for (int i = 0; i < 4; ++i) cwv[a][i] = cw[i * 768 + a * 256 + h * 64 + lane];
            float gv[8];
#pragma unroll
            for (int i = 0; i < 8; ++i) { float o3[3];
#pragma unroll
                for (int a = 0; a < 3; ++a) o3[a] = siluf_(cwv[a][0] * raw[a][i] + cwv[a][1] * raw[a][i + 1] + cwv[a][2] * raw[a][i + 2] + cwv[a][3] * raw[a][i + 3]);
                const float sq = wave_sum(o3[0] * o3[0]), sk = wave_sum(o3[1] * o3[1]);
                e_q[i] = o3[0] * rsqf_(sq + 1e-6f) * 0.125f; e_k[i] = o3[1] * rsqf_(sk + 1e-6f); e_v[i] = o3[2];
                e_be[i] = sigmoidf_(braw[i]); gv[i] = -__expf(alog) * softplusf_(araw[i] + dtb); }
            float gsel = gv[0], bsel = e_be[0];
#pragma unroll
            for (int i = 1; i < 8; ++i) { gsel = (lane == i) ? gv[i] : gsel; bsel = (lane == i) ? e_be[i] : bsel; }
            if (lane < 8) { sG[wv * 8 + lane] = gsel; sBe[wv * 8 + lane] = bsel; }
        }
        LDS_SYNC();
        { const float gl = sG[lane]; float run = gl;
#pragma unroll
            for (int o = 1; o < 64; o <<= 1) { const float up = __shfl_up(run, o); if (lane >= o) run += up; }
            gc63 = __shfl(run, 63);
#pragma unroll
            for (int i = 0; i < 8; ++i) gcs[i] = __shfl(run, wv * 8 + i);
            if (wv == 0) { sGc[lane] = run; XG[ch * 64 + lane] = __expf(gc63); } }
        float bk[8], kd[8], bv[8];
#pragma unroll
        for (int i = 0; i < 8; ++i) { const int t = wv * 8 + i;
            tKn[t * TS + lane] = (bf16)f2bf(e_k[i]); tQn[t * TS + lane] = (bf16)f2bf(e_q[i]);
            bv[i] = e_be[i] * e_v[i]; bk[i] = e_be[i] * e_k[i] * __expf(gcs[i]); kd[i] = e_k[i] * __expf(gc63 - gcs[i]); }
        { v4u w; w.x = pk2(bv[0], bv[1]); w.y = pk2(bv[2], bv[3]); w.z = pk2(bv[4], bv[5]); w.w = pk2(bv[6], bv[7]); *(LAS v4u*)(tBV + lane * TS + wv * 8) = w;
          w.x = pk2(bk[0], bk[1]); w.y = pk2(bk[2], bk[3]); w.z = pk2(bk[4], bk[5]); w.w = pk2(bk[6], bk[7]); *(LAS v4u*)(tBK + lane * TS + wv * 8) = w;
          w.x = pk2(kd[0], kd[1]); w.y = pk2(kd[2], kd[3]); w.z = pk2(kd[4], kd[5]); w.w = pk2(kd[6], kd[7]); *(LAS v4u*)(tKd + lane * TS + wv * 8) = w; }
        LDS_SYNC();
        for (int rpd_ = 0; rpd_ < REP_GS; ++rpd_)
        { const int mat = wv >> 2, r = wv & 3; const int tb = (r == 0 || r == 3) ? 0 : 1, sb = (r == 0 || r == 1) ? 0 : 1;
            f32x16 acc = zero16(); const int c = lane & 31, hh = lane >> 5;
            if (r < 3) { mm_tile<4>(acc, tKn + sb * 32 * TS, (mat ? tQn : tKn) + tb * 32 * TS, lane);
                const int tI = 32 * tb + c; const float gct = sGc[tI], bet = sBe[tI];
#pragma unroll
                for (int q = 0; q < 16; ++q) { const int sI = 32 * sb + acc_i(q, hh);
                    if ((mat == 0) ? (sI >= tI) : (sI > tI)) acc[q] = 0.f;
                    else { const float dcy = __expf(gct - sGc[sI]); acc[q] = (mat == 0) ? (-bet * acc[q] * dcy) : (acc[q] * dcy); } } }
            if (mat == 0) { store_lane_major(tAab, 32 * tb, 32 * sb, acc, lane);
                if (r == 3) store_lane_major(tT1, 0, 32, acc, lane);
                else { store_reg_major(tAabT, 32 * sb, 32 * tb, acc, lane);
#pragma unroll
                    for (int q = 0; q < 16; ++q) if (32 * sb + acc_i(q, hh) == 32 * tb + c) acc[q] += 1.0f;
                    store_lane_major(tT0, 32 * tb, 32 * sb, acc, lane); } }
            else store_lane_major(tQk, 32 * tb, 32 * sb, acc, lane);
        }
        LDS_SYNC();
        { LAS bf16* const Xr[2] = {tAab, tX1r}; LAS bf16* const Xc[2] = {tAabT, tX1c}; LAS bf16* const Tb[2] = {tT0, tT1};
          neumann_solve(Xr, Xc, Tb, wv, lane, [&]() {}); }
        { const int which = wv >> 2, tb = (wv >> 1) & 1, jb2 = wv & 1; f32x16 acc = zero16();
            mm_tile<4>(acc, tT + tb * 32 * TS, (which ? tBV : tBK) + jb2 * 32 * TS, lane);
            store_lane_major(which ? tU : tW, 32 * jb2, 32 * tb, acc, lane); }
        LDS_SYNC();
        for (int rpg_ = 0; rpg_ < REP_G4; ++rpg_)
        for (int jb = wv; jb < 16; jb += 8) { const int out = jb >> 2, ib = (jb >> 1) & 1, jb2 = jb & 1; f32x16 acc = zero16(); const int c = lane & 31, hh = lane >> 5;
            if (out < 2) mm_tile<4>(acc, tKd + ib * 32 * TS, (out ? tU : tW) + jb2 * 32 * TS, lane);
            else mm_tile<4>(acc, tQk + ib * 32 * TS, (out == 3 ? tU : tW) + jb2 * 32 * TS, lane);
            if (out == 0) { bf16* g = XP + ch * 4096 + 32 * jb2 + c;
#pragma unroll
                for (int q = 0; q < 16; ++q) { const int row = 32 * ib + acc_i(q, hh); g[row * 64] = (bf16)f2bf(-acc[q]); } }
            else if (out == 1) { bf16* g = XQ + ch * 4096 + (32 * jb2 + c) * 64 + 32 * ib + 4 * hh;
#pragma unroll
                for (int q = 0; q < 4; ++q) { uint2 w; w.x = pk2(acc[4 * q], acc[4 * q + 1]); w.y = pk2(acc[4 * q + 2], acc[4 * q + 3]); *(uint2*)(g + 8 * q) = w; } }
            else if (out == 2) { bf16* g = XR + ch * 4096 + 32 * jb2 + c;
#pragma unroll
                for (int q = 0; q < 16; ++q) { const int row = 32 * ib + acc_i(q, hh); g[row * 64] = (bf16)f2bf(bf2f(tQn[row * TS + 32 * jb2 + c]) * __expf(sGc[row]) - acc[q]); } }
            else { bf16* g = Y + (size_t)t0 * 1024 + 256 + h * 64 + 32 * jb2 + c;
#pragma unroll
                for (int q = 0; q < 16; ++q) { const int row = 32 * ib + acc_i(q, hh); g[(size_t)row * 1024] = (bf16)f2bf(acc[q]); } }
        }
        LDS_SYNC();
    }
}
__device__ __forceinline__ void gdn_m3(const Params& P, int l, int ci, LAS unsigned char* lds, int tid, bool do_store = true) {
    const bf16* cols = (const bf16*)(P.ws + WS_COLS); bf16* Y = (bf16*)(P.ws + WS_Y); const bf16* XQ = (const bf16*)(P.ws + WS_DQ); const bf16* XR = (const bf16*)(P.ws + WS_DR);
    const float* ng = P.in[I_GDNG] + l * 64;
    const int lane = tid & 63, wv = __builtin_amdgcn_readfirstlane(tid >> 6), t0 = ci * 64;
    dplr_m3_stage(XQ, ci, lds, tid);
    LDS_SYNC();
    const int h = wv >> 1, tb = wv & 1, c = lane & 31, hh = lane >> 5; const size_t ch = (size_t)ci * 4 + h;
    f32x16 acc[2];
    dplr_m3_core(acc, (const LAS bf16*)(lds + h * TILE_B), XR + ch * 4096, tb, lane);
    const size_t trow = (size_t)(t0 + 32 * tb + c);
    bf16* yrow = Y + trow * 1024 + 256 + h * 64; const bf16* zrow = cols + trow * NPAD + C_GDN + 768 + h * 64;
    float ss = 0.f;
#pragma unroll
    for (int vb = 0; vb < 2; ++vb)
#pragma unroll
        for (int q = 0; q < 4; ++q) { const int v = 32 * vb + 8 * q + 4 * hh; const uint2 w = *(const uint2*)(yrow + v);
            acc[vb][4 * q] += bf2f((bf16)(w.x & 0xffff)); acc[vb][4 * q + 1] += bf2f((bf16)(w.x >> 16)); acc[vb][4 * q + 2] += bf2f((bf16)(w.y & 0xffff)); acc[vb][4 * q + 3] += bf2f((bf16)(w.y >> 16));
#pragma unroll
            for (int e = 0; e < 4; ++e) ss += acc[vb][4 * q + e] * acc[vb][4 * q + e]; }
    ss += __shfl_xor(ss, 32);
    const float rstd = rsqf_(ss * (1.0f / 64.0f) + 1e-6f);
#pragma unroll
    for (int vb = 0; vb < 2; ++vb)
#pragma unroll
        for (int q = 0; q < 4; ++q) { const int v = 32 * vb + 8 * q + 4 * hh; const uint2 zw = *(const uint2*)(zrow + v); float o[4];
            const float z4[4] = {bf2f((bf16)(zw.x & 0xffff)), bf2f((bf16)(zw.x >> 16)), bf2f((bf16)(zw.y & 0xffff)), bf2f((bf16)(zw.y >> 16))};
#pragma unroll
            for (int e = 0; e < 4; ++e) o[e] = acc[vb][4 * q + e] * rstd * ng[v + e] * siluf_(z4[e]);
            uint2 w; w.x = pk2(o[0], o[1]); w.y = pk2(o[2], o[3]); if (do_store) *(uint2*)(yrow + v) = w; }
    LDS_SYNC();
}
constexpr int SGS = 136;
__device__ __forceinline__ void sgu_m3(const Params& P, int l, int ci, LAS unsigned char* lds, int tid) {
    const bf16* cols = (const bf16*)(P.ws + WS_COLS); bf16* Y = (bf16*)(P.ws + WS_Y);
    LAS bf16* VlT = (LAS bf16*)lds;
    LAS bf16* Wt = VlT + 256 * SGS;
    const int lane = tid & 63, wv = __builtin_amdgcn_readfirstlane(tid >> 6), half = ci & 1, tbase = (ci >> 1) * 128, ntok = half ? 128 : 64;
    const float* lg = P.in[I_SLG] + l * 256; const float* lb = P.in[I_SLB] + l * 256;
    const float* ws_ = P.in[I_SWS] + (size_t)l * 4 * 128 * 128; const float* bs_ = P.in[I_SBS] + l * 4 * 128;
    { const f32x4 g4 = *(const f32x4*)(lg + lane * 4), b4 = *(const f32x4*)(lb + lane * 4);
#pragma unroll 1
      for (int tb8 = 0; tb8 < ntok / 8; tb8 += 8) { uint2 raw[8];
#pragma unroll
        for (int i = 0; i < 8; ++i) raw[i] = *(const uint2*)(cols + (size_t)(tbase + wv + 8 * (tb8 + i)) * NPAD + C_SGU + 256 + lane * 4);
#pragma unroll
        for (int i = 0; i < 8; ++i) { const int t = wv + 8 * (tb8 + i); float v[4]; float s = 0.f;
            v[0] = geluf_(bf2f((bf16)(raw[i].x & 0xffff))); v[1] = geluf_(bf2f((bf16)(raw[i].x >> 16))); v[2] = geluf_(bf2f((bf16)(raw[i].y & 0xffff))); v[3] = geluf_(bf2f((bf16)(raw[i].y >> 16)));
            s = (v[0] + v[1]) + (v[2] + v[3]);
            const float mean = wave_sum(s) * (1.0f / 256.0f); float q = 0.f;
#pragma unroll
            for (int e = 0; e < 4; ++e) { v[e] -= mean; q += v[e] * v[e]; }
            const float rstd = rsqf_(wave_sum(q) * (1.0f / 256.0f) + 1e-5f);
#pragma unroll
            for (int e = 0; e < 4; ++e) VlT[(lane * 4 + e) * SGS + t] = (bf16)f2bf(v[e] * rstd * g4[e] + b4[e]); } } }
    { const int n4 = ntok / 4;
#pragma unroll 4
      for (int idx = tid; idx < 4 * 64 * n4; idx += NT) { const int s4 = idx % n4, row = idx / n4, g = row >> 6, t = row & 63, ta = 64 * half + t;
        const f32x4 w = *(const f32x4*)(ws_ + ((size_t)g * 128 + ta) * 128 + 4 * s4);
        u32x2 o; o.x = pk2(4 * s4 <= ta ? w[0] : 0.f, 4 * s4 + 1 <= ta ? w[1] : 0.f); o.y = pk2(4 * s4 + 2 <= ta ? w[2] : 0.f, 4 * s4 + 3 <= ta ? w[3] : 0.f);
        *(LAS u32x2*)(Wt + (g * 64 + t) * SGS + 4 * s4) = o; } }
    LDS_SYNC();
#pragma unroll 1
    for (int jb = wv; jb < 16; jb += 8) { const int g = jb >> 2, tb = (jb >> 1) & 1, cb = jb & 1; const int c = lane & 31, hh = lane >> 5;
        const int KT = 4 * half + 2 * tb + 2;
        f32x16 acc = zero16();
        const LAS bf16* Ar = Wt + (g * 64 + tb * 32 + c) * SGS + hh * 8; const LAS bf16* Br = VlT + (g * 64 + cb * 32 + c) * SGS + hh * 8;
#pragma unroll 2
        for (int kk = 0; kk < KT; ++kk) acc = __builtin_amdgcn_mfma_f32_32x32x16_bf16(*(const LAS bf16x8*)(Ar + kk * 16), *(const LAS bf16x8*)(Br + kk * 16), acc, 0, 0, 0);
        const int ch = g * 64 + cb * 32 + c; float uu[16], bb[16];
#pragma unroll
        for (int q = 0; q < 16; ++q) { const int ta = 64 * half + 32 * tb + acc_i(q, hh); uu[q] = ldcol(cols, tbase + ta, C_SGU + ch); bb[q] = bs_[g * 128 + ta]; }
#pragma unroll
        for (int q = 0; q < 16; ++q) { const int ta = 64 * half + 32 * tb + acc_i(q, hh); Y[(size_t)(tbase + ta) * 1024 + 768 + ch] = (bf16)f2bf(geluf_(uu[q]) * (acc[q] + bb[q])); } }
    LDS_SYNC();
}
#ifndef REP_P0
#define REP_P0 1
#endif
#ifndef REP_FN
#define REP_FN 1
#endif
#ifndef REP_G2
#define REP_G2 1
#endif
#ifndef REP_DN
#define REP_DN 1
#endif
#ifndef REP_M2
#define REP_M2 1
#endif
#ifndef REP_M3
#define REP_M3 1
#endif
#ifndef REP_RW
#define REP_RW 1
#endif
#ifndef REP_GD
#define REP_GD 1
#endif
#ifndef REP_M1
#define REP_M1 1
#endif
#ifndef REP_SGU
#define REP_SGU 1
#endif
#ifndef REP_G1
#define REP_G1 1
#endif
#ifndef REP_UP
#define REP_UP 1
#endif
#define GRID_SYNC() xcd_barrier(xbar)
__global__ void __launch_bounds__(NT, 2) fwd_kernel(Params P) {
    extern __shared__ __attribute__((aligned(16))) unsigned char lds_raw[];
    LAS unsigned char* ldsl = (LAS unsigned char*)lds_raw;
    const int G = gridDim.x;
    if (threadIdx.x < 16) ((LAS unsigned*)(ldsl + LDS_BYTES - 64))[threadIdx.x] = 0u;
    __syncthreads();
    const XcdBarrier xbar = xcd_barrier_post((unsigned*)(P.ws + WS_BAR), (volatile LAS unsigned*)(ldsl + LDS_BYTES - 64));
#define PHASE_TID() int tid = threadIdx.x; asm volatile("" : "+v"(tid)); const int lane = tid & 63, wave = __builtin_amdgcn_readfirstlane(tid >> 6); const int gw = blockIdx.x * NWAVES + wave, NGW = G * NWAVES; (void)lane; (void)gw; (void)NGW
    {
        PHASE_TID();
        for (int rep_ = 0; rep_ < REP_P0; ++rep_) {
        prologue_weights(P, 0, 1, (float*)lds_raw, gw, NGW, wave, lane);
        prologue_lora(P, blockIdx.x * NT + tid, G * NT);
        prologue_rows(P, gw, NGW, lane); }
    }
    GRID_SYNC();
#pragma unroll 1
    for (int l_ = 0; l_ < DEPTH; ++l_) {
        int l = l_; asm volatile("" : "+s"(l));
        bf16* XB = (bf16*)(P.ws + WS_XB); bf16* YB = (bf16*)(P.ws + WS_Y); bf16* HB = (bf16*)(P.ws + WS_H); bf16* COLS = (bf16*)(P.ws + WS_COLS); float* SSQ = (float*)(P.ws + WS_SSQ);
        const unsigned char* wb = P.ws + WS_W;
        {
            pg8::Gemm g{XB, (const bf16*)(wb + W_IN), T, NPAD, D}; pg8::StaticOrder S; S.init(T, NPAD, G, (int)blockIdx.x);
            pg8::EpiScaleBf16<0> E{COLS, NPAD, SSQ};
            for (int rep_ = 0; rep_ < REP_G1; ++rep_) pg8::gemm_phase<pg8::EpiScaleBf16<0>, pg8::StaticOrder, true, true>(ldsl, g, S, E);
        }
        GRID_SYNC();
        {
            PHASE_TID();
            for (int rep_ = 0; rep_ < REP_M1; ++rep_)
            for (int ci = blockIdx.x; ci < T / 64; ci += G) {
#ifndef NO_RWKV1
                for (int r2_ = 0; r2_ < REP_RW; ++r2_) rwkv_m1(P, l, ci, ldsl, tid);
#endif
#ifndef NO_GDN1
                for (int r2_ = 0; r2_ < REP_GD; ++r2_) gdn_m1(P, l, ci, ldsl, tid);
#endif
#ifndef NO_GLA1
                gla_m1(P, l, ci, ldsl, tid);
#endif
            }
        }
        GRID_SYNC();
        {
            PHASE_TID();
            const int b = blockIdx.x, seg = b >> 4, mh = (b >> 1) & 7, hh_ = mh & 3; const bool gdn = mh >= 4;
            const bf16* XP = (const bf16*)(P.ws + (gdn ? WS_DP : WS_RP)) + ((size_t)seg * 64 + hh_) * 4096; bf16* XQ = (bf16*)(P.ws + (gdn ? WS_DQ : WS_RQ)) + ((size_t)seg * 64 + hh_) * 4096;
            const float* XG = (const float*)(P.ws + WS_XG) + (gdn ? 1024 * 64 : 0) + ((size_t)seg * 64 + hh_) * 64;
            bf16* SN = (bf16*)(P.ws + WS_SN) + ((size_t)seg * 8 + mh) * 4096; bf16* SQ = (bf16*)(P.ws + WS_SQ) + ((size_t)seg * 8 + mh) * 4096; float* SG = (float*)(P.ws + WS_SG) + ((size_t)seg * 8 + mh) * 64;
            if (b & 1) dplr_chain<true, false>(XP, XQ, XG, 4 * 4096, 4 * 64, 16, nullptr, SN, SG, ldsl, tid);
            else dplr_chain<false, false>(XP, XQ, XG, 4 * 4096, 4 * 64, 16, nullptr, SQ, nullptr, ldsl, tid);
            gla_m2_A(P, b >> 4, (b & 15) * NT + tid);
        }
        GRID_SYNC();
        {
            PHASE_TID();
            const int b = blockIdx.x;
            if (b < 8) dplr_chain<false, true>((const bf16*)(P.ws + WS_SN) + (size_t)b * 4096, (bf16*)(P.ws + WS_SQ) + (size_t)b * 4096, (const float*)(P.ws + WS_SG) + b * 64, 8 * 4096, 8 * 64, 16, nullptr, nullptr, nullptr, ldsl, tid);
            else if (b < 24) gla_m2_B(P, (b - 8) * NT + tid);
            else prologue_weights(P, l, 12, (float*)lds_raw, (b - 24) * NWAVES + wave, (G - 24) * NWAVES, wave, lane);
        }
        GRID_SYNC();
        {
            PHASE_TID();
            const int b = blockIdx.x;
            if (b < 128) { const int seg = b >> 3, mh = b & 7, hh_ = mh & 3; const bool gdn = mh >= 4;
                const bf16* XP = (const bf16*)(P.ws + (gdn ? WS_DP : WS_RP)) + ((size_t)seg * 64 + hh_) * 4096; bf16* XQ = (bf16*)(P.ws + (gdn ? WS_DQ : WS_RQ)) + ((size_t)seg * 64 + hh_) * 4096;
                const float* XG = (const float*)(P.ws + WS_XG) + (gdn ? 1024 * 64 : 0) + ((size_t)seg * 64 + hh_) * 64;
                dplr_chain<false, true>(XP, XQ, XG, 4 * 4096, 4 * 64, 16, (const bf16*)(P.ws + WS_SQ) + ((size_t)seg * 8 + mh) * 4096, nullptr, nullptr, ldsl, tid); }
            else { const int gw2 = (b - 128) * NWAVES + wave, ngw2 = (G - 128) * NWAVES;
                prologue_weights(P, l, 2, (float*)lds_raw, gw2, ngw2, wave, lane);
                if (l == 0) prologue_weights(P, 1, 1, (float*)lds_raw, gw2, ngw2, wave, lane); }
            gla_m2_C(P, b >> 4, (b & 15) * NT + tid);
        }
        GRID_SYNC();
        {
            PHASE_TID();
            for (int ci = blockIdx.x; ci < T / 64; ci += G) {
#ifndef NO_M3
                for (int rep_ = REP_M3 - 1; rep_ >= 0; --rep_) { int sti = (rep_ == 0) ? 1 : 0; asm volatile("" : "+v"(sti)); const bool st = sti != 0; rwkv_m3(P, l, ci, ldsl, tid, st); gdn_m3(P, l, ci, ldsl, tid, st); gla_m3(P, l, ci, ldsl, tid, st); }
                for (int rep_ = 0; rep_ < REP_SGU; ++rep_) sgu_m3(P, l, ci, ldsl, tid);
#endif
            }
        }
        GRID_SYNC();
        {
            pg8::Gemm g{YB, (const bf16*)(wb + W_OUT), T, D, D}; pg8::StaticOrder S; S.init(T, D, G, (int)blockIdx.x);
            for (int rep_ = REP_G2 - 1; rep_ >= 0; --rep_) { int dry = rep_; asm volatile("" : "+v"(dry));
            pg8::EpiResid E{l == 0 ? P.in[I_X] : (const float*)P.out, P.out, XB, SSQ, dry};
            pg8::gemm_phase<pg8::EpiResid, pg8::StaticOrder, true, true>(ldsl, g, S, E); }
        }
        GRID_SYNC();
        {
            pg8::Gemm g{XB, (const bf16*)(wb + W_UP), T, FF, D}; pg8::StaticOrder S; S.init(T, FF, G, (int)blockIdx.x);
            pg8::EpiScaleBf16<2> E{HB, FF, SSQ};
            for (int rep_ = 0; rep_ < REP_UP; ++rep_) pg8::gemm_phase<pg8::EpiScaleBf16<2>, pg8::StaticOrder, true, true>(ldsl, g, S, E);
        }
        GRID_SYNC();
        {
            pg8::Gemm g{HB, (const bf16*)(wb + W_DN), T, D, FF}; pg8::StaticOrder S; S.init(T, D, G, (int)blockIdx.x);
            for (int rep_ = REP_DN - 1; rep_ >= 0; --rep_) { int dry = rep_; asm volatile("" : "+v"(dry));
            pg8::EpiResid E{(const float*)P.out, P.out, XB, SSQ, dry};
            pg8::gemm_phase<pg8::EpiResid, pg8::StaticOrder, true, true>(ldsl, g, S, E); }
        }
        GRID_SYNC();
    }
    { PHASE_TID(); for (int rep_ = REP_FN - 1; rep_ >= 0; --rep_) { int dry = rep_; asm volatile("" : "+v"(dry)); final_norm(P, gw, NGW, lane, dry); } }
    if (P.ws == nullptr) cg::this_grid().sync();
}

extern "C" void kernel_launch(void* const* d_in, const int* in_sizes, int n_in, void* d_out, int out_size, void* d_ws, size_t ws_size, hipStream_t stream) {
    static int grid_blocks = 0;
    if (!grid_blocks) {
        int dev = 0, cus = 0, per_cu = 0;
        if (n_in != 33 || out_size != T * D || ws_size < WS_END) { fprintf(stderr, "kernel_launch: unexpected shapes n_in %d out %d ws %zu\n", n_in, out_size, ws_size); grid_blocks = -1; return; }
        (void)hipGetDevice(&dev);
        (void)hipDeviceGetAttribute(&cus, hipDeviceAttributeMultiprocessorCount, dev);
        (void)hipFuncSetAttribute((const void*)fwd_kernel, hipFuncAttributeMaxDynamicSharedMemorySize, LDS_BYTES);
        (void)hipOccupancyMaxActiveBlocksPerMultiprocessor(&per_cu, (const void*)fwd_kernel, NT, LDS_BYTES);
        if (per_cu < 1) fprintf(stderr, "kernel_launch: occupancy query says %d blocks/CU\n", per_cu);
        grid_blocks = cus;
        (void)hipGetLastError();
    }
    if (grid_blocks < 0) return;
    (void)hipMemsetAsync((char*)d_ws + WS_BAR, 0, 16384, stream);
    Params p{};
    for (int i = 0; i < 33; ++i) p.in[i] = (const float*)d_in[i];
    p.out = (float*)d_out; p.ws = (unsigned char*)d_ws;
    void* args[] = {&p};
    hipError_t e = hipLaunchCooperativeKernel((void*)fwd_kernel, dim3(grid_blocks), dim3(NT), args, LDS_BYTES, stream);
    if (e != hipSuccess) fprintf(stderr, "cooperative launch failed: %s (grid %d)\n", hipGetErrorString(e), grid_blocks);
}
```

```cpp
#include <hip/hip_runtime.h>
#include <hip/hip_cooperative_groups.h>
#include <cstdio>
#include <cstdint>
namespace cg = cooperative_groups;
namespace pg8 {
#define PG8_LAS __attribute__((address_space(3)))
typedef unsigned short bf16_t;
typedef short bf16x8 __attribute__((ext_vector_type(8)));
typedef float f32x4 __attribute__((ext_vector_type(4)));
typedef unsigned u32x4 __attribute__((ext_vector_type(4)));
constexpr int BM = 256, BK = 64, HALF = 128, HTB = HALF * BK * 2  , STAGE_BYTES = 8 * HTB, NXCD = 8, WGM = 8;

__host__ __device__ __forceinline__ int lds_byte(int r, int c) { const int st = (r >> 4) * 2 + (c >> 5), rr = r & 15, cc = c & 31, ob = rr * 64 + cc * 2; return st * 1024 + (ob ^ (((ob >> 9) & 1) << 5)); }
__host__ __device__ __forceinline__ void stage_rc(int b, int& R, int& C) { const int st = b / 1024, sb = b % 1024, swz = sb ^ (((sb >> 9) & 1) << 5); R = (st >> 1) * 16 + swz / 64; C = (st & 1) * 32 + (swz % 64) / 2; }
__host__ __device__ __forceinline__ int perm32(int rho) { const int n = rho >> 4, i = rho & 15; return 8 * (i >> 2) + 4 * n + (i & 3); }

struct Unit { int pm, pn; };
struct Gemm { const bf16_t* A; const bf16_t* Bt; int M, N, K; };

struct StaticOrder {
    int nM, nN, nwg, G, c;
    __host__ __device__ void init(int M, int N, int G_, int c_) { nM = M / BM; nN = N / BM; nwg = nM * nN; G = G_; c = c_; }
    __host__ __device__ bool next(int i, Unit& u) const {
        const long L = (long)i * G + c; if (L >= nwg) return false;
        int wgid = (int)L; { const int q = nwg / NXCD, r = nwg % NXCD, xcd = wgid % NXCD, off = wgid / NXCD; wgid = (xcd < r ? xcd * (q + 1) : r * (q + 1) + (xcd - r) * q) + off; }
        const int nig = WGM * nN, gid = wgid / nig, fm = gid * WGM, gsz = (nM - fm) < WGM ? (nM - fm) : WGM;
        u.pm = fm + ((wgid % nig) % gsz); u.pn = (wgid % nig) / gsz; return true;
    }
    __device__ __forceinline__ void a_ready(const Unit&) const {}
    __device__ __forceinline__ void done(const Unit&) const {}
};

__device__ __forceinline__ unsigned cvt_pk_bf16(float lo, float hi) { unsigned r; asm volatile("v_cvt_pk_bf16_f32 %0, %1, %2" : "=v"(r) : "v"(lo), "v"(hi)); return r; }
typedef float f32x2 __attribute__((ext_vector_type(2)));
__device__ __forceinline__ float row_rstd16(const float* ssq, int row) {
    const f32x4* p = (const f32x4*)(ssq + (size_t)row * 16);
    const f32x4 a = p[0], b = p[1], c = p[2], d = p[3];
    const float s = ((a[0] + a[1]) + (a[2] + a[3])) + ((b[0] + b[1]) + (b[2] + b[3])) + ((c[0] + c[1]) + (c[2] + c[3])) + ((d[0] + d[1]) + (d[2] + d[3]));
    return 1.0f / sqrtf(s * (1.0f / 1024.0f) + 1e-6f);
}
template <int ACT> struct EpiScaleBf16 {
    static constexpr bool PERM = true, AFTER_DRAIN = false;
    bf16_t* O; int ldc; const float* ssq;
    __device__ __forceinline__ void operator()(const f32x4 (&acc)[2][2][4][2], const Unit& u, int wr, int wc, int fr, int fq) const {
        const int row0 = u.pm * BM + wr * 64 + fr; const int col0 = u.pn * BM + wc * 32 + 8 * fq;
#pragma unroll
        for (int ai = 0; ai < 2; ++ai)
#pragma unroll
            for (int m = 0; m < 4; ++m) { const int row = row0 + ai * HALF + m * 16; const float sc = row_rstd16(ssq, row); bf16_t* rowp = O + (size_t)row * ldc + col0;
#pragma unroll
                for (int bj = 0; bj < 2; ++bj) { f32x4 v0 = acc[ai][bj][m][0] * sc, v1 = acc[ai][bj][m][1] * sc;
                    if (ACT == 2) {
#pragma unroll
                        for (int e = 0; e < 4; ++e) { const float a0 = v0[e] > 0.f ? v0[e] : 0.f, a1 = v1[e] > 0.f ? v1[e] : 0.f; v0[e] = a0 * a0; v1[e] = a1 * a1; } }
                    u32x4 w; w.x = cvt_pk_bf16(v0[0], v0[1]); w.y = cvt_pk_bf16(v0[2], v0[3]); w.z = cvt_pk_bf16(v1[0], v1[1]); w.w = cvt_pk_bf16(v1[2], v1[3]);
                    *(u32x4*)(rowp + bj * HALF) = w; } }
    }
};
struct EpiResid {
    static constexpr bool PERM = false, AFTER_DRAIN = false;
    const float* base; float* out; bf16_t* xb; float* ssq; int dry;
    __device__ __forceinline__ void operator()(const f32x4 (&acc)[2][2][4][2], const Unit& u, int wr, int wc, int fr, int fq) const {
        typedef unsigned u32x2v __attribute__((ext_vector_type(2)));
        const int row0 = u.pm * BM + wr * 64 + fr; const int col0 = u.pn * BM + wc * 32 + 4 * fq;
#pragma unroll
        for (int ai = 0; ai < 2; ++ai)
#pragma unroll
            for (int m = 0; m < 4; ++m) { const int row = row0 + ai * HALF + m * 16; const size_t off = (size_t)row * 1024 + col0; float s = 0.f;
#pragma unroll
                for (int bj = 0; bj < 2; ++bj)
#pragma unroll
                    for (int n = 0; n < 2; ++n) { const f32x4 bs = *(const f32x4*)(base + off + bj * HALF + n * 16); const f32x4 o = bs + acc[ai][bj][m][n];
                        if (!dry) *(f32x4*)(out + off + bj * HALF + n * 16) = o; s += (o[0] * o[0] + o[1] * o[1]) + (o[2] * o[2] + o[3] * o[3]);
                        u32x2v w; w.x = cvt_pk_bf16(o[0], o[1]); w.y = cvt_pk_bf16(o[2], o[3]); if (!dry) *(u32x2v*)(xb + off + bj * HALF + n * 16) = w; }
                s += __shfl_xor(s, 16); s += __shfl_xor(s, 32);
                if (fq == 0 && !dry) ssq[(size_t)row * 16 + u.pn * 4 + wc] = s; }
    }
};
template <class Epi, class Sched, bool ALIGN_EPI = false, bool SP2 = false>
__device__ __forceinline__ void gemm_phase(PG8_LAS unsigned char* lds, const Gemm g, const Sched& S, const Epi& E) {
    int tid_o = threadIdx.x; asm volatile("" : "+v"(tid_o));
    const int tid = tid_o, wid = __builtin_amdgcn_readfirstlane(tid >> 6), lane = tid & 63, wr = wid >> 2, wc = wid & 3, fr = lane & 15, fq = lane >> 4;
    const int K = g.K, nt = K / BK;
    unsigned voffA[2], voffB[2];
#pragma unroll
    for (int i = 0; i < 2; ++i) { int R, C; stage_rc(tid * 16 + i * 8192, R, C); const int Rb = Epi::PERM ? ((R & ~31) + perm32(R & 31)) : R;
        voffA[i] = (unsigned)(R * K + C) * 2u; voffB[i] = (unsigned)(Rb * K + C) * 2u; }
    const size_t kstep = (size_t)(BK * 2);
    const size_t hstep = (size_t)HALF * K * 2;
    const size_t tstep = 2 * hstep;
    const unsigned ldsw = (unsigned)wid * 1024u;
    const int aoff = lds_byte(wr * 64 + fr, fq * 8), boff = lds_byte(wc * 32 + fr, fq * 8);
#define PG8_SA(b, h) (((b) * 2 + (h)) * HTB)
#define PG8_SB(b, h) ((4 + (b) * 2 + (h)) * HTB)
#define PG8_STAGE(bufoff, gbase, voff) do { _Pragma("unroll") for (int _i = 0; _i < 2; ++_i) \
        __builtin_amdgcn_global_load_lds((const unsigned*)((const char*)(gbase) + (voff)[_i]), (PG8_LAS unsigned*)(lds + (bufoff) + ldsw + _i * 8192), 16, 0, 0); } while (0)
#define PG8_LDA(dst, b, h) do { _Pragma("unroll") for (int m = 0; m < 4; ++m) _Pragma("unroll") for (int k = 0; k < 2; ++k) dst[m][k] = *(const PG8_LAS bf16x8*)(lds + PG8_SA(b, h) + aoff + m * 2048 + k * 1024); } while (0)
#define PG8_LDB(dst, b, h) do { _Pragma("unroll") for (int n = 0; n < 2; ++n) _Pragma("unroll") for (int k = 0; k < 2; ++k) dst[n][k] = *(const PG8_LAS bf16x8*)(lds + PG8_SB(b, h) + boff + n * 2048 + k * 1024); } while (0)
#define PG8_MMA(ai, bj, At, Bt) do { __builtin_amdgcn_s_setprio(1); _Pragma("unroll") for (int m = 0; m < 4; ++m) _Pragma("unroll") for (int n = 0; n < 2; ++n) _Pragma("unroll") for (int k = 0; k < 2; ++k) \
        acc[ai][bj][m][n] = __builtin_amdgcn_mfma_f32_16x16x32_bf16(Bt[n][k], At[m][k], acc[ai][bj][m][n], 0, 0, 0); __builtin_amdgcn_s_setprio(0); } while (0)
#define PG8_WAIT_V(n) asm volatile("s_waitcnt vmcnt(" #n ")" ::: "memory")
#define PG8_WAIT_L(n) asm volatile("s_waitcnt lgkmcnt(" #n ")" ::: "memory")
#define PG8_BAR __builtin_amdgcn_s_barrier()
#define PG8_SCHED __builtin_amdgcn_sched_barrier(0)
    Unit cur, nxt; int ui = 0;
    if (!S.next(0, cur)) return;
    f32x4 acc[2][2][4][2];
#pragma unroll
    for (int a = 0; a < 2; ++a)
#pragma unroll
        for (int b = 0; b < 2; ++b)
#pragma unroll
            for (int m = 0; m < 4; ++m)
#pragma unroll
                for (int n = 0; n < 2; ++n) acc[a][b][m][n] = (f32x4){0.f, 0.f, 0.f, 0.f};
    bf16x8 At[4][2], B0[2][2], B1[2][2];
    const char* cA = (const char*)g.A + (size_t)cur.pm * tstep; const char* cB = (const char*)g.Bt + (size_t)cur.pn * tstep;
    S.a_ready(cur);
    if constexpr (SP2) {
        PG8_STAGE(PG8_SB(0, 0), cB, voffB); PG8_STAGE(PG8_SB(0, 1), cB + hstep, voffB); PG8_STAGE(PG8_SA(0, 0), cA, voffA); PG8_STAGE(PG8_SA(0, 1), cA + hstep, voffA);
        if (wr == 1) PG8_BAR;
        PG8_WAIT_V(2); PG8_BAR;
        PG8_STAGE(PG8_SB(1, 0), cB + kstep, voffB); PG8_STAGE(PG8_SA(1, 0), cA + kstep, voffA); PG8_STAGE(PG8_SB(1, 1), cB + hstep + kstep, voffB);
        PG8_WAIT_V(6); PG8_BAR;
    } else {
        PG8_STAGE(PG8_SB(0, 0), cB, voffB); PG8_STAGE(PG8_SA(0, 0), cA, voffA); PG8_STAGE(PG8_SB(0, 1), cB + hstep, voffB); PG8_STAGE(PG8_SA(0, 1), cA + hstep, voffA);
        if (wr == 1) PG8_BAR;
        PG8_WAIT_V(4); PG8_BAR;
        PG8_STAGE(PG8_SB(1, 0), cB + kstep, voffB); PG8_STAGE(PG8_SA(1, 0), cA + kstep, voffA); PG8_STAGE(PG8_SB(1, 1), cB + hstep + kstep, voffB);
        PG8_WAIT_V(6); PG8_BAR;
    }
    for (;;) {
        const bool has_next = S.next(ui + 1, nxt);
        const char* nA = has_next ? (const char*)g.A + (size_t)nxt.pm * tstep : cA; const char* nB = has_next ? (const char*)g.Bt + (size_t)nxt.pn * tstep : cB;
        for (int t = 0; t < nt; t += 2) {
            const bool last = (t == nt - 2);
            const char* a1 = cA + (size_t)(t + 1) * kstep;
            const char* a2 = last ? nA : cA + (size_t)(t + 2) * kstep; const char* b2 = last ? nB : cB + (size_t)(t + 2) * kstep;
            const char* a3 = a2 + kstep; const char* b3 = b2 + kstep;
            if (last && has_next) S.a_ready(nxt);
            if constexpr (SP2) {
            PG8_LDB(B0, 0, 0); PG8_LDB(B1, 0, 1); PG8_SCHED; PG8_LDA(At, 0, 0); PG8_STAGE(PG8_SA(1, 1), a1 + hstep, voffA);
            PG8_WAIT_V(8); PG8_WAIT_L(0); PG8_BAR; PG8_MMA(0, 0, At, B0); PG8_MMA(0, 1, At, B1); PG8_BAR; PG8_SCHED;
            PG8_LDA(At, 0, 1); PG8_STAGE(PG8_SB(0, 0), b2, voffB); PG8_STAGE(PG8_SB(0, 1), b2 + hstep, voffB); PG8_STAGE(PG8_SA(0, 0), a2, voffA);
            PG8_WAIT_V(8); PG8_WAIT_L(0); PG8_BAR; PG8_MMA(1, 0, At, B0); PG8_MMA(1, 1, At, B1); PG8_BAR; PG8_SCHED;
            PG8_LDB(B0, 1, 0); PG8_LDB(B1, 1, 1); PG8_SCHED; PG8_LDA(At, 1, 0); PG8_STAGE(PG8_SA(0, 1), a2 + hstep, voffA);
            PG8_WAIT_V(8); PG8_WAIT_L(0); PG8_BAR; PG8_MMA(0, 0, At, B0); PG8_MMA(0, 1, At, B1); PG8_BAR; PG8_SCHED;
            PG8_LDA(At, 1, 1); PG8_STAGE(PG8_SB(1, 0), b3, voffB); PG8_STAGE(PG8_SB(1, 1), b3 + hstep, voffB); PG8_STAGE(PG8_SA(1, 0), a3, voffA);
            PG8_WAIT_V(8); PG8_WAIT_L(0); PG8_BAR; PG8_MMA(1, 0, At, B0); PG8_MMA(1, 1, At, B1); PG8_BAR; PG8_SCHED;
            } else {
            PG8_LDB(B0, 0, 0); PG8_SCHED; PG8_LDA(At, 0, 0); PG8_STAGE(PG8_SA(1, 1), a1 + hstep, voffA);
            PG8_WAIT_L(8); PG8_BAR; PG8_WAIT_L(0); PG8_MMA(0, 0, At, B0); PG8_BAR; PG8_SCHED;
            PG8_LDB(B1, 0, 1); PG8_STAGE(PG8_SB(0, 0), b2, voffB);
            PG8_BAR; PG8_WAIT_L(0); PG8_MMA(0, 1, At, B1); PG8_BAR;
            PG8_LDA(At, 0, 1); PG8_STAGE(PG8_SA(0, 0), a2, voffA);
            PG8_BAR; PG8_WAIT_L(0); PG8_MMA(1, 0, At, B0); PG8_BAR; PG8_SCHED;
            PG8_STAGE(PG8_SB(0, 1), b2 + hstep, voffB);
            PG8_WAIT_V(6); PG8_BAR; PG8_MMA(1, 1, At, B1); PG8_BAR;
            PG8_LDB(B0, 1, 0); PG8_SCHED; PG8_LDA(At, 1, 0); PG8_STAGE(PG8_SA(0, 1), a2 + hstep, voffA);
            PG8_WAIT_L(8); PG8_BAR; PG8_WAIT_L(0); PG8_MMA(0, 0, At, B0); PG8_BAR; PG8_SCHED;
            PG8_LDB(B1, 1, 1); PG8_STAGE(PG8_SB(1, 0), b3, voffB);
            PG8_BAR; PG8_WAIT_L(0); PG8_MMA(0, 1, At, B1); PG8_BAR;
            PG8_LDA(At, 1, 1); PG8_STAGE(PG8_SA(1, 0), a3, voffA);
            PG8_BAR; PG8_WAIT_L(0); PG8_MMA(1, 0, At, B0); PG8_BAR; PG8_SCHED;
            PG8_STAGE(PG8_SB(1, 1), b3 + hstep, voffB);
            PG8_WAIT_V(6); PG8_BAR; PG8_MMA(1, 1, At, B1); PG8_BAR;
            }
        }
        if constexpr (ALIGN_EPI) { if (wr == 0) PG8_BAR; }
        if constexpr (!Epi::AFTER_DRAIN) { E(acc, cur, wr, wc, fr, fq); S.done(cur); }
        if (!has_next) break;
#pragma unroll
        for (int a = 0; a < 2; ++a)
#pragma unroll
            for (int b = 0; b < 2; ++b)
#pragma unroll
                for (int m = 0; m < 4; ++m)
#pragma unroll
                    for (int n = 0; n < 2; ++n) acc[a][b][m][n] = (f32x4){0.f, 0.f, 0.f, 0.f};
        cur = nxt; cA = nA; cB = nB; ++ui;
        if constexpr (ALIGN_EPI) { if (wr == 1) PG8_BAR; }
    }
    PG8_WAIT_V(0);
    if constexpr (!ALIGN_EPI) { if (wr == 0) PG8_BAR; }
    PG8_BAR;
    if constexpr (Epi::AFTER_DRAIN) { E.fused(acc, cur, wr, wc, fr, fq, lds, wid, lane); S.done(cur); }
#undef PG8_SA
#undef PG8_SB
#undef PG8_STAGE
#undef PG8_LDA
#undef PG8_LDB
#undef PG8_MMA
#undef PG8_WAIT_V
#undef PG8_WAIT_L
#undef PG8_BAR
#undef PG8_SCHED
}
}
constexpr int T = 16384, D = 1024, FF = 4096, DEPTH = 2;
constexpr int NIN = 3352, NPAD = 3584;
constexpr int C_RWKV = 0, C_GDN = 1024, C_GLA = 2056, C_SGU = 2840, C_VRES = 3352;
constexpr int NT = 512, NWAVES = 8;
constexpr int LDS_BYTES = 147456;
typedef unsigned short bf16;
typedef float f32x4 __attribute__((ext_vector_type(4)));
typedef unsigned v4u __attribute__((ext_vector_type(4)));
#define LAS __attribute__((address_space(3)))

constexpr size_t MiB = 1u << 20;
constexpr size_t WS_BAR = 0;
constexpr size_t WS_SSQ = 1 * MiB;
constexpr size_t WS_GAL = 2 * MiB;
constexpr size_t WS_XG = 2 * MiB + 256 * 1024;
constexpr size_t WS_W = 3 * MiB;
constexpr size_t W_LAYER = 0, W_IN = 0, W_OUT = 7 * MiB, W_UP = 9 * MiB, W_DN = 17 * MiB;
constexpr size_t WS_XB = 30 * MiB;
constexpr size_t WS_Y = 62 * MiB;
constexpr size_t WS_H = 94 * MiB;
constexpr size_t WS_COLS = 94 * MiB;
constexpr size_t WS_VF = 222 * MiB;
constexpr size_t WS_RP = 30 * MiB, WS_RQ = 38 * MiB, WS_RR = 46 * MiB, WS_RBV = 54 * MiB;
constexpr size_t WS_DP = 206 * MiB, WS_DQ = 214 * MiB, WS_DR = 230 * MiB;
constexpr size_t WS_GKV = 238 * MiB, WS_GQI = 246 * MiB;
constexpr size_t WS_LORA = 250 * MiB;
constexpr int LORA_W = 0, LORA_A = 256 * 64, LORA_G = 2 * 256 * 64, LORA_V = 2 * 256 * 64 + 256 * 128, LORA_LAYER = LORA_V + 256 * 32;
constexpr size_t WS_SN = 251 * MiB, WS_SQ = 252 * MiB, WS_SG = 253 * MiB, WS_GSB = 253 * MiB + 64 * 1024, WS_GSA = 254 * MiB;
constexpr size_t WS_END = 255 * MiB;

typedef float f32x2_t __attribute__((ext_vector_type(2))); typedef __bf16 bf16x2_t __attribute__((ext_vector_type(2)));
__device__ __forceinline__ unsigned pk2(float lo, float hi) { f32x2_t v = {lo, hi}; bf16x2_t b = __builtin_convertvector(v, bf16x2_t); return __builtin_bit_cast(unsigned, b); }
__device__ __forceinline__ unsigned f2bf(float f) { return pk2(f, f) & 0xffffu; }
__device__ __forceinline__ float bf2f(bf16 b) { return __builtin_bit_cast(float, (unsigned)b << 16); }
__device__ __forceinline__ float wave_sum(float v) {
    v += __builtin_bit_cast(float, __builtin_amdgcn_mov_dpp(__builtin_bit_cast(int, v), 0xB1, 0xF, 0xF, true));
    v += __builtin_bit_cast(float, __builtin_amdgcn_mov_dpp(__builtin_bit_cast(int, v), 0x4E, 0xF, 0xF, true));
    v += __builtin_bit_cast(float, __builtin_amdgcn_mov_dpp(__builtin_bit_cast(int, v), 0x141, 0xF, 0xF, true));
    v += __builtin_bit_cast(float, __builtin_amdgcn_mov_dpp(__builtin_bit_cast(int, v), 0x140, 0xF, 0xF, true));
    v += __shfl_xor(v, 16); v += __shfl_xor(v, 32);
    return v;
}
__device__ __forceinline__ float rcpf_(float x) { return __builtin_amdgcn_rcpf(x); }
__device__ __forceinline__ float rsqf_(float x) { return __builtin_amdgcn_rsqf(x); }
__device__ __forceinline__ float sigmoidf_(float x) { return rcpf_(1.0f + __expf(-x)); }
__device__ __forceinline__ float softplusf_(float x) { return fmaxf(x, 0.f) + __logf(1.0f + __expf(-fabsf(x))); }
__device__ __forceinline__ float siluf_(float x) { return x * sigmoidf_(x); }
__device__ __forceinline__ float tanhf_(float x) { return 1.0f - 2.0f * rcpf_(1.0f + __expf(2.0f * x)); }
__device__ __forceinline__ float geluf_(float x) { const float u = 0.7978845608028654f * (x + 0.044715f * x * x * x); return x * sigmoidf_(2.0f * u); }

struct Params { const float* in[33]; float* out; unsigned char* ws; };
enum { I_X = 0, I_WIN, I_WOUT, I_NMIX, I_NFFN, I_NFIN, I_MU, I_W0, I_WUP, I_A0, I_AUP, I_GUP, I_KK, I_KA, I_RK, I_LNW, I_LNB, I_V0, I_VDOWN, I_VUP,
       I_CONV, I_ALOG, I_DTB, I_GDNG, I_GKUP, I_GKB, I_GLAG, I_SLG, I_SLB, I_SWS, I_SBS, I_FUP, I_FDN };

__device__ __forceinline__ void transpose_item(const float* W, int K, int N, const float* gk, bf16* WT, int row_off, float* scr, int item, int lane) {
    const int nblk = (N + 31) / 32, kb = item / nblk, nb = item % nblk, k0 = 64 * kb, n0 = 32 * nb;
    const bool nok = (n0 + (lane & 31)) < N;
#pragma unroll 8
    for (int i = 0; i < 32; ++i) { const int kk = 2 * i + (lane >> 5); float v = 0.f; if (nok) v = W[(size_t)(k0 + kk) * N + n0 + (lane & 31)]; if (gk) v *= gk[k0 + kk]; scr[kk * 33 + (lane & 31)] = v; }
    __builtin_amdgcn_wave_barrier(); asm volatile("s_waitcnt lgkmcnt(0)" ::: "memory");
    const int c = lane & 7;
#pragma unroll
    for (int j = 0; j < 4; ++j) { const int n = (lane >> 3) + 8 * j; const float* s = scr + (8 * c) * 33 + n;
        v4u o; o.x = pk2(s[0 * 33], s[1 * 33]); o.y = pk2(s[2 * 33], s[3 * 33]); o.z = pk2(s[4 * 33], s[5 * 33]); o.w = pk2(s[6 * 33], s[7 * 33]);
        if (n0 + n < N) *(v4u*)(WT + (size_t)(row_off + n0 + n) * K + k0 + 8 * c) = o; }
    __builtin_amdgcn_wave_barrier(); asm volatile("s_waitcnt lgkmcnt(0)" ::: "memory");
}
__device__ __forceinline__ void prologue_weights(const Params& P, int l, int mask, float* lds, int gw, int NGW, int wave, int lane) {
    float* scr = lds + wave * 4096;
    unsigned char* wb = P.ws + WS_W;
    const int I_in = (mask & 1) ? (D / 64) * ((NIN + 31) / 32) : 0, I_vr = ((mask & 1) && l > 0) ? (D / 64) * 1 : 0, I_out = (mask & 2) ? (D / 64) * (D / 32) : 0, I_up = (mask & 4) ? (D / 64) * (FF / 32) : 0, I_dn = (mask & 8) ? (FF / 64) * (D / 32) : 0;
    const int NITEMS = I_in + I_vr + I_out + I_up + I_dn;
    for (int it = gw; it < NITEMS; it += NGW) {
        int r = it;
        if (r < I_in) { transpose_item(P.in[I_WIN] + (size_t)l * D * NIN, D, NIN, P.in[I_NMIX] + l * D, (bf16*)(wb + W_IN), 0, scr, r, lane); continue; } r -= I_in;
        if (r < I_vr) { transpose_item(P.in[I_VDOWN] + (size_t)(l - 1) * D * 32, D, 32, P.in[I_NMIX] + l * D, (bf16*)(wb + W_IN), NIN, scr, r, lane); continue; } r -= I_vr;
        if (r < I_out) { transpose_item(P.in[I_WOUT] + (size_t)l * D * D, D, D, nullptr, (bf16*)(wb + W_OUT), 0, scr, r, lane); continue; } r -= I_out;
        if (r < I_up) { transpose_item(P.in[I_FUP] + (size_t)l * D * FF, D, FF, P.in[I_NFFN] + l * D, (bf16*)(wb + W_UP), 0, scr, r, lane); continue; } r -= I_up;
        transpose_item(P.in[I_FDN] + (size_t)l * FF * D, FF, D, nullptr, (bf16*)(wb + W_DN), 0, scr, r, lane);
    }
}
__device__ __forceinline__ void prologue_lora(const Params& P, int gtid, int gsz) {
    bf16* dst = (bf16*)(P.ws + WS_LORA);
    for (int idx = gtid; idx < 2 * 288 * 256; idx += gsz) { const int l = idx / (288 * 256), r = idx % (288 * 256), j = r >> 8, c = r & 255; bf16* d = dst + (size_t)l * LORA_LAYER;
        if (j < 64) d[LORA_W + c * 64 + j] = (bf16)f2bf(P.in[I_WUP][((size_t)l * 64 + j) * 256 + c]);
        else if (j < 128) d[LORA_A + c * 64 + j - 64] = (bf16)f2bf(P.in[I_AUP][((size_t)l * 64 + j - 64) * 256 + c]);
        else if (j < 256) d[LORA_G + c * 128 + j - 128] = (bf16)f2bf(P.in[I_GUP][((size_t)l * 128 + j - 128) * 256 + c]);
        else if (l > 0) d[LORA_V + c * 32 + j - 256] = (bf16)f2bf(P.in[I_VUP][((size_t)(l - 1) * 32 + j - 256) * 256 + c]); }
}
__device__ __forceinline__ void prologue_rows(const Params& P, int gw, int NGW, int lane) {
    const float* x = P.in[I_X]; bf16* xb = (bf16*)(P.ws + WS_XB); float* ssq = (float*)(P.ws + WS_SSQ);
    for (int m0 = gw; m0 < T; m0 += 2 * NGW) { f32x4 v[2][4];
#pragma unroll
        for (int r = 0; r < 2; ++r) { const int m = m0 + r * NGW; const f32x4* xr = (const f32x4*)(x + (size_t)(m < T ? m : 0) * D) + lane;
#pragma unroll
            for (int j = 0; j < 4; ++j) v[r][j] = xr[64 * j]; }
#pragma unroll
        for (int r = 0; r < 2; ++r) { const int m = m0 + r * NGW; if (m >= T) break; float s = 0.f;
#pragma unroll
            for (int j = 0; j < 4; ++j) s += (v[r][j][0] * v[r][j][0] + v[r][j][1] * v[r][j][1]) + (v[r][j][2] * v[r][j][2] + v[r][j][3] * v[r][j][3]);
            s = wave_sum(s);
            unsigned long long* o8 = (unsigned long long*)(xb + (size_t)m * D) + lane;
#pragma unroll
            for (int j = 0; j < 4; ++j) o8[64 * j] = (unsigned long long)pk2(v[r][j][0], v[r][j][1]) | ((unsigned long long)pk2(v[r][j][2], v[r][j][3]) << 32);
            if (lane < 16) ssq[(size_t)m * 16 + lane] = (lane == 0) ? s : 0.f; } }
}
__device__ __forceinline__ void final_norm(const Params& P, int gw, int NGW, int lane, int dry = 0) {
    float* x = P.out; const float* ssq = (const float*)(P.ws + WS_SSQ); const f32x4* g4 = (const f32x4*)P.in[I_NFIN] + lane;
    f32x4 g[4];
#pragma unroll
    for (int j = 0; j < 4; ++j) g[j] = g4[64 * j];
    for (int m0 = gw; m0 < T; m0 += 2 * NGW) { f32x4 v[2][4]; float rs[2];
#pragma unroll
        for (int r = 0; r < 2; ++r) { const int m = m0 + r * NGW, mc = m < T ? m : 0; const f32x4* xr = (const f32x4*)(x + (size_t)mc * D) + lane; rs[r] = pg8::row_rstd16(ssq, mc);
#pragma unroll
            for (int j = 0; j < 4; ++j) v[r][j] = xr[64 * j]; }
#pragma unroll
        for (int r = 0; r < 2; ++r) { const int m = m0 + r * NGW; if (m >= T) break; f32x4* xr = (f32x4*)(x + (size_t)m * D) + lane;
#pragma unroll
            for (int j = 0; j < 4; ++j) { const f32x4 o = v[r][j] * rs[r] * g[j]; if (!dry) xr[64 * j] = o; } } }
}
typedef __attribute__((address_space(1))) unsigned gu32;
#define XB_TMO      128
#define XB_XCNT(j)  (256  + 64 * (j))
#define XB_XSUB(j)  (1280 + 64 * (j))
#define XB_XGEN(j)  (2304 + 64 * (j))
#define XB_TOP      3328
#define XB_TOPGEN   3392
#define XCD_BAR_WORDS 3456
#define XB_SPIN_CAP (1u << 18)

__device__ __forceinline__ unsigned xb_ld(unsigned* p)              { return __hip_atomic_load(p, __ATOMIC_RELAXED, __HIP_MEMORY_SCOPE_AGENT); }
__device__ __forceinline__ unsigned xb_add(unsigned* p, unsigned v) { return __hip_atomic_fetch_add(p, v, __ATOMIC_RELAXED, __HIP_MEMORY_SCOPE_AGENT); }
__device__ __forceinline__ unsigned xb_xcc_id() { return (unsigned)__builtin_amdgcn_s_getreg((3 << 11) | 20) & 0xFu; }
#define XB_SPIN(cond, bar) do { unsigned _sp = 0; while (cond) { __builtin_amdgcn_s_sleep(1); \
    if ((++_sp & 255u) == 0u) { if (xb_ld(&(bar)[XB_TMO])) break; if (_sp > XB_SPIN_CAP) { atomicAdd(&(bar)[XB_TMO], 1u); break; } } } } while (0)

struct XcdBarrier {
    unsigned* bar; unsigned x;
    volatile LAS unsigned* st;
};

__device__ __forceinline__ XcdBarrier xcd_barrier_post(unsigned* bar, volatile LAS unsigned* st) {
    XcdBarrier b; b.bar = bar; b.x = xb_xcc_id(); b.st = st;
    if (threadIdx.x == 0) (void)xb_add(&bar[XB_XCNT(b.x)], 1u);
    return b;
}
__device__ __forceinline__ void xcd_barrier_complete(unsigned* bar, unsigned x, unsigned& nloc, unsigned& nx) {
    const unsigned G = gridDim.x * gridDim.y * gridDim.z;
    unsigned sum, cnt, mine, sp = 0u;
    for (;;) {
        sum = 0u; cnt = 0u; mine = 0u;
#pragma unroll
        for (unsigned j = 0; j < 16; ++j) { const unsigned c = xb_ld(&bar[XB_XCNT(j)]); sum += c; cnt += (c > 0u) ? 1u : 0u; mine = (j == x) ? c : mine; }
        if (sum == G) break;
        __builtin_amdgcn_s_sleep(1);
        if ((++sp & 255u) == 0u) { if (xb_ld(&bar[XB_TMO])) break; if (sp > XB_SPIN_CAP) { atomicAdd(&bar[XB_TMO], 1u); break; } }
    }
    nloc = mine > 0u ? mine : 1u; nx = cnt > 0u ? cnt : 1u;
}

__device__ __forceinline__ void xcd_barrier(const XcdBarrier& b) {
    asm volatile("s_waitcnt vmcnt(0)" ::: "memory");
    __syncthreads();
    if (threadIdx.x == 0) {
        unsigned* bar = b.bar;
        __builtin_amdgcn_s_waitcnt(0);
        unsigned nloc = b.st[0], nx = b.st[1];
        if (nloc == 0u) { xcd_barrier_complete(bar, b.x, nloc, nx); b.st[0] = nloc; b.st[1] = nx; }
        const unsigned old = xb_add(&bar[XB_XSUB(b.x)], 1u);
        const unsigned gen = old / nloc;
        if (old + 1u == (gen + 1u) * nloc) {
            __builtin_amdgcn_fence(__ATOMIC_RELEASE, "agent");
            asm volatile("s_waitcnt vmcnt(0)" ::: "memory");
            const unsigned og = xb_add(&bar[XB_TOP], 1u);
            const unsigned tg = og / nx;
            if (og + 1u == (tg + 1u) * nx) xb_add(&bar[XB_TOPGEN], 1u);
            else XB_SPIN(xb_ld(&bar[XB_TOPGEN]) == tg, bar);
            __builtin_amdgcn_fence(__ATOMIC_ACQUIRE, "agent");
            xb_add(&bar[XB_XGEN(b.x)], 1u);
            asm volatile("s_waitcnt vmcnt(0)" ::: "memory");
        } else {
            XB_SPIN(xb_ld(&bar[XB_XGEN(b.x)]) == gen, bar);
            __builtin_amdgcn_fence(__ATOMIC_ACQUIRE, "agent");
            asm volatile("s_waitcnt vmcnt(0)" ::: "memory");
        }
    }
    __syncthreads();
}
__device__ __forceinline__ float ldcol(const bf16* cols, int t, int c) { return bf2f(cols[(size_t)t * NPAD + c]); }

__device__ __forceinline__ void rwkv_head_v1(const Params& P, int l, int h, float* lds, int tid) {
    const bf16* cols = (const bf16*)(P.ws + WS_COLS); bf16* Y = (bf16*)(P.ws + WS_Y); bf16* VF = (bf16*)(P.ws + WS_VF);
    float* sR = lds; float* sK = sR + 4096; float* sV = sK + 4096; float* sX = sV + 4096;
    float* sW = sX; float* sA = sX + 4096; float* sB = sX + 8192; float* sG = sX + 12288;
    float* sY = sX + 16384; float* sS = sY + 4096; float* sVr = sS + 64;
    const float* mu = P.in[I_MU] + l * 1024;
    const float* w_up = P.in[I_WUP] + (size_t)l * 64 * 256; const float* a_up = P.in[I_AUP] + (size_t)l * 64 * 256; const float* g_up = P.in[I_GUP] + (size_t)l * 128 * 256;
    const float* vr_up = P.in[I_VUP];
    const int lane = tid & 63, wv = tid >> 6, cc = h * 64 + lane;
    const float w0c = P.in[I_W0][l * 256 + cc], a0c = P.in[I_A0][l * 256 + cc], kkc = P.in[I_KK][l * 256 + cc], kac = P.in[I_KA][l * 256 + cc];
    const float rkc = P.in[I_RK][l * 256 + cc], lnw = P.in[I_LNW][l * 256 + cc], lnb = P.in[I_LNB][l * 256 + cc];
    const float v0c = (l > 0) ? P.in[I_V0][(l - 1) * 256 + cc] : 0.f;
    float S[64];
#pragma unroll
    for (int k = 0; k < 64; ++k) S[k] = 0.f;
    for (int ci = 0; ci < T / 64; ++ci) {
        const int t0 = ci * 64;
#pragma unroll 1
        for (int idx = tid; idx < 3 * 4096; idx += NT) { const int a = idx >> 12, t = (idx >> 6) & 63, c = idx & 63, col = a * 256 + h * 64 + c, tt = t0 + t;
            const float cur = ldcol(cols, tt, col), prv = (tt > 0) ? ldcol(cols, tt - 1, col) : 0.f; const float xs = cur + (prv - cur) * mu[col];
            (a == 0 ? sR : (a == 1 ? sK : sV))[t * 64 + c] = xs; }
#pragma unroll 1
        for (int idx = tid; idx < 64 * 256; idx += NT) { const int t = idx >> 8, j = idx & 255, col = 768 + j, tt = t0 + t;
            const float cur = ldcol(cols, tt, col), prv = (tt > 0) ? ldcol(cols, tt - 1, col) : 0.f; float xs = cur + (prv - cur) * mu[col];
            if (j < 64) xs = tanhf(xs); else if (j >= 128) xs = sigmoidf_(xs);
            sX[t * 256 + j] = xs; }
        if (l > 0)
#pragma unroll 1
        for (int idx = tid; idx < 64 * 32; idx += NT) { const int t = idx >> 5, j = idx & 31; sVr[idx] = ldcol(cols, t0 + t, C_VRES + j); }
        __syncthreads();
        float o_decay[8], o_asig[8], o_g[8], o_vmix[8];
#pragma unroll
        for (int hp = 0; hp < 2; ++hp) {
            float accw[4], acca[4], accg[4], accv[4];
#pragma unroll
            for (int i = 0; i < 4; ++i) { accw[i] = 0.f; acca[i] = 0.f; accg[i] = 0.f; accv[i] = 0.f; }
            const float* xb = sX + (wv * 8 + hp * 4) * 256;
#pragma unroll 2
            for (int j = 0; j < 64; ++j) { const float wvv = w_up[j * 256 + cc], avv = a_up[j * 256 + cc];
#pragma unroll
                for (int i = 0; i < 4; ++i) { accw[i] += xb[i * 256 + j] * wvv; acca[i] += xb[i * 256 + 64 + j] * avv; } }
#pragma unroll 2
            for (int j = 0; j < 128; ++j) { const float gvv = g_up[j * 256 + cc];
#pragma unroll
                for (int i = 0; i < 4; ++i) accg[i] += xb[i * 256 + 128 + j] * gvv; }
            if (l > 0) {
#pragma unroll 2
                for (int j = 0; j < 32; ++j) { const float vv = vr_up[j * 256 + cc];
#pragma unroll
                    for (int i = 0; i < 4; ++i) accv[i] += sVr[(wv * 8 + hp * 4 + i) * 32 + j] * vv; } }
#pragma unroll
            for (int i = 0; i < 4; ++i) { const float wpre = w0c + accw[i]; const float wlog = -softplusf_(-wpre) - 0.5f; o_decay[hp * 4 + i] = __expf(-__expf(wlog));
                o_asig[hp * 4 + i] = sigmoidf_(a0c + acca[i]); o_g[hp * 4 + i] = accg[i]; o_vmix[hp * 4 + i] = sigmoidf_(v0c + accv[i]); }
        }
        __syncthreads();
#pragma unroll
        for (int i = 0; i < 8; ++i) { const int t = wv * 8 + i, tt = t0 + t;
            const float r = sR[t * 64 + lane], k = sK[t * 64 + lane]; float v = sV[t * 64 + lane];
            const float asig = o_asig[i];
            if (l == 0) VF[(size_t)tt * 256 + cc] = (bf16)f2bf(v);
            else { const float vf = bf2f(VF[(size_t)tt * 256 + cc]); v = v + (vf - v) * o_vmix[i]; }
            const float kkr = k * kkc; const float ss = wave_sum(kkr * kkr); const float kk = kkr * (1.0f / sqrtf(ss + 1e-24f));
            const float kmod = k * (1.0f + (asig - 1.0f) * kac);
            const float bon = wave_sum(r * kmod * rkc);
            sW[t * 64 + lane] = o_decay[i]; sA[t * 64 + lane] = -kk; sB[t * 64 + lane] = kk * asig; sG[t * 64 + lane] = o_g[i]; sK[t * 64 + lane] = kmod; sV[t * 64 + lane] = v;
            if (lane == 0) sS[t] = bon; }
        __syncthreads();
        if (wv == 0) {
            for (int t = 0; t < 64; ++t) {
                const float vt = sV[t * 64 + lane];
                const f32x4* a4 = (const f32x4*)(sA + t * 64); const f32x4* w4 = (const f32x4*)(sW + t * 64); const f32x4* b4 = (const f32x4*)(sB + t * 64);
                const f32x4* k4 = (const f32x4*)(sK + t * 64); const f32x4* r4 = (const f32x4*)(sR + t * 64);
                float s0 = 0.f, s1 = 0.f, s2 = 0.f, s3 = 0.f;
#pragma unroll
                for (int q = 0; q < 16; ++q) { const f32x4 a = a4[q]; s0 += S[4 * q] * a[0]; s1 += S[4 * q + 1] * a[1]; s2 += S[4 * q + 2] * a[2]; s3 += S[4 * q + 3] * a[3]; }
                const float sa = (s0 + s1) + (s2 + s3);
                float y0 = 0.f, y1 = 0.f, y2 = 0.f, y3 = 0.f;
#pragma unroll
                for (int q = 0; q < 16; ++q) { const f32x4 w = w4[q], b = b4[q], kq = k4[q], rq = r4[q];
#pragma unroll
                    for (int e = 0; e < 4; ++e) S[4 * q + e] = S[4 * q + e] * w[e] + sa * b[e] + vt * kq[e];
                    y0 += S[4 * q] * rq[0]; y1 += S[4 * q + 1] * rq[1]; y2 += S[4 * q + 2] * rq[2]; y3 += S[4 * q + 3] * rq[3]; }
                sY[t * 64 + lane] = (y0 + y1) + (y2 + y3);
            }
        }
        __syncthreads();
#pragma unroll
        for (int i = 0; i < 8; ++i) { const int t = wv * 8 + i, tt = t0 + t;
            const float y = sY[t * 64 + lane]; const float mean = wave_sum(y) * (1.0f / 64.0f); const float d = y - mean; const float var = wave_sum(d * d) * (1.0f / 64.0f);
            float yn = d * (1.0f / sqrtf(var + 64e-5f)) * lnw + lnb; yn += sS[t] * sV[t * 64 + lane];
            Y[(size_t)tt * 1024 + cc] = (bf16)f2bf(yn * sG[t * 64 + lane]); }
        __syncthreads();
    }
}

__device__ __forceinline__ void gdn_head_v1(const Params& P, int l, int h, float* lds, int tid) {
    const bf16* cols = (const bf16*)(P.ws + WS_COLS); bf16* Y = (bf16*)(P.ws + WS_Y);
    float* sQ = lds; float* sK = sQ + 4096; float* sV = sK + 4096; float* sO = sV + 4096; float* sBeta = sO + 4096; float* sAl = sBeta + 64;
    const float* cw = P.in[I_CONV] + (size_t)l * 4 * 768;
    const int lane = tid & 63, wv = tid >> 6;
    const float alog = P.in[I_ALOG][l * 4 + h], dtb = P.in[I_DTB][l * 4 + h], ng = P.in[I_GDNG][l * 64 + lane];
    float S[64];
#pragma unroll
    for (int k = 0; k < 64; ++k) S[k] = 0.f;
    for (int ci = 0; ci < T / 64; ++ci) {
        const int t0 = ci * 64;
#pragma unroll 1
        for (int idx = tid; idx < 3 * 4096; idx += NT) { const int a = idx >> 12, t = (idx >> 6) & 63, c = idx & 63, ch = a * 256 + h * 64 + c, tt = t0 + t; float acc = 0.f;
#pragma unroll
            for (int i = 0; i < 4; ++i) { const int ts = tt - 3 + i; if (ts >= 0) acc += cw[i * 768 + ch] * ldcol(cols, ts, C_GDN + ch); }
            (a == 0 ? sQ : (a == 1 ? sK : sV))[t * 64 + c] = siluf_(acc); }
        if (tid < 64) { const int tt = t0 + tid; const float braw = ldcol(cols, tt, C_GDN + 1024 + h), araw = ldcol(cols, tt, C_GDN + 1028 + h);
            sBeta[tid] = sigmoidf_(braw); sAl[tid] = __expf(-__expf(alog) * softplusf_(araw + dtb)); }
        __syncthreads();
#pragma unroll
        for (int i = 0; i < 8; ++i) { const int t = wv * 8 + i; const float q = sQ[t * 64 + lane], k = sK[t * 64 + lane];
            const float sq = wave_sum(q * q), sk = wave_sum(k * k);
            sQ[t * 64 + lane] = q * (1.0f / sqrtf(sq + 1e-6f)) * 0.125f; sK[t * 64 + lane] = k * (1.0f / sqrtf(sk + 1e-6f)); }
        __syncthreads();
        if (wv == 0) {
            for (int t = 0; t < 64; ++t) {
                const float vt = sV[t * 64 + lane], beta = sBeta[t], al = sAl[t];
                const f32x4* k4 = (const f32x4*)(sK + t * 64); const f32x4* q4 = (const f32x4*)(sQ + t * 64);
                float s0 = 0.f, s1 = 0.f, s2 = 0.f, s3 = 0.f;
#pragma unroll
                for (int q = 0; q < 16; ++q) { const f32x4 kq = k4[q]; s0 += S[4 * q] * kq[0]; s1 += S[4 * q + 1] * kq[1]; s2 += S[4 * q + 2] * kq[2]; s3 += S[4 * q + 3] * kq[3]; }
                const float kS = al * ((s0 + s1) + (s2 + s3)); const float vn = beta * (vt - kS);
                float y0 = 0.f, y1 = 0.f, y2 = 0.f, y3 = 0.f;
#pragma unroll
                for (int q = 0; q < 16; ++q) { const f32x4 kq = k4[q], qq = q4[q];
#pragma unroll
                    for (int e = 0; e < 4; ++e) S[4 * q + e] = al * S[4 * q + e] + kq[e] * vn;
                    y0 += S[4 * q] * qq[0]; y1 += S[4 * q + 1] * qq[1]; y2 += S[4 * q + 2] * qq[2]; y3 += S[4 * q + 3] * qq[3]; }
                sO[t * 64 + lane] = (y0 + y1) + (y2 + y3);
            }
        }
        __syncthreads();
#pragma unroll
        for (int i = 0; i < 8; ++i) { const int t = wv * 8 + i, tt = t0 + t; const float o = sO[t * 64 + lane]; const float ms = wave_sum(o * o) * (1.0f / 64.0f);
            const float z = ldcol(cols, tt, C_GDN + 768 + h * 64 + lane);
            Y[(size_t)tt * 1024 + 256 + h * 64 + lane] = (bf16)f2bf(o * (1.0f / sqrtf(ms + 1e-6f)) * ng * siluf_(z)); }
        __syncthreads();
    }
}

__device__ __forceinline__ void gla_head_v1(const Params& P, int l, int h, float* lds, int tid) {
    const bf16* cols = (const bf16*)(P.ws + WS_COLS); bf16* Y = (bf16*)(P.ws + WS_Y);
    float* sQ = lds; float* sK = sQ + 2048; float* sAl = sK + 2048; float* sV = sAl + 2048; float* sO = sV + 4096; float* sGd = sO + 4096;
    const float* gk_up = P.in[I_GKUP] + (size_t)l * 16 * 128; const float* gk_b = P.in[I_GKB] + l * 128;
    const int lane = tid & 63, wv = tid >> 6; const float ng = P.in[I_GLAG][l * 64 + lane];
    float S[32];
#pragma unroll
    for (int k = 0; k < 32; ++k) S[k] = 0.f;
    for (int ci = 0; ci < T / 64; ++ci) {
        const int t0 = ci * 64;
#pragma unroll 1
        for (int idx = tid; idx < 64 * 32; idx += NT) { const int t = idx >> 5, j = idx & 31; sQ[idx] = ldcol(cols, t0 + t, C_GLA + h * 32 + j) * 0.17677669529663687f; sK[idx] = ldcol(cols, t0 + t, C_GLA + 128 + h * 32 + j); }
#pragma unroll 1
        for (int idx = tid; idx < 64 * 64; idx += NT) { const int t = idx >> 6, c = idx & 63; sV[idx] = ldcol(cols, t0 + t, C_GLA + 256 + h * 64 + c); }
#pragma unroll 1
        for (int idx = tid; idx < 64 * 16; idx += NT) { const int t = idx >> 4, i = idx & 15; sGd[idx] = ldcol(cols, t0 + t, C_GLA + 768 + i); }
        __syncthreads();
#pragma unroll 1
        for (int idx = tid; idx < 64 * 32; idx += NT) { const int t = idx >> 5, j = idx & 31; float a = gk_b[h * 32 + j];
#pragma unroll
            for (int i = 0; i < 16; ++i) a += sGd[t * 16 + i] * gk_up[i * 128 + h * 32 + j];
            sAl[idx] = __expf(-softplusf_(-a) * (1.0f / 16.0f)); }
        __syncthreads();
        if (wv == 0) {
            for (int t = 0; t < 64; ++t) {
                const float vt = sV[t * 64 + lane];
                const f32x4* a4 = (const f32x4*)(sAl + t * 32); const f32x4* k4 = (const f32x4*)(sK + t * 32); const f32x4* q4 = (const f32x4*)(sQ + t * 32);
                float y0 = 0.f, y1 = 0.f, y2 = 0.f, y3 = 0.f;
#pragma unroll
                for (int q = 0; q < 8; ++q) { const f32x4 a = a4[q], kq = k4[q], qq = q4[q];
#pragma unroll
                    for (int e = 0; e < 4; ++e) S[4 * q + e] = a[e] * S[4 * q + e] + kq[e] * vt;
                    y0 += S[4 * q] * qq[0]; y1 += S[4 * q + 1] * qq[1]; y2 += S[4 * q + 2] * qq[2]; y3 += S[4 * q + 3] * qq[3]; }
                sO[t * 64 + lane] = (y0 + y1) + (y2 + y3);
            }
        }
        __syncthreads();
#pragma unroll
        for (int i = 0; i < 8; ++i) { const int t = wv * 8 + i, tt = t0 + t; const float o = sO[t * 64 + lane]; const float ms = wave_sum(o * o) * (1.0f / 64.0f);
            const float gt = ldcol(cols, tt, C_GLA + 512 + h * 64 + lane);
            Y[(size_t)tt * 1024 + 512 + h * 64 + lane] = (bf16)f2bf(o * (1.0f / sqrtf(ms + 1e-6f)) * ng * siluf_(gt)); }
        __syncthreads();
    }
}

__device__ __forceinline__ void sgu_unit_v1(const Params& P, int l, int n, float* lds, int tid) {
    const bf16* cols = (const bf16*)(P.ws + WS_COLS); bf16* Y = (bf16*)(P.ws + WS_Y);
    float* sVl = lds;
    const int lane = tid & 63, wv = tid >> 6, t0 = n * 128;
    const float* lg = P.in[I_SLG] + l * 256; const float* lb = P.in[I_SLB] + l * 256;
    const float* ws_ = P.in[I_SWS] + (size_t)l * 4 * 128 * 128; const float* bs_ = P.in[I_SBS] + l * 4 * 128;
    for (int i = 0; i < 16; ++i) { const int t = wv * 16 + i; float v[4]; float s = 0.f;
#pragma unroll
        for (int e = 0; e < 4; ++e) { v[e] = geluf_(ldcol(cols, t0 + t, C_SGU + 256 + lane * 4 + e)); s += v[e]; }
        const float mean = wave_sum(s) * (1.0f / 256.0f); float q = 0.f;
#pragma unroll
        for (int e = 0; e < 4; ++e) { v[e] -= mean; q += v[e] * v[e]; }
        const float rstd = 1.0f / sqrtf(wave_sum(q) * (1.0f / 256.0f) + 1e-5f);
#pragma unroll
        for (int e = 0; e < 4; ++e) sVl[t * 256 + lane * 4 + e] = v[e] * rstd * lg[lane * 4 + e] + lb[lane * 4 + e]; }
    __syncthreads();
    const int g = lane >> 4;
    for (int i = 0; i < 16; ++i) { const int t = wv + 8 * i; const float* wr = ws_ + ((size_t)g * 128 + t) * 128; f32x4 acc = {0.f, 0.f, 0.f, 0.f};
        for (int s = 0; s <= t; ++s) { const float w = wr[s]; const f32x4 vv = *(const f32x4*)(sVl + s * 256 + lane * 4); acc += vv * w; }
        const float b = bs_[g * 128 + t];
#pragma unroll
        for (int e = 0; e < 4; ++e) { const float u = geluf_(ldcol(cols, t0 + t, C_SGU + lane * 4 + e)); Y[(size_t)(t0 + t) * 1024 + 768 + lane * 4 + e] = (bf16)f2bf(u * (acc[e] + b)); } }
    __syncthreads();
}
#define LDS_SYNC() do { asm volatile("s_waitcnt lgkmcnt(0)" ::: "memory"); __builtin_amdgcn_s_barrier(); asm volatile("" ::: "memory"); } while (0)
typedef short bf16x8 __attribute__((ext_vector_type(8)));
typedef float f32x16 __attribute__((ext_vector_type(16)));
typedef unsigned u32x2 __attribute__((ext_vector_type(2)));
constexpr int TS = 72;
constexpr int TILE_B = 64 * TS * 2;
template <int KT> __device__ __forceinline__ void mm_tile(f32x16& acc, const LAS bf16* Arows, const LAS bf16* Bcols, int lane) {
    const int off = (lane & 31) * TS + (lane >> 5) * 8;
#pragma unroll
    for (int kk = 0; kk < KT; ++kk) {
        const bf16x8 a = *(const LAS bf16x8*)(Arows + off + kk * 16);
        const bf16x8 b = *(const LAS bf16x8*)(Bcols + off + kk * 16);
        acc = __builtin_amdgcn_mfma_f32_32x32x16_bf16(a, b, acc, 0, 0, 0);
    }
}
template <int KT> __device__ __forceinline__ void mm_tile_gb(f32x16& acc, const LAS bf16* Arows, int lda, const bf16* Bg, int ldb, int lane) {
    const int r = lane & 31, hh = lane >> 5;
#pragma unroll
    for (int kk = 0; kk < KT; ++kk) {
        const bf16x8 a = *(const LAS bf16x8*)(Arows + r * lda + hh * 8 + kk * 16);
        const bf16x8 b = *(const bf16x8*)(Bg + r * ldb + hh * 8 + kk * 16);
        acc = __builtin_amdgcn_mfma_f32_32x32x16_bf16(a, b, acc, 0, 0, 0);
    }
}
__device__ __forceinline__ int acc_i(int r, int hh) { return (r & 3) + 8 * (r >> 2) + 4 * hh; }
__device__ __forceinline__ void store_lane_major(LAS bf16* Z, int j0, int i0, const f32x16& acc, int lane) {
    const int c = lane & 31, hh = lane >> 5;
    LAS bf16* p = Z + (j0 + c) * TS + i0 + 4 * hh;
#pragma unroll
    for (int q = 0; q < 4; ++q) { uint2 w; w.x = pk2(acc[4 * q], acc[4 * q + 1]); w.y = pk2(acc[4 * q + 2], acc[4 * q + 3]); *(LAS u32x2*)(p + 8 * q) = (u32x2){w.x, w.y}; }
}
__device__ __forceinline__ void store_reg_major(LAS bf16* Z, int i0, int j0, const f32x16& acc, int lane) {
    const int c = lane & 31, hh = lane >> 5;
#pragma unroll
    for (int r = 0; r < 16; ++r) Z[(i0 + acc_i(r, hh)) * TS + j0 + c] = (bf16)f2bf(acc[r]);
}
__device__ __forceinline__ f32x16 zero16() { f32x16 z;
#pragma unroll
    for (int r = 0; r < 16; ++r) z[r] = 0.f; return z; }
__device__ __forceinline__ void gla_m1(const Params& P, int l, int ci, LAS unsigned char* lds, int tid) {
    const bf16* cols = (const bf16*)(P.ws + WS_COLS); bf16* Y = (bf16*)(P.ws + WS_Y);
    float* GKV = (float*)(P.ws + WS_GKV); float* GAL = (float*)(P.ws + WS_GAL); bf16* GQI = (bf16*)(P.ws + WS_GQI);
    LAS float* fLa = (LAS float*)lds; LAS float* fGd = fLa + 64 * 128; LAS unsigned char* tb0 = lds + 32768 + 4096;
    const float* gk_up = P.in[I_GKUP] + (size_t)l * 16 * 128; const float* gk_b = P.in[I_GKB] + l * 128;
    const int lane = tid & 63, wv = __builtin_amdgcn_readfirstlane(tid >> 6), t0 = ci * 64;
#pragma unroll
    for (int idx = tid; idx < 64 * 16; idx += NT) fGd[idx] = ldcol(cols, t0 + (idx >> 4), C_GLA + 768 + (idx & 15));
    LDS_SYNC();
#pragma unroll 4
    for (int idx = tid; idx < 64 * 128; idx += NT) { const int t = idx >> 7, j = idx & 127; float a = gk_b[j];
#pragma unroll
        for (int i = 0; i < 16; ++i) a += fGd[t * 16 + i] * gk_up[i * 128 + j];
        fLa[idx] = -softplusf_(-a) * (1.0f / 16.0f); }
    LDS_SYNC();
    if (tid < 128) { float run = 0.f;
#pragma unroll 8
        for (int t = 0; t < 64; ++t) { run += fLa[t * 128 + tid]; fLa[t * 128 + tid] = run; }
        GAL[ci * 128 + tid] = __expf(run); }
    LDS_SYNC();
#pragma unroll 1
    for (int hp = 0; hp < 2; ++hp) {
#pragma unroll 4
        for (int idx = tid; idx < 2 * 64 * 32; idx += NT) { const int s = idx >> 11, t = (idx >> 5) & 63, j = idx & 31, h = 2 * hp + s;
            LAS bf16* tQ = (LAS bf16*)(tb0 + s * 5 * TILE_B); LAS bf16* tK = tQ + 64 * TS; LAS bf16* tKs = tK + 64 * TS;
            const float b = fLa[t * 128 + h * 32 + j], b63 = fLa[63 * 128 + h * 32 + j];
            const float q = ldcol(cols, t0 + t, C_GLA + h * 32 + j) * 0.17677669529663687f, k = ldcol(cols, t0 + t, C_GLA + 128 + h * 32 + j);
            const bf16 qt = (bf16)f2bf(q * __expf(b));
            tQ[t * TS + j] = qt; tK[t * TS + j] = (bf16)f2bf(k * __expf(-b)); tKs[j * TS + t] = (bf16)f2bf(k * __expf(b63 - b));
            GQI[(((size_t)ci * 4 + h) * 64 + t) * 32 + j] = qt; }
#pragma unroll 8
        for (int idx = tid; idx < 2 * 64 * 64; idx += NT) { const int s = idx >> 12, t = (idx >> 6) & 63, v = idx & 63, h = 2 * hp + s;
            LAS bf16* tV = (LAS bf16*)(tb0 + s * 5 * TILE_B + 3 * TILE_B);
            tV[v * TS + t] = cols[(size_t)(t0 + t) * NPAD + C_GLA + 256 + h * 64 + v]; }
        LDS_SYNC();
        for (int jb = wv; jb < 12; jb += 8) { const int s = jb / 6, r = jb % 6, h = 2 * hp + s;
            LAS bf16* tQ = (LAS bf16*)(tb0 + s * 5 * TILE_B); LAS bf16* tK = tQ + 64 * TS; LAS bf16* tKs = tK + 64 * TS; LAS bf16* tV = tKs + 64 * TS; LAS bf16* tSc = tV + 64 * TS;
            f32x16 acc = zero16(); const int c = lane & 31, hh = lane >> 5;
            if (r < 4) { const int tb = (r == 0 || r == 3) ? 0 : 1, sb = (r == 0 || r == 1) ? 0 : 1;
                if (r < 3) { mm_tile<2>(acc, tK + sb * 32 * TS, tQ + tb * 32 * TS, lane);
#pragma unroll
                    for (int q = 0; q < 16; ++q) { const int sI = 32 * sb + acc_i(q, hh), tI = 32 * tb + c; if (sI > tI) acc[q] = 0.f; } }
                store_lane_major(tSc, 32 * tb, 32 * sb, acc, lane);
            } else { const int vb = r - 4; mm_tile<4>(acc, tKs, tV + vb * 32 * TS, lane);
                float* g = GKV + (((size_t)ci * 4 + h) * 32) * 64 + 32 * vb + c;
#pragma unroll
                for (int q = 0; q < 16; ++q) g[acc_i(q, hh) * 64] = acc[q]; }
        }
        LDS_SYNC();
        { const int s = wv >> 2, tb = (wv >> 1) & 1, vb = wv & 1, h = 2 * hp + s;
            LAS bf16* tV = (LAS bf16*)(tb0 + s * 5 * TILE_B + 3 * TILE_B); LAS bf16* tSc = tV + 64 * TS;
            f32x16 acc = zero16(); const int c = lane & 31, hh = lane >> 5;
            mm_tile<4>(acc, tSc + tb * 32 * TS, tV + vb * 32 * TS, lane);
            bf16* y = Y + (size_t)(t0 + 32 * tb) * 1024 + 512 + h * 64 + 32 * vb + c;
#pragma unroll
            for (int q = 0; q < 16; ++q) y[(size_t)acc_i(q, hh) * 1024] = (bf16)f2bf(acc[q]); }
        LDS_SYNC();
    }
}
__device__ __forceinline__ void gla_m2_A(const Params& P, int seg, int e) {
    const float* GKV = (const float*)(P.ws + WS_GKV); const float* GAL = (const float*)(P.ws + WS_GAL); float* GSB = (float*)(P.ws + WS_GSB); float* GSA = (float*)(P.ws + WS_GSA);
    const int hk = e >> 6; float kv[16], al[16];
#pragma unroll
    for (int u = 0; u < 16; ++u) { kv[u] = GKV[(size_t)(seg * 16 + u) * 8192 + e]; al[u] = GAL[(seg * 16 + u) * 128 + hk]; }
    float S = 0.f, A = 1.f;
#pragma unroll
    for (int u = 0; u < 16; ++u) { S = al[u] * S + kv[u]; A *= al[u]; }
    GSB[seg * 8192 + e] = S; if ((e & 63) == 0) GSA[seg * 128 + hk] = A;
}
__device__ __forceinline__ void gla_m2_B(const Params& P, int e) {
    float* GSB = (float*)(P.ws + WS_GSB); const float* GSA = (const float*)(P.ws + WS_GSA);
    const int hk = e >> 6; float b[16], a[16];
#pragma unroll
    for (int s = 0; s < 16; ++s) { b[s] = GSB[s * 8192 + e]; a[s] = GSA[s * 128 + hk]; }
    float S = 0.f;
#pragma unroll
    for (int s = 0; s < 16; ++s) { GSB[s * 8192 + e] = S; S = a[s] * S + b[s]; }
}
__device__ __forceinline__ void gla_m2_C(const Params& P, int seg, int e) {
    float* GKV = (float*)(P.ws + WS_GKV); const float* GAL = (const float*)(P.ws + WS_GAL); const float* GSB = (const float*)(P.ws + WS_GSB);
    const int hk = e >> 6; float kv[16], al[16];
#pragma unroll
    for (int u = 0; u < 16; ++u) { kv[u] = GKV[(size_t)(seg * 16 + u) * 8192 + e]; al[u] = GAL[(seg * 16 + u) * 128 + hk]; }
    float S = GSB[seg * 8192 + e];
#pragma unroll
    for (int u = 0; u < 16; ++u) { GKV[(size_t)(seg * 16 + u) * 8192 + e] = S; S = al[u] * S + kv[u]; }
}
__device__ __forceinline__ void gla_m3(const Params& P, int l, int ci, LAS unsigned char* lds, int tid, bool do_store = true) {
    const bf16* cols = (const bf16*)(P.ws + WS_COLS); bf16* Y = (bf16*)(P.ws + WS_Y);
    const float* GKV = (const float*)(P.ws + WS_GKV); const bf16* GQI = (const bf16*)(P.ws + WS_GQI);
    const float* ng = P.in[I_GLAG] + l * 64;
    const int lane = tid & 63, wv = __builtin_amdgcn_readfirstlane(tid >> 6), t0 = ci * 64;
#pragma unroll 8
    for (int idx = tid; idx < 4 * 32 * 64; idx += NT) { const int h = idx >> 11, k = (idx >> 6) & 31, v = idx & 63;
        ((LAS bf16*)(lds + h * TILE_B))[v * TS + k] = (bf16)f2bf(GKV[(size_t)ci * 8192 + idx]); }
    LDS_SYNC();
    const int h = wv >> 1, tb = wv & 1, c = lane & 31, hh = lane >> 5;
    const LAS bf16* tS = (const LAS bf16*)(lds + h * TILE_B);
    f32x16 acc[2]; acc[0] = zero16(); acc[1] = zero16();
    const bf16* qg = GQI + (((size_t)ci * 4 + h) * 64 + 32 * tb + c) * 32 + hh * 8;
#pragma unroll
    for (int kk = 0; kk < 2; ++kk) { const bf16x8 b = *(const bf16x8*)(qg + kk * 16);
#pragma unroll
        for (int vb = 0; vb < 2; ++vb) { const bf16x8 a = *(const LAS bf16x8*)(tS + (vb * 32 + c) * TS + hh * 8 + kk * 16);
            acc[vb] = __builtin_amdgcn_mfma_f32_32x32x16_bf16(a, b, acc[vb], 0, 0, 0); } }
    const size_t trow = (size_t)(t0 + 32 * tb + c);
    bf16* yrow = Y + trow * 1024 + 512 + h * 64; const bf16* grow = cols + trow * NPAD + C_GLA + 512 + h * 64;
    float ss = 0.f;
#pragma unroll
    for (int vb = 0; vb < 2; ++vb)
#pragma unroll
        for (int q = 0; q < 4; ++q) { const int v = 32 * vb + 8 * q + 4 * hh; const uint2 w = *(const uint2*)(yrow + v);
            acc[vb][4 * q] += bf2f((bf16)(w.x & 0xffff)); acc[vb][4 * q + 1] += bf2f((bf16)(w.x >> 16)); acc[vb][4 * q + 2] += bf2f((bf16)(w.y & 0xffff)); acc[vb][4 * q + 3] += bf2f((bf16)(w.y >> 16));
#pragma unroll
            for (int e = 0; e < 4; ++e) ss += acc[vb][4 * q + e] * acc[vb][4 * q + e]; }
    ss += __shfl_xor(ss, 32);
    const float rstd = rsqf_(ss * (1.0f / 64.0f) + 1e-6f);
#pragma unroll
    for (int vb = 0; vb < 2; ++vb)
#pragma unroll
        for (int q = 0; q < 4; ++q) { const int v = 32 * vb + 8 * q + 4 * hh; const uint2 gw = *(const uint2*)(grow + v); float o[4];
            const float g0 = bf2f((bf16)(gw.x & 0xffff)), g1 = bf2f((bf16)(gw.x >> 16)), g2 = bf2f((bf16)(gw.y & 0xffff)), g3 = bf2f((bf16)(gw.y >> 16));
            o[0] = acc[vb][4 * q] * rstd * ng[v] * siluf_(g0); o[1] = acc[vb][4 * q + 1] * rstd * ng[v + 1] * siluf_(g1);
            o[2] = acc[vb][4 * q + 2] * rstd * ng[v + 2] * siluf_(g2); o[3] = acc[vb][4 * q + 3] * rstd * ng[v + 3] * siluf_(g3);
            uint2 w; w.x = pk2(o[0], o[1]); w.y = pk2(o[2], o[3]); if (do_store) *(uint2*)(yrow + v) = w; }
    LDS_SYNC();
}
__device__ __forceinline__ void nm_square(const LAS bf16* Xr, const LAS bf16* Xc, LAS bf16* Xr_o, LAS bf16* Xc_o, int I, int J, int lane) {
    f32x16 acc = zero16();
    if (I == J) mm_tile<2>(acc, Xr + I * 32 * TS + 32 * I, Xc + J * 32 * TS + 32 * I, lane);
    else mm_tile<4>(acc, Xr + 32 * TS, Xc, lane);
    store_lane_major(Xc_o, 32 * J, 32 * I, acc, lane);
    store_reg_major(Xr_o, 32 * I, 32 * J, acc, lane);
}
__device__ __forceinline__ void nm_update(const LAS bf16* Tt, const LAS bf16* Xc, LAS bf16* Tt_o, int I, int J, int lane) {
    const int c = lane & 31, hh = lane >> 5; f32x16 acc;
#pragma unroll
    for (int q = 0; q < 4; ++q) { const u32x2 w = *(const LAS u32x2*)(Tt + (32 * I + c) * TS + 32 * J + 8 * q + 4 * hh);
        acc[4 * q] = bf2f((bf16)(w.x & 0xffff)); acc[4 * q + 1] = bf2f((bf16)(w.x >> 16)); acc[4 * q + 2] = bf2f((bf16)(w.y & 0xffff)); acc[4 * q + 3] = bf2f((bf16)(w.y >> 16)); }
    if (I == J) mm_tile<2>(acc, Xc + J * 32 * TS + 32 * I, Tt + I * 32 * TS + 32 * I, lane);
    else mm_tile<4>(acc, Xc, Tt + 32 * TS, lane);
    store_lane_major(Tt_o, 32 * I, 32 * J, acc, lane);
}
#define NM_TILE_IJ(w3, I_, J_) const int I_ = ((w3) == 0) ? 0 : 1, J_ = ((w3) == 2) ? 1 : 0
template <class Extra> __device__ __forceinline__ void neumann_solve(LAS bf16* const (&Xr)[2], LAS bf16* const (&Xc)[2], LAS bf16* const (&Tt)[2], int wv, int lane, const Extra& extra) {
    if (wv < 3) { NM_TILE_IJ(wv, I, J); nm_square(Xr[0], Xc[0], Xr[1], Xc[1], I, J, lane); }
    else if (wv >= 4) extra();
    LDS_SYNC();
#pragma unroll 1
    for (int k = 1; k <= 4; ++k) {
        const int xb = k & 1, tbuf = (k - 1) & 1;
        if (wv < 3) { NM_TILE_IJ(wv, I, J); nm_update(Tt[tbuf], Xc[xb], Tt[tbuf ^ 1], I, J, lane); }
        else if (wv < 6) { NM_TILE_IJ(wv - 3, I, J); nm_square(Xr[xb], Xc[xb], Xr[xb ^ 1], Xc[xb ^ 1], I, J, lane); }
        LDS_SYNC();
    }
    if (wv < 3) { NM_TILE_IJ(wv, I, J); nm_update(Tt[0], Xc[1], Tt[1], I, J, lane); }
    LDS_SYNC();
}
typedef float f32x4v __attribute__((ext_vector_type(4)));
constexpr int M2_D = 6;
constexpr int M2_SLOT = 2 * TILE_B + 256;
template <bool NMODE, bool STORE_EACH> __device__ __forceinline__ void dplr_chain(const bf16* XP, bf16* XQ, const float* XG, int pstride, int gstride, int nsteps, const bf16* initH, bf16* outF, float* outG, LAS unsigned char* lds, int tid) {
    const int lane = tid & 63, wv = __builtin_amdgcn_readfirstlane(tid >> 6);
    const int g = lane >> 4, n = lane & 15, v0 = wv * 16;
    const int q = tid - 256;
#define M2_BAR() do { asm volatile("s_waitcnt lgkmcnt(0)" ::: "memory"); __builtin_amdgcn_s_barrier(); asm volatile("" ::: "memory"); } while (0)
    if (wv >= 4) {
        v4u ring[M2_D][5];
#define M2_ISSUE(c, R) do { const int c_ = (c) < nsteps ? (c) : nsteps - 1; const v4u* Pp = (const v4u*)(XP + (size_t)c_ * pstride); \
        R[0] = Pp[q]; R[1] = Pp[q + 256]; if (!NMODE) { const v4u* Qp = (const v4u*)(XQ + (size_t)c_ * pstride); R[2] = Qp[q]; R[3] = Qp[q + 256]; } R[4] = ((const v4u*)(XG + (size_t)c_ * gstride))[q & 15]; } while (0)
#define M2_PUT(slot, R) do { LAS unsigned char* sp = lds + (slot) * M2_SLOT; \
        *(LAS v4u*)(sp + (q >> 3) * (TS * 2) + (q & 7) * 16) = R[0]; *(LAS v4u*)(sp + ((q >> 3) + 32) * (TS * 2) + (q & 7) * 16) = R[1]; \
        if (!NMODE) { *(LAS v4u*)(sp + TILE_B + (q >> 3) * (TS * 2) + (q & 7) * 16) = R[2]; *(LAS v4u*)(sp + TILE_B + ((q >> 3) + 32) * (TS * 2) + (q & 7) * 16) = R[3]; } \
        if (q < 16) *(LAS v4u*)(sp + 2 * TILE_B + q * 16) = R[4]; } while (0)
#pragma unroll
        for (int d = 0; d < M2_D; ++d) M2_ISSUE(d, ring[d]);
        M2_PUT(0, ring[0]);
        M2_ISSUE(M2_D, ring[0]);
        M2_BAR();
#pragma unroll 1
        for (int c0 = 0; c0 < nsteps; c0 += M2_D) {
#pragma unroll
            for (int u = 0; u < M2_D; ++u) {
                M2_PUT((u + 1) & 1, ring[(u + 1) % M2_D]);
                M2_ISSUE(c0 + u + 1 + M2_D, ring[(u + 1) % M2_D]);
                M2_BAR(); }
        }
#undef M2_ISSUE
#undef M2_PUT
    } else {
        f32x4v H[4], Gam[4];
#pragma unroll
        for (int m = 0; m < 4; ++m) { H[m] = (f32x4v){0.f, 0.f, 0.f, 0.f}; Gam[m] = (f32x4v){1.f, 1.f, 1.f, 1.f}; }
        if (!NMODE && initH) {
#pragma unroll
            for (int m = 0; m < 4; ++m) { const uint2 w = *(const uint2*)(initH + (v0 + n) * 64 + 16 * m + 4 * g);
                H[m][0] = bf2f((bf16)(w.x & 0xffff)); H[m][1] = bf2f((bf16)(w.x >> 16)); H[m][2] = bf2f((bf16)(w.y & 0xffff)); H[m][3] = bf2f((bf16)(w.y >> 16)); } }
        M2_BAR();
#pragma unroll 1
        for (int c0 = 0; c0 < nsteps; c0 += M2_D) {
#pragma unroll
            for (int u = 0; u < M2_D; ++u) { const int c = c0 + u;
                if (c < nsteps) { const LAS unsigned char* sp = lds + (u & 1) * M2_SLOT; bf16* Qg = XQ + (size_t)c * pstride;
                    bf16x8 bfr[2];
#pragma unroll
                    for (int s = 0; s < 2; ++s) { f32x4v b0 = H[2 * s], b1 = H[2 * s + 1];
                        if (NMODE) {
#pragma unroll
                            for (int i = 0; i < 4; ++i) { if (2 * s == wv && 4 * g + i == n) b0[i] += Gam[2 * s][i]; if (2 * s + 1 == wv && 4 * g + i == n) b1[i] += Gam[2 * s + 1][i]; } }
                        v4u w; w.x = pk2(b0[0], b0[1]); w.y = pk2(b0[2], b0[3]); w.z = pk2(b1[0], b1[1]); w.w = pk2(b1[2], b1[3]); bfr[s] = __builtin_bit_cast(bf16x8, w); }
#pragma unroll
                    for (int m = 0; m < 4; ++m) {
                        const f32x4v gm = *(const LAS f32x4v*)(sp + 2 * TILE_B + (16 * m + 4 * g) * 4); f32x4v a;
                        if (NMODE) { a = gm * H[m]; Gam[m] = Gam[m] * gm; }
                        else { const u32x2 qw = *(const LAS u32x2*)(sp + TILE_B + (v0 + n) * (TS * 2) + (16 * m + 4 * g) * 2);
                            if (STORE_EACH) { u32x2 hw; hw.x = pk2(H[m][0], H[m][1]); hw.y = pk2(H[m][2], H[m][3]); *(u32x2*)(Qg + (v0 + n) * 64 + 16 * m + 4 * g) = hw; }
                            a[0] = gm[0] * H[m][0] + bf2f((bf16)(qw.x & 0xffff)); a[1] = gm[1] * H[m][1] + bf2f((bf16)(qw.x >> 16)); a[2] = gm[2] * H[m][2] + bf2f((bf16)(qw.y & 0xffff)); a[3] = gm[3] * H[m][3] + bf2f((bf16)(qw.y >> 16)); }
#pragma unroll
                        for (int s = 0; s < 2; ++s) { const u32x2 p0 = *(const LAS u32x2*)(sp + (16 * m + n) * (TS * 2) + (32 * s + 4 * g) * 2); const u32x2 p1 = *(const LAS u32x2*)(sp + (16 * m + n) * (TS * 2) + (32 * s + 16 + 4 * g) * 2);
                            v4u w; w.x = p0.x; w.y = p0.y; w.z = p1.x; w.w = p1.y;
                            a = __builtin_amdgcn_mfma_f32_16x16x32_bf16(__builtin_bit_cast(bf16x8, w), bfr[s], a, 0, 0, 0); }
                        H[m] = a; } }
                M2_BAR(); }
        }
        if (outF) {
            if (NMODE) {
#pragma unroll
                for (int m = 0; m < 4; ++m)
#pragma unroll
                    for (int i = 0; i < 4; ++i) outF[(16 * m + 4 * g + i) * 64 + v0 + n] = (bf16)f2bf(H[m][i]);
                if (wv == 0 && n == 0) {
#pragma unroll
                    for (int m = 0; m < 4; ++m) *(f32x4v*)(outG + 16 * m + 4 * g) = Gam[m]; }
            } else {
#pragma unroll
                for (int m = 0; m < 4; ++m) { u32x2 hw; hw.x = pk2(H[m][0], H[m][1]); hw.y = pk2(H[m][2], H[m][3]); *(u32x2*)(outF + (v0 + n) * 64 + 16 * m + 4 * g) = hw; } }
        }
    }
#undef M2_BAR
}
__device__ __forceinline__ void dplr_m3_stage(const bf16* XQ, int ci, LAS unsigned char* lds, int tid) {
#pragma unroll
    for (int i = 0; i < 4; ++i) { const int idx = tid + NT * i, h = idx >> 9, v = (idx >> 3) & 63, c8 = idx & 7;
        *(LAS v4u*)(lds + h * TILE_B + v * (TS * 2) + c8 * 16) = *(const v4u*)(XQ + (size_t)ci * 16384 + (size_t)idx * 8); }
}
__device__ __forceinline__ void dplr_m3_core(f32x16 (&acc)[2], const LAS bf16* tHT, const bf16* XRch, int tb, int lane) {
    const int c = lane & 31, hh = lane >> 5;
    const bf16* rg = XRch + (32 * tb + c) * 64 + hh * 8;
    acc[0] = zero16(); acc[1] = zero16();
#pragma unroll
    for (int kk = 0; kk < 4; ++kk) { const bf16x8 b = *(const bf16x8*)(rg + kk * 16);
#pragma unroll
        for (int vb = 0; vb < 2; ++vb) { const bf16x8 a = *(const LAS bf16x8*)(tHT + (vb * 32 + c) * TS + hh * 8 + kk * 16);
            acc[vb] = __builtin_amdgcn_mfma_f32_32x32x16_bf16(a, b, acc[vb], 0, 0, 0); } }
}
__device__ __forceinline__ void rwkv_m1(const Params& P, int l, int ci, LAS unsigned char* lds, int tid) {
    const bf16* cols = (const bf16*)(P.ws + WS_COLS); bf16* Y = (bf16*)(P.ws + WS_Y); bf16* VF = (bf16*)(P.ws + WS_VF);
    bf16* XP = (bf16*)(P.ws + WS_RP); bf16* XQ = (bf16*)(P.ws + WS_RQ); bf16* XR = (bf16*)(P.ws + WS_RR); bf16* XBV = (bf16*)(P.ws + WS_RBV); float* XG = (float*)(P.ws + WS_XG);
    LAS bf16* tA = (LAS bf16*)lds; LAS bf16* tB = tA + 64 * TS; LAS bf16* tK = tB + 64 * TS; LAS bf16* tR = tK + 64 * TS; LAS bf16* tV = tR + 64 * TS;
    LAS bf16* tAab = tV + 64 * TS; LAS bf16* tAak = tAab + 64 * TS; LAS bf16* tArb = tAak + 64 * TS; LAS bf16* tArk = tArb + 64 * TS;
    LAS bf16* tAabT = tArk + 64 * TS; LAS bf16* tX1r = tAabT + 64 * TS; LAS bf16* tX1c = tX1r + 64 * TS; LAS bf16* tT0 = tX1c + 64 * TS; LAS bf16* tT1 = tT0 + 64 * TS; LAS bf16* tAV = tT1 + 64 * TS;
    LAS bf16* tW = tAab; LAS bf16* tU = tAak; LAS bf16* tT = tT1;
    LAS float* gC = (LAS float*)(lds + 5 * TILE_B + 77824 + 16384);
    LAS bf16* xW = (LAS bf16*)(lds + 5 * TILE_B); LAS bf16* xA = xW + 64 * 72; LAS bf16* xG = xA + 64 * 72; LAS bf16* xV = xG + 64 * 136; LAS bf16* Lw = xV + 64 * 40;
    LAS float* sLw = (LAS float*)(lds + 5 * TILE_B + 77824);
    const float* mu = P.in[I_MU] + l * 1024;
    {   int tid0 = tid, t0 = ci * 64; asm volatile("" : "+v"(tid0), "+s"(t0));
        const int lane = tid0 & 63, wv = __builtin_amdgcn_readfirstlane(tid0 >> 6);
        {
            const int c8 = tid0 & 31, tg = tid0 >> 5; v4u raw[5];
#pragma unroll
            for (int k = 0; k < 5; ++k) { const int tt = t0 + 4 * tg - 1 + k; raw[k] = *(const v4u*)(cols + (size_t)(tt < 0 ? 0 : tt) * NPAD + 768 + 8 * c8); if (tt < 0) raw[k] = (v4u){0u, 0u, 0u, 0u}; }
            const f32x4 m0 = *(const f32x4*)(mu + 768 + 8 * c8), m1 = *(const f32x4*)(mu + 768 + 8 * c8 + 4);
            const float mu8[8] = {m0[0], m0[1], m0[2], m0[3], m1[0], m1[1], m1[2], m1[3]};
#pragma unroll
            for (int k = 1; k < 5; ++k) { const int t = 4 * tg + k - 1; float o[8];
#pragma unroll
                for (int e = 0; e < 8; ++e) { const unsigned uc = (e < 2 ? raw[k].x : e < 4 ? raw[k].y : e < 6 ? raw[k].z : raw[k].w), up = (e < 2 ? raw[k - 1].x : e < 4 ? raw[k - 1].y : e < 6 ? raw[k - 1].z : raw[k - 1].w);
                    const float cur = bf2f((bf16)((e & 1) ? (uc >> 16) : (uc & 0xffff))), prv = bf2f((bf16)((e & 1) ? (up >> 16) : (up & 0xffff))); const float xs = cur + (prv - cur) * mu8[e];
                    o[e] = (c8 < 8) ? tanhf_(xs) : ((c8 < 16) ? xs : sigmoidf_(xs)); }
                v4u w; w.x = pk2(o[0], o[1]); w.y = pk2(o[2], o[3]); w.z = pk2(o[4], o[5]); w.w = pk2(o[6], o[7]);
                LAS bf16* dst = (c8 < 8) ? (xW + t * 72 + 8 * c8) : ((c8 < 16) ? (xA + t * 72 + 8 * (c8 - 8)) : (xG + t * 136 + 8 * (c8 - 16)));
                *(LAS v4u*)dst = w; }
            if (l > 0 && tid0 < 256) { const int t = tid0 >> 2, c4 = tid0 & 3; *(LAS v4u*)(xV + t * 40 + 8 * c4) = *(const v4u*)(cols + (size_t)(t0 + t) * NPAD + C_VRES + 8 * c4); }
        }
        LDS_SYNC();
        {
            const bf16* lw = (const bf16*)(P.ws + WS_LORA) + (size_t)l * LORA_LAYER; const int c = lane & 31, hh = lane >> 5;
#pragma unroll
            for (int u = 0; u < 8; ++u) { const int which = u >> 1; if (which == 3 && l == 0) continue;
                const int hd = 2 * (u & 1) + (wv >> 2), tb = (wv >> 1) & 1, cb = wv & 1, crow = hd * 64 + cb * 32; f32x16 acc = zero16();
                if (which == 0) mm_tile_gb<4>(acc, xW + tb * 32 * 72, 72, lw + LORA_W + crow * 64, 64, lane);
                else if (which == 1) mm_tile_gb<4>(acc, xA + tb * 32 * 72, 72, lw + LORA_A + crow * 64, 64, lane);
                else if (which == 2) mm_tile_gb<8>(acc, xG + tb * 32 * 136, 136, lw + LORA_G + crow * 128, 128, lane);
                else mm_tile_gb<2>(acc, xV + tb * 32 * 40, 40, lw + LORA_V + crow * 32, 32, lane);
                const size_t chd = (size_t)ci * 4 + hd;
                if (which == 2) { bf16* g = Y + (size_t)(t0 + 32 * tb) * 1024 + 768 + crow + c;
#pragma unroll
                    for (int q = 0; q < 16; ++q) g[(size_t)acc_i(q, hh) * 1024] = (bf16)f2bf(acc[q]); }
                else { bf16* g = (which == 0 ? XP : (which == 1 ? XQ : XR)) + chd * 4096 + (cb * 32 + c) * 64 + 32 * tb + 4 * hh;
#pragma unroll
                    for (int q = 0; q < 4; ++q) { uint2 w; w.x = pk2(acc[4 * q], acc[4 * q + 1]); w.y = pk2(acc[4 * q + 2], acc[4 * q + 3]); *(uint2*)(g + 8 * q) = w; } }
                if (u & 1) asm volatile("" ::: "memory"); }
        }
        __syncthreads();
    }
    v4u pf_w, pf_a, pf_v; unsigned pf_raw[3][5]; unsigned pf_vf[4];
#define RW_PREFETCH(hn) do { const int lane_ = tid & 63, wv_ = tid >> 6, cc_ = (hn) * 64 + lane_; const size_t ch_ = (size_t)ci * 4 + (hn); const int t0_ = ci * 64; \
        pf_w = *(const v4u*)(XP + ch_ * 4096 + lane_ * 64 + wv_ * 8); pf_a = *(const v4u*)(XQ + ch_ * 4096 + lane_ * 64 + wv_ * 8); pf_v = (l > 0) ? *(const v4u*)(XR + ch_ * 4096 + lane_ * 64 + wv_ * 8) : (v4u){0u, 0u, 0u, 0u}; \
        _Pragma("unroll") for (int a_ = 0; a_ < 3; ++a_) _Pragma("unroll") for (int j_ = 0; j_ < 5; ++j_) { const int t0r_ = t0_ + wv_ * 8 - 1 + 2 * j_, t1r_ = t0r_ + 1; \
            unsigned lo_ = cols[(size_t)(t0r_ < 0 ? 0 : t0r_) * NPAD + a_ * 256 + cc_]; if (t0r_ < 0) lo_ = 0u; const unsigned hi_ = (j_ < 4) ? (unsigned)cols[(size_t)t1r_ * NPAD + a_ * 256 + cc_] : 0u; pf_raw[a_][j_] = lo_ | (hi_ << 16); } \
        _Pragma("unroll") for (int j_ = 0; j_ < 4; ++j_) pf_vf[j_] = (l > 0) ? ((unsigned)VF[(size_t)(t0_ + wv_ * 8 + 2 * j_) * 256 + cc_] | ((unsigned)VF[(size_t)(t0_ + wv_ * 8 + 2 * j_ + 1) * 256 + cc_] << 16)) : 0u; } while (0)
#define PF_RAW(a, rr) bf2f((bf16)(((rr) & 1) ? (pf_raw[a][(rr) >> 1] >> 16) : (pf_raw[a][(rr) >> 1] & 0xffffu)))
#define PF_VF(i) bf2f((bf16)(((i) & 1) ? (pf_vf[(i) >> 1] >> 16) : (pf_vf[(i) >> 1] & 0xffffu)))
    RW_PREFETCH(0);
#pragma unroll 1
    for (int h = 0; h < 4; ++h) {
        int tidh = tid, t0 = ci * 64; asm volatile("" : "+v"(tidh), "+s"(t0));
        const int lane = tidh & 63, wv = __builtin_amdgcn_readfirstlane(tidh >> 6);
        const int cc = h * 64 + lane; const size_t ch = (size_t)ci * 4 + h;
        const float w0c = P.in[I_W0][l * 256 + cc], a0c = P.in[I_A0][l * 256 + cc], kkc = P.in[I_KK][l * 256 + cc], kac = P.in[I_KA][l * 256 + cc], rkc = P.in[I_RK][l * 256 + cc];
        const float v0c = (l > 0) ? P.in[I_V0][(l - 1) * 256 + cc] : 0.f;
        const float mu_r = mu[cc], mu_k = mu[256 + cc], mu_v = mu[512 + cc];
        float o_asig[8]; float e_r[8], e_k[8], e_v[8], e_kk[8];
#pragma unroll
        for (int i = 0; i < 8; ++i) { const int t = wv * 8 + i, tt = t0 + t;
            const unsigned uw = (i < 2 ? pf_w.x : i < 4 ? pf_w.y : i < 6 ? pf_w.z : pf_w.w), ua = (i < 2 ? pf_a.x : i < 4 ? pf_a.y : i < 6 ? pf_a.z : pf_a.w), uv = (i < 2 ? pf_v.x : i < 4 ? pf_v.y : i < 6 ? pf_v.z : pf_v.w);
            const float accw = bf2f((bf16)((i & 1) ? (uw >> 16) : (uw & 0xffff))), acca = bf2f((bf16)((i & 1) ? (ua >> 16) : (ua & 0xffff))), accv = bf2f((bf16)((i & 1) ? (uv >> 16) : (uv & 0xffff)));
            const float wlog = -softplusf_(-(w0c + accw)) - 0.5f; const float lwv = -__expf(wlog);
            const float asig = sigmoidf_(a0c + acca); o_asig[i] = asig;
            const float r0 = PF_RAW(0, i + 1), r1 = PF_RAW(0, i), k0 = PF_RAW(1, i + 1), k1 = PF_RAW(1, i), vv0 = PF_RAW(2, i + 1), vv1 = PF_RAW(2, i);
            const float r = r0 + (r1 - r0) * mu_r, k = k0 + (k1 - k0) * mu_k; float v = vv0 + (vv1 - vv0) * mu_v;
            if (l == 0) VF[(size_t)tt * 256 + cc] = (bf16)f2bf(v);
            else v = v + (PF_VF(i) - v) * sigmoidf_(v0c + accv);
            const float kkr = k * kkc; const float ss = wave_sum(kkr * kkr); const float kk = kkr * rsqf_(ss + 1e-24f);
            const float kmod = k * (1.0f + (asig - 1.0f) * kac);
            const float bon = wave_sum(r * kmod * rkc);
            XBV[(ch * 64 + t) * 64 + lane] = (bf16)f2bf(bon * v);
            sLw[t * 64 + lane] = lwv;
            e_r[i] = r; e_k[i] = kmod; e_v[i] = v; e_kk[i] = kk; }
        LDS_SYNC();
        if (tidh < 64) { float run = 0.f;
#pragma unroll 8
            for (int t = 0; t < 64; ++t) { run += sLw[t * 64 + tidh]; sLw[t * 64 + tidh] = run; }
            const float gam = __expf(run); gC[tidh] = gam; XG[ch * 64 + tidh] = gam; }
        LDS_SYNC();
        float at[8], bt[8], kt[8];
#pragma unroll
        for (int i = 0; i < 8; ++i) { const int t = wv * 8 + i; const float cum = sLw[t * 64 + lane], cumm = (t > 0) ? sLw[(t - 1) * 64 + lane] : 0.f;
            const float ep = __expf(cum), en = __expf(-cum), epm = __expf(cumm);
            at[i] = -e_kk[i] * epm; bt[i] = e_kk[i] * o_asig[i] * en; kt[i] = e_k[i] * en;
            tA[t * TS + lane] = (bf16)f2bf(at[i]); tB[t * TS + lane] = (bf16)f2bf(bt[i]); tK[t * TS + lane] = (bf16)f2bf(kt[i]); tR[t * TS + lane] = (bf16)f2bf(e_r[i] * ep); }
        { v4u w; w.x = pk2(e_v[0], e_v[1]); w.y = pk2(e_v[2], e_v[3]); w.z = pk2(e_v[4], e_v[5]); w.w = pk2(e_v[6], e_v[7]); *(LAS v4u*)(tV + lane * TS + wv * 8) = w; }
        LDS_SYNC();
        if (h < 3) RW_PREFETCH(h + 1);
        for (int jb = wv; jb < 16; jb += 8) { const int mat = jb >> 2, r = jb & 3; const int tb = (r == 0 || r == 3) ? 0 : 1, sb = (r == 0 || r == 1) ? 0 : 1;
            f32x16 acc = zero16(); const int c = lane & 31, hh = lane >> 5;
            if (r < 3) { mm_tile<4>(acc, ((mat & 1) ? tK : tB) + sb * 32 * TS, ((mat >> 1) ? tR : tA) + tb * 32 * TS, lane);
#pragma unroll
                for (int q = 0; q < 16; ++q) { const int sI = 32 * sb + acc_i(q, hh), tI = 32 * tb + c; if ((mat < 2) ? (sI >= tI) : (sI > tI)) acc[q] = 0.f; } }
            store_lane_major(tAab + mat * 64 * TS, 32 * tb, 32 * sb, acc, lane);
            if (mat == 0) {
                if (r == 3) store_lane_major(tT1, 0, 32, acc, lane);
                else { store_reg_major(tAabT, 32 * sb, 32 * tb, acc, lane);
#pragma unroll
                    for (int q = 0; q < 16; ++q) if (32 * sb + acc_i(q, hh) == 32 * tb + c) acc[q] += 1.0f;
                    store_lane_major(tT0, 32 * tb, 32 * sb, acc, lane); } }
        }
        LDS_SYNC();
        { v4u w; w.x = pk2(at[0], at[1]); w.y = pk2(at[2], at[3]); w.z = pk2(at[4], at[5]); w.w = pk2(at[6], at[7]); *(LAS v4u*)(tA + lane * TS + wv * 8) = w;
          w.x = pk2(bt[0], bt[1]); w.y = pk2(bt[2], bt[3]); w.z = pk2(bt[4], bt[5]); w.w = pk2(bt[6], bt[7]); *(LAS v4u*)(tB + lane * TS + wv * 8) = w;
          w.x = pk2(kt[0], kt[1]); w.y = pk2(kt[2], kt[3]); w.z = pk2(kt[4], kt[5]); w.w = pk2(kt[6], kt[7]); *(LAS v4u*)(tK + lane * TS + wv * 8) = w; }
        { LAS bf16* const Xr[2] = {tAab, tX1r}; LAS bf16* const Xc[2] = {tAabT, tX1c}; LAS bf16* const Tb[2] = {tT0, tT1};
          neumann_solve(Xr, Xc, Tb, wv, lane, [&]() { const int sb = (wv - 4) >> 1, vb = (wv - 4) & 1; f32x16 acc = zero16();
              mm_tile<4>(acc, tAak + sb * 32 * TS, tV + vb * 32 * TS, lane); store_lane_major(tAV, 32 * vb, 32 * sb, acc, lane); }); }
        { const int which = wv >> 2, tb = (wv >> 1) & 1, jb2 = wv & 1; f32x16 acc = zero16();
            mm_tile<4>(acc, tT + tb * 32 * TS, (which ? tAV : tA) + jb2 * 32 * TS, lane);
            store_lane_major(which ? tU : tW, 32 * jb2, 32 * tb, acc, lane); }
        LDS_SYNC();
        for (int jb = wv; jb < 16; jb += 8) { const int out = jb >> 2, ib = (jb >> 1) & 1, jb2 = jb & 1; f32x16 acc = zero16(); const int c = lane & 31, hh = lane >> 5;
            if (out == 0) mm_tile<4>(acc, tB + ib * 32 * TS, tW + jb2 * 32 * TS, lane);
            else if (out == 1) { mm_tile<4>(acc, tB + ib * 32 * TS, tU + jb2 * 32 * TS, lane); mm_tile<4>(acc, tK + ib * 32 * TS, tV + jb2 * 32 * TS, lane); }
            else if (out == 2) mm_tile<4>(acc, tArb + ib * 32 * TS, tW + jb2 * 32 * TS, lane);
            else { mm_tile<4>(acc, tArb + ib * 32 * TS, tU + jb2 * 32 * TS, lane); mm_tile<4>(acc, tArk + ib * 32 * TS, tV + jb2 * 32 * TS, lane); }
            if (out == 0) { bf16* g = XP + ch * 4096 + 32 * jb2 + c;
#pragma unroll
                for (int q = 0; q < 16; ++q) { const int row = 32 * ib + acc_i(q, hh); g[row * 64] = (bf16)f2bf(acc[q] * gC[row]); } }
            else if (out == 1) { bf16* g = XQ + ch * 4096 + (32 * jb2 + c) * 64 + 32 * ib + 4 * hh;
#pragma unroll
                for (int q = 0; q < 4; ++q) { const int row = 32 * ib + 8 * q + 4 * hh; uint2 w; w.x = pk2(acc[4 * q] * gC[row], acc[4 * q + 1] * gC[row + 1]); w.y = pk2(acc[4 * q + 2] * gC[row + 2], acc[4 * q + 3] * gC[row + 3]); *(uint2*)(g + 8 * q) = w; } }
            else if (out == 2) { bf16* g = XR + ch * 4096 + 32 * jb2 + c;
#pragma unroll
                for (int q = 0; q < 16; ++q) { const int row = 32 * ib + acc_i(q, hh); g[row * 64] = (bf16)f2bf(acc[q] + bf2f(tR[row * TS + 32 * jb2 + c])); } }
            else { bf16* g = Y + (size_t)t0 * 1024 + h * 64 + 32 * jb2 + c;
#pragma unroll
                for (int q = 0; q < 16; ++q) { const int row = 32 * ib + acc_i(q, hh); g[(size_t)row * 1024] = (bf16)f2bf(acc[q]); } }
        }
        LDS_SYNC();
    }
}
__device__ __forceinline__ void rwkv_m3(const Params& P, int l, int ci, LAS unsigned char* lds, int tid, bool do_store = true) {
    bf16* Y = (bf16*)(P.ws + WS_Y); const bf16* XQ = (const bf16*)(P.ws + WS_RQ); const bf16* XR = (const bf16*)(P.ws + WS_RR); const bf16* XBV = (const bf16*)(P.ws + WS_RBV);
    const int lane = tid & 63, wv = __builtin_amdgcn_readfirstlane(tid >> 6), t0 = ci * 64;
    dplr_m3_stage(XQ, ci, lds, tid);
    LDS_SYNC();
    const int h = wv >> 1, tb = wv & 1, c = lane & 31, hh = lane >> 5; const size_t ch = (size_t)ci * 4 + h;
    f32x16 acc[2];
    dplr_m3_core(acc, (const LAS bf16*)(lds + h * TILE_B), XR + ch * 4096, tb, lane);
    const size_t trow = (size_t)(t0 + 32 * tb + c);
    bf16* yrow = Y + trow * 1024 + h * 64; const bf16* grow = Y + trow * 1024 + 768 + h * 64; const bf16* bvrow = XBV + (ch * 64 + 32 * tb + c) * 64;
    const float* lnw = P.in[I_LNW] + l * 256 + h * 64; const float* lnb = P.in[I_LNB] + l * 256 + h * 64;
    float s = 0.f;
#pragma unroll
    for (int vb = 0; vb < 2; ++vb)
#pragma unroll
        for (int q = 0; q < 4; ++q) { const int v = 32 * vb + 8 * q + 4 * hh; const uint2 w = *(const uint2*)(yrow + v);
            acc[vb][4 * q] += bf2f((bf16)(w.x & 0xffff)); acc[vb][4 * q + 1] += bf2f((bf16)(w.x >> 16)); acc[vb][4 * q + 2] += bf2f((bf16)(w.y & 0xffff)); acc[vb][4 * q + 3] += bf2f((bf16)(w.y >> 16));
            s += (acc[vb][4 * q] + acc[vb][4 * q + 1]) + (acc[vb][4 * q + 2] + acc[vb][4 * q + 3]); }
    s += __shfl_xor(s, 32);
    const float mean = s * (1.0f / 64.0f); float qq = 0.f;
#pragma unroll
    for (int vb = 0; vb < 2; ++vb)
#pragma unroll
        for (int r = 0; r < 16; ++r) { acc[vb][r] -= mean; qq += acc[vb][r] * acc[vb][r]; }
    qq += __shfl_xor(qq, 32);
    const float rstd = rsqf_(qq * (1.0f / 64.0f) + 64e-5f);
#pragma unroll
    for (int vb = 0; vb < 2; ++vb)
#pragma unroll
        for (int q = 0; q < 4; ++q) { const int v = 32 * vb + 8 * q + 4 * hh; const uint2 gw = *(const uint2*)(grow + v); const uint2 bw = *(const uint2*)(bvrow + v); float o[4];
            const float g4[4] = {bf2f((bf16)(gw.x & 0xffff)), bf2f((bf16)(gw.x >> 16)), bf2f((bf16)(gw.y & 0xffff)), bf2f((bf16)(gw.y >> 16))};
            const float b4[4] = {bf2f((bf16)(bw.x & 0xffff)), bf2f((bf16)(bw.x >> 16)), bf2f((bf16)(bw.y & 0xffff)), bf2f((bf16)(bw.y >> 16))};
#pragma unroll
            for (int e = 0; e < 4; ++e) o[e] = (acc[vb][4 * q + e] * rstd * lnw[v + e] + lnb[v + e] + b4[e]) * g4[e];
            uint2 w; w.x = pk2(o[0], o[1]); w.y = pk2(o[2], o[3]); if (do_store) *(uint2*)(yrow + v) = w; }
    LDS_SYNC();
}
#ifndef REP_GA
#define REP_GA 1
#endif
#ifndef REP_GS
#define REP_GS 1
#endif
#ifndef REP_G4
#define REP_G4 1
#endif
__device__ __forceinline__ void gdn_m1(const Params& P, int l, int ci, LAS unsigned char* lds, int tid) {
    const bf16* cols = (const bf16*)(P.ws + WS_COLS); bf16* Y = (bf16*)(P.ws + WS_Y);
    bf16* XP = (bf16*)(P.ws + WS_DP); bf16* XQ = (bf16*)(P.ws + WS_DQ); bf16* XR = (bf16*)(P.ws + WS_DR); float* XG = (float*)(P.ws + WS_XG) + 1024 * 64;
    LAS bf16* tKn = (LAS bf16*)lds; LAS bf16* tQn = tKn + 64 * TS; LAS bf16* tBV = tQn + 64 * TS; LAS bf16* tBK = tBV + 64 * TS; LAS bf16* tKd = tBK + 64 * TS;
    LAS bf16* tAab = tKd + 64 * TS; LAS bf16* tAabT = tAab + 64 * TS; LAS bf16* tX1r = tAabT + 64 * TS; LAS bf16* tX1c = tX1r + 64 * TS; LAS bf16* tT0 = tX1c + 64 * TS; LAS bf16* tT1 = tT0 + 64 * TS; LAS bf16* tQk = tT1 + 64 * TS;
    LAS bf16* tW = tAab; LAS bf16* tU = tAabT; LAS bf16* tT = tT1;
    LAS float* sG = (LAS float*)(lds + 12 * TILE_B); LAS float* sGc = sG + 64; LAS float* sBe = sGc + 64;
    const float* cw = P.in[I_CONV] + (size_t)l * 4 * 768;
#pragma unroll 1
    for (int h = 0; h < 4; ++h) {
        int tidh = tid, t0 = ci * 64; asm volatile("" : "+v"(tidh), "+s"(t0));
        const int lane = tidh & 63, wv = __builtin_amdgcn_readfirstlane(tidh >> 6); const size_t ch = (size_t)ci * 4 + h;
        const float alog = P.in[I_ALOG][l * 4 + h], dtb = P.in[I_DTB][l * 4 + h];
        float e_q[8], e_k[8], e_v[8], e_be[8]; float gcs[8], gc63;
        {
            float raw[3][11], braw[8], araw[8], cwv[3][4];
#pragma unroll
            for (int a = 0; a < 3; ++a)
#pragma unroll
                for (int r = 0; r < 11; ++r) { const int ts = t0 + wv * 8 - 3 + r; const float v = ldcol(cols, ts < 0 ? 0 : ts, C_GDN + a * 256 + h * 64 + lane); raw[a][r] = (ts < 0) ? 0.f : v; }
#pragma unroll
            for (int i = 0; i < 8; ++i) { braw[i] = ldcol(cols, t0 + wv * 8 + i, C_GDN + 1024 + h); araw[i] = ldcol(cols, t0 + wv * 8 + i, C_GDN + 1028 + h); }
#pragma unroll
            for (int a = 0; a < 3; ++a)
#pragma unroll
                for (int i = 0; i < 4; ++i) cwv[a][i] = cw[i * 768 + a * 256 + h * 64 + lane];
            float gv[8];
#pragma unroll
            for (int i = 0; i < 8; ++i) { float o3[3];
#pragma unroll
                for (int a = 0; a < 3; ++a) o3[a] = siluf_(cwv[a][0] * raw[a][i] + cwv[a][1] * raw[a][i + 1] + cwv[a][2] * raw[a][i + 2] + cwv[a][3] * raw[a][i + 3]);
                const float sq = wave_sum(o3[0] * o3[0]), sk = wave_sum(o3[1] * o3[1]);
                e_q[i] = o3[0] * rsqf_(sq + 1e-6f) * 0.125f; e_k[i] = o3[1] * rsqf_(sk + 1e-6f); e_v[i] = o3[2];
                e_be[i] = sigmoidf_(braw[i]); gv[i] = -__expf(alog) * softplusf_(araw[i] + dtb); }
            float gsel = gv[0], bsel = e_be[0];
#pragma unroll
            for (int i = 1; i < 8; ++i) { gsel = (lane == i) ? gv[i] : gsel; bsel = (lane == i) ? e_be[i] : bsel; }
            if (lane < 8) { sG[wv * 8 + lane] = gsel; sBe[wv * 8 + lane] = bsel; }
        }
        LDS_SYNC();
        { const float gl = sG[lane]; float run = gl;
#pragma unroll
            for (int o = 1; o < 64; o <<= 1) { const float up = __shfl_up(run, o); if (lane >= o) run += up; }
            gc63 = __shfl(run, 63);
#pragma unroll
            for (int i = 0; i < 8; ++i) gcs[i] = __shfl(run, wv * 8 + i);
            if (wv == 0) { sGc[lane] = run; XG[ch * 64 + lane] = __expf(gc63); } }
        float bk[8], kd[8], bv[8];
#pragma unroll
        for (int i = 0; i < 8; ++i) { const int t = wv * 8 + i;
            tKn[t * TS + lane] = (bf16)f2bf(e_k[i]); tQn[t * TS + lane] = (bf16)f2bf(e_q[i]);
            bv[i] = e_be[i] * e_v[i]; bk[i] = e_be[i] * e_k[i] * __expf(gcs[i]); kd[i] = e_k[i] * __expf(gc63 - gcs[i]); }
        { v4u w; w.x = pk2(bv[0], bv[1]); w.y = pk2(bv[2], bv[3]); w.z = pk2(bv[4], bv[5]); w.w = pk2(bv[6], bv[7]); *(LAS v4u*)(tBV + lane * TS + wv * 8) = w;
          w.x = pk2(bk[0], bk[1]); w.y = pk2(bk[2], bk[3]); w.z = pk2(bk[4], bk[5]); w.w = pk2(bk[6], bk[7]); *(LAS v4u*)(tBK + lane * TS + wv * 8) = w;
          w.x = pk2(kd[0], kd[1]); w.y = pk2(kd[2], kd[3]); w.z = pk2(kd[4], kd[5]); w.w = pk2(kd[6], kd[7]); *(LAS v4u*)(tKd + lane * TS + wv * 8) = w; }
        LDS_SYNC();
        for (int rpd_ = 0; rpd_ < REP_GS; ++rpd_)
        { const int mat = wv >> 2, r = wv & 3; const int tb = (r == 0 || r == 3) ? 0 : 1, sb = (r == 0 || r == 1) ? 0 : 1;
            f32x16 acc = zero16(); const int c = lane & 31, hh = lane >> 5;
            if (r < 3) { mm_tile<4>(acc, tKn + sb * 32 * TS, (mat ? tQn : tKn) + tb * 32 * TS, lane);
                const int tI = 32 * tb + c; const float gct = sGc[tI], bet = sBe[tI];
#pragma unroll
                for (int q = 0; q < 16; ++q) { const int sI = 32 * sb + acc_i(q, hh);
                    if ((mat == 0) ? (sI >= tI) : (sI > tI)) acc[q] = 0.f;
                    else { const float dcy = __expf(gct - sGc[sI]); acc[q] = (mat == 0) ? (-bet * acc[q] * dcy) : (acc[q] * dcy); } } }
            if (mat == 0) { store_lane_major(tAab, 32 * tb, 32 * sb, acc, lane);
                if (r == 3) store_lane_major(tT1, 0, 32, acc, lane);
                else { store_reg_major(tAabT, 32 * sb, 32 * tb, acc, lane);
#pragma unroll
                    for (int q = 0; q < 16; ++q) if (32 * sb + acc_i(q, hh) == 32 * tb + c) acc[q] += 1.0f;
                    store_lane_major(tT0, 32 * tb, 32 * sb, acc, lane); } }
            else store_lane_major(tQk, 32 * tb, 32 * sb, acc, lane);
        }
        LDS_SYNC();
        { LAS bf16* const Xr[2] = {tAab, tX1r}; LAS bf16* const Xc[2] = {tAabT, tX1c}; LAS bf16* const Tb[2] = {tT0, tT1};
          neumann_solve(Xr, Xc, Tb, wv, lane, [&]() {}); }
        { const int which = wv >> 2, tb = (wv >> 1) & 1, jb2 = wv & 1; f32x16 acc = zero16();
            mm_tile<4>(acc, tT + tb * 32 * TS, (which ? tBV : tBK) + jb2 * 32 * TS, lane);
            store_lane_major(which ? tU : tW, 32 * jb2, 32 * tb, acc, lane); }
        LDS_SYNC();
        for (int rpg_ = 0; rpg_ < REP_G4; ++rpg_)
        for (int jb = wv; jb < 16; jb += 8) { const int out = jb >> 2, ib = (jb >> 1) & 1, jb2 = jb & 1; f32x16 acc = zero16(); const int c = lane & 31, hh = lane >> 5;
            if (out < 2) mm_tile<4>(acc, tKd + ib * 32 * TS, (out ? tU : tW) + jb2 * 32 * TS, lane);
            else mm_tile<4>(acc, tQk + ib * 32 * TS, (out == 3 ? tU : tW) + jb2 * 32 * TS, lane);
            if (out == 0) { bf16* g = XP + ch * 4096 + 32 * jb2 + c;
#pragma unroll
                for (int q = 0; q < 16; ++q) { const int row = 32 * ib + acc_i(q, hh); g[row * 64] = (bf16)f2bf(-acc[q]); } }
            else if (out == 1) { bf16* g = XQ + ch * 4096 + (32 * jb2 + c) * 64 + 32 * ib + 4 * hh;
#pragma unroll
                for (int q = 0; q < 4; ++q) { uint2 w; w.x = pk2(acc[4 * q], acc[4 * q + 1]); w.y = pk2(acc[4 * q + 2], acc[4 * q + 3]); *(uint2*)(g + 8 * q) = w; } }
            else if (out == 2) { bf16* g = XR + ch * 4096 + 32 * jb2 + c;
#pragma unroll
                for (int q = 0; q < 16; ++q) { const int row = 32 * ib + acc_i(q, hh); g[row * 64] = (bf16)f2bf(bf2f(tQn[row * TS + 32 * jb2 + c]) * __expf(sGc[row]) - acc[q]); } }
            else { bf16* g = Y + (size_t)t0 * 1024 + 256 + h * 64 + 32 * jb2 + c;
#pragma unroll
                for (int q = 0; q < 16; ++q) { const int row = 32 * ib + acc_i(q, hh); g[(size_t)row * 1024] = (bf16)f2bf(acc[q]); } }
        }
        LDS_SYNC();
    }
}
__device__ __forceinline__ void gdn_m3(const Params& P, int l, int ci, LAS unsigned char* lds, int tid, bool do_store = true) {
    const bf16* cols = (const bf16*)(P.ws + WS_COLS); bf16* Y = (bf16*)(P.ws + WS_Y); const bf16* XQ = (const bf16*)(P.ws + WS_DQ); const bf16* XR = (const bf16*)(P.ws + WS_DR);
    const float* ng = P.in[I_GDNG] + l * 64;
    const int lane = tid & 63, wv = __builtin_amdgcn_readfirstlane(tid >> 6), t0 = ci * 64;
    dplr_m3_stage(XQ, ci, lds, tid);
    LDS_SYNC();
    const int h = wv >> 1, tb = wv & 1, c = lane & 31, hh = lane >> 5; const size_t ch = (size_t)ci * 4 + h;
    f32x16 acc[2];
    dplr_m3_core(acc, (const LAS bf16*)(lds + h * TILE_B), XR + ch * 4096, tb, lane);
    const size_t trow = (size_t)(t0 + 32 * tb + c);
    bf16* yrow = Y + trow * 1024 + 256 + h * 64; const bf16* zrow = cols + trow * NPAD + C_GDN + 768 + h * 64;
    float ss = 0.f;
#pragma unroll
    for (int vb = 0; vb < 2; ++vb)
#pragma unroll
        for (int q = 0; q < 4; ++q) { const int v = 32 * vb + 8 * q + 4 * hh; const uint2 w = *(const uint2*)(yrow + v);
            acc[vb][4 * q] += bf2f((bf16)(w.x & 0xffff)); acc[vb][4 * q + 1] += bf2f((bf16)(w.x >> 16)); acc[vb][4 * q + 2] += bf2f((bf16)(w.y & 0xffff)); acc[vb][4 * q + 3] += bf2f((bf16)(w.y >> 16));
#pragma unroll
            for (int e = 0; e < 4; ++e) ss += acc[vb][4 * q + e] * acc[vb][4 * q + e]; }
    ss += __shfl_xor(ss, 32);
    const float rstd = rsqf_(ss * (1.0f / 64.0f) + 1e-6f);
#pragma unroll
    for (int vb = 0; vb < 2; ++vb)
#pragma unroll
        for (int q = 0; q < 4; ++q) { const int v = 32 * vb + 8 * q + 4 * hh; const uint2 zw = *(const uint2*)(zrow + v); float o[4];
            const float z4[4] = {bf2f((bf16)(zw.x & 0xffff)), bf2f((bf16)(zw.x >> 16)), bf2f((bf16)(zw.y & 0xffff)), bf2f((bf16)(zw.y >> 16))};
#pragma unroll
            for (int e = 0; e < 4; ++e) o[e] = acc[vb][4 * q + e] * rstd * ng[v + e] * siluf_(z4[e]);
            uint2 w; w.x = pk2(o[0], o[1]); w.y = pk2(o[2], o[3]); if (do_store) *(uint2*)(yrow + v) = w; }
    LDS_SYNC();
}
constexpr int SGS = 136;
__device__ __forceinline__ void sgu_m3(const Params& P, int l, int ci, LAS unsigned char* lds, int tid) {
    const bf16* cols = (const bf16*)(P.ws + WS_COLS); bf16* Y = (bf16*)(P.ws + WS_Y);
    LAS bf16* VlT = (LAS bf16*)lds;
    LAS bf16* Wt = VlT + 256 * SGS;
    const int lane = tid & 63, wv = __builtin_amdgcn_readfirstlane(tid >> 6), half = ci & 1, tbase = (ci >> 1) * 128, ntok = half ? 128 : 64;
    const float* lg = P.in[I_SLG] + l * 256; const float* lb = P.in[I_SLB] + l * 256;
    const float* ws_ = P.in[I_SWS] + (size_t)l * 4 * 128 * 128; const float* bs_ = P.in[I_SBS] + l * 4 * 128;
    { const f32x4 g4 = *(const f32x4*)(lg + lane * 4), b4 = *(const f32x4*)(lb + lane * 4);
#pragma unroll 1
      for (int tb8 = 0; tb8 < ntok / 8; tb8 += 8) { uint2 raw[8];
#pragma unroll
        for (int i = 0; i < 8; ++i) raw[i] = *(const uint2*)(cols + (size_t)(tbase + wv + 8 * (tb8 + i)) * NPAD + C_SGU + 256 + lane * 4);
#pragma unroll
        for (int i = 0; i < 8; ++i) { const int t = wv + 8 * (tb8 + i); float v[4]; float s = 0.f;
            v[0] = geluf_(bf2f((bf16)(raw[i].x & 0xffff))); v[1] = geluf_(bf2f((bf16)(raw[i].x >> 16))); v[2] = geluf_(bf2f((bf16)(raw[i].y & 0xffff))); v[3] = geluf_(bf2f((bf16)(raw[i].y >> 16)));
            s = (v[0] + v[1]) + (v[2] + v[3]);
            const float mean = wave_sum(s) * (1.0f / 256.0f); float q = 0.f;
#pragma unroll
            for (int e = 0; e < 4; ++e) { v[e] -= mean; q += v[e] * v[e]; }
            const float rstd = rsqf_(wave_sum(q) * (1.0f / 256.0f) + 1e-5f);
#pragma unroll
            for (int e = 0; e < 4; ++e) VlT[(lane * 4 + e) * SGS + t] = (bf16)f2bf(v[e] * rstd * g4[e] + b4[e]); } } }
    { const int n4 = ntok / 4;
#pragma unroll 4
      for (int idx = tid; idx < 4 * 64 * n4; idx += NT) { const int s4 = idx % n4, row = idx / n4, g = row >> 6, t = row & 63, ta = 64 * half + t;
        const f32x4 w = *(const f32x4*)(ws_ + ((size_t)g * 128 + ta) * 128 + 4 * s4);
        u32x2 o; o.x = pk2(4 * s4 <= ta ? w[0] : 0.f, 4 * s4 + 1 <= ta ? w[1] : 0.f); o.y = pk2(4 * s4 + 2 <= ta ? w[2] : 0.f, 4 * s4 + 3 <= ta ? w[3] : 0.f);
        *(LAS u32x2*)(Wt + (g * 64 + t) * SGS + 4 * s4) = o; } }
    LDS_SYNC();
#pragma unroll 1
    for (int jb = wv; jb < 16; jb += 8) { const int g = jb >> 2, tb = (jb >> 1) & 1, cb = jb & 1; const int c = lane & 31, hh = lane >> 5;
        const int KT = 4 * half + 2 * tb + 2;
        f32x16 acc = zero16();
        const LAS bf16* Ar = Wt + (g * 64 + tb * 32 + c) * SGS + hh * 8; const LAS bf16* Br = VlT + (g * 64 + cb * 32 + c) * SGS + hh * 8;
#pragma unroll 2
        for (int kk = 0; kk < KT; ++kk) acc = __builtin_amdgcn_mfma_f32_32x32x16_bf16(*(const LAS bf16x8*)(Ar + kk * 16), *(const LAS bf16x8*)(Br + kk * 16), acc, 0, 0, 0);
        const int ch = g * 64 + cb * 32 + c; float uu[16], bb[16];
#pragma unroll
        for (int q = 0; q < 16; ++q) { const int ta = 64 * half + 32 * tb + acc_i(q, hh); uu[q] = ldcol(cols, tbase + ta, C_SGU + ch); bb[q] = bs_[g * 128 + ta]; }
#pragma unroll
        for (int q = 0; q < 16; ++q) { const int ta = 64 * half + 32 * tb + acc_i(q, hh); Y[(size_t)(tbase + ta) * 1024 + 768 + ch] = (bf16)f2bf(geluf_(uu[q]) * (acc[q] + bb[q])); } }
    LDS_SYNC();
}
__device__ __forceinline__ void unpack4(const uint2 w, float (&o)[4]) { o[0] = bf2f((bf16)(w.x & 0xffff)); o[1] = bf2f((bf16)(w.x >> 16)); o[2] = bf2f((bf16)(w.y & 0xffff)); o[3] = bf2f((bf16)(w.y >> 16)); }
__device__ __forceinline__ void mix_m3(const Params& P, int l, int ci, LAS unsigned char* lds, int tid) {
    const bf16* cols = (const bf16*)(P.ws + WS_COLS); bf16* Y = (bf16*)(P.ws + WS_Y);
    const bf16* RQ = (const bf16*)(P.ws + WS_RQ); const bf16* RR = (const bf16*)(P.ws + WS_RR); const bf16* RBV = (const bf16*)(P.ws + WS_RBV);
    const bf16* DQ = (const bf16*)(P.ws + WS_DQ); const bf16* DR = (const bf16*)(P.ws + WS_DR);
    const float* GKV = (const float*)(P.ws + WS_GKV); const bf16* GQI = (const bf16*)(P.ws + WS_GQI);
    const int lane = tid & 63, wv = __builtin_amdgcn_readfirstlane(tid >> 6), t0 = ci * 64;
    const int h = wv >> 1, tb = wv & 1, c = lane & 31, hh = lane >> 5; const size_t ch = (size_t)ci * 4 + h;
    const size_t trow = (size_t)(t0 + 32 * tb + c);
    v4u st_r[4], st_d[4]; float st_g[16];
#pragma unroll
    for (int i = 0; i < 4; ++i) { st_r[i] = *(const v4u*)(RQ + (size_t)ci * 16384 + (size_t)(tid + NT * i) * 8); st_d[i] = *(const v4u*)(DQ + (size_t)ci * 16384 + (size_t)(tid + NT * i) * 8); }
#pragma unroll
    for (int i = 0; i < 16; ++i) st_g[i] = GKV[(size_t)ci * 8192 + tid + NT * i];
#pragma unroll
    for (int i = 0; i < 4; ++i) { const int idx = tid + NT * i, hq = idx >> 9, v = (idx >> 3) & 63, c8 = idx & 7;
        *(LAS v4u*)(lds + hq * TILE_B + v * (TS * 2) + c8 * 16) = st_r[i]; *(LAS v4u*)(lds + (4 + hq) * TILE_B + v * (TS * 2) + c8 * 16) = st_d[i]; }
#pragma unroll
    for (int i = 0; i < 16; ++i) { const int idx = tid + NT * i, hq = idx >> 11, k = (idx >> 6) & 31, v = idx & 63; ((LAS bf16*)(lds + (8 + hq) * TILE_B))[v * TS + k] = (bf16)f2bf(st_g[i]); }
    asm volatile("" ::: "memory");
    bf16x8 b_r[4], b_d[4], b_g[2];
#pragma unroll
    for (int kk = 0; kk < 4; ++kk) { b_r[kk] = *(const bf16x8*)(RR + ch * 4096 + (32 * tb + c) * 64 + hh * 8 + kk * 16); b_d[kk] = *(const bf16x8*)(DR + ch * 4096 + (32 * tb + c) * 64 + hh * 8 + kk * 16); }
#pragma unroll
    for (int kk = 0; kk < 2; ++kk) b_g[kk] = *(const bf16x8*)(GQI + (ch * 64 + 32 * tb + c) * 32 + hh * 8 + kk * 16);
    bf16* y_r = Y + trow * 1024 + h * 64; bf16* y_d = Y + trow * 1024 + 256 + h * 64; bf16* y_g = Y + trow * 1024 + 512 + h * 64;
    const bf16* g_r = Y + trow * 1024 + 768 + h * 64; const bf16* bv_r = RBV + (ch * 64 + 32 * tb + c) * 64;
    const bf16* z_d = cols + trow * NPAD + C_GDN + 768 + h * 64; const bf16* gt_g = cols + trow * NPAD + C_GLA + 512 + h * 64;
    uint2 e_y[8], e_g[8], e_b[8];
#pragma unroll
    for (int j = 0; j < 8; ++j) { const int v = 32 * (j >> 2) + 8 * (j & 3) + 4 * hh; e_y[j] = *(const uint2*)(y_r + v); e_g[j] = *(const uint2*)(g_r + v); e_b[j] = *(const uint2*)(bv_r + v); }
    uint2 d_y[8], d_z[8], g_y[8], g_t[8];
    LDS_SYNC();
    {   f32x16 acc[2]; acc[0] = zero16(); acc[1] = zero16(); const LAS bf16* tH = (const LAS bf16*)(lds + h * TILE_B);
#pragma unroll
        for (int kk = 0; kk < 4; ++kk)
#pragma unroll
            for (int vb = 0; vb < 2; ++vb) acc[vb] = __builtin_amdgcn_mfma_f32_32x32x16_bf16(*(const LAS bf16x8*)(tH + (vb * 32 + c) * TS + hh * 8 + kk * 16), b_r[kk], acc[vb], 0, 0, 0);
#pragma unroll
        for (int j = 0; j < 8; ++j) { const int v = 32 * (j >> 2) + 8 * (j & 3) + 4 * hh; d_y[j] = *(const uint2*)(y_d + v); d_z[j] = *(const uint2*)(z_d + v); }
        const float* lnw = P.in[I_LNW] + l * 256 + h * 64; const float* lnb = P.in[I_LNB] + l * 256 + h * 64;
        float s = 0.f;
#pragma unroll
        for (int j = 0; j < 8; ++j) { float o4[4]; unpack4(e_y[j], o4);
#pragma unroll
            for (int e = 0; e < 4; ++e) { acc[j >> 2][4 * (j & 3) + e] += o4[e]; s += acc[j >> 2][4 * (j & 3) + e]; } }
        s += __shfl_xor(s, 32);
        const float mean = s * (1.0f / 64.0f); float qq = 0.f;
#pragma unroll
        for (int vb = 0; vb < 2; ++vb)
#pragma unroll
            for (int r = 0; r < 16; ++r) { acc[vb][r] -= mean; qq += acc[vb][r] * acc[vb][r]; }
        qq += __shfl_xor(qq, 32);
        const float rstd = rsqf_(qq * (1.0f / 64.0f) + 64e-5f);
#pragma unroll
        for (int j = 0; j < 8; ++j) { const int v = 32 * (j >> 2) + 8 * (j & 3) + 4 * hh; float g4[4], b4[4], o[4]; unpack4(e_g[j], g4); unpack4(e_b[j], b4);
            const f32x4 w4 = *(const f32x4*)(lnw + v), bb4 = *(const f32x4*)(lnb + v);
#pragma unroll
            for (int e = 0; e < 4; ++e) o[e] = (acc[j >> 2][4 * (j & 3) + e] * rstd * w4[e] + bb4[e] + b4[e]) * g4[e];
            uint2 w; w.x = pk2(o[0], o[1]); w.y = pk2(o[2], o[3]); *(uint2*)(y_r + v) = w; if (j & 1) asm volatile("" ::: "memory"); }
    }
    asm volatile("" ::: "memory");
#pragma unroll
    for (int j = 0; j < 8; ++j) { const int v = 32 * (j >> 2) + 8 * (j & 3) + 4 * hh; g_y[j] = *(const uint2*)(y_g + v); g_t[j] = *(const uint2*)(gt_g + v); }
    {   f32x16 acc[2]; acc[0] = zero16(); acc[1] = zero16(); const LAS bf16* tH = (const LAS bf16*)(lds + (4 + h) * TILE_B);
#pragma unroll
        for (int kk = 0; kk < 4; ++kk)
#pragma unroll
            for (int vb = 0; vb < 2; ++vb) acc[vb] = __builtin_amdgcn_mfma_f32_32x32x16_bf16(*(const LAS bf16x8*)(tH + (vb * 32 + c) * TS + hh * 8 + kk * 16), b_d[kk], acc[vb], 0, 0, 0);
        const float* ng = P.in[I_GDNG] + l * 64; float ss = 0.f;
#pragma unroll
        for (int j = 0; j < 8; ++j) { float o4[4]; unpack4(d_y[j], o4);
#pragma unroll
            for (int e = 0; e < 4; ++e) { acc[j >> 2][4 * (j & 3) + e] += o4[e]; ss += acc[j >> 2][4 * (j & 3) + e] * acc[j >> 2][4 * (j & 3) + e]; } }
        ss += __shfl_xor(ss, 32);
        const float rstd = rsqf_(ss * (1.0f / 64.0f) + 1e-6f);
#pragma unroll
        for (int j = 0; j < 8; ++j) { const int v = 32 * (j >> 2) + 8 * (j & 3) + 4 * hh; float z4[4], o[4]; unpack4(d_z[j], z4); const f32x4 n4 = *(const f32x4*)(ng + v);
#pragma unroll
            for (int e = 0; e < 4; ++e) o[e] = acc[j >> 2][4 * (j & 3) + e] * rstd * n4[e] * siluf_(z4[e]);
            uint2 w; w.x = pk2(o[0], o[1]); w.y = pk2(o[2], o[3]); *(uint2*)(y_d + v) = w; if (j & 1) asm volatile("" ::: "memory"); }
    }
    {   f32x16 acc[2]; acc[0] = zero16(); acc[1] = zero16(); const LAS bf16* tS = (const LAS bf16*)(lds + (8 + h) * TILE_B);
#pragma unroll
        for (int kk = 0; kk < 2; ++kk)
#pragma unroll
            for (int vb = 0; vb < 2; ++vb) acc[vb] = __builtin_amdgcn_mfma_f32_32x32x16_bf16(*(const LAS bf16x8*)(tS + (vb * 32 + c) * TS + hh * 8 + kk * 16), b_g[kk], acc[vb], 0, 0, 0);
        const float* ng = P.in[I_GLAG] + l * 64; float ss = 0.f;
#pragma unroll
        for (int j = 0; j < 8; ++j) { float o4[4]; unpack4(g_y[j], o4);
#pragma unroll
            for (int e = 0; e < 4; ++e) { acc[j >> 2][4 * (j & 3) + e] += o4[e]; ss += acc[j >> 2][4 * (j & 3) + e] * acc[j >> 2][4 * (j & 3) + e]; } }
        ss += __shfl_xor(ss, 32);
        const float rstd = rsqf_(ss * (1.0f / 64.0f) + 1e-6f);
#pragma unroll
        for (int j = 0; j < 8; ++j) { const int v = 32 * (j >> 2) + 8 * (j & 3) + 4 * hh; float t4[4], o[4]; unpack4(g_t[j], t4); const f32x4 n4 = *(const f32x4*)(ng + v);
#pragma unroll
            for (int e = 0; e < 4; ++e) o[e] = acc[j >> 2][4 * (j & 3) + e] * rstd * n4[e] * siluf_(t4[e]);
            uint2 w; w.x = pk2(o[0], o[1]); w.y = pk2(o[2], o[3]); *(uint2*)(y_g + v) = w; if (j & 1) asm volatile("" ::: "memory"); }
    }
    LDS_SYNC();
}
#ifndef REP_P0
#define REP_P0 1
#endif
#ifndef REP_FN
#define REP_FN 1
#endif
#ifndef REP_G2
#define REP_G2 1
#endif
#ifndef REP_DN
#define REP_DN 1
#endif
#ifndef REP_M2
#define REP_M2 1
#endif
#ifndef REP_M3
#define REP_M3 1
#endif
#ifndef REP_RW
#define REP_RW 1
#endif
#ifndef REP_GD
#define REP_GD 1
#endif
#ifndef REP_M1
#define REP_M1 1
#endif
#ifndef REP_SGU
#define REP_SGU 1
#endif
#ifndef REP_G1
#define REP_G1 1
#endif
#ifndef REP_UP
#define REP_UP 1
#endif
#define GRID_SYNC() xcd_barrier(xbar)
__global__ void __launch_bounds__(NT, 2) fwd_kernel(Params P) {
    extern __shared__ __attribute__((aligned(16))) unsigned char lds_raw[];
    LAS unsigned char* ldsl = (LAS unsigned char*)lds_raw;
    const int G = gridDim.x;
    if (threadIdx.x < 16) ((LAS unsigned*)(ldsl + LDS_BYTES - 64))[threadIdx.x] = 0u;
    __syncthreads();
    const XcdBarrier xbar = xcd_barrier_post((unsigned*)(P.ws + WS_BAR), (volatile LAS unsigned*)(ldsl + LDS_BYTES - 64));
#define PHASE_TID() int tid = threadIdx.x; asm volatile("" : "+v"(tid)); const int lane = tid & 63, wave = __builtin_amdgcn_readfirstlane(tid >> 6); const int gw = blockIdx.x * NWAVES + wave, NGW = G * NWAVES; (void)lane; (void)gw; (void)NGW
    {
        PHASE_TID();
        for (int rep_ = 0; rep_ < REP_P0; ++rep_) {
        prologue_weights(P, 0, 1, (float*)lds_raw, gw, NGW, wave, lane);
        prologue_lora(P, blockIdx.x * NT + tid, G * NT);
        prologue_rows(P, gw, NGW, lane); }
    }
    GRID_SYNC();
#pragma unroll 1
    for (int l_ = 0; l_ < DEPTH; ++l_) {
        int l = l_; asm volatile("" : "+s"(l));
        bf16* XB = (bf16*)(P.ws + WS_XB); bf16* YB = (bf16*)(P.ws + WS_Y); bf16* HB = (bf16*)(P.ws + WS_H); bf16* COLS = (bf16*)(P.ws + WS_COLS); float* SSQ = (float*)(P.ws + WS_SSQ);
        const unsigned char* wb = P.ws + WS_W;
        {
            pg8::Gemm g{XB, (const bf16*)(wb + W_IN), T, NPAD, D}; pg8::StaticOrder S; S.init(T, NPAD, G, (int)blockIdx.x);
            pg8::EpiScaleBf16<0> E{COLS, NPAD, SSQ};
            for (int rep_ = 0; rep_ < REP_G1; ++rep_) pg8::gemm_phase<pg8::EpiScaleBf16<0>, pg8::StaticOrder, true, true>(ldsl, g, S, E);
        }
        GRID_SYNC();
        {
            PHASE_TID();
            for (int rep_ = 0; rep_ < REP_M1; ++rep_)
            for (int ci = blockIdx.x; ci < T / 64; ci += G) {
#ifndef NO_RWKV1
                for (int r2_ = 0; r2_ < REP_RW; ++r2_) rwkv_m1(P, l, ci, ldsl, tid);
#endif
#ifndef NO_GDN1
                for (int r2_ = 0; r2_ < REP_GD; ++r2_) gdn_m1(P, l, ci, ldsl, tid);
#endif
#ifndef NO_GLA1
                gla_m1(P, l, ci, ldsl, tid);
#endif
            }
        }
        GRID_SYNC();
        {
            PHASE_TID();
            const int b = blockIdx.x, seg = b >> 4, mh = (b >> 1) & 7, hh_ = mh & 3; const bool gdn = mh >= 4;
            const bf16* XP = (const bf16*)(P.ws + (gdn ? WS_DP : WS_RP)) + ((size_t)seg * 64 + hh_) * 4096; bf16* XQ = (bf16*)(P.ws + (gdn ? WS_DQ : WS_RQ)) + ((size_t)seg * 64 + hh_) * 4096;
            const float* XG = (const float*)(P.ws + WS_XG) + (gdn ? 1024 * 64 : 0) + ((size_t)seg * 64 + hh_) * 64;
            bf16* SN = (bf16*)(P.ws + WS_SN) + ((size_t)seg * 8 + mh) * 4096; bf16* SQ = (bf16*)(P.ws + WS_SQ) + ((size_t)seg * 8 + mh) * 4096; float* SG = (float*)(P.ws + WS_SG) + ((size_t)seg * 8 + mh) * 64;
            if (b & 1) dplr_chain<true, false>(XP, XQ, XG, 4 * 4096, 4 * 64, 16, nullptr, SN, SG, ldsl, tid);
            else dplr_chain<false, false>(XP, XQ, XG, 4 * 4096, 4 * 64, 16, nullptr, SQ, nullptr, ldsl, tid);
            gla_m2_A(P, b >> 4, (b & 15) * NT + tid);
        }
        GRID_SYNC();
        {
            PHASE_TID();
            const int b = blockIdx.x;
            if (b < 8) dplr_chain<false, true>((const bf16*)(P.ws + WS_SN) + (size_t)b * 4096, (bf16*)(P.ws + WS_SQ) + (size_t)b * 4096, (const float*)(P.ws + WS_SG) + b * 64, 8 * 4096, 8 * 64, 16, nullptr, nullptr, nullptr, ldsl, tid);
            else if (b < 24) gla_m2_B(P, (b - 8) * NT + tid);
            else prologue_weights(P, l, 12, (float*)lds_raw, (b - 24) * NWAVES + wave, (G - 24) * NWAVES, wave, lane);
        }
        GRID_SYNC();
        {
            PHASE_TID();
            const int b = blockIdx.x;
            if (b < 128) { const int seg = b >> 3, mh = b & 7, hh_ = mh & 3; const bool gdn = mh >= 4;
                const bf16* XP = (const bf16*)(P.ws + (gdn ? WS_DP : WS_RP)) + ((size_t)seg * 64 + hh_) * 4096; bf16* XQ = (bf16*)(P.ws + (gdn ? WS_DQ : WS_RQ)) + ((size_t)seg * 64 + hh_) * 4096;
                const float* XG = (const float*)(P.ws + WS_XG) + (gdn ? 1024 * 64 : 0) + ((size_t)seg * 64 + hh_) * 64;
                dplr_chain<false, true>(XP, XQ, XG, 4 * 4096, 4 * 64, 16, (const bf16*)(P.ws + WS_SQ) + ((size_t)seg * 8 + mh) * 4096, nullptr, nullptr, ldsl, tid); }
            else { const int gw2 = (b - 128) * NWAVES + wave, ngw2 = (G - 128) * NWAVES;
                prologue_weights(P, l, 2, (float*)lds_raw, gw2, ngw2, wave, lane);
                if (l == 0) prologue_weights(P, 1, 1, (float*)lds_raw, gw2, ngw2, wave, lane); }
            gla_m2_C(P, b >> 4, (b & 15) * NT + tid);
        }
        GRID_SYNC();
        {
            PHASE_TID();
            for (int ci = blockIdx.x; ci < T / 64; ci += G) {
#ifndef NO_M3
                mix_m3(P, l, ci, ldsl, tid);
                for (int rep_ = 0; rep_ < REP_SGU; ++rep_) sgu_m3(P, l, ci, ldsl, tid);
#endif
            }
        }
        GRID_SYNC();
        {
            pg8::Gemm g{YB, (const bf16*)(wb + W_OUT), T, D, D}; pg8::StaticOrder S; S.init(T, D, G, (int)blockIdx.x);
            for (int rep_ = REP_G2 - 1; rep_ >= 0; --rep_) { int dry = rep_; asm volatile("" : "+v"(dry));
            pg8::EpiResid E{l == 0 ? P.in[I_X] : (const float*)P.out, P.out, XB, SSQ, dry};
            pg8::gemm_phase<pg8::EpiResid, pg8::StaticOrder, true, true>(ldsl, g, S, E); }
        }
        GRID_SYNC();
        {
            pg8::Gemm g{XB, (const bf16*)(wb + W_UP), T, FF, D}; pg8::StaticOrder S; S.init(T, FF, G, (int)blockIdx.x);
            pg8::EpiScaleBf16<2> E{HB, FF, SSQ};
            for (int rep_ = 0; rep_ < REP_UP; ++rep_) pg8::gemm_phase<pg8::EpiScaleBf16<2>, pg8::StaticOrder, true, true>(ldsl, g, S, E);
        }
        GRID_SYNC();
        {
            pg8::Gemm g{HB, (const bf16*)(wb + W_DN), T, D, FF}; pg8::StaticOrder S; S.init(T, D, G, (int)blockIdx.x);
            for (int rep_ = REP_DN - 1; rep_ >= 0; --rep_) { int dry = rep_; asm volatile("" : "+v"(dry));
            pg8::EpiResid E{(const float*)P.out, P.out, XB, SSQ, dry};
            pg8::gemm_phase<pg8::EpiResid, pg8::StaticOrder, true, true>(ldsl, g, S, E); }
        }
        GRID_SYNC();
    }
    { PHASE_TID(); for (int rep_ = REP_FN - 1; rep_ >= 0; --rep_) { int dry = rep_; asm volatile("" : "+v"(dry)); final_norm(P, gw, NGW, lane, dry); } }
    if (P.ws == nullptr) cg::this_grid().sync();
}

extern "C" void kernel_launch(void* const* d_in, const int* in_sizes, int n_in, void* d_out, int out_size, void* d_ws, size_t ws_size, hipStream_t stream) {
    static int grid_blocks = 0;
    if (!grid_blocks) {
        int dev = 0, cus = 0, per_cu = 0;
        if (n_in != 33 || out_size != T * D || ws_size < WS_END) { fprintf(stderr, "kernel_launch: unexpected shapes n_in %d out %d ws %zu\n", n_in, out_size, ws_size); grid_blocks = -1; return; }
        (void)hipGetDevice(&dev);
        (void)hipDeviceGetAttribute(&cus, hipDeviceAttributeMultiprocessorCount, dev);
        (void)hipFuncSetAttribute((const void*)fwd_kernel, hipFuncAttributeMaxDynamicSharedMemorySize, LDS_BYTES);
        (void)hipOccupancyMaxActiveBlocksPerMultiprocessor(&per_cu, (const void*)fwd_kernel, NT, LDS_BYTES);
        if (per_cu < 1) fprintf(stderr, "kernel_launch: occupancy query says %d blocks/CU\n", per_cu);
        grid_blocks = cus;
        (void)hipGetLastError();
    }
    if (grid_blocks < 0) return;
    (void)hipMemsetAsync((char*)d_ws + WS_BAR, 0, 16384, stream);
    Params p{};
    for (int i = 0; i < 33; ++i) p.in[i] = (const float*)d_in[i];
    p.out = (float*)d_out; p.ws = (unsigned char*)d_ws;
    void* args[] = {&p};
    hipError_t e = hipLaunchCooperativeKernel((void*)fwd_kernel, dim3(grid_blocks), dim3(NT), args, LDS_BYTES, stream);
    if (e != hipSuccess) fprintf(stderr, "cooperative launch failed: %s (grid %d)\n", hipGetErrorString(e), grid_blocks);
}
```

```cpp
#include <hip/hip_runtime.h>
#include <hip/hip_cooperative_groups.h>
#include <cstdio>
#include <cstdint>
namespace cg = cooperative_groups;
namespace pg8 {
#define PG8_LAS __attribute__((address_space(3)))
typedef unsigned short bf16_t;
typedef short bf16x8 __attribute__((ext_vector_type(8)));
typedef float f32x4 __attribute__((ext_vector_type(4)));
typedef unsigned u32x4 __attribute__((ext_vector_type(4)));
constexpr int BM = 256, BK = 64, HALF = 128, HTB = HALF * BK * 2  , STAGE_BYTES = 8 * HTB, NXCD = 8, WGM = 8;

__host__ __device__ __forceinline__ int lds_byte(int r, int c) { const int st = (r >> 4) * 2 + (c >> 5), rr = r & 15, cc = c & 31, ob = rr * 64 + cc * 2; return st * 1024 + (ob ^ (((ob >> 9) & 1) << 5)); }
__host__ __device__ __forceinline__ void stage_rc(int b, int& R, int& C) { const int st = b / 1024, sb = b % 1024, swz = sb ^ (((sb >> 9) & 1) << 5); R = (st >> 1) * 16 + swz / 64; C = (st & 1) * 32 + (swz % 64) / 2; }
__host__ __device__ __forceinline__ int perm32(int rho) { const int n = rho >> 4, i = rho & 15; return 8 * (i >> 2) + 4 * n + (i & 3); }

struct Unit { int pm, pn; };
struct Gemm { const bf16_t* A; const bf16_t* Bt; int M, N, K; };

struct StaticOrder {
    int nM, nN, nwg, G, c;
    __host__ __device__ void init(int M, int N, int G_, int c_) { nM = M / BM; nN = N / BM; nwg = nM * nN; G = G_; c = c_; }
    __host__ __device__ bool next(int i, Unit& u) const {
        const long L = (long)i * G + c; if (L >= nwg) return false;
        int wgid = (int)L; { const int q = nwg / NXCD, r = nwg % NXCD, xcd = wgid % NXCD, off = wgid / NXCD; wgid = (xcd < r ? xcd * (q + 1) : r * (q + 1) + (xcd - r) * q) + off; }
        const int nig = WGM * nN, gid = wgid / nig, fm = gid * WGM, gsz = (nM - fm) < WGM ? (nM - fm) : WGM;
        u.pm = fm + ((wgid % nig) % gsz); u.pn = (wgid % nig) / gsz; return true;
    }
    __device__ __forceinline__ void a_ready(const Unit&) const {}
    __device__ __forceinline__ void done(const Unit&) const {}
};

__device__ __forceinline__ unsigned cvt_pk_bf16(float lo, float hi) { unsigned r; asm volatile("v_cvt_pk_bf16_f32 %0, %1, %2" : "=v"(r) : "v"(lo), "v"(hi)); return r; }
typedef float f32x2 __attribute__((ext_vector_type(2)));
__device__ __forceinline__ float row_rstd16(const float* ssq, int row) {
    const f32x4* p = (const f32x4*)(ssq + (size_t)row * 16);
    const f32x4 a = p[0], b = p[1], c = p[2], d = p[3];
    const float s = ((a[0] + a[1]) + (a[2] + a[3])) + ((b[0] + b[1]) + (b[2] + b[3])) + ((c[0] + c[1]) + (c[2] + c[3])) + ((d[0] + d[1]) + (d[2] + d[3]));
    return 1.0f / sqrtf(s * (1.0f / 1024.0f) + 1e-6f);
}
template <int ACT> struct EpiScaleBf16 {
    static constexpr bool PERM = true, AFTER_DRAIN = false;
    bf16_t* O; int ldc; const float* ssq;
    __device__ __forceinline__ void operator()(const f32x4 (&acc)[2][2][4][2], const Unit& u, int wr, int wc, int fr, int fq) const {
        const int row0 = u.pm * BM + wr * 64 + fr; const int col0 = u.pn * BM + wc * 32 + 8 * fq;
#pragma unroll
        for (int ai = 0; ai < 2; ++ai)
#pragma unroll
            for (int m = 0; m < 4; ++m) { const int row = row0 + ai * HALF + m * 16; const float sc = row_rstd16(ssq, row); bf16_t* rowp = O + (size_t)row * ldc + col0;
#pragma unroll
                for (int bj = 0; bj < 2; ++bj) { f32x4 v0 = acc[ai][bj][m][0] * sc, v1 = acc[ai][bj][m][1] * sc;
                    if (ACT == 2) {
#pragma unroll
                        for (int e = 0; e < 4; ++e) { const float a0 = v0[e] > 0.f ? v0[e] : 0.f, a1 = v1[e] > 0.f ? v1[e] : 0.f; v0[e] = a0 * a0; v1[e] = a1 * a1; } }
                    u32x4 w; w.x = cvt_pk_bf16(v0[0], v0[1]); w.y = cvt_pk_bf16(v0[2], v0[3]); w.z = cvt_pk_bf16(v1[0], v1[1]); w.w = cvt_pk_bf16(v1[2], v1[3]);
                    *(u32x4*)(rowp + bj * HALF) = w; } }
    }
};
struct EpiResid {
    static constexpr bool PERM = false, AFTER_DRAIN = false;
    const float* base; float* out; bf16_t* xb; float* ssq; int dry;
    __device__ __forceinline__ void operator()(const f32x4 (&acc)[2][2][4][2], const Unit& u, int wr, int wc, int fr, int fq) const {
        typedef unsigned u32x2v __attribute__((ext_vector_type(2)));
        const int row0 = u.pm * BM + wr * 64 + fr; const int col0 = u.pn * BM + wc * 32 + 4 * fq;
#pragma unroll
        for (int ai = 0; ai < 2; ++ai)
#pragma unroll
            for (int m = 0; m < 4; ++m) { const int row = row0 + ai * HALF + m * 16; const size_t off = (size_t)row * 1024 + col0; float s = 0.f;
#pragma unroll
                for (int bj = 0; bj < 2; ++bj)
#pragma unroll
                    for (int n = 0; n < 2; ++n) { const f32x4 bs = *(const f32x4*)(base + off + bj * HALF + n * 16); const f32x4 o = bs + acc[ai][bj][m][n];
                        if (!dry) *(f32x4*)(out + off + bj * HALF + n * 16) = o; s += (o[0] * o[0] + o[1] * o[1]) + (o[2] * o[2] + o[3] * o[3]);
                        u32x2v w; w.x = cvt_pk_bf16(o[0], o[1]); w.y = cvt_pk_bf16(o[2], o[3]); if (!dry) *(u32x2v*)(xb + off + bj * HALF + n * 16) = w; }
                s += __shfl_xor(s, 16); s += __shfl_xor(s, 32);
                if (fq == 0 && !dry) ssq[(size_t)row * 16 + u.pn * 4 + wc] = s; }
    }
};
template <class Epi, class Sched, bool ALIGN_EPI = false, bool SP2 = false>
__device__ __forceinline__ void gemm_phase(PG8_LAS unsigned char* lds, const Gemm g, const Sched& S, const Epi& E) {
    int tid_o = threadIdx.x; asm volatile("" : "+v"(tid_o));
    const int tid = tid_o, wid = __builtin_amdgcn_readfirstlane(tid >> 6), lane = tid & 63, wr = wid >> 2, wc = wid & 3, fr = lane & 15, fq = lane >> 4;
    const int K = g.K, nt = K / BK;
    unsigned voffA[2], voffB[2];
#pragma unroll
    for (int i = 0; i < 2; ++i) { int R, C; stage_rc(tid * 16 + i * 8192, R, C); const int Rb = Epi::PERM ? ((R & ~31) + perm32(R & 31)) : R;
        voffA[i] = (unsigned)(R * K + C) * 2u; voffB[i] = (unsigned)(Rb * K + C) * 2u; }
    const size_t kstep = (size_t)(BK * 2);
    const size_t hstep = (size_t)HALF * K * 2;
    const size_t tstep = 2 * hstep;
    const unsigned ldsw = (unsigned)wid * 1024u;
    const int aoff = lds_byte(wr * 64 + fr, fq * 8), boff = lds_byte(wc * 32 + fr, fq * 8);
#define PG8_SA(b, h) (((b) * 2 + (h)) * HTB)
#define PG8_SB(b, h) ((4 + (b) * 2 + (h)) * HTB)
#define PG8_STAGE(bufoff, gbase, voff) do { _Pragma("unroll") for (int _i = 0; _i < 2; ++_i) \
        __builtin_amdgcn_global_load_lds((const unsigned*)((const char*)(gbase) + (voff)[_i]), (PG8_LAS unsigned*)(lds + (bufoff) + ldsw + _i * 8192), 16, 0, 0); } while (0)
#define PG8_LDA(dst, b, h) do { _Pragma("unroll") for (int m = 0; m < 4; ++m) _Pragma("unroll") for (int k = 0; k < 2; ++k) dst[m][k] = *(const PG8_LAS bf16x8*)(lds + PG8_SA(b, h) + aoff + m * 2048 + k * 1024); } while (0)
#define PG8_LDB(dst, b, h) do { _Pragma("unroll") for (int n = 0; n < 2; ++n) _Pragma("unroll") for (int k = 0; k < 2; ++k) dst[n][k] = *(const PG8_LAS bf16x8*)(lds + PG8_SB(b, h) + boff + n * 2048 + k * 1024); } while (0)
#define PG8_MMA(ai, bj, At, Bt) do { __builtin_amdgcn_s_setprio(1); _Pragma("unroll") for (int m = 0; m < 4; ++m) _Pragma("unroll") for (int n = 0; n < 2; ++n) _Pragma("unroll") for (int k = 0; k < 2; ++k) \
        acc[ai][bj][m][n] = __builtin_amdgcn_mfma_f32_16x16x32_bf16(Bt[n][k], At[m][k], acc[ai][bj][m][n], 0, 0, 0); __builtin_amdgcn_s_setprio(0); } while (0)
#define PG8_WAIT_V(n) asm volatile("s_waitcnt vmcnt(" #n ")" ::: "memory")
#define PG8_WAIT_L(n) asm volatile("s_waitcnt lgkmcnt(" #n ")" ::: "memory")
#define PG8_BAR __builtin_amdgcn_s_barrier()
#define PG8_SCHED __builtin_amdgcn_sched_barrier(0)
    Unit cur, nxt; int ui = 0;
    if (!S.next(0, cur)) return;
    f32x4 acc[2][2][4][2];
#pragma unroll
    for (int a = 0; a < 2; ++a)
#pragma unroll
        for (int b = 0; b < 2; ++b)
#pragma unroll
            for (int m = 0; m < 4; ++m)
#pragma unroll
                for (int n = 0; n < 2; ++n) acc[a][b][m][n] = (f32x4){0.f, 0.f, 0.f, 0.f};
    bf16x8 At[4][2], B0[2][2], B1[2][2];
    const char* cA = (const char*)g.A + (size_t)cur.pm * tstep; const char* cB = (const char*)g.Bt + (size_t)cur.pn * tstep;
    S.a_ready(cur);
    if constexpr (SP2) {
        PG8_STAGE(PG8_SB(0, 0), cB, voffB); PG8_STAGE(PG8_SB(0, 1), cB + hstep, voffB); PG8_STAGE(PG8_SA(0, 0), cA, voffA); PG8_STAGE(PG8_SA(0, 1), cA + hstep, voffA);
        if (wr == 1) PG8_BAR;
        PG8_WAIT_V(2); PG8_BAR;
        PG8_STAGE(PG8_SB(1, 0), cB + kstep, voffB); PG8_STAGE(PG8_SA(1, 0), cA + kstep, voffA); PG8_STAGE(PG8_SB(1, 1), cB + hstep + kstep, voffB);
        PG8_WAIT_V(6); PG8_BAR;
    } else {
        PG8_STAGE(PG8_SB(0, 0), cB, voffB); PG8_STAGE(PG8_SA(0, 0), cA, voffA); PG8_STAGE(PG8_SB(0, 1), cB + hstep, voffB); PG8_STAGE(PG8_SA(0, 1), cA + hstep, voffA);
        if (wr == 1) PG8_BAR;
        PG8_WAIT_V(4); PG8_BAR;
        PG8_STAGE(PG8_SB(1, 0), cB + kstep, voffB); PG8_STAGE(PG8_SA(1, 0), cA + kstep, voffA); PG8_STAGE(PG8_SB(1, 1), cB + hstep + kstep, voffB);
        PG8_WAIT_V(6); PG8_BAR;
    }
    for (;;) {
        const bool has_next = S.next(ui + 1, nxt);
        const char* nA = has_next ? (const char*)g.A + (size_t)nxt.pm * tstep : cA; const char* nB = has_next ? (const char*)g.Bt + (size_t)nxt.pn * tstep : cB;
        for (int t = 0; t < nt; t += 2) {
            const bool last = (t == nt - 2);
            const char* a1 = cA + (size_t)(t + 1) * kstep;
            const char* a2 = last ? nA : cA + (size_t)(t + 2) * kstep; const char* b2 = last ? nB : cB + (size_t)(t + 2) * kstep;
            const char* a3 = a2 + kstep; const char* b3 = b2 + kstep;
            if (last && has_next) S.a_ready(nxt);
            if constexpr (SP2) {
            PG8_LDB(B0, 0, 0); PG8_LDB(B1, 0, 1); PG8_SCHED; PG8_LDA(At, 0, 0); PG8_STAGE(PG8_SA(1, 1), a1 + hstep, voffA);
            PG8_WAIT_V(8); PG8_WAIT_L(0); PG8_BAR; PG8_MMA(0, 0, At, B0); PG8_MMA(0, 1, At, B1); PG8_BAR; PG8_SCHED;
            PG8_LDA(At, 0, 1); PG8_STAGE(PG8_SB(0, 0), b2, voffB); PG8_STAGE(PG8_SB(0, 1), b2 + hstep, voffB); PG8_STAGE(PG8_SA(0, 0), a2, voffA);
            PG8_WAIT_V(8); PG8_WAIT_L(0); PG8_BAR; PG8_MMA(1, 0, At, B0); PG8_MMA(1, 1, At, B1); PG8_BAR; PG8_SCHED;
            PG8_LDB(B0, 1, 0); PG8_LDB(B1, 1, 1); PG8_SCHED; PG8_LDA(At, 1, 0); PG8_STAGE(PG8_SA(0, 1), a2 + hstep, voffA);
            PG8_WAIT_V(8); PG8_WAIT_L(0); PG8_BAR; PG8_MMA(0, 0, At, B0); PG8_MMA(0, 1, At, B1); PG8_BAR; PG8_SCHED;
            PG8_LDA(At, 1, 1); PG8_STAGE(PG8_SB(1, 0), b3, voffB); PG8_STAGE(PG8_SB(1, 1), b3 + hstep, voffB); PG8_STAGE(PG8_SA(1, 0), a3, voffA);
            PG8_WAIT_V(8); PG8_WAIT_L(0); PG8_BAR; PG8_MMA(1, 0, At, B0); PG8_MMA(1, 1, At, B1); PG8_BAR; PG8_SCHED;
            } else {
            PG8_LDB(B0, 0, 0); PG8_SCHED; PG8_LDA(At, 0, 0); PG8_STAGE(PG8_SA(1, 1), a1 + hstep, voffA);
            PG8_WAIT_L(8); PG8_BAR; PG8_WAIT_L(0); PG8_MMA(0, 0, At, B0); PG8_BAR; PG8_SCHED;
            PG8_LDB(B1, 0, 1); PG8_STAGE(PG8_SB(0, 0), b2, voffB);
            PG8_BAR; PG8_WAIT_L(0); PG8_MMA(0, 1, At, B1); PG8_BAR;
            PG8_LDA(At, 0, 1); PG8_STAGE(PG8_SA(0, 0), a2, voffA);
            PG8_BAR; PG8_WAIT_L(0); PG8_MMA(1, 0, At, B0); PG8_BAR; PG8_SCHED;
            PG8_STAGE(PG8_SB(0, 1), b2 + hstep, voffB);
            PG8_WAIT_V(6); PG8_BAR; PG8_MMA(1, 1, At, B1); PG8_BAR;
            PG8_LDB(B0, 1, 0); PG8_SCHED; PG8_LDA(At, 1, 0); PG8_STAGE(PG8_SA(0, 1), a2 + hstep, voffA);
            PG8_WAIT_L(8); PG8_BAR; PG8_WAIT_L(0); PG8_MMA(0, 0, At, B0); PG8_BAR; PG8_SCHED;
            PG8_LDB(B1, 1, 1); PG8_STAGE(PG8_SB(1, 0), b3, voffB);
            PG8_BAR; PG8_WAIT_L(0); PG8_MMA(0, 1, At, B1); PG8_BAR;
            PG8_LDA(At, 1, 1); PG8_STAGE(PG8_SA(1, 0), a3, voffA);
            PG8_BAR; PG8_WAIT_L(0); PG8_MMA(1, 0, At, B0); PG8_BAR; PG8_SCHED;
            PG8_STAGE(PG8_SB(1, 1), b3 + hstep, voffB);
            PG8_WAIT_V(6); PG8_BAR; PG8_MMA(1, 1, At, B1); PG8_BAR;
            }
        }
        if constexpr (ALIGN_EPI) { if (wr == 0) PG8_BAR; }
        if constexpr (!Epi::AFTER_DRAIN) { E(acc, cur, wr, wc, fr, fq); S.done(cur); }
        if (!has_next) break;
#pragma unroll
        for (int a = 0; a < 2; ++a)
#pragma unroll
            for (int b = 0; b < 2; ++b)
#pragma unroll
                for (int m = 0; m < 4; ++m)
#pragma unroll
                    for (int n = 0; n < 2; ++n) acc[a][b][m][n] = (f32x4){0.f, 0.f, 0.f, 0.f};
        cur = nxt; cA = nA; cB = nB; ++ui;
        if constexpr (ALIGN_EPI) { if (wr == 1) PG8_BAR; }
    }
    PG8_WAIT_V(0);
    if constexpr (!ALIGN_EPI) { if (wr == 0) PG8_BAR; }
    PG8_BAR;
    if constexpr (Epi::AFTER_DRAIN) { E.fused(acc, cur, wr, wc, fr, fq, lds, wid, lane); S.done(cur); }
#undef PG8_SA
#undef PG8_SB
#undef PG8_STAGE
#undef PG8_LDA
#undef PG8_LDB
#undef PG8_MMA
#undef PG8_WAIT_V
#undef PG8_WAIT_L
#undef PG8_BAR
#undef PG8_SCHED
}
}
constexpr int T = 16384, D = 1024, FF = 4096, DEPTH = 2;
constexpr int NIN = 3352, NPAD = 3584;
constexpr int C_RWKV = 0, C_GDN = 1024, C_GLA = 2056, C_SGU = 2840, C_VRES = 3352;
constexpr int NT = 512, NWAVES = 8;
constexpr int LDS_BYTES = 147456;
typedef unsigned short bf16;
typedef float f32x4 __attribute__((ext_vector_type(4)));
typedef unsigned v4u __attribute__((ext_vector_type(4)));
#define LAS __attribute__((address_space(3)))

constexpr size_t MiB = 1u << 20;
constexpr size_t WS_BAR = 0;
constexpr size_t WS_SSQ = 1 * MiB;
constexpr size_t WS_GAL = 2 * MiB;
constexpr size_t WS_XG = 2 * MiB + 256 * 1024;
constexpr size_t WS_W = 3 * MiB;
constexpr size_t W_LAYER = 0, W_IN = 0, W_OUT = 7 * MiB, W_UP = 9 * MiB, W_DN = 17 * MiB;
constexpr size_t WS_XB = 30 * MiB;
constexpr size_t WS_Y = 62 * MiB;
constexpr size_t WS_H = 94 * MiB;
constexpr size_t WS_COLS = 94 * MiB;
constexpr size_t WS_VF = 222 * MiB;
constexpr size_t WS_RP = 30 * MiB, WS_RQ = 38 * MiB, WS_RR = 46 * MiB, WS_RBV = 54 * MiB;
constexpr size_t WS_DP = 206 * MiB, WS_DQ = 214 * MiB, WS_DR = 230 * MiB;
constexpr size_t WS_GKV = 238 * MiB, WS_GQI = 246 * MiB;
constexpr size_t WS_LORA = 250 * MiB;
constexpr int LORA_W = 0, LORA_A = 256 * 64, LORA_G = 2 * 256 * 64, LORA_V = 2 * 256 * 64 + 256 * 128, LORA_LAYER = LORA_V + 256 * 32;
constexpr size_t WS_SN = 251 * MiB, WS_SQ = 252 * MiB, WS_SG = 253 * MiB, WS_GSB = 253 * MiB + 64 * 1024, WS_GSA = 254 * MiB;
constexpr size_t WS_END = 255 * MiB;

typedef float f32x2_t __attribute__((ext_vector_type(2))); typedef __bf16 bf16x2_t __attribute__((ext_vector_type(2)));
__device__ __forceinline__ unsigned pk2(float lo, float hi) { f32x2_t v = {lo, hi}; bf16x2_t b = __builtin_convertvector(v, bf16x2_t); return __builtin_bit_cast(unsigned, b); }
__device__ __forceinline__ unsigned f2bf(float f) { return pk2(f, f) & 0xffffu; }
__device__ __forceinline__ float bf2f(bf16 b) { return __builtin_bit_cast(float, (unsigned)b << 16); }
__device__ __forceinline__ float wave_sum(float v) {
    v += __builtin_bit_cast(float, __builtin_amdgcn_mov_dpp(__builtin_bit_cast(int, v), 0xB1, 0xF, 0xF, true));
    v += __builtin_bit_cast(float, __builtin_amdgcn_mov_dpp(__builtin_bit_cast(int, v), 0x4E, 0xF, 0xF, true));
    v += __builtin_bit_cast(float, __builtin_amdgcn_mov_dpp(__builtin_bit_cast(int, v), 0x141, 0xF, 0xF, true));
    v += __builtin_bit_cast(float, __builtin_amdgcn_mov_dpp(__builtin_bit_cast(int, v), 0x140, 0xF, 0xF, true));
    v += __shfl_xor(v, 16); v += __shfl_xor(v, 32);
    return v;
}
__device__ __forceinline__ float rcpf_(float x) { return __builtin_amdgcn_rcpf(x); }
__device__ __forceinline__ float rsqf_(float x) { return __builtin_amdgcn_rsqf(x); }
__device__ __forceinline__ float sigmoidf_(float x) { return rcpf_(1.0f + __expf(-x)); }
__device__ __forceinline__ float softplusf_(float x) { return fmaxf(x, 0.f) + __logf(1.0f + __expf(-fabsf(x))); }
__device__ __forceinline__ float siluf_(float x) { return x * sigmoidf_(x); }
__device__ __forceinline__ float tanhf_(float x) { return 1.0f - 2.0f * rcpf_(1.0f + __expf(2.0f * x)); }
__device__ __forceinline__ float geluf_(float x) { const float u = 0.7978845608028654f * (x + 0.044715f * x * x * x); return x * sigmoidf_(2.0f * u); }

struct Params { const float* in[33]; float* out; unsigned char* ws; };
enum { I_X = 0, I_WIN, I_WOUT, I_NMIX, I_NFFN, I_NFIN, I_MU, I_W0, I_WUP, I_A0, I_AUP, I_GUP, I_KK, I_KA, I_RK, I_LNW, I_LNB, I_V0, I_VDOWN, I_VUP,
       I_CONV, I_ALOG, I_DTB, I_GDNG, I_GKUP, I_GKB, I_GLAG, I_SLG, I_SLB, I_SWS, I_SBS, I_FUP, I_FDN };

__device__ __forceinline__ void transpose_item(const float* W, int K, int N, const float* gk, bf16* WT, int row_off, float* scr, int item, int lane) {
    const int nblk = (N + 31) / 32, kb = item / nblk, nb = item % nblk, k0 = 64 * kb, n0 = 32 * nb;
    const int kr = lane >> 3, n4 = lane & 7; const bool nok = (n0 + 4 * n4) < N;
    f32x4 v[8]; float gv[8];
#pragma unroll
    for (int p = 0; p < 8; ++p) { v[p] = nok ? *(const f32x4*)(W + (size_t)(k0 + kr + 8 * p) * N + n0 + 4 * n4) : (f32x4){0.f, 0.f, 0.f, 0.f}; gv[p] = gk ? gk[k0 + kr + 8 * p] : 1.0f; }
#pragma unroll
    for (int p = 0; p < 8; ++p) { const int kk = kr + 8 * p; float* s = scr + kk * 33 + 4 * n4; s[0] = v[p][0] * gv[p]; s[1] = v[p][1] * gv[p]; s[2] = v[p][2] * gv[p]; s[3] = v[p][3] * gv[p]; }
    __builtin_amdgcn_wave_barrier(); asm volatile("s_waitcnt lgkmcnt(0)" ::: "memory");
    const int c = lane & 7;
#pragma unroll
    for (int j = 0; j < 4; ++j) { const int n = (lane >> 3) + 8 * j; const float* s = scr + (8 * c) * 33 + n;
        v4u o; o.x = pk2(s[0 * 33], s[1 * 33]); o.y = pk2(s[2 * 33], s[3 * 33]); o.z = pk2(s[4 * 33], s[5 * 33]); o.w = pk2(s[6 * 33], s[7 * 33]);
        if (n0 + n < N) *(v4u*)(WT + (size_t)(row_off + n0 + n) * K + k0 + 8 * c) = o; }
    __builtin_amdgcn_wave_barrier(); asm volatile("s_waitcnt lgkmcnt(0)" ::: "memory");
}
__device__ __forceinline__ void prologue_weights(const Params& P, int l, int mask, float* lds, int gw, int NGW, int wave, int lane) {
    float* scr = lds + wave * 4096;
    unsigned char* wb = P.ws + WS_W;
    const int I_in = (mask & 1) ? (D / 64) * ((NIN + 31) / 32) : 0, I_vr = ((mask & 1) && l > 0) ? (D / 64) * 1 : 0, I_out = (mask & 2) ? (D / 64) * (D / 32) : 0, I_up = (mask & 4) ? (D / 64) * (FF / 32) : 0, I_dn = (mask & 8) ? (FF / 64) * (D / 32) : 0;
    const int NITEMS = I_in + I_vr + I_out + I_up + I_dn;
    for (int it = gw; it < NITEMS; it += NGW) {
        int r = it;
        if (r < I_in) { transpose_item(P.in[I_WIN] + (size_t)l * D * NIN, D, NIN, P.in[I_NMIX] + l * D, (bf16*)(wb + W_IN), 0, scr, r, lane); continue; } r -= I_in;
        if (r < I_vr) { transpose_item(P.in[I_VDOWN] + (size_t)(l - 1) * D * 32, D, 32, P.in[I_NMIX] + l * D, (bf16*)(wb + W_IN), NIN, scr, r, lane); continue; } r -= I_vr;
        if (r < I_out) { transpose_item(P.in[I_WOUT] + (size_t)l * D * D, D, D, nullptr, (bf16*)(wb + W_OUT), 0, scr, r, lane); continue; } r -= I_out;
        if (r < I_up) { transpose_item(P.in[I_FUP] + (size_t)l * D * FF, D, FF, P.in[I_NFFN] + l * D, (bf16*)(wb + W_UP), 0, scr, r, lane); continue; } r -= I_up;
        transpose_item(P.in[I_FDN] + (size_t)l * FF * D, FF, D, nullptr, (bf16*)(wb + W_DN), 0, scr, r, lane);
    }
}
__device__ __forceinline__ void prologue_lora(const Params& P, int gtid, int gsz) {
    bf16* dst = (bf16*)(P.ws + WS_LORA);
    for (int idx = gtid; idx < 2 * 288 * 256; idx += gsz) { const int l = idx / (288 * 256), r = idx % (288 * 256), j = r >> 8, c = r & 255; bf16* d = dst + (size_t)l * LORA_LAYER;
        if (j < 64) d[LORA_W + c * 64 + j] = (bf16)f2bf(P.in[I_WUP][((size_t)l * 64 + j) * 256 + c]);
        else if (j < 128) d[LORA_A + c * 64 + j - 64] = (bf16)f2bf(P.in[I_AUP][((size_t)l * 64 + j - 64) * 256 + c]);
        else if (j < 256) d[LORA_G + c * 128 + j - 128] = (bf16)f2bf(P.in[I_GUP][((size_t)l * 128 + j - 128) * 256 + c]);
        else if (l > 0) d[LORA_V + c * 32 + j - 256] = (bf16)f2bf(P.in[I_VUP][((size_t)(l - 1) * 32 + j - 256) * 256 + c]); }
}
__device__ __forceinline__ void prologue_rows(const Params& P, int gw, int NGW, int lane) {
    const float* x = P.in[I_X]; bf16* xb = (bf16*)(P.ws + WS_XB); float* ssq = (float*)(P.ws + WS_SSQ);
    for (int m0 = gw; m0 < T; m0 += 2 * NGW) { f32x4 v[2][4];
#pragma unroll
        for (int r = 0; r < 2; ++r) { const int m = m0 + r * NGW; const f32x4* xr = (const f32x4*)(x + (size_t)(m < T ? m : 0) * D) + lane;
#pragma unroll
            for (int j = 0; j < 4; ++j) v[r][j] = xr[64 * j]; }
#pragma unroll
        for (int r = 0; r < 2; ++r) { const int m = m0 + r * NGW; if (m >= T) break; float s = 0.f;
#pragma unroll
            for (int j = 0; j < 4; ++j) s += (v[r][j][0] * v[r][j][0] + v[r][j][1] * v[r][j][1]) + (v[r][j][2] * v[r][j][2] + v[r][j][3] * v[r][j][3]);
            s = wave_sum(s);
            unsigned long long* o8 = (unsigned long long*)(xb + (size_t)m * D) + lane;
#pragma unroll
            for (int j = 0; j < 4; ++j) o8[64 * j] = (unsigned long long)pk2(v[r][j][0], v[r][j][1]) | ((unsigned long long)pk2(v[r][j][2], v[r][j][3]) << 32);
            if (lane < 16) ssq[(size_t)m * 16 + lane] = (lane == 0) ? s : 0.f; } }
}
__device__ __forceinline__ void final_norm(const Params& P, int gw, int NGW, int lane, int dry = 0) {
    float* x = P.out; const float* ssq = (const float*)(P.ws + WS_SSQ); const f32x4* g4 = (const f32x4*)P.in[I_NFIN] + lane;
    f32x4 g[4];
#pragma unroll
    for (int j = 0; j < 4; ++j) g[j] = g4[64 * j];
    for (int m0 = gw; m0 < T; m0 += 2 * NGW) { f32x4 v[2][4]; float rs[2];
#pragma unroll
        for (int r = 0; r < 2; ++r) { const int m = m0 + r * NGW, mc = m < T ? m : 0; const f32x4* xr = (const f32x4*)(x + (size_t)mc * D) + lane; rs[r] = pg8::row_rstd16(ssq, mc);
#pragma unroll
            for (int j = 0; j < 4; ++j) v[r][j] = xr[64 * j]; }
#pragma unroll
        for (int r = 0; r < 2; ++r) { const int m = m0 + r * NGW; if (m >= T) break; f32x4* xr = (f32x4*)(x + (size_t)m * D) + lane;
#pragma unroll
            for (int j = 0; j < 4; ++j) { const f32x4 o = v[r][j] * rs[r] * g[j]; if (!dry) xr[64 * j] = o; } } }
}
typedef __attribute__((address_space(1))) unsigned gu32;
#define XB_TMO      128
#define XB_XCNT(j)  (256  + 64 * (j))
#define XB_XSUB(j)  (1280 + 64 * (j))
#define XB_XGEN(j)  (2304 + 64 * (j))
#define XB_TOP      3328
#define XB_TOPGEN   3392
#define XCD_BAR_WORDS 3456
#define XB_SPIN_CAP (1u << 18)

__device__ __forceinline__ unsigned xb_ld(unsigned* p)              { return __hip_atomic_load(p, __ATOMIC_RELAXED, __HIP_MEMORY_SCOPE_AGENT); }
__device__ __forceinline__ unsigned xb_add(unsigned* p, unsigned v) { return __hip_atomic_fetch_add(p, v, __ATOMIC_RELAXED, __HIP_MEMORY_SCOPE_AGENT); }
__device__ __forceinline__ unsigned xb_xcc_id() { return (unsigned)__builtin_amdgcn_s_getreg((3 << 11) | 20) & 0xFu; }
#define XB_SPIN(cond, bar) do { unsigned _sp = 0; while (cond) { __builtin_amdgcn_s_sleep(1); \
    if ((++_sp & 255u) == 0u) { if (xb_ld(&(bar)[XB_TMO])) break; if (_sp > XB_SPIN_CAP) { atomicAdd(&(bar)[XB_TMO], 1u); break; } } } } while (0)

struct XcdBarrier {
    unsigned* bar; unsigned x;
    volatile LAS unsigned* st;
};

__device__ __forceinline__ XcdBarrier xcd_barrier_post(unsigned* bar, volatile LAS unsigned* st) {
    XcdBarrier b; b.bar = bar; b.x = xb_xcc_id(); b.st = st;
    if (threadIdx.x == 0) (void)xb_add(&bar[XB_XCNT(b.x)], 1u);
    return b;
}
__device__ __forceinline__ void xcd_barrier_complete(unsigned* bar, unsigned x, unsigned& nloc, unsigned& nx) {
    const unsigned G = gridDim.x * gridDim.y * gridDim.z;
    unsigned sum, cnt, mine, sp = 0u;
    for (;;) {
        sum = 0u; cnt = 0u; mine = 0u;
#pragma unroll
        for (unsigned j = 0; j < 16; ++j) { const unsigned c = xb_ld(&bar[XB_XCNT(j)]); sum += c; cnt += (c > 0u) ? 1u : 0u; mine = (j == x) ? c : mine; }
        if (sum == G) break;
        __builtin_amdgcn_s_sleep(1);
        if ((++sp & 255u) == 0u) { if (xb_ld(&bar[XB_TMO])) break; if (sp > XB_SPIN_CAP) { atomicAdd(&bar[XB_TMO], 1u); break; } }
    }
    nloc = mine > 0u ? mine : 1u; nx = cnt > 0u ? cnt : 1u;
}

__device__ __forceinline__ void xcd_barrier(const XcdBarrier& b) {
    asm volatile("s_waitcnt vmcnt(0)" ::: "memory");
    __syncthreads();
    if (threadIdx.x == 0) {
        unsigned* bar = b.bar;
        __builtin_amdgcn_s_waitcnt(0);
        unsigned nloc = b.st[0], nx = b.st[1];
        if (nloc == 0u) { xcd_barrier_complete(bar, b.x, nloc, nx); b.st[0] = nloc; b.st[1] = nx; }
        const unsigned old = xb_add(&bar[XB_XSUB(b.x)], 1u);
        const unsigned gen = old / nloc;
        if (old + 1u == (gen + 1u) * nloc) {
            __builtin_amdgcn_fence(__ATOMIC_RELEASE, "agent");
            asm volatile("s_waitcnt vmcnt(0)" ::: "memory");
            const unsigned og = xb_add(&bar[XB_TOP], 1u);
            const unsigned tg = og / nx;
            if (og + 1u == (tg + 1u) * nx) xb_add(&bar[XB_TOPGEN], 1u);
            else XB_SPIN(xb_ld(&bar[XB_TOPGEN]) == tg, bar);
            __builtin_amdgcn_fence(__ATOMIC_ACQUIRE, "agent");
            xb_add(&bar[XB_XGEN(b.x)], 1u);
            asm volatile("s_waitcnt vmcnt(0)" ::: "memory");
        } else {
            XB_SPIN(xb_ld(&bar[XB_XGEN(b.x)]) == gen, bar);
            __builtin_amdgcn_fence(__ATOMIC_ACQUIRE, "agent");
            asm volatile("s_waitcnt vmcnt(0)" ::: "memory");
        }
    }
    __syncthreads();
}
__device__ __forceinline__ float ldcol(const bf16* cols, int t, int c) { return bf2f(cols[(size_t)t * NPAD + c]); }

__device__ __forceinline__ void rwkv_head_v1(const Params& P, int l, int h, float* lds, int tid) {
    const bf16* cols = (const bf16*)(P.ws + WS_COLS); bf16* Y = (bf16*)(P.ws + WS_Y); bf16* VF = (bf16*)(P.ws + WS_VF);
    float* sR = lds; float* sK = sR + 4096; float* sV = sK + 4096; float* sX = sV + 4096;
    float* sW = sX; float* sA = sX + 4096; float* sB = sX + 8192; float* sG = sX + 12288;
    float* sY = sX + 16384; float* sS = sY + 4096; float* sVr = sS + 64;
    const float* mu = P.in[I_MU] + l * 1024;
    const float* w_up = P.in[I_WUP] + (size_t)l * 64 * 256; const float* a_up = P.in[I_AUP] + (size_t)l * 64 * 256; const float* g_up = P.in[I_GUP] + (size_t)l * 128 * 256;
    const float* vr_up = P.in[I_VUP];
    const int lane = tid & 63, wv = tid >> 6, cc = h * 64 + lane;
    const float w0c = P.in[I_W0][l * 256 + cc], a0c = P.in[I_A0][l * 256 + cc], kkc = P.in[I_KK][l * 256 + cc], kac = P.in[I_KA][l * 256 + cc];
    const float rkc = P.in[I_RK][l * 256 + cc], lnw = P.in[I_LNW][l * 256 + cc], lnb = P.in[I_LNB][l * 256 + cc];
    const float v0c = (l > 0) ? P.in[I_V0][(l - 1) * 256 + cc] : 0.f;
    float S[64];
#pragma unroll
    for (int k = 0; k < 64; ++k) S[k] = 0.f;
    for (int ci = 0; ci < T / 64; ++ci) {
        const int t0 = ci * 64;
#pragma unroll 1
        for (int idx = tid; idx < 3 * 4096; idx += NT) { const int a = idx >> 12, t = (idx >> 6) & 63, c = idx & 63, col = a * 256 + h * 64 + c, tt = t0 + t;
            const float cur = ldcol(cols, tt, col), prv = (tt > 0) ? ldcol(cols, tt - 1, col) : 0.f; const float xs = cur + (prv - cur) * mu[col];
            (a == 0 ? sR : (a == 1 ? sK : sV))[t * 64 + c] = xs; }
#pragma unroll 1
        for (int idx = tid; idx < 64 * 256; idx += NT) { const int t = idx >> 8, j = idx & 255, col = 768 + j, tt = t0 + t;
            const float cur = ldcol(cols, tt, col), prv = (tt > 0) ? ldcol(cols, tt - 1, col) : 0.f; float xs = cur + (prv - cur) * mu[col];
            if (j < 64) xs = tanhf(xs); else if (j >= 128) xs = sigmoidf_(xs);
            sX[t * 256 + j] = xs; }
        if (l > 0)
#pragma unroll 1
        for (int idx = tid; idx < 64 * 32; idx += NT) { const int t = idx >> 5, j = idx & 31; sVr[idx] = ldcol(cols, t0 + t, C_VRES + j); }
        __syncthreads();
        float o_decay[8], o_asig[8], o_g[8], o_vmix[8];
#pragma unroll
        for (int hp = 0; hp < 2; ++hp) {
            float accw[4], acca[4], accg[4], accv[4];
#pragma unroll
            for (int i = 0; i < 4; ++i) { accw[i] = 0.f; acca[i] = 0.f; accg[i] = 0.f; accv[i] = 0.f; }
            const float* xb = sX + (wv * 8 + hp * 4) * 256;
#pragma unroll 2
            for (int j = 0; j < 64; ++j) { const float wvv = w_up[j * 256 + cc], avv = a_up[j * 256 + cc];
#pragma unroll
                for (int i = 0; i < 4; ++i) { accw[i] += xb[i * 256 + j] * wvv; acca[i] += xb[i * 256 + 64 + j] * avv; } }
#pragma unroll 2
            for (int j = 0; j < 128; ++j) { const float gvv = g_up[j * 256 + cc];
#pragma unroll
                for (int i = 0; i < 4; ++i) accg[i] += xb[i * 256 + 128 + j] * gvv; }
            if (l > 0) {
#pragma unroll 2
                for (int j = 0; j < 32; ++j) { const float vv = vr_up[j * 256 + cc];
#pragma unroll
                    for (int i = 0; i < 4; ++i) accv[i] += sVr[(wv * 8 + hp * 4 + i) * 32 + j] * vv; } }
#pragma unroll
            for (int i = 0; i < 4; ++i) { const float wpre = w0c + accw[i]; const float wlog = -softplusf_(-wpre) - 0.5f; o_decay[hp * 4 + i] = __expf(-__expf(wlog));
                o_asig[hp * 4 + i] = sigmoidf_(a0c + acca[i]); o_g[hp * 4 + i] = accg[i]; o_vmix[hp * 4 + i] = sigmoidf_(v0c + accv[i]); }
        }
        __syncthreads();
#pragma unroll
        for (int i = 0; i < 8; ++i) { const int t = wv * 8 + i, tt = t0 + t;
            const float r = sR[t * 64 + lane], k = sK[t * 64 + lane]; float v = sV[t * 64 + lane];
            const float asig = o_asig[i];
            if (l == 0) VF[(size_t)tt * 256 + cc] = (bf16)f2bf(v);
            else { const float vf = bf2f(VF[(size_t)tt * 256 + cc]); v = v + (vf - v) * o_vmix[i]; }
            const float kkr = k * kkc; const float ss = wave_sum(kkr * kkr); const float kk = kkr * (1.0f / sqrtf(ss + 1e-24f));
            const float kmod = k * (1.0f + (asig - 1.0f) * kac);
            const float bon = wave_sum(r * kmod * rkc);
            sW[t * 64 + lane] = o_decay[i]; sA[t * 64 + lane] = -kk; sB[t * 64 + lane] = kk * asig; sG[t * 64 + lane] = o_g[i]; sK[t * 64 + lane] = kmod; sV[t * 64 + lane] = v;
            if (lane == 0) sS[t] = bon; }
        __syncthreads();
        if (wv == 0) {
            for (int t = 0; t < 64; ++t) {
                const float vt = sV[t * 64 + lane];
                const f32x4* a4 = (const f32x4*)(sA + t * 64); const f32x4* w4 = (const f32x4*)(sW + t * 64); const f32x4* b4 = (const f32x4*)(sB + t * 64);
                const f32x4* k4 = (const f32x4*)(sK + t * 64); const f32x4* r4 = (const f32x4*)(sR + t * 64);
                float s0 = 0.f, s1 = 0.f, s2 = 0.f, s3 = 0.f;
#pragma unroll
                for (int q = 0; q < 16; ++q) { const f32x4 a = a4[q]; s0 += S[4 * q] * a[0]; s1 += S[4 * q + 1] * a[1]; s2 += S[4 * q + 2] * a[2]; s3 += S[4 * q + 3] * a[3]; }
                const float sa = (s0 + s1) + (s2 + s3);
                float y0 = 0.f, y1 = 0.f, y2 = 0.f, y3 = 0.f;
#pragma unroll
                for (int q = 0; q < 16; ++q) { const f32x4 w = w4[q], b = b4[q], kq = k4[q], rq = r4[q];
#pragma unroll
                    for (int e = 0; e < 4; ++e) S[4 * q + e] = S[4 * q + e] * w[e] + sa * b[e] + vt * kq[e];
                    y0 += S[4 * q] * rq[0]; y1 += S[4 * q + 1] * rq[1]; y2 += S[4 * q + 2] * rq[2]; y3 += S[4 * q + 3] * rq[3]; }
                sY[t * 64 + lane] = (y0 + y1) + (y2 + y3);
            }
        }
        __syncthreads();
#pragma unroll
        for (int i = 0; i < 8; ++i) { const int t = wv * 8 + i, tt = t0 + t;
            const float y = sY[t * 64 + lane]; const float mean = wave_sum(y) * (1.0f / 64.0f); const float d = y - mean; const float var = wave_sum(d * d) * (1.0f / 64.0f);
            float yn = d * (1.0f / sqrtf(var + 64e-5f)) * lnw + lnb; yn += sS[t] * sV[t * 64 + lane];
            Y[(size_t)tt * 1024 + cc] = (bf16)f2bf(yn * sG[t * 64 + lane]); }
        __syncthreads();
    }
}

__device__ __forceinline__ void gdn_head_v1(const Params& P, int l, int h, float* lds, int tid) {
    const bf16* cols = (const bf16*)(P.ws + WS_COLS); bf16* Y = (bf16*)(P.ws + WS_Y);
    float* sQ = lds; float* sK = sQ + 4096; float* sV = sK + 4096; float* sO = sV + 4096; float* sBeta = sO + 4096; float* sAl = sBeta + 64;
    const float* cw = P.in[I_CONV] + (size_t)l * 4 * 768;
    const int lane = tid & 63, wv = tid >> 6;
    const float alog = P.in[I_ALOG][l * 4 + h], dtb = P.in[I_DTB][l * 4 + h], ng = P.in[I_GDNG][l * 64 + lane];
    float S[64];
#pragma unroll
    for (int k = 0; k < 64; ++k) S[k] = 0.f;
    for (int ci = 0; ci < T / 64; ++ci) {
        const int t0 = ci * 64;
#pragma unroll 1
        for (int idx = tid; idx < 3 * 4096; idx += NT) { const int a = idx >> 12, t = (idx >> 6) & 63, c = idx & 63, ch = a * 256 + h * 64 + c, tt = t0 + t; float acc = 0.f;
#pragma unroll
            for (int i = 0; i < 4; ++i) { const int ts = tt - 3 + i; if (ts >= 0) acc += cw[i * 768 + ch] * ldcol(cols, ts, C_GDN + ch); }
            (a == 0 ? sQ : (a == 1 ? sK : sV))[t * 64 + c] = siluf_(acc); }
        if (tid < 64) { const int tt = t0 + tid; const float braw = ldcol(cols, tt, C_GDN + 1024 + h), araw = ldcol(cols, tt, C_GDN + 1028 + h);
            sBeta[tid] = sigmoidf_(braw); sAl[tid] = __expf(-__expf(alog) * softplusf_(araw + dtb)); }
        __syncthreads();
#pragma unroll
        for (int i = 0; i < 8; ++i) { const int t = wv * 8 + i; const float q = sQ[t * 64 + lane], k = sK[t * 64 + lane];
            const float sq = wave_sum(q * q), sk = wave_sum(k * k);
            sQ[t * 64 + lane] = q * (1.0f / sqrtf(sq + 1e-6f)) * 0.125f; sK[t * 64 + lane] = k * (1.0f / sqrtf(sk + 1e-6f)); }
        __syncthreads();
        if (wv == 0) {
            for (int t = 0; t < 64; ++t) {
                const float vt = sV[t * 64 + lane], beta = sBeta[t], al = sAl[t];
                const f32x4* k4 = (const f32x4*)(sK + t * 64); const f32x4* q4 = (const f32x4*)(sQ + t * 64);
                float s0 = 0.f, s1 = 0.f, s2 = 0.f, s3 = 0.f;
#pragma unroll
                for (int q = 0; q < 16; ++q) { const f32x4 kq = k4[q]; s0 += S[4 * q] * kq[0]; s1 += S[4 * q + 1] * kq[1]; s2 += S[4 * q + 2] * kq[2]; s3 += S[4 * q + 3] * kq[3]; }
                const float kS = al * ((s0 + s1) + (s2 + s3)); const float vn = beta * (vt - kS);
                float y0 = 0.f, y1 = 0.f, y2 = 0.f, y3 = 0.f;
#pragma unroll
                for (int q = 0; q < 16; ++q) { const f32x4 kq = k4[q], qq = q4[q];
#pragma unroll
                    for (int e = 0; e < 4; ++e) S[4 * q + e] = al * S[4 * q + e] + kq[e] * vn;
                    y0 += S[4 * q] * qq[0]; y1 += S[4 * q + 1] * qq[1]; y2 += S[4 * q + 2] * qq[2]; y3 += S[4 * q + 3] * qq[3]; }
                sO[t * 64 + lane] = (y0 + y1) + (y2 + y3);
            }
        }
        __syncthreads();
#pragma unroll
        for (int i = 0; i < 8; ++i) { const int t = wv * 8 + i, tt = t0 + t; const float o = sO[t * 64 + lane]; const float ms = wave_sum(o * o) * (1.0f / 64.0f);
            const float z = ldcol(cols, tt, C_GDN + 768 + h * 64 + lane);
            Y[(size_t)tt * 1024 + 256 + h * 64 + lane] = (bf16)f2bf(o * (1.0f / sqrtf(ms + 1e-6f)) * ng * siluf_(z)); }
        __syncthreads();
    }
}

__device__ __forceinline__ void gla_head_v1(const Params& P, int l, int h, float* lds, int tid) {
    const bf16* cols = (const bf16*)(P.ws + WS_COLS); bf16* Y = (bf16*)(P.ws + WS_Y);
    float* sQ = lds; float* sK = sQ + 2048; float* sAl = sK + 2048; float* sV = sAl + 2048; float* sO = sV + 4096; float* sGd = sO + 4096;
    const float* gk_up = P.in[I_GKUP] + (size_t)l * 16 * 128; const float* gk_b = P.in[I_GKB] + l * 128;
    const int lane = tid & 63, wv = tid >> 6; const float ng = P.in[I_GLAG][l * 64 + lane];
    float S[32];
#pragma unroll
    for (int k = 0; k < 32; ++k) S[k] = 0.f;
    for (int ci = 0; ci < T / 64; ++ci) {
        const int t0 = ci * 64;
#pragma unroll 1
        for (int idx = tid; idx < 64 * 32; idx += NT) { const int t = idx >> 5, j = idx & 31; sQ[idx] = ldcol(cols, t0 + t, C_GLA + h * 32 + j) * 0.17677669529663687f; sK[idx] = ldcol(cols, t0 + t, C_GLA + 128 + h * 32 + j); }
#pragma unroll 1
        for (int idx = tid; idx < 64 * 64; idx += NT) { const int t = idx >> 6, c = idx & 63; sV[idx] = ldcol(cols, t0 + t, C_GLA + 256 + h * 64 + c); }
#pragma unroll 1
        for (int idx = tid; idx < 64 * 16; idx += NT) { const int t = idx >> 4, i = idx & 15; sGd[idx] = ldcol(cols, t0 + t, C_GLA + 768 + i); }
        __syncthreads();
#pragma unroll 1
        for (int idx = tid; idx < 64 * 32; idx += NT) { const int t = idx >> 5, j = idx & 31; float a = gk_b[h * 32 + j];
#pragma unroll
            for (int i = 0; i < 16; ++i) a += sGd[t * 16 + i] * gk_up[i * 128 + h * 32 + j];
            sAl[idx] = __expf(-softplusf_(-a) * (1.0f / 16.0f)); }
        __syncthreads();
        if (wv == 0) {
            for (int t = 0; t < 64; ++t) {
                const float vt = sV[t * 64 + lane];
                const f32x4* a4 = (const f32x4*)(sAl + t * 32); const f32x4* k4 = (const f32x4*)(sK + t * 32); const f32x4* q4 = (const f32x4*)(sQ + t * 32);
                float y0 = 0.f, y1 = 0.f, y2 = 0.f, y3 = 0.f;
#pragma unroll
                for (int q = 0; q < 8; ++q) { const f32x4 a = a4[q], kq = k4[q], qq = q4[q];
#pragma unroll
                    for (int e = 0; e < 4; ++e) S[4 * q + e] = a[e] * S[4 * q + e] + kq[e] * vt;
                    y0 += S[4 * q] * qq[0]; y1 += S[4 * q + 1] * qq[1]; y2 += S[4 * q + 2] * qq[2]; y3 += S[4 * q + 3] * qq[3]; }
                sO[t * 64 + lane] = (y0 + y1) + (y2 + y3);
            }
        }
        __syncthreads();
#pragma unroll
        for (int i = 0; i < 8; ++i) { const int t = wv * 8 + i, tt = t0 + t; const float o = sO[t * 64 + lane]; const float ms = wave_sum(o * o) * (1.0f / 64.0f);
            const float gt = ldcol(cols, tt, C_GLA + 512 + h * 64 + lane);
            Y[(size_t)tt * 1024 + 512 + h * 64 + lane] = (bf16)f2bf(o * (1.0f / sqrtf(ms + 1e-6f)) * ng * siluf_(gt)); }
        __syncthreads();
    }
}

__device__ __forceinline__ void sgu_unit_v1(const Params& P, int l, int n, float* lds, int tid) {
    const bf16* cols = (const bf16*)(P.ws + WS_COLS); bf16* Y = (bf16*)(P.ws + WS_Y);
    float* sVl = lds;
    const int lane = tid & 63, wv = tid >> 6, t0 = n * 128;
    const float* lg = P.in[I_SLG] + l * 256; const float* lb = P.in[I_SLB] + l * 256;
    const float* ws_ = P.in[I_SWS] + (size_t)l * 4 * 128 * 128; const float* bs_ = P.in[I_SBS] + l * 4 * 128;
    for (int i = 0; i < 16; ++i) { const int t = wv * 16 + i; float v[4]; float s = 0.f;
#pragma unroll
        for (int e = 0; e < 4; ++e) { v[e] = geluf_(ldcol(cols, t0 + t, C_SGU + 256 + lane * 4 + e)); s += v[e]; }
        const float mean = wave_sum(s) * (1.0f / 256.0f); float q = 0.f;
#pragma unroll
        for (int e = 0; e < 4; ++e) { v[e] -= mean; q += v[e] * v[e]; }
        const float rstd = 1.0f / sqrtf(wave_sum(q) * (1.0f / 256.0f) + 1e-5f);
#pragma unroll
        for (int e = 0; e < 4; ++e) sVl[t * 256 + lane * 4 + e] = v[e] * rstd * lg[lane * 4 + e] + lb[lane * 4 + e]; }
    __syncthreads();
    const int g = lane >> 4;
    for (int i = 0; i < 16; ++i) { const int t = wv + 8 * i; const float* wr = ws_ + ((size_t)g * 128 + t) * 128; f32x4 acc = {0.f, 0.f, 0.f, 0.f};
        for (int s = 0; s <= t; ++s) { const float w = wr[s]; const f32x4 vv = *(const f32x4*)(sVl + s * 256 + lane * 4); acc += vv * w; }
        const float b = bs_[g * 128 + t];
#pragma unroll
        for (int e = 0; e < 4; ++e) { const float u = geluf_(ldcol(cols, t0 + t, C_SGU + lane * 4 + e)); Y[(size_t)(t0 + t) * 1024 + 768 + lane * 4 + e] = (bf16)f2bf(u * (acc[e] + b)); } }
    __syncthreads();
}
#define LDS_SYNC() do { asm volatile("s_waitcnt lgkmcnt(0)" ::: "memory"); __builtin_amdgcn_s_barrier(); asm volatile("" ::: "memory"); } while (0)
typedef short bf16x8 __attribute__((ext_vector_type(8)));
typedef float f32x16 __attribute__((ext_vector_type(16)));
typedef unsigned u32x2 __attribute__((ext_vector_type(2)));
constexpr int TS = 72;
constexpr int TILE_B = 64 * TS * 2;
template <int KT> __device__ __forceinline__ void mm_tile(f32x16& acc, const LAS bf16* Arows, const LAS bf16* Bcols, int lane) {
    const int off = (lane & 31) * TS + (lane >> 5) * 8;
#pragma unroll
    for (int kk = 0; kk < KT; ++kk) {
        const bf16x8 a = *(const LAS bf16x8*)(Arows + off + kk * 16);
        const bf16x8 b = *(const LAS bf16x8*)(Bcols + off + kk * 16);
        acc = __builtin_amdgcn_mfma_f32_32x32x16_bf16(a, b, acc, 0, 0, 0);
    }
}
template <int KT> __device__ __forceinline__ void mm_tile_gb(f32x16& acc, const LAS bf16* Arows, int lda, const bf16* Bg, int ldb, int lane) {
    const int r = lane & 31, hh = lane >> 5;
#pragma unroll
    for (int kk = 0; kk < KT; ++kk) {
        const bf16x8 a = *(const LAS bf16x8*)(Arows + r * lda + hh * 8 + kk * 16);
        const bf16x8 b = *(const bf16x8*)(Bg + r * ldb + hh * 8 + kk * 16);
        acc = __builtin_amdgcn_mfma_f32_32x32x16_bf16(a, b, acc, 0, 0, 0);
    }
}
__device__ __forceinline__ int acc_i(int r, int hh) { return (r & 3) + 8 * (r >> 2) + 4 * hh; }
__device__ __forceinline__ void store_lane_major(LAS bf16* Z, int j0, int i0, const f32x16& acc, int lane) {
    const int c = lane & 31, hh = lane >> 5;
    LAS bf16* p = Z + (j0 + c) * TS + i0 + 4 * hh;
#pragma unroll
    for (int q = 0; q < 4; ++q) { uint2 w; w.x = pk2(acc[4 * q], acc[4 * q + 1]); w.y = pk2(acc[4 * q + 2], acc[4 * q + 3]); *(LAS u32x2*)(p + 8 * q) = (u32x2){w.x, w.y}; }
}
__device__ __forceinline__ void store_reg_major(LAS bf16* Z, int i0, int j0, const f32x16& acc, int lane) {
    const int c = lane & 31, hh = lane >> 5;
#pragma unroll
    for (int r = 0; r < 16; ++r) Z[(i0 + acc_i(r, hh)) * TS + j0 + c] = (bf16)f2bf(acc[r]);
}
__device__ __forceinline__ f32x16 zero16() { f32x16 z;
#pragma unroll
    for (int r = 0; r < 16; ++r) z[r] = 0.f; return z; }
__device__ __forceinline__ void gla_m1(const Params& P, int l, int ci, LAS unsigned char* lds, int tid) {
    const bf16* cols = (const bf16*)(P.ws + WS_COLS); bf16* Y = (bf16*)(P.ws + WS_Y);
    float* GKV = (float*)(P.ws + WS_GKV); float* GAL = (float*)(P.ws + WS_GAL); bf16* GQI = (bf16*)(P.ws + WS_GQI);
    LAS float* fLa = (LAS float*)lds; LAS float* fGd = fLa + 64 * 128; LAS unsigned char* tb0 = lds + 32768 + 4096;
    const float* gk_up = P.in[I_GKUP] + (size_t)l * 16 * 128; const float* gk_b = P.in[I_GKB] + l * 128;
    const int lane = tid & 63, wv = __builtin_amdgcn_readfirstlane(tid >> 6), t0 = ci * 64;
#pragma unroll
    for (int idx = tid; idx < 64 * 16; idx += NT) fGd[idx] = ldcol(cols, t0 + (idx >> 4), C_GLA + 768 + (idx & 15));
    LDS_SYNC();
#pragma unroll 4
    for (int idx = tid; idx < 64 * 128; idx += NT) { const int t = idx >> 7, j = idx & 127; float a = gk_b[j];
#pragma unroll
        for (int i = 0; i < 16; ++i) a += fGd[t * 16 + i] * gk_up[i * 128 + j];
        fLa[idx] = -softplusf_(-a) * (1.0f / 16.0f); }
    LDS_SYNC();
    if (tid < 128) { float run = 0.f;
#pragma unroll 8
        for (int t = 0; t < 64; ++t) { run += fLa[t * 128 + tid]; fLa[t * 128 + tid] = run; }
        GAL[ci * 128 + tid] = __expf(run); }
    LDS_SYNC();
#pragma unroll 1
    for (int hp = 0; hp < 2; ++hp) {
#pragma unroll 4
        for (int idx = tid; idx < 2 * 64 * 32; idx += NT) { const int s = idx >> 11, t = (idx >> 5) & 63, j = idx & 31, h = 2 * hp + s;
            LAS bf16* tQ = (LAS bf16*)(tb0 + s * 5 * TILE_B); LAS bf16* tK = tQ + 64 * TS; LAS bf16* tKs = tK + 64 * TS;
            const float b = fLa[t * 128 + h * 32 + j], b63 = fLa[63 * 128 + h * 32 + j];
            const float q = ldcol(cols, t0 + t, C_GLA + h * 32 + j) * 0.17677669529663687f, k = ldcol(cols, t0 + t, C_GLA + 128 + h * 32 + j);
            const bf16 qt = (bf16)f2bf(q * __expf(b));
            tQ[t * TS + j] = qt; tK[t * TS + j] = (bf16)f2bf(k * __expf(-b)); tKs[j * TS + t] = (bf16)f2bf(k * __expf(b63 - b));
            GQI[(((size_t)ci * 4 + h) * 64 + t) * 32 + j] = qt; }
#pragma unroll 8
        for (int idx = tid; idx < 2 * 64 * 64; idx += NT) { const int s = idx >> 12, t = (idx >> 6) & 63, v = idx & 63, h = 2 * hp + s;
            LAS bf16* tV = (LAS bf16*)(tb0 + s * 5 * TILE_B + 3 * TILE_B);
            tV[v * TS + t] = cols[(size_t)(t0 + t) * NPAD + C_GLA + 256 + h * 64 + v]; }
        LDS_SYNC();
        for (int jb = wv; jb < 12; jb += 8) { const int s = jb / 6, r = jb % 6, h = 2 * hp + s;
            LAS bf16* tQ = (LAS bf16*)(tb0 + s * 5 * TILE_B); LAS bf16* tK = tQ + 64 * TS; LAS bf16* tKs = tK + 64 * TS; LAS bf16* tV = tKs + 64 * TS; LAS bf16* tSc = tV + 64 * TS;
            f32x16 acc = zero16(); const int c = lane & 31, hh = lane >> 5;
            if (r < 4) { const int tb = (r == 0 || r == 3) ? 0 : 1, sb = (r == 0 || r == 1) ? 0 : 1;
                if (r < 3) { mm_tile<2>(acc, tK + sb * 32 * TS, tQ + tb * 32 * TS, lane);
#pragma unroll
                    for (int q = 0; q < 16; ++q) { const int sI = 32 * sb + acc_i(q, hh), tI = 32 * tb + c; if (sI > tI) acc[q] = 0.f; } }
                store_lane_major(tSc, 32 * tb, 32 * sb, acc, lane);
            } else { const int vb = r - 4; mm_tile<4>(acc, tKs, tV + vb * 32 * TS, lane);
                float* g = GKV + (((size_t)ci * 4 + h) * 32) * 64 + 32 * vb + c;
#pragma unroll
                for (int q = 0; q < 16; ++q) g[acc_i(q, hh) * 64] = acc[q]; }
        }
        LDS_SYNC();
        { const int s = wv >> 2, tb = (wv >> 1) & 1, vb = wv & 1, h = 2 * hp + s;
            LAS bf16* tV = (LAS bf16*)(tb0 + s * 5 * TILE_B + 3 * TILE_B); LAS bf16* tSc = tV + 64 * TS;
            f32x16 acc = zero16(); const int c = lane & 31, hh = lane >> 5;
            mm_tile<4>(acc, tSc + tb * 32 * TS, tV + vb * 32 * TS, lane);
            bf16* y = Y + (size_t)(t0 + 32 * tb) * 1024 + 512 + h * 64 + 32 * vb + c;
#pragma unroll
            for (int q = 0; q < 16; ++q) y[(size_t)acc_i(q, hh) * 1024] = (bf16)f2bf(acc[q]); }
        LDS_SYNC();
    }
}
__device__ __forceinline__ void gla_m2_A(const Params& P, int seg, int e) {
    const float* GKV = (const float*)(P.ws + WS_GKV); const float* GAL = (const float*)(P.ws + WS_GAL); float* GSB = (float*)(P.ws + WS_GSB); float* GSA = (float*)(P.ws + WS_GSA);
    const int hk = e >> 6; float kv[16], al[16];
#pragma unroll
    for (int u = 0; u < 16; ++u) { kv[u] = GKV[(size_t)(seg * 16 + u) * 8192 + e]; al[u] = GAL[(seg * 16 + u) * 128 + hk]; }
    float S = 0.f, A = 1.f;
#pragma unroll
    for (int u = 0; u < 16; ++u) { S = al[u] * S + kv[u]; A *= al[u]; }
    GSB[seg * 8192 + e] = S; if ((e & 63) == 0) GSA[seg * 128 + hk] = A;
}
__device__ __forceinline__ void gla_m2_B(const Params& P, int e) {
    float* GSB = (float*)(P.ws + WS_GSB); const float* GSA = (const float*)(P.ws + WS_GSA);
    const int hk = e >> 6; float b[16], a[16];
#pragma unroll
    for (int s = 0; s < 16; ++s) { b[s] = GSB[s * 8192 + e]; a[s] = GSA[s * 128 + hk]; }
    float S = 0.f;
#pragma unroll
    for (int s = 0; s < 16; ++s) { GSB[s * 8192 + e] = S; S = a[s] * S + b[s]; }
}
__device__ __forceinline__ void gla_m2_C(const Params& P, int seg, int e) {
    float* GKV = (float*)(P.ws + WS_GKV); const float* GAL = (const float*)(P.ws + WS_GAL); const float* GSB = (const float*)(P.ws + WS_GSB);
    const int hk = e >> 6; float kv[16], al[16];
#pragma unroll
    for (int u = 0; u < 16; ++u) { kv[u] = GKV[(size_t)(seg * 16 + u) * 8192 + e]; al[u] = GAL[(seg * 16 + u) * 128 + hk]; }
    float S = GSB[seg * 8192 + e];
#pragma unroll
    for (int u = 0; u < 16; ++u) { GKV[(size_t)(seg * 16 + u) * 8192 + e] = S; S = al[u] * S + kv[u]; }
}
__device__ __forceinline__ void gla_m3(const Params& P, int l, int ci, LAS unsigned char* lds, int tid, bool do_store = true) {
    const bf16* cols = (const bf16*)(P.ws + WS_COLS); bf16* Y = (bf16*)(P.ws + WS_Y);
    const float* GKV = (const float*)(P.ws + WS_GKV); const bf16* GQI = (const bf16*)(P.ws + WS_GQI);
    const float* ng = P.in[I_GLAG] + l * 64;
    const int lane = tid & 63, wv = __builtin_amdgcn_readfirstlane(tid >> 6), t0 = ci * 64;
#pragma unroll 8
    for (int idx = tid; idx < 4 * 32 * 64; idx += NT) { const int h = idx >> 11, k = (idx >> 6) & 31, v = idx & 63;
        ((LAS bf16*)(lds + h * TILE_B))[v * TS + k] = (bf16)f2bf(GKV[(size_t)ci * 8192 + idx]); }
    LDS_SYNC();
    const int h = wv >> 1, tb = wv & 1, c = lane & 31, hh = lane >> 5;
    const LAS bf16* tS = (const LAS bf16*)(lds + h * TILE_B);
    f32x16 acc[2]; acc[0] = zero16(); acc[1] = zero16();
    const bf16* qg = GQI + (((size_t)ci * 4 + h) * 64 + 32 * tb + c) * 32 + hh * 8;
#pragma unroll
    for (int kk = 0; kk < 2; ++kk) { const bf16x8 b = *(const bf16x8*)(qg + kk * 16);
#pragma unroll
        for (int vb = 0; vb < 2; ++vb) { const bf16x8 a = *(const LAS bf16x8*)(tS + (vb * 32 + c) * TS + hh * 8 + kk * 16);
            acc[vb] = __builtin_amdgcn_mfma_f32_32x32x16_bf16(a, b, acc[vb], 0, 0, 0); } }
    const size_t trow = (size_t)(t0 + 32 * tb + c);
    bf16* yrow = Y + trow * 1024 + 512 + h * 64; const bf16* grow = cols + trow * NPAD + C_GLA + 512 + h * 64;
    float ss = 0.f;
#pragma unroll
    for (int vb = 0; vb < 2; ++vb)
#pragma unroll
        for (int q = 0; q < 4; ++q) { const int v = 32 * vb + 8 * q + 4 * hh; const uint2 w = *(const uint2*)(yrow + v);
            acc[vb][4 * q] += bf2f((bf16)(w.x & 0xffff)); acc[vb][4 * q + 1] += bf2f((bf16)(w.x >> 16)); acc[vb][4 * q + 2] += bf2f((bf16)(w.y & 0xffff)); acc[vb][4 * q + 3] += bf2f((bf16)(w.y >> 16));
#pragma unroll
            for (int e = 0; e < 4; ++e) ss += acc[vb][4 * q + e] * acc[vb][4 * q + e]; }
    ss += __shfl_xor(ss, 32);
    const float rstd = rsqf_(ss * (1.0f / 64.0f) + 1e-6f);
#pragma unroll
    for (int vb = 0; vb < 2; ++vb)
#pragma unroll
        for (int q = 0; q < 4; ++q) { const int v = 32 * vb + 8 * q + 4 * hh; const uint2 gw = *(const uint2*)(grow + v); float o[4];
            const float g0 = bf2f((bf16)(gw.x & 0xffff)), g1 = bf2f((bf16)(gw.x >> 16)), g2 = bf2f((bf16)(gw.y & 0xffff)), g3 = bf2f((bf16)(gw.y >> 16));
            o[0] = acc[vb][4 * q] * rstd * ng[v] * siluf_(g0); o[1] = acc[vb][4 * q + 1] * rstd * ng[v + 1] * siluf_(g1);
            o[2] = acc[vb][4 * q + 2] * rstd * ng[v + 2] * siluf_(g2); o[3] = acc[vb][4 * q + 3] * rstd * ng[v + 3] * siluf_(g3);
            uint2 w; w.x = pk2(o[0], o[1]); w.y = pk2(o[2], o[3]); if (do_store) *(uint2*)(yrow + v) = w; }
    LDS_SYNC();
}
__device__ __forceinline__ void nm_square(const LAS bf16* Xr, const LAS bf16* Xc, LAS bf16* Xr_o, LAS bf16* Xc_o, int I, int J, int lane) {
    f32x16 acc = zero16();
    if (I == J) mm_tile<2>(acc, Xr + I * 32 * TS + 32 * I, Xc + J * 32 * TS + 32 * I, lane);
    else mm_tile<4>(acc, Xr + 32 * TS, Xc, lane);
    store_lane_major(Xc_o, 32 * J, 32 * I, acc, lane);
    store_reg_major(Xr_o, 32 * I, 32 * J, acc, lane);
}
__device__ __forceinline__ void nm_update(const LAS bf16* Tt, const LAS bf16* Xc, LAS bf16* Tt_o, int I, int J, int lane) {
    const int c = lane & 31, hh = lane >> 5; f32x16 acc;
#pragma unroll
    for (int q = 0; q < 4; ++q) { const u32x2 w = *(const LAS u32x2*)(Tt + (32 * I + c) * TS + 32 * J + 8 * q + 4 * hh);
        acc[4 * q] = bf2f((bf16)(w.x & 0xffff)); acc[4 * q + 1] = bf2f((bf16)(w.x >> 16)); acc[4 * q + 2] = bf2f((bf16)(w.y & 0xffff)); acc[4 * q + 3] = bf2f((bf16)(w.y >> 16)); }
    if (I == J) mm_tile<2>(acc, Xc + J * 32 * TS + 32 * I, Tt + I * 32 * TS + 32 * I, lane);
    else mm_tile<4>(acc, Xc, Tt + 32 * TS, lane);
    store_lane_major(Tt_o, 32 * I, 32 * J, acc, lane);
}
#define NM_TILE_IJ(w3, I_, J_) const int I_ = ((w3) == 0) ? 0 : 1, J_ = ((w3) == 2) ? 1 : 0
template <class Extra> __device__ __forceinline__ void neumann_solve(LAS bf16* const (&Xr)[2], LAS bf16* const (&Xc)[2], LAS bf16* const (&Tt)[2], int wv, int lane, const Extra& extra) {
    if (wv < 3) { NM_TILE_IJ(wv, I, J); nm_square(Xr[0], Xc[0], Xr[1], Xc[1], I, J, lane); }
    else if (wv >= 4) extra();
    LDS_SYNC();
#pragma unroll 1
    for (int k = 1; k <= 4; ++k) {
        const int xb = k & 1, tbuf = (k - 1) & 1;
        if (wv < 3) { NM_TILE_IJ(wv, I, J); nm_update(Tt[tbuf], Xc[xb], Tt[tbuf ^ 1], I, J, lane); }
        else if (wv < 6) { NM_TILE_IJ(wv - 3, I, J); nm_square(Xr[xb], Xc[xb], Xr[xb ^ 1], Xc[xb ^ 1], I, J, lane); }
        LDS_SYNC();
    }
    if (wv < 3) { NM_TILE_IJ(wv, I, J); nm_update(Tt[0], Xc[1], Tt[1], I, J, lane); }
    LDS_SYNC();
}
typedef float f32x4v __attribute__((ext_vector_type(4)));
constexpr int M2_D = 6;
constexpr int M2_SLOT = 2 * TILE_B + 256;
template <bool NMODE, bool STORE_EACH> __device__ __forceinline__ void dplr_chain(const bf16* XP, bf16* XQ, const float* XG, int pstride, int gstride, int nsteps, const bf16* initH, bf16* outF, float* outG, LAS unsigned char* lds, int tid) {
    const int lane = tid & 63, wv = __builtin_amdgcn_readfirstlane(tid >> 6);
    const int g = lane >> 4, n = lane & 15, v0 = wv * 16;
    const int q = tid - 256;
#define M2_BAR() do { asm volatile("s_waitcnt lgkmcnt(0)" ::: "memory"); __builtin_amdgcn_s_barrier(); asm volatile("" ::: "memory"); } while (0)
    if (wv >= 4) {
        v4u ring[M2_D][5];
#define M2_ISSUE(c, R) do { const int c_ = (c) < nsteps ? (c) : nsteps - 1; const v4u* Pp = (const v4u*)(XP + (size_t)c_ * pstride); \
        R[0] = Pp[q]; R[1] = Pp[q + 256]; if (!NMODE) { const v4u* Qp = (const v4u*)(XQ + (size_t)c_ * pstride); R[2] = Qp[q]; R[3] = Qp[q + 256]; } R[4] = ((const v4u*)(XG + (size_t)c_ * gstride))[q & 15]; } while (0)
#define M2_PUT(slot, R) do { LAS unsigned char* sp = lds + (slot) * M2_SLOT; \
        *(LAS v4u*)(sp + (q >> 3) * (TS * 2) + (q & 7) * 16) = R[0]; *(LAS v4u*)(sp + ((q >> 3) + 32) * (TS * 2) + (q & 7) * 16) = R[1]; \
        if (!NMODE) { *(LAS v4u*)(sp + TILE_B + (q >> 3) * (TS * 2) + (q & 7) * 16) = R[2]; *(LAS v4u*)(sp + TILE_B + ((q >> 3) + 32) * (TS * 2) + (q & 7) * 16) = R[3]; } \
        if (q < 16) *(LAS v4u*)(sp + 2 * TILE_B + q * 16) = R[4]; } while (0)
#pragma unroll
        for (int d = 0; d < M2_D; ++d) M2_ISSUE(d, ring[d]);
        M2_PUT(0, ring[0]);
        M2_ISSUE(M2_D, ring[0]);
        M2_BAR();
#pragma unroll 1
        for (int c0 = 0; c0 < nsteps; c0 += M2_D) {
#pragma unroll
            for (int u = 0; u < M2_D; ++u) {
                M2_PUT((u + 1) & 1, ring[(u + 1) % M2_D]);
                M2_ISSUE(c0 + u + 1 + M2_D, ring[(u + 1) % M2_D]);
                M2_BAR(); }
        }
#undef M2_ISSUE
#undef M2_PUT
    } else {
        f32x4v H[4], Gam[4];
#pragma unroll
        for (int m = 0; m < 4; ++m) { H[m] = (f32x4v){0.f, 0.f, 0.f, 0.f}; Gam[m] = (f32x4v){1.f, 1.f, 1.f, 1.f}; }
        if (!NMODE && initH) {
#pragma unroll
            for (int m = 0; m < 4; ++m) { const uint2 w = *(const uint2*)(initH + (v0 + n) * 64 + 16 * m + 4 * g);
                H[m][0] = bf2f((bf16)(w.x & 0xffff)); H[m][1] = bf2f((bf16)(w.x >> 16)); H[m][2] = bf2f((bf16)(w.y & 0xffff)); H[m][3] = bf2f((bf16)(w.y >> 16)); } }
        M2_BAR();
#pragma unroll 1
        for (int c0 = 0; c0 < nsteps; c0 += M2_D) {
#pragma unroll
            for (int u = 0; u < M2_D; ++u) { const int c = c0 + u;
                if (c < nsteps) { const LAS unsigned char* sp = lds + (u & 1) * M2_SLOT; bf16* Qg = XQ + (size_t)c * pstride;
                    bf16x8 bfr[2];
#pragma unroll
                    for (int s = 0; s < 2; ++s) { f32x4v b0 = H[2 * s], b1 = H[2 * s + 1];
                        if (NMODE) {
#pragma unroll
                            for (int i = 0; i < 4; ++i) { if (2 * s == wv && 4 * g + i == n) b0[i] += Gam[2 * s][i]; if (2 * s + 1 == wv && 4 * g + i == n) b1[i] += Gam[2 * s + 1][i]; } }
                        v4u w; w.x = pk2(b0[0], b0[1]); w.y = pk2(b0[2], b0[3]); w.z = pk2(b1[0], b1[1]); w.w = pk2(b1[2], b1[3]); bfr[s] = __builtin_bit_cast(bf16x8, w); }
#pragma unroll
                    for (int m = 0; m < 4; ++m) {
                        const f32x4v gm = *(const LAS f32x4v*)(sp + 2 * TILE_B + (16 * m + 4 * g) * 4); f32x4v a;
                        if (NMODE) { a = gm * H[m]; Gam[m] = Gam[m] * gm; }
                        else { const u32x2 qw = *(const LAS u32x2*)(sp + TILE_B + (v0 + n) * (TS * 2) + (16 * m + 4 * g) * 2);
                            if (STORE_EACH) { u32x2 hw; hw.x = pk2(H[m][0], H[m][1]); hw.y = pk2(H[m][2], H[m][3]); *(u32x2*)(Qg + (v0 + n) * 64 + 16 * m + 4 * g) = hw; }
                            a[0] = gm[0] * H[m][0] + bf2f((bf16)(qw.x & 0xffff)); a[1] = gm[1] * H[m][1] + bf2f((bf16)(qw.x >> 16)); a[2] = gm[2] * H[m][2] + bf2f((bf16)(qw.y & 0xffff)); a[3] = gm[3] * H[m][3] + bf2f((bf16)(qw.y >> 16)); }
#pragma unroll
                        for (int s = 0; s < 2; ++s) { const u32x2 p0 = *(const LAS u32x2*)(sp + (16 * m + n) * (TS * 2) + (32 * s + 4 * g) * 2); const u32x2 p1 = *(const LAS u32x2*)(sp + (16 * m + n) * (TS * 2) + (32 * s + 16 + 4 * g) * 2);
                            v4u w; w.x = p0.x; w.y = p0.y; w.z = p1.x; w.w = p1.y;
                            a = __builtin_amdgcn_mfma_f32_16x16x32_bf16(__builtin_bit_cast(bf16x8, w), bfr[s], a, 0, 0, 0); }
                        H[m] = a; } }
                M2_BAR(); }
        }
        if (outF) {
            if (NMODE) {
#pragma unroll
                for (int m = 0; m < 4; ++m)
#pragma unroll
                    for (int i = 0; i < 4; ++i) outF[(16 * m + 4 * g + i) * 64 + v0 + n] = (bf16)f2bf(H[m][i]);
                if (wv == 0 && n == 0) {
#pragma unroll
                    for (int m = 0; m < 4; ++m) *(f32x4v*)(outG + 16 * m + 4 * g) = Gam[m]; }
            } else {
#pragma unroll
                for (int m = 0; m < 4; ++m) { u32x2 hw; hw.x = pk2(H[m][0], H[m][1]); hw.y = pk2(H[m][2], H[m][3]); *(u32x2*)(outF + (v0 + n) * 64 + 16 * m + 4 * g) = hw; } }
        }
    }
#undef M2_BAR
}
__device__ __forceinline__ void dplr_m3_stage(const bf16* XQ, int ci, LAS unsigned char* lds, int tid) {
#pragma unroll
    for (int i = 0; i < 4; ++i) { const int idx = tid + NT * i, h = idx >> 9, v = (idx >> 3) & 63, c8 = idx & 7;
        *(LAS v4u*)(lds + h * TILE_B + v * (TS * 2) + c8 * 16) = *(const v4u*)(XQ + (size_t)ci * 16384 + (size_t)idx * 8); }
}
__device__ __forceinline__ void dplr_m3_core(f32x16 (&acc)[2], const LAS bf16* tHT, const bf16* XRch, int tb, int lane) {
    const int c = lane & 31, hh = lane >> 5;
    const bf16* rg = XRch + (32 * tb + c) * 64 + hh * 8;
    acc[0] = zero16(); acc[1] = zero16();
#pragma unroll
    for (int kk = 0; kk < 4; ++kk) { const bf16x8 b = *(const bf16x8*)(rg + kk * 16);
#pragma unroll
        for (int vb = 0; vb < 2; ++vb) { const bf16x8 a = *(const LAS bf16x8*)(tHT + (vb * 32 + c) * TS + hh * 8 + kk * 16);
            acc[vb] = __builtin_amdgcn_mfma_f32_32x32x16_bf16(a, b, acc[vb], 0, 0, 0); } }
}
__device__ __forceinline__ void rwkv_m1(const Params& P, int l, int ci, LAS unsigned char* lds, int tid) {
    const bf16* cols = (const bf16*)(P.ws + WS_COLS); bf16* Y = (bf16*)(P.ws + WS_Y); bf16* VF = (bf16*)(P.ws + WS_VF);
    bf16* XP = (bf16*)(P.ws + WS_RP); bf16* XQ = (bf16*)(P.ws + WS_RQ); bf16* XR = (bf16*)(P.ws + WS_RR); bf16* XBV = (bf16*)(P.ws + WS_RBV); float* XG = (float*)(P.ws + WS_XG);
    LAS bf16* tA = (LAS bf16*)lds; LAS bf16* tB = tA + 64 * TS; LAS bf16* tK = tB + 64 * TS; LAS bf16* tR = tK + 64 * TS; LAS bf16* tV = tR + 64 * TS;
    LAS bf16* tAab = tV + 64 * TS; LAS bf16* tAak = tAab + 64 * TS; LAS bf16* tArb = tAak + 64 * TS; LAS bf16* tArk = tArb + 64 * TS;
    LAS bf16* tAabT = tArk + 64 * TS; LAS bf16* tX1r = tAabT + 64 * TS; LAS bf16* tX1c = tX1r + 64 * TS; LAS bf16* tT0 = tX1c + 64 * TS; LAS bf16* tT1 = tT0 + 64 * TS; LAS bf16* tAV = tT1 + 64 * TS;
    LAS bf16* tW = tAab; LAS bf16* tU = tAak; LAS bf16* tT = tT1;
    LAS float* gC = (LAS float*)(lds + 5 * TILE_B + 77824 + 16384);
    LAS bf16* xW = (LAS bf16*)(lds + 5 * TILE_B); LAS bf16* xA = xW + 64 * 72; LAS bf16* xG = xA + 64 * 72; LAS bf16* xV = xG + 64 * 136; LAS bf16* Lw = xV + 64 * 40;
    LAS float* sLw = (LAS float*)(lds + 5 * TILE_B + 77824);
    const float* mu = P.in[I_MU] + l * 1024;
    {   int tid0 = tid, t0 = ci * 64; asm volatile("" : "+v"(tid0), "+s"(t0));
        const int lane = tid0 & 63, wv = __builtin_amdgcn_readfirstlane(tid0 >> 6);
        {
            const int c8 = tid0 & 31, tg = tid0 >> 5; v4u raw[5];
#pragma unroll
            for (int k = 0; k < 5; ++k) { const int tt = t0 + 4 * tg - 1 + k; raw[k] = *(const v4u*)(cols + (size_t)(tt < 0 ? 0 : tt) * NPAD + 768 + 8 * c8); if (tt < 0) raw[k] = (v4u){0u, 0u, 0u, 0u}; }
            const f32x4 m0 = *(const f32x4*)(mu + 768 + 8 * c8), m1 = *(const f32x4*)(mu + 768 + 8 * c8 + 4);
            const float mu8[8] = {m0[0], m0[1], m0[2], m0[3], m1[0], m1[1], m1[2], m1[3]};
#pragma unroll
            for (int k = 1; k < 5; ++k) { const int t = 4 * tg + k - 1; float o[8];
#pragma unroll
                for (int e = 0; e < 8; ++e) { const unsigned uc = (e < 2 ? raw[k].x : e < 4 ? raw[k].y : e < 6 ? raw[k].z : raw[k].w), up = (e < 2 ? raw[k - 1].x : e < 4 ? raw[k - 1].y : e < 6 ? raw[k - 1].z : raw[k - 1].w);
                    const float cur = bf2f((bf16)((e & 1) ? (uc >> 16) : (uc & 0xffff))), prv = bf2f((bf16)((e & 1) ? (up >> 16) : (up & 0xffff))); const float xs = cur + (prv - cur) * mu8[e];
                    o[e] = (c8 < 8) ? tanhf_(xs) : ((c8 < 16) ? xs : sigmoidf_(xs)); }
                v4u w; w.x = pk2(o[0], o[1]); w.y = pk2(o[2], o[3]); w.z = pk2(o[4], o[5]); w.w = pk2(o[6], o[7]);
                LAS bf16* dst = (c8 < 8) ? (xW + t * 72 + 8 * c8) : ((c8 < 16) ? (xA + t * 72 + 8 * (c8 - 8)) : (xG + t * 136 + 8 * (c8 - 16)));
                *(LAS v4u*)dst = w; }
            if (l > 0 && tid0 < 256) { const int t = tid0 >> 2, c4 = tid0 & 3; *(LAS v4u*)(xV + t * 40 + 8 * c4) = *(const v4u*)(cols + (size_t)(t0 + t) * NPAD + C_VRES + 8 * c4); }
        }
        LDS_SYNC();
        {
            const bf16* lw = (const bf16*)(P.ws + WS_LORA) + (size_t)l * LORA_LAYER; const int c = lane & 31, hh = lane >> 5;
#pragma unroll
            for (int u = 0; u < 8; ++u) { const int which = u >> 1; if (which == 3 && l == 0) continue;
                const int hd = 2 * (u & 1) + (wv >> 2), tb = (wv >> 1) & 1, cb = wv & 1, crow = hd * 64 + cb * 32; f32x16 acc = zero16();
                if (which == 0) mm_tile_gb<4>(acc, xW + tb * 32 * 72, 72, lw + LORA_W + crow * 64, 64, lane);
                else if (which == 1) mm_tile_gb<4>(acc, xA + tb * 32 * 72, 72, lw + LORA_A + crow * 64, 64, lane);
                else if (which == 2) mm_tile_gb<8>(acc, xG + tb * 32 * 136, 136, lw + LORA_G + crow * 128, 128, lane);
                else mm_tile_gb<2>(acc, xV + tb * 32 * 40, 40, lw + LORA_V + crow * 32, 32, lane);
                const size_t chd = (size_t)ci * 4 + hd;
                if (which == 2) { bf16* g = Y + (size_t)(t0 + 32 * tb) * 1024 + 768 + crow + c;
#pragma unroll
                    for (int q = 0; q < 16; ++q) g[(size_t)acc_i(q, hh) * 1024] = (bf16)f2bf(acc[q]); }
                else { bf16* g = (which == 0 ? XP : (which == 1 ? XQ : XR)) + chd * 4096 + (cb * 32 + c) * 64 + 32 * tb + 4 * hh;
#pragma unroll
                    for (int q = 0; q < 4; ++q) { uint2 w; w.x = pk2(acc[4 * q], acc[4 * q + 1]); w.y = pk2(acc[4 * q + 2], acc[4 * q + 3]); *(uint2*)(g + 8 * q) = w; } }
                if (u & 1) asm volatile("" ::: "memory"); }
        }
        __syncthreads();
    }
    v4u pf_w, pf_a, pf_v; unsigned pf_raw[3][5]; unsigned pf_vf[4];
#define RW_PREFETCH(hn) do { const int lane_ = tid & 63, wv_ = tid >> 6, cc_ = (hn) * 64 + lane_; const size_t ch_ = (size_t)ci * 4 + (hn); const int t0_ = ci * 64; \
        pf_w = *(const v4u*)(XP + ch_ * 4096 + lane_ * 64 + wv_ * 8); pf_a = *(const v4u*)(XQ + ch_ * 4096 + lane_ * 64 + wv_ * 8); pf_v = (l > 0) ? *(const v4u*)(XR + ch_ * 4096 + lane_ * 64 + wv_ * 8) : (v4u){0u, 0u, 0u, 0u}; \
        _Pragma("unroll") for (int a_ = 0; a_ < 3; ++a_) _Pragma("unroll") for (int j_ = 0; j_ < 5; ++j_) { const int t0r_ = t0_ + wv_ * 8 - 1 + 2 * j_, t1r_ = t0r_ + 1; \
            unsigned lo_ = cols[(size_t)(t0r_ < 0 ? 0 : t0r_) * NPAD + a_ * 256 + cc_]; if (t0r_ < 0) lo_ = 0u; const unsigned hi_ = (j_ < 4) ? (unsigned)cols[(size_t)t1r_ * NPAD + a_ * 256 + cc_] : 0u; pf_raw[a_][j_] = lo_ | (hi_ << 16); } \
        _Pragma("unroll") for (int j_ = 0; j_ < 4; ++j_) pf_vf[j_] = (l > 0) ? ((unsigned)VF[(size_t)(t0_ + wv_ * 8 + 2 * j_) * 256 + cc_] | ((unsigned)VF[(size_t)(t0_ + wv_ * 8 + 2 * j_ + 1) * 256 + cc_] << 16)) : 0u; } while (0)
#define PF_RAW(a, rr) bf2f((bf16)(((rr) & 1) ? (pf_raw[a][(rr) >> 1] >> 16) : (pf_raw[a][(rr) >> 1] & 0xffffu)))
#define PF_VF(i) bf2f((bf16)(((i) & 1) ? (pf_vf[(i) >> 1] >> 16) : (pf_vf[(i) >> 1] & 0xffffu)))
    RW_PREFETCH(0);
#pragma unroll 1
    for (int h = 0; h < 4; ++h) {
        int tidh = tid, t0 = ci * 64; asm volatile("" : "+v"(tidh), "+s"(t0));
        const int lane = tidh & 63, wv = __builtin_amdgcn_readfirstlane(tidh >> 6);
        const int cc = h * 64 + lane; const size_t ch = (size_t)ci * 4 + h;
        const float w0c = P.in[I_W0][l * 256 + cc], a0c = P.in[I_A0][l * 256 + cc], kkc = P.in[I_KK][l * 256 + cc], kac = P.in[I_KA][l * 256 + cc], rkc = P.in[I_RK][l * 256 + cc];
        const float v0c = (l > 0) ? P.in[I_V0][(l - 1) * 256 + cc] : 0.f;
        const float mu_r = mu[cc], mu_k = mu[256 + cc], mu_v = mu[512 + cc];
        float o_asig[8]; float e_r[8], e_k[8], e_v[8], e_kk[8];
#pragma unroll
        for (int i = 0; i < 8; ++i) { const int t = wv * 8 + i, tt = t0 + t;
            const unsigned uw = (i < 2 ? pf_w.x : i < 4 ? pf_w.y : i < 6 ? pf_w.z : pf_w.w), ua = (i < 2 ? pf_a.x : i < 4 ? pf_a.y : i < 6 ? pf_a.z : pf_a.w), uv = (i < 2 ? pf_v.x : i < 4 ? pf_v.y : i < 6 ? pf_v.z : pf_v.w);
            const float accw = bf2f((bf16)((i & 1) ? (uw >> 16) : (uw & 0xffff))), acca = bf2f((bf16)((i & 1) ? (ua >> 16) : (ua & 0xffff))), accv = bf2f((bf16)((i & 1) ? (uv >> 16) : (uv & 0xffff)));
            const float wlog = -softplusf_(-(w0c + accw)) - 0.5f; const float lwv = -__expf(wlog);
            const float asig = sigmoidf_(a0c + acca); o_asig[i] = asig;
            const float r0 = PF_RAW(0, i + 1), r1 = PF_RAW(0, i), k0 = PF_RAW(1, i + 1), k1 = PF_RAW(1, i), vv0 = PF_RAW(2, i + 1), vv1 = PF_RAW(2, i);
            const float r = r0 + (r1 - r0) * mu_r, k = k0 + (k1 - k0) * mu_k; float v = vv0 + (vv1 - vv0) * mu_v;
            if (l == 0) VF[(size_t)tt * 256 + cc] = (bf16)f2bf(v);
            else v = v + (PF_VF(i) - v) * sigmoidf_(v0c + accv);
            const float kkr = k * kkc; const float ss = wave_sum(kkr * kkr); const float kk = kkr * rsqf_(ss + 1e-24f);
            const float kmod = k * (1.0f + (asig - 1.0f) * kac);
            const float bon = wave_sum(r * kmod * rkc);
            XBV[(ch * 64 + t) * 64 + lane] = (bf16)f2bf(bon * v);
            sLw[t * 64 + lane] = lwv;
            e_r[i] = r; e_k[i] = kmod; e_v[i] = v; e_kk[i] = kk; }
        LDS_SYNC();
        if (tidh < 64) { float run = 0.f;
#pragma unroll 8
            for (int t = 0; t < 64; ++t) { run += sLw[t * 64 + tidh]; sLw[t * 64 + tidh] = run; }
            const float gam = __expf(run); gC[tidh] = gam; XG[ch * 64 + tidh] = gam; }
        LDS_SYNC();
        float at[8], bt[8], kt[8];
#pragma unroll
        for (int i = 0; i < 8; ++i) { const int t = wv * 8 + i; const float cum = sLw[t * 64 + lane], cumm = (t > 0) ? sLw[(t - 1) * 64 + lane] : 0.f;
            const float ep = __expf(cum), en = __expf(-cum), epm = __expf(cumm);
            at[i] = -e_kk[i] * epm; bt[i] = e_kk[i] * o_asig[i] * en; kt[i] = e_k[i] * en;
            tA[t * TS + lane] = (bf16)f2bf(at[i]); tB[t * TS + lane] = (bf16)f2bf(bt[i]); tK[t * TS + lane] = (bf16)f2bf(kt[i]); tR[t * TS + lane] = (bf16)f2bf(e_r[i] * ep); }
        { v4u w; w.x = pk2(e_v[0], e_v[1]); w.y = pk2(e_v[2], e_v[3]); w.z = pk2(e_v[4], e_v[5]); w.w = pk2(e_v[6], e_v[7]); *(LAS v4u*)(tV + lane * TS + wv * 8) = w; }
        LDS_SYNC();
        if (h < 3) RW_PREFETCH(h + 1);
        for (int jb = wv; jb < 16; jb += 8) { const int mat = jb >> 2, r = jb & 3; const int tb = (r == 0 || r == 3) ? 0 : 1, sb = (r == 0 || r == 1) ? 0 : 1;
            f32x16 acc = zero16(); const int c = lane & 31, hh = lane >> 5;
            if (r < 3) { mm_tile<4>(acc, ((mat & 1) ? tK : tB) + sb * 32 * TS, ((mat >> 1) ? tR : tA) + tb * 32 * TS, lane);
#pragma unroll
                for (int q = 0; q < 16; ++q) { const int sI = 32 * sb + acc_i(q, hh), tI = 32 * tb + c; if ((mat < 2) ? (sI >= tI) : (sI > tI)) acc[q] = 0.f; } }
            store_lane_major(tAab + mat * 64 * TS, 32 * tb, 32 * sb, acc, lane);
            if (mat == 0) {
                if (r == 3) store_lane_major(tT1, 0, 32, acc, lane);
                else { store_reg_major(tAabT, 32 * sb, 32 * tb, acc, lane);
#pragma unroll
                    for (int q = 0; q < 16; ++q) if (32 * sb + acc_i(q, hh) == 32 * tb + c) acc[q] += 1.0f;
                    store_lane_major(tT0, 32 * tb, 32 * sb, acc, lane); } }
        }
        LDS_SYNC();
        { v4u w; w.x = pk2(at[0], at[1]); w.y = pk2(at[2], at[3]); w.z = pk2(at[4], at[5]); w.w = pk2(at[6], at[7]); *(LAS v4u*)(tA + lane * TS + wv * 8) = w;
          w.x = pk2(bt[0], bt[1]); w.y = pk2(bt[2], bt[3]); w.z = pk2(bt[4], bt[5]); w.w = pk2(bt[6], bt[7]); *(LAS v4u*)(tB + lane * TS + wv * 8) = w;
          w.x = pk2(kt[0], kt[1]); w.y = pk2(kt[2], kt[3]); w.z = pk2(kt[4], kt[5]); w.w = pk2(kt[6], kt[7]); *(LAS v4u*)(tK + lane * TS + wv * 8) = w; }
        { LAS bf16* const Xr[2] = {tAab, tX1r}; LAS bf16* const Xc[2] = {tAabT, tX1c}; LAS bf16* const Tb[2] = {tT0, tT1};
          neumann_solve(Xr, Xc, Tb, wv, lane, [&]() { const int sb = (wv - 4) >> 1, vb = (wv - 4) & 1; f32x16 acc = zero16();
              mm_tile<4>(acc, tAak + sb * 32 * TS, tV + vb * 32 * TS, lane); store_lane_major(tAV, 32 * vb, 32 * sb, acc, lane); }); }
        { const int which = wv >> 2, tb = (wv >> 1) & 1, jb2 = wv & 1; f32x16 acc = zero16();
            mm_tile<4>(acc, tT + tb * 32 * TS, (which ? tAV : tA) + jb2 * 32 * TS, lane);
            store_lane_major(which ? tU : tW, 32 * jb2, 32 * tb, acc, lane); }
        LDS_SYNC();
        for (int jb = wv; jb < 16; jb += 8) { const int out = jb >> 2, ib = (jb >> 1) & 1, jb2 = jb & 1; f32x16 acc = zero16(); const int c = lane & 31, hh = lane >> 5;
            if (out == 0) mm_tile<4>(acc, tB + ib * 32 * TS, tW + jb2 * 32 * TS, lane);
            else if (out == 1) { mm_tile<4>(acc, tB + ib * 32 * TS, tU + jb2 * 32 * TS, lane); mm_tile<4>(acc, tK + ib * 32 * TS, tV + jb2 * 32 * TS, lane); }
            else if (out == 2) mm_tile<4>(acc, tArb + ib * 32 * TS, tW + jb2 * 32 * TS, lane);
            else { mm_tile<4>(acc, tArb + ib * 32 * TS, tU + jb2 * 32 * TS, lane); mm_tile<4>(acc, tArk + ib * 32 * TS, tV + jb2 * 32 * TS, lane); }
            if (out == 0) { bf16* g = XP + ch * 4096 + 32 * jb2 + c;
#pragma unroll
                for (int q = 0; q < 16; ++q) { const int row = 32 * ib + acc_i(q, hh); g[row * 64] = (bf16)f2bf(acc[q] * gC[row]); } }
            else if (out == 1) { bf16* g = XQ + ch * 4096 + (32 * jb2 + c) * 64 + 32 * ib + 4 * hh;
#pragma unroll
                for (int q = 0; q < 4; ++q) { const int row = 32 * ib + 8 * q + 4 * hh; uint2 w; w.x = pk2(acc[4 * q] * gC[row], acc[4 * q + 1] * gC[row + 1]); w.y = pk2(acc[4 * q + 2] * gC[row + 2], acc[4 * q + 3] * gC[row + 3]); *(uint2*)(g + 8 * q) = w; } }
            else if (out == 2) { bf16* g = XR + ch * 4096 + 32 * jb2 + c;
#pragma unroll
                for (int q = 0; q < 16; ++q) { const int row = 32 * ib + acc_i(q, hh); g[row * 64] = (bf16)f2bf(acc[q] + bf2f(tR[row * TS + 32 * jb2 + c])); } }
            else { bf16* g = Y + (size_t)t0 * 1024 + h * 64 + 32 * jb2 + c;
#pragma unroll
                for (int q = 0; q < 16; ++q) { const int row = 32 * ib + acc_i(q, hh); g[(size_t)row * 1024] = (bf16)f2bf(acc[q]); } }
        }
        LDS_SYNC();
    }
}
__device__ __forceinline__ void rwkv_m3(const Params& P, int l, int ci, LAS unsigned char* lds, int tid, bool do_store = true) {
    bf16* Y = (bf16*)(P.ws + WS_Y); const bf16* XQ = (const bf16*)(P.ws + WS_RQ); const bf16* XR = (const bf16*)(P.ws + WS_RR); const bf16* XBV = (const bf16*)(P.ws + WS_RBV);
    const int lane = tid & 63, wv = __builtin_amdgcn_readfirstlane(tid >> 6), t0 = ci * 64;
    dplr_m3_stage(XQ, ci, lds, tid);
    LDS_SYNC();
    const int h = wv >> 1, tb = wv & 1, c = lane & 31, hh = lane >> 5; const size_t ch = (size_t)ci * 4 + h;
    f32x16 acc[2];
    dplr_m3_core(acc, (const LAS bf16*)(lds + h * TILE_B), XR + ch * 4096, tb, lane);
    const size_t trow = (size_t)(t0 + 32 * tb + c);
    bf16* yrow = Y + trow * 1024 + h * 64; const bf16* grow = Y + trow * 1024 + 768 + h * 64; const bf16* bvrow = XBV + (ch * 64 + 32 * tb + c) * 64;
    const float* lnw = P.in[I_LNW] + l * 256 + h * 64; const float* lnb = P.in[I_LNB] + l * 256 + h * 64;
    float s = 0.f;
#pragma unroll
    for (int vb = 0; vb < 2; ++vb)
#pragma unroll
        for (int q = 0; q < 4; ++q) { const int v = 32 * vb + 8 * q + 4 * hh; const uint2 w = *(const uint2*)(yrow + v);
            acc[vb][4 * q] += bf2f((bf16)(w.x & 0xffff)); acc[vb][4 * q + 1] += bf2f((bf16)(w.x >> 16)); acc[vb][4 * q + 2] += bf2f((bf16)(w.y & 0xffff)); acc[vb][4 * q + 3] += bf2f((bf16)(w.y >> 16));
            s += (acc[vb][4 * q] + acc[vb][4 * q + 1]) + (acc[vb][4 * q + 2] + acc[vb][4 * q + 3]); }
    s += __shfl_xor(s, 32);
    const float mean = s * (1.0f / 64.0f); float qq = 0.f;
#pragma unroll
    for (int vb = 0; vb < 2; ++vb)
#pragma unroll
        for (int r = 0; r < 16; ++r) { acc[vb][r] -= mean; qq += acc[vb][r] * acc[vb][r]; }
    qq += __shfl_xor(qq, 32);
    const float rstd = rsqf_(qq * (1.0f / 64.0f) + 64e-5f);
#pragma unroll
    for (int vb = 0; vb < 2; ++vb)
#pragma unroll
        for (int q = 0; q < 4; ++q) { const int v = 32 * vb + 8 * q + 4 * hh; const uint2 gw = *(const uint2*)(grow + v); const uint2 bw = *(const uint2*)(bvrow + v); float o[4];
            const float g4[4] = {bf2f((bf16)(gw.x & 0xffff)), bf2f((bf16)(gw.x >> 16)), bf2f((bf16)(gw.y & 0xffff)), bf2f((bf16)(gw.y >> 16))};
            const float b4[4] = {bf2f((bf16)(bw.x & 0xffff)), bf2f((bf16)(bw.x >> 16)), bf2f((bf16)(bw.y & 0xffff)), bf2f((bf16)(bw.y >> 16))};
#pragma unroll
            for (int e = 0; e < 4; ++e) o[e] = (acc[vb][4 * q + e] * rstd * lnw[v + e] + lnb[v + e] + b4[e]) * g4[e];
            uint2 w; w.x = pk2(o[0], o[1]); w.y = pk2(o[2], o[3]); if (do_store) *(uint2*)(yrow + v) = w; }
    LDS_SYNC();
}
#ifndef REP_GA
#define REP_GA 1
#endif
#ifndef REP_GS
#define REP_GS 1
#endif
#ifndef REP_G4
#define REP_G4 1
#endif
__device__ __forceinline__ void gdn_m1(const Params& P, int l, int ci, LAS unsigned char* lds, int tid) {
    const bf16* cols = (const bf16*)(P.ws + WS_COLS); bf16* Y = (bf16*)(P.ws + WS_Y);
    bf16* XP = (bf16*)(P.ws + WS_DP); bf16* XQ = (bf16*)(P.ws + WS_DQ); bf16* XR = (bf16*)(P.ws + WS_DR); float* XG = (float*)(P.ws + WS_XG) + 1024 * 64;
    LAS bf16* tKn = (LAS bf16*)lds; LAS bf16* tQn = tKn + 64 * TS; LAS bf16* tBV = tQn + 64 * TS; LAS bf16* tBK = tBV + 64 * TS; LAS bf16* tKd = tBK + 64 * TS;
    LAS bf16* tAab = tKd + 64 * TS; LAS bf16* tAabT = tAab + 64 * TS; LAS bf16* tX1r = tAabT + 64 * TS; LAS bf16* tX1c = tX1r + 64 * TS; LAS bf16* tT0 = tX1c + 64 * TS; LAS bf16* tT1 = tT0 + 64 * TS; LAS bf16* tQk = tT1 + 64 * TS;
    LAS bf16* tW = tAab; LAS bf16* tU = tAabT; LAS bf16* tT = tT1;
    LAS float* sG = (LAS float*)(lds + 12 * TILE_B); LAS float* sGc = sG + 64; LAS float* sBe = sGc + 64;
    const float* cw = P.in[I_CONV] + (size_t)l * 4 * 768;
#pragma unroll 1
    for (int h = 0; h < 4; ++h) {
        int tidh = tid, t0 = ci * 64; asm volatile("" : "+v"(tidh), "+s"(t0));
        const int lane = tidh & 63, wv = __builtin_amdgcn_readfirstlane(tidh >> 6); const size_t ch = (size_t)ci * 4 + h;
        const float alog = P.in[I_ALOG][l * 4 + h], dtb = P.in[I_DTB][l * 4 + h];
        float e_q[8], e_k[8], e_v[8], e_be[8]; float gcs[8], gc63;
        {
            float raw[3][11], braw[8], araw[8], cwv[3][4];
#pragma unroll
            for (int a = 0; a < 3; ++a)
#pragma unroll
                for (int r = 0; r < 11; ++r) { const int ts = t0 + wv * 8 - 3 + r; const float v = ldcol(cols, ts < 0 ? 0 : ts, C_GDN + a * 256 + h * 64 + lane); raw[a][r] = (ts < 0) ? 0.f : v; }
#pragma unroll
            for (int i = 0; i < 8; ++i) { braw[i] = ldcol(cols, t0 + wv * 8 + i, C_GDN + 1024 + h); araw[i] = ldcol(cols, t0 + wv * 8 + i, C_GDN + 1028 + h); }
#pragma unroll
            for (int a = 0; a < 3; ++a)
#pragma unroll
                for (int i = 0; i < 4; ++i) cwv[a][i] = cw[i * 768 + a * 256 + h * 64 + lane];
            float gv[8];
#pragma unroll
            for (int i = 0; i < 8; ++i) { float o3[3];
#pragma unroll
                for (int a = 0; a < 3; ++a) o3[a] = siluf_(cwv[a][0] * raw[a][i] + cwv[a][1] * raw[a][i + 1] + cwv[a][2] * raw[a][i + 2] + cwv[a][3] * raw[a][i + 3]);
                const float sq = wave_sum(o3[0] * o3[0]), sk = wave_sum(o3[1] * o3[1]);
                e_q[i] = o3[0] * rsqf_(sq + 1e-6f) * 0.125f; e_k[i] = o3[1] * rsqf_(sk + 1e-6f); e_v[i] = o3[2];
                e_be[i] = sigmoidf_(braw[i]); gv[i] = -__expf(alog) * softplusf_(araw[i] + dtb); }
            float gsel = gv[0], bsel = e_be[0];
#pragma unroll
            for (int i = 1; i < 8; ++i) { gsel = (lane == i) ? gv[i] : gsel; bsel = (lane == i) ? e_be[i] : bsel; }
            if (lane < 8) { sG[wv * 8 + lane] = gsel; sBe[wv * 8 + lane] = bsel; }
        }
        LDS_SYNC();
        { const float gl = sG[lane]; float run = gl;
#pragma unroll
            for (int o = 1; o < 64; o <<= 1) { const float up = __shfl_up(run, o); if (lane >= o) run += up; }
            gc63 = __shfl(run, 63);
#pragma unroll
            for (int i = 0; i < 8; ++i) gcs[i] = __shfl(run, wv * 8 + i);
            if (wv == 0) { sGc[lane] = run; XG[ch * 64 + lane] = __expf(gc63); } }
        float bk[8], kd[8], bv[8];
#pragma unroll
        for (int i = 0; i < 8; ++i) { const int t = wv * 8 + i;
            tKn[t * TS + lane] = (bf16)f2bf(e_k[i]); tQn[t * TS + lane] = (bf16)f2bf(e_q[i]);
            bv[i] = e_be[i] * e_v[i]; bk[i] = e_be[i] * e_k[i] * __expf(gcs[i]); kd[i] = e_k[i] * __expf(gc63 - gcs[i]); }
        { v4u w; w.x = pk2(bv[0], bv[1]); w.y = pk2(bv[2], bv[3]); w.z = pk2(bv[4], bv[5]); w.w = pk2(bv[6], bv[7]); *(LAS v4u*)(tBV + lane * TS + wv * 8) = w;
          w.x = pk2(bk[0], bk[1]); w.y = pk2(bk[2], bk[3]); w.z = pk2(bk[4], bk[5]); w.w = pk2(bk[6], bk[7]); *(LAS v4u*)(tBK + lane * TS + wv * 8) = w;
          w.x = pk2(kd[0], kd[1]); w.y = pk2(kd[2], kd[3]); w.z = pk2(kd[4], kd[5]); w.w = pk2(kd[6], kd[7]); *(LAS v4u*)(tKd + lane * TS + wv * 8) = w; }
        LDS_SYNC();
        for (int rpd_ = 0; rpd_ < REP_GS; ++rpd_)
        { const int mat = wv >> 2, r = wv & 3; const int tb = (r == 0 || r == 3) ? 0 : 1, sb = (r == 0 || r == 1) ? 0 : 1;
            f32x16 acc = zero16(); const int c = lane & 31, hh = lane >> 5;
            if (r < 3) { mm_tile<4>(acc, tKn + sb * 32 * TS, (mat ? tQn : tKn) + tb * 32 * TS, lane);
                const int tI = 32 * tb + c; const float gct = sGc[tI], bet = sBe[tI];
#pragma unroll
                for (int q = 0; q < 16; ++q) { const int sI = 32 * sb + acc_i(q, hh);
                    if ((mat == 0) ? (sI >= tI) : (sI > tI)) acc[q] = 0.f;
                    else { const float dcy = __expf(gct - sGc[sI]); acc[q] = (mat == 0) ? (-bet * acc[q] * dcy) : (acc[q] * dcy); } } }
            if (mat == 0) { store_lane_major(tAab, 32 * tb, 32 * sb, acc, lane);
                if (r == 3) store_lane_major(tT1, 0, 32, acc, lane);
                else { store_reg_major(tAabT, 32 * sb, 32 * tb, acc, lane);
#pragma unroll
                    for (int q = 0; q < 16; ++q) if (32 * sb + acc_i(q, hh) == 32 * tb + c) acc[q] += 1.0f;
                    store_lane_major(tT0, 32 * tb, 32 * sb, acc, lane); } }
            else store_lane_major(tQk, 32 * tb, 32 * sb, acc, lane);
        }
        LDS_SYNC();
        { LAS bf16* const Xr[2] = {tAab, tX1r}; LAS bf16* const Xc[2] = {tAabT, tX1c}; LAS bf16* const Tb[2] = {tT0, tT1};
          neumann_solve(Xr, Xc, Tb, wv, lane, [&]() {}); }
        { const int which = wv >> 2, tb = (wv >> 1) & 1, jb2 = wv & 1; f32x16 acc = zero16();
            mm_tile<4>(acc, tT + tb * 32 * TS, (which ? tBV : tBK) + jb2 * 32 * TS, lane);
            store_lane_major(which ? tU : tW, 32 * jb2, 32 * tb, acc, lane); }
        LDS_SYNC();
        for (int rpg_ = 0; rpg_ < REP_G4; ++rpg_)
        for (int jb = wv; jb < 16; jb += 8) { const int out = jb >> 2, ib = (jb >> 1) & 1, jb2 = jb & 1; f32x16 acc = zero16(); const int c = lane & 31, hh = lane >> 5;
            if (out < 2) mm_tile<4>(acc, tKd + ib * 32 * TS, (out ? tU : tW) + jb2 * 32 * TS, lane);
            else mm_tile<4>(acc, tQk + ib * 32 * TS, (out == 3 ? tU : tW) + jb2 * 32 * TS, lane);
            if (out == 0) { bf16* g = XP + ch * 4096 + 32 * jb2 + c;
#pragma unroll
                for (int q = 0; q < 16; ++q) { const int row = 32 * ib + acc_i(q, hh); g[row * 64] = (bf16)f2bf(-acc[q]); } }
            else if (out == 1) { bf16* g = XQ + ch * 4096 + (32 * jb2 + c) * 64 + 32 * ib + 4 * hh;
#pragma unroll
                for (int q = 0; q < 4; ++q) { uint2 w; w.x = pk2(acc[4 * q], acc[4 * q + 1]); w.y = pk2(acc[4 * q + 2], acc[4 * q + 3]); *(uint2*)(g + 8 * q) = w; } }
            else if (out == 2) { bf16* g = XR + ch * 4096 + 32 * jb2 + c;
#pragma unroll
                for (int q = 0; q < 16; ++q) { const int row = 32 * ib + acc_i(q, hh); g[row * 64] = (bf16)f2bf(bf2f(tQn[row * TS + 32 * jb2 + c]) * __expf(sGc[row]) - acc[q]); } }
            else { bf16* g = Y + (size_t)t0 * 1024 + 256 + h * 64 + 32 * jb2 + c;
#pragma unroll
                for (int q = 0; q < 16; ++q) { const int row = 32 * ib + acc_i(q, hh); g[(size_t)row * 1024] = (bf16)f2bf(acc[q]); } }
        }
        LDS_SYNC();
    }
}
__device__ __forceinline__ void gdn_m3(const Params& P, int l, int ci, LAS unsigned char* lds, int tid, bool do_store = true) {
    const bf16* cols = (const bf16*)(P.ws + WS_COLS); bf16* Y = (bf16*)(P.ws + WS_Y); const bf16* XQ = (const bf16*)(P.ws + WS_DQ); const bf16* XR = (const bf16*)(P.ws + WS_DR);
    const float* ng = P.in[I_GDNG] + l * 64;
    const int lane = tid & 63, wv = __builtin_amdgcn_readfirstlane(tid >> 6), t0 = ci * 64;
    dplr_m3_stage(XQ, ci, lds, tid);
    LDS_SYNC();
    const int h = wv >> 1, tb = wv & 1, c = lane & 31, hh = lane >> 5; const size_t ch = (size_t)ci * 4 + h;
    f32x16 acc[2];
    dplr_m3_core(acc, (const LAS bf16*)(lds + h * TILE_B), XR + ch * 4096, tb, lane);
    const size_t trow = (size_t)(t0 + 32 * tb + c);
    bf16* yrow = Y + trow * 1024 + 256 + h * 64; const bf16* zrow = cols + trow * NPAD + C_GDN + 768 + h * 64;
    float ss = 0.f;
#pragma unroll
    for (int vb = 0; vb < 2; ++vb)
#pragma unroll
        for (int q = 0; q < 4; ++q) { const int v = 32 * vb + 8 * q + 4 * hh; const uint2 w = *(const uint2*)(yrow + v);
            acc[vb][4 * q] += bf2f((bf16)(w.x & 0xffff)); acc[vb][4 * q + 1] += bf2f((bf16)(w.x >> 16)); acc[vb][4 * q + 2] += bf2f((bf16)(w.y & 0xffff)); acc[vb][4 * q + 3] += bf2f((bf16)(w.y >> 16));
#pragma unroll
            for (int e = 0; e < 4; ++e) ss += acc[vb][4 * q + e] * acc[vb][4 * q + e]; }
    ss += __shfl_xor(ss, 32);
    const float rstd = rsqf_(ss * (1.0f / 64.0f) + 1e-6f);
#pragma unroll
    for (int vb = 0; vb < 2; ++vb)
#pragma unroll
        for (int q = 0; q < 4; ++q) { const int v = 32 * vb + 8 * q + 4 * hh; const uint2 zw = *(const uint2*)(zrow + v); float o[4];
            const float z4[4] = {bf2f((bf16)(zw.x & 0xffff)), bf2f((bf16)(zw.x >> 16)), bf2f((bf16)(zw.y & 0xffff)), bf2f((bf16)(zw.y >> 16))};
#pragma unroll
            for (int e = 0; e < 4; ++e) o[e] = acc[vb][4 * q + e] * rstd * ng[v + e] * siluf_(z4[e]);
            uint2 w; w.x = pk2(o[0], o[1]); w.y = pk2(o[2], o[3]); if (do_store) *(uint2*)(yrow + v) = w; }
    LDS_SYNC();
}
constexpr int SGS = 136;
__device__ __forceinline__ void sgu_m3(const Params& P, int l, int ci, LAS unsigned char* lds, int tid) {
    const bf16* cols = (const bf16*)(P.ws + WS_COLS); bf16* Y = (bf16*)(P.ws + WS_Y);
    LAS bf16* VlT = (LAS bf16*)lds;
    LAS bf16* Wt = VlT + 256 * SGS;
    const int lane = tid & 63, wv = __builtin_amdgcn_readfirstlane(tid >> 6), half = ci & 1, tbase = (ci >> 1) * 128, ntok = half ? 128 : 64;
    const float* lg = P.in[I_SLG] + l * 256; const float* lb = P.in[I_SLB] + l * 256;
    const float* ws_ = P.in[I_SWS] + (size_t)l * 4 * 128 * 128; const float* bs_ = P.in[I_SBS] + l * 4 * 128;
    { const f32x4 g4 = *(const f32x4*)(lg + lane * 4), b4 = *(const f32x4*)(lb + lane * 4);
#pragma unroll 1
      for (int tb8 = 0; tb8 < ntok / 8; tb8 += 8) { uint2 raw[8];
#pragma unroll
        for (int i = 0; i < 8; ++i) raw[i] = *(const uint2*)(cols + (size_t)(tbase + wv + 8 * (tb8 + i)) * NPAD + C_SGU + 256 + lane * 4);
#pragma unroll
        for (int i = 0; i < 8; ++i) { const int t = wv + 8 * (tb8 + i); float v[4]; float s = 0.f;
            v[0] = geluf_(bf2f((bf16)(raw[i].x & 0xffff))); v[1] = geluf_(bf2f((bf16)(raw[i].x >> 16))); v[2] = geluf_(bf2f((bf16)(raw[i].y & 0xffff))); v[3] = geluf_(bf2f((bf16)(raw[i].y >> 16)));
            s = (v[0] + v[1]) + (v[2] + v[3]);
            const float mean = wave_sum(s) * (1.0f / 256.0f); float q = 0.f;
#pragma unroll
            for (int e = 0; e < 4; ++e) { v[e] -= mean; q += v[e] * v[e]; }
            const float rstd = rsqf_(wave_sum(q) * (1.0f / 256.0f) + 1e-5f);
#pragma unroll
            for (int e = 0; e < 4; ++e) VlT[(lane * 4 + e) * SGS + t] = (bf16)f2bf(v[e] * rstd * g4[e] + b4[e]); } } }
    { const int n4 = ntok / 4;
#pragma unroll 4
      for (int idx = tid; idx < 4 * 64 * n4; idx += NT) { const int s4 = idx % n4, row = idx / n4, g = row >> 6, t = row & 63, ta = 64 * half + t;
        const f32x4 w = *(const f32x4*)(ws_ + ((size_t)g * 128 + ta) * 128 + 4 * s4);
        u32x2 o; o.x = pk2(4 * s4 <= ta ? w[0] : 0.f, 4 * s4 + 1 <= ta ? w[1] : 0.f); o.y = pk2(4 * s4 + 2 <= ta ? w[2] : 0.f, 4 * s4 + 3 <= ta ? w[3] : 0.f);
        *(LAS u32x2*)(Wt + (g * 64 + t) * SGS + 4 * s4) = o; } }
    LDS_SYNC();
#pragma unroll 1
    for (int jb = wv; jb < 16; jb += 8) { const int g = jb >> 2, tb = (jb >> 1) & 1, cb = jb & 1; const int c = lane & 31, hh = lane >> 5;
        const int KT = 4 * half + 2 * tb + 2;
        f32x16 acc = zero16();
        const LAS bf16* Ar = Wt + (g * 64 + tb * 32 + c) * SGS + hh * 8; const LAS bf16* Br = VlT + (g * 64 + cb * 32 + c) * SGS + hh * 8;
#pragma unroll 2
        for (int kk = 0; kk < KT; ++kk) acc = __builtin_amdgcn_mfma_f32_32x32x16_bf16(*(const LAS bf16x8*)(Ar + kk * 16), *(const LAS bf16x8*)(Br + kk * 16), acc, 0, 0, 0);
        const int ch = g * 64 + cb * 32 + c; float uu[16], bb[16];
#pragma unroll
        for (int q = 0; q < 16; ++q) { const int ta = 64 * half + 32 * tb + acc_i(q, hh); uu[q] = ldcol(cols, tbase + ta, C_SGU + ch); bb[q] = bs_[g * 128 + ta]; }
#pragma unroll
        for (int q = 0; q < 16; ++q) { const int ta = 64 * half + 32 * tb + acc_i(q, hh); Y[(size_t)(tbase + ta) * 1024 + 768 + ch] = (bf16)f2bf(geluf_(uu[q]) * (acc[q] + bb[q])); } }
    LDS_SYNC();
}
__device__ __forceinline__ void unpack4(const uint2 w, float (&o)[4]) { o[0] = bf2f((bf16)(w.x & 0xffff)); o[1] = bf2f((bf16)(w.x >> 16)); o[2] = bf2f((bf16)(w.y & 0xffff)); o[3] = bf2f((bf16)(w.y >> 16)); }
__device__ __forceinline__ void mix_m3(const Params& P, int l, int ci, LAS unsigned char* lds, int tid) {
    const bf16* cols = (const bf16*)(P.ws + WS_COLS); bf16* Y = (bf16*)(P.ws + WS_Y);
    const bf16* RQ = (const bf16*)(P.ws + WS_RQ); const bf16* RR = (const bf16*)(P.ws + WS_RR); const bf16* RBV = (const bf16*)(P.ws + WS_RBV);
    const bf16* DQ = (const bf16*)(P.ws + WS_DQ); const bf16* DR = (const bf16*)(P.ws + WS_DR);
    const float* GKV = (const float*)(P.ws + WS_GKV); const bf16* GQI = (const bf16*)(P.ws + WS_GQI);
    const int lane = tid & 63, wv = __builtin_amdgcn_readfirstlane(tid >> 6), t0 = ci * 64;
    const int h = wv >> 1, tb = wv & 1, c = lane & 31, hh = lane >> 5; const size_t ch = (size_t)ci * 4 + h;
    const size_t trow = (size_t)(t0 + 32 * tb + c);
    v4u st_r[4], st_d[4]; float st_g[16];
#pragma unroll
    for (int i = 0; i < 4; ++i) { st_r[i] = *(const v4u*)(RQ + (size_t)ci * 16384 + (size_t)(tid + NT * i) * 8); st_d[i] = *(const v4u*)(DQ + (size_t)ci * 16384 + (size_t)(tid + NT * i) * 8); }
#pragma unroll
    for (int i = 0; i < 16; ++i) st_g[i] = GKV[(size_t)ci * 8192 + tid + NT * i];
#pragma unroll
    for (int i = 0; i < 4; ++i) { const int idx = tid + NT * i, hq = idx >> 9, v = (idx >> 3) & 63, c8 = idx & 7;
        *(LAS v4u*)(lds + hq * TILE_B + v * (TS * 2) + c8 * 16) = st_r[i]; *(LAS v4u*)(lds + (4 + hq) * TILE_B + v * (TS * 2) + c8 * 16) = st_d[i]; }
#pragma unroll
    for (int i = 0; i < 16; ++i) { const int idx = tid + NT * i, hq = idx >> 11, k = (idx >> 6) & 31, v = idx & 63; ((LAS bf16*)(lds + (8 + hq) * TILE_B))[v * TS + k] = (bf16)f2bf(st_g[i]); }
    asm volatile("" ::: "memory");
    bf16x8 b_r[4], b_d[4], b_g[2];
#pragma unroll
    for (int kk = 0; kk < 4; ++kk) { b_r[kk] = *(const bf16x8*)(RR + ch * 4096 + (32 * tb + c) * 64 + hh * 8 + kk * 16); b_d[kk] = *(const bf16x8*)(DR + ch * 4096 + (32 * tb + c) * 64 + hh * 8 + kk * 16); }
#pragma unroll
    for (int kk = 0; kk < 2; ++kk) b_g[kk] = *(const bf16x8*)(GQI + (ch * 64 + 32 * tb + c) * 32 + hh * 8 + kk * 16);
    bf16* y_r = Y + trow * 1024 + h * 64; bf16* y_d = Y + trow * 1024 + 256 + h * 64; bf16* y_g = Y + trow * 1024 + 512 + h * 64;
    const bf16* g_r = Y + trow * 1024 + 768 + h * 64; const bf16* bv_r = RBV + (ch * 64 + 32 * tb + c) * 64;
    const bf16* z_d = cols + trow * NPAD + C_GDN + 768 + h * 64; const bf16* gt_g = cols + trow * NPAD + C_GLA + 512 + h * 64;
    uint2 e_y[8], e_g[8], e_b[8];
#pragma unroll
    for (int j = 0; j < 8; ++j) { const int v = 32 * (j >> 2) + 8 * (j & 3) + 4 * hh; e_y[j] = *(const uint2*)(y_r + v); e_g[j] = *(const uint2*)(g_r + v); e_b[j] = *(const uint2*)(bv_r + v); }
    uint2 d_y[8], d_z[8], g_y[8], g_t[8];
    LDS_SYNC();
    {   f32x16 acc[2]; acc[0] = zero16(); acc[1] = zero16(); const LAS bf16* tH = (const LAS bf16*)(lds + h * TILE_B);
#pragma unroll
        for (int kk = 0; kk < 4; ++kk)
#pragma unroll
            for (int vb = 0; vb < 2; ++vb) acc[vb] = __builtin_amdgcn_mfma_f32_32x32x16_bf16(*(const LAS bf16x8*)(tH + (vb * 32 + c) * TS + hh * 8 + kk * 16), b_r[kk], acc[vb], 0, 0, 0);
#pragma unroll
        for (int j = 0; j < 8; ++j) { const int v = 32 * (j >> 2) + 8 * (j & 3) + 4 * hh; d_y[j] = *(const uint2*)(y_d + v); d_z[j] = *(const uint2*)(z_d + v); }
        const float* lnw = P.in[I_LNW] + l * 256 + h * 64; const float* lnb = P.in[I_LNB] + l * 256 + h * 64;
        float s = 0.f;
#pragma unroll
        for (int j = 0; j < 8; ++j) { float o4[4]; unpack4(e_y[j], o4);
#pragma unroll
            for (int e = 0; e < 4; ++e) { acc[j >> 2][4 * (j & 3) + e] += o4[e]; s += acc[j >> 2][4 * (j & 3) + e]; } }
        s += __shfl_xor(s, 32);
        const float mean = s * (1.0f / 64.0f); float qq = 0.f;
#pragma unroll
        for (int vb = 0; vb < 2; ++vb)
#pragma unroll
            for (int r = 0; r < 16; ++r) { acc[vb][r] -= mean; qq += acc[vb][r] * acc[vb][r]; }
        qq += __shfl_xor(qq, 32);
        const float rstd = rsqf_(qq * (1.0f / 64.0f) + 64e-5f);
#pragma unroll
        for (int j = 0; j < 8; ++j) { const int v = 32 * (j >> 2) + 8 * (j & 3) + 4 * hh; float g4[4], b4[4], o[4]; unpack4(e_g[j], g4); unpack4(e_b[j], b4);
            const f32x4 w4 = *(const f32x4*)(lnw + v), bb4 = *(const f32x4*)(lnb + v);
#pragma unroll
            for (int e = 0; e < 4; ++e) o[e] = (acc[j >> 2][4 * (j & 3) + e] * rstd * w4[e] + bb4[e] + b4[e]) * g4[e];
            uint2 w; w.x = pk2(o[0], o[1]); w.y = pk2(o[2], o[3]); *(uint2*)(y_r + v) = w; if (j & 1) asm volatile("" ::: "memory"); }
    }
    asm volatile("" ::: "memory");
#pragma unroll
    for (int j = 0; j < 8; ++j) { const int v = 32 * (j >> 2) + 8 * (j & 3) + 4 * hh; g_y[j] = *(const uint2*)(y_g + v); g_t[j] = *(const uint2*)(gt_g + v); }
    {   f32x16 acc[2]; acc[0] = zero16(); acc[1] = zero16(); const LAS bf16* tH = (const LAS bf16*)(lds + (4 + h) * TILE_B);
#pragma unroll
        for (int kk = 0; kk < 4; ++kk)
#pragma unroll
            for (int vb = 0; vb < 2; ++vb) acc[vb] = __builtin_amdgcn_mfma_f32_32x32x16_bf16(*(const LAS bf16x8*)(tH + (vb * 32 + c) * TS + hh * 8 + kk * 16), b_d[kk], acc[vb], 0, 0, 0);
        const float* ng = P.in[I_GDNG] + l * 64; float ss = 0.f;
#pragma unroll
        for (int j = 0; j < 8; ++j) { float o4[4]; unpack4(d_y[j], o4);
#pragma unroll
            for (int e = 0; e < 4; ++e) { acc[j >> 2][4 * (j & 3) + e] += o4[e]; ss += acc[j >> 2][4 * (j & 3) + e] * acc[j >> 2][4 * (j & 3) + e]; } }
        ss += __shfl_xor(ss, 32);
        const float rstd = rsqf_(ss * (1.0f / 64.0f) + 1e-6f);
#pragma unroll
        for (int j = 0; j < 8; ++j) { const int v = 32 * (j >> 2) + 8 * (j & 3) + 4 * hh; float z4[4], o[4]; unpack4(d_z[j], z4); const f32x4 n4 = *(const f32x4*)(ng + v);
#pragma unroll
            for (int e = 0; e < 4; ++e) o[e] = acc[j >> 2][4 * (j & 3) + e] * rstd * n4[e] * siluf_(z4[e]);
            uint2 w; w.x = pk2(o[0], o[1]); w.y = pk2(o[2], o[3]); *(uint2*)(y_d + v) = w; if (j & 1) asm volatile("" ::: "memory"); }
    }
    {   f32x16 acc[2]; acc[0] = zero16(); acc[1] = zero16(); const LAS bf16* tS = (const LAS bf16*)(lds + (8 + h) * TILE_B);
#pragma unroll
        for (int kk = 0; kk < 2; ++kk)
#pragma unroll
            for (int vb = 0; vb < 2; ++vb) acc[vb] = __builtin_amdgcn_mfma_f32_32x32x16_bf16(*(const LAS bf16x8*)(tS + (vb * 32 + c) * TS + hh * 8 + kk * 16), b_g[kk], acc[vb], 0, 0, 0);
        const float* ng = P.in[I_GLAG] + l * 64; float ss = 0.f;
#pragma unroll
        for (int j = 0; j < 8; ++j) { float o4[4]; unpack4(g_y[j], o4);
#pragma unroll
            for (int e = 0; e < 4; ++e) { acc[j >> 2][4 * (j & 3) + e] += o4[e]; ss += acc[j >> 2][4 * (j & 3) + e] * acc[j >> 2][4 * (j & 3) + e]; } }
        ss += __shfl_xor(ss, 32);
        const float rstd = rsqf_(ss * (1.0f / 64.0f) + 1e-6f);
#pragma unroll
        for (int j = 0; j < 8; ++j) { const int v = 32 * (j >> 2) + 8 * (j & 3) + 4 * hh; float t4[4], o[4]; unpack4(g_t[j], t4); const f32x4 n4 = *(const f32x4*)(ng + v);
#pragma unroll
            for (int e = 0; e < 4; ++e) o[e] = acc[j >> 2][4 * (j & 3) + e] * rstd * n4[e] * siluf_(t4[e]);
            uint2 w; w.x = pk2(o[0], o[1]); w.y = pk2(o[2], o[3]); *(uint2*)(y_g + v) = w; if (j & 1) asm volatile("" ::: "memory"); }
    }
    LDS_SYNC();
}
#ifndef REP_P0
#define REP_P0 1
#endif
#ifndef REP_FN
#define REP_FN 1
#endif
#ifndef REP_G2
#define REP_G2 1
#endif
#ifndef REP_DN
#define REP_DN 1
#endif
#ifndef REP_M2
#define REP_M2 1
#endif
#ifndef REP_M3
#define REP_M3 1
#endif
#ifndef REP_RW
#define REP_RW 1
#endif
#ifndef REP_GD
#define REP_GD 1
#endif
#ifndef REP_M1
#define REP_M1 1
#endif
#ifndef REP_SGU
#define REP_SGU 1
#endif
#ifndef REP_G1
#define REP_G1 1
#endif
#ifndef REP_UP
#define REP_UP 1
#endif
#define GRID_SYNC() xcd_barrier(xbar)
__global__ void __launch_bounds__(NT, 2) fwd_kernel(Params P) {
    extern __shared__ __attribute__((aligned(16))) unsigned char lds_raw[];
    LAS unsigned char* ldsl = (LAS unsigned char*)lds_raw;
    const int G = gridDim.x;
    if (threadIdx.x < 16) ((LAS unsigned*)(ldsl + LDS_BYTES - 64))[threadIdx.x] = 0u;
    __syncthreads();
    const XcdBarrier xbar = xcd_barrier_post((unsigned*)(P.ws + WS_BAR), (volatile LAS unsigned*)(ldsl + LDS_BYTES - 64));
#define PHASE_TID() int tid = threadIdx.x; asm volatile("" : "+v"(tid)); const int lane = tid & 63, wave = __builtin_amdgcn_readfirstlane(tid >> 6); const int gw = blockIdx.x * NWAVES + wave, NGW = G * NWAVES; (void)lane; (void)gw; (void)NGW
    {
        PHASE_TID();
        for (int rep_ = 0; rep_ < REP_P0; ++rep_) {
        prologue_weights(P, 0, 1, (float*)lds_raw, gw, NGW, wave, lane);
        prologue_lora(P, blockIdx.x * NT + tid, G * NT);
        prologue_rows(P, gw, NGW, lane); }
    }
    GRID_SYNC();
#pragma unroll 1
    for (int l_ = 0; l_ < DEPTH; ++l_) {
        int l = l_; asm volatile("" : "+s"(l));
        bf16* XB = (bf16*)(P.ws + WS_XB); bf16* YB = (bf16*)(P.ws + WS_Y); bf16* HB = (bf16*)(P.ws + WS_H); bf16* COLS = (bf16*)(P.ws + WS_COLS); float* SSQ = (float*)(P.ws + WS_SSQ);
        const unsigned char* wb = P.ws + WS_W;
        {
            pg8::Gemm g{XB, (const bf16*)(wb + W_IN), T, NPAD, D}; pg8::StaticOrder S; S.init(T, NPAD, G, (int)blockIdx.x);
            pg8::EpiScaleBf16<0> E{COLS, NPAD, SSQ};
            for (int rep_ = 0; rep_ < REP_G1; ++rep_) pg8::gemm_phase<pg8::EpiScaleBf16<0>, pg8::StaticOrder, true, true>(ldsl, g, S, E);
        }
        GRID_SYNC();
        {
            PHASE_TID();
            for (int rep_ = 0; rep_ < REP_M1; ++rep_)
            for (int ci = blockIdx.x; ci < T / 64; ci += G) {
#ifndef NO_RWKV1
                for (int r2_ = 0; r2_ < REP_RW; ++r2_) rwkv_m1(P, l, ci, ldsl, tid);
#endif
#ifndef NO_GDN1
                for (int r2_ = 0; r2_ < REP_GD; ++r2_) gdn_m1(P, l, ci, ldsl, tid);
#endif
#ifndef NO_GLA1
                gla_m1(P, l, ci, ldsl, tid);
#endif
            }
        }
        GRID_SYNC();
        {
            PHASE_TID();
            const int b = blockIdx.x, seg = b >> 4, mh = (b >> 1) & 7, hh_ = mh & 3; const bool gdn = mh >= 4;
            const bf16* XP = (const bf16*)(P.ws + (gdn ? WS_DP : WS_RP)) + ((size_t)seg * 64 + hh_) * 4096; bf16* XQ = (bf16*)(P.ws + (gdn ? WS_DQ : WS_RQ)) + ((size_t)seg * 64 + hh_) * 4096;
            const float* XG = (const float*)(P.ws + WS_XG) + (gdn ? 1024 * 64 : 0) + ((size_t)seg * 64 + hh_) * 64;
            bf16* SN = (bf16*)(P.ws + WS_SN) + ((size_t)seg * 8 + mh) * 4096; bf16* SQ = (bf16*)(P.ws + WS_SQ) + ((size_t)seg * 8 + mh) * 4096; float* SG = (float*)(P.ws + WS_SG) + ((size_t)seg * 8 + mh) * 64;
            if (b & 1) dplr_chain<true, false>(XP, XQ, XG, 4 * 4096, 4 * 64, 16, nullptr, SN, SG, ldsl, tid);
            else dplr_chain<false, false>(XP, XQ, XG, 4 * 4096, 4 * 64, 16, nullptr, SQ, nullptr, ldsl, tid);
            gla_m2_A(P, b >> 4, (b & 15) * NT + tid);
        }
        GRID_SYNC();
        {
            PHASE_TID();
            const int b = blockIdx.x;
            if (b < 8) dplr_chain<false, true>((const bf16*)(P.ws + WS_SN) + (size_t)b * 4096, (bf16*)(P.ws + WS_SQ) + (size_t)b * 4096, (const float*)(P.ws + WS_SG) + b * 64, 8 * 4096, 8 * 64, 16, nullptr, nullptr, nullptr, ldsl, tid);
            else if (b < 24) gla_m2_B(P, (b - 8) * NT + tid);
            else prologue_weights(P, l, 12, (float*)lds_raw, (b - 24) * NWAVES + wave, (G - 24) * NWAVES, wave, lane);
        }
        GRID_SYNC();
        {
            PHASE_TID();
            const int b = blockIdx.x;
            if (b < 128) { const int seg = b >> 3, mh = b & 7, hh_ = mh & 3; const bool gdn = mh >= 4;
                const bf16* XP = (const bf16*)(P.ws + (gdn ? WS_DP : WS_RP)) + ((size_t)seg * 64 + hh_) * 4096; bf16* XQ = (bf16*)(P.ws + (gdn ? WS_DQ : WS_RQ)) + ((size_t)seg * 64 + hh_) * 4096;
                const float* XG = (const float*)(P.ws + WS_XG) + (gdn ? 1024 * 64 : 0) + ((size_t)seg * 64 + hh_) * 64;
                dplr_chain<false, true>(XP, XQ, XG, 4 * 4096, 4 * 64, 16, (const bf16*)(P.ws + WS_SQ) + ((size_t)seg * 8 + mh) * 4096, nullptr, nullptr, ldsl, tid); }
            else { const int gw2 = (b - 128) * NWAVES + wave, ngw2 = (G - 128) * NWAVES;
                prologue_weights(P, l, 2, (float*)lds_raw, gw2, ngw2, wave, lane);
                if (l == 0) prologue_weights(P, 1, 1, (float*)lds_raw, gw2, ngw2, wave, lane); }
            gla_m2_C(P, b >> 4, (b & 15) * NT + tid);
        }
        GRID_SYNC();
        {
            PHASE_TID();
            for (int ci = blockIdx.x; ci < T / 64; ci += G) {
#ifndef NO_M3
                mix_m3(P, l, ci, ldsl, tid);
                for (int rep_ = 0; rep_ < REP_SGU; ++rep_) sgu_m3(P, l, ci, ldsl, tid);
#endif
            }
        }
        GRID_SYNC();
        {
            pg8::Gemm g{YB, (const bf16*)(wb + W_OUT), T, D, D}; pg8::StaticOrder S; S.init(T, D, G, (int)blockIdx.x);
            for (int rep_ = REP_G2 - 1; rep_ >= 0; --rep_) { int dry = rep_; asm volatile("" : "+v"(dry));
            pg8::EpiResid E{l == 0 ? P.in[I_X] : (const float*)P.out, P.out, XB, SSQ, dry};
            pg8::gemm_phase<pg8::EpiResid, pg8::StaticOrder, true, true>(ldsl, g, S, E); }
        }
        GRID_SYNC();
        {
            pg8::Gemm g{XB, (const bf16*)(wb + W_UP), T, FF, D}; pg8::StaticOrder S; S.init(T, FF, G, (int)blockIdx.x);
            pg8::EpiScaleBf16<2> E{HB, FF, SSQ};
            for (int rep_ = 0; rep_ < REP_UP; ++rep_) pg8::gemm_phase<pg8::EpiScaleBf16<2>, pg8::StaticOrder, true, true>(ldsl, g, S, E);
        }
        GRID_SYNC();
        {
            pg8::Gemm g{HB, (const bf16*)(wb + W_DN), T, D, FF}; pg8::StaticOrder S; S.init(T, D, G, (int)blockIdx.x);
            for (int rep_ = REP_DN - 1; rep_ >= 0; --rep_) { int dry = rep_; asm volatile("" : "+v"(dry));
            pg8::EpiResid E{(const float*)P.out, P.out, XB, SSQ, dry};
            pg8::gemm_phase<pg8::EpiResid, pg8::StaticOrder, true, true>(ldsl, g, S, E); }
        }
        GRID_SYNC();
    }
    { PHASE_TID(); for (int rep_ = REP_FN - 1; rep_ >= 0; --rep_) { int dry = rep_; asm volatile("" : "+v"(dry)); final_norm(P, gw, NGW, lane, dry); } }
    if (P.ws == nullptr) cg::this_grid().sync();
}

extern "C" void kernel_launch(void* const* d_in, const int* in_sizes, int n_in, void* d_out, int out_size, void* d_ws, size_t ws_size, hipStream_t stream) {
    static int grid_blocks = 0;
    if (!grid_blocks) {
        int dev = 0, cus = 0, per_cu = 0;
        if (n_in != 33 || out_size != T * D || ws_size < WS_END) { fprintf(stderr, "kernel_launch: unexpected shapes n_in %d out %d ws %zu\n", n_in, out_size, ws_size); grid_blocks = -1; return; }
        (void)hipGetDevice(&dev);
        (void)hipDeviceGetAttribute(&cus, hipDeviceAttributeMultiprocessorCount, dev);
        (void)hipFuncSetAttribute((const void*)fwd_kernel, hipFuncAttributeMaxDynamicSharedMemorySize, LDS_BYTES);
        (void)hipOccupancyMaxActiveBlocksPerMultiprocessor(&per_cu, (const void*)fwd_kernel, NT, LDS_BYTES);
        if (per_cu < 1) fprintf(stderr, "kernel_launch: occupancy query says %d blocks/CU\n", per_cu);
        grid_blocks = cus;
        (void)hipGetLastError();
    }
    if (grid_blocks < 0) return;
    (void)hipMemsetAsync((char*)d_ws + WS_BAR, 0, 16384, stream);
    Params p{};
    for (int i = 0; i < 33; ++i) p.in[i] = (const float*)d_in[i];
    p.out = (float*)d_out; p.ws = (unsigned char*)d_ws;
    void* args[] = {&p};
    hipError_t e = hipLaunchCooperativeKernel((void*)fwd_kernel, dim3(grid_blocks), dim3(NT), args, LDS_BYTES, stream);
    if (e != hipSuccess) fprintf(stderr, "cooperative launch failed: %s (grid %d)\n", hipGetErrorString(e), grid_blocks);
}
```
